# Optimizing an MI355X kernel written in HIP

```python
import math
import jax
import jax.numpy as jnp
from jax import lax
import numpy as np

D_MODEL = 1024
BATCH = 4
SEQ = 4096
DEPTH = 2

EPS = 1e-6
HEAD_DIM = 64
A_Q_HEADS = 8
A_KV_HEADS = 2
A_GROUP = A_Q_HEADS // A_KV_HEADS
WINDOW = 128
N_BUCKETS = 32
MAX_DISTANCE = 128
B_HEADS = 8
B_DK = 64
B_DV = 64
B_CONV = 4
CHUNK = 64
A_Q_W = A_Q_HEADS * HEAD_DIM
A_KV_W = A_KV_HEADS * HEAD_DIM
B_QK_W = B_HEADS * B_DK
B_V_W = B_HEADS * B_DV
B_QKV_W = 2 * B_QK_W + B_V_W
AB_SIZES = (A_Q_W, A_KV_W, A_KV_W, B_QKV_W, B_V_W, B_HEADS, B_HEADS)
AB_IN = sum(AB_SIZES)
AB_OUT = A_Q_W + B_V_W
LRU_WIDTH = D_MODEL
LRU_BLOCKS = 8
LRU_BW = LRU_WIDTH // LRU_BLOCKS
LRU_CONV = 4
LRU_C = 8.0
SC_WIDTH = D_MODEL // 2
SC_CONV = 3
CD_SIZES = (LRU_WIDTH, LRU_WIDTH, SC_WIDTH, SC_WIDTH, SC_WIDTH)
CD_IN = sum(CD_SIZES)
CD_OUT = LRU_WIDTH + SC_WIDTH
D_FF = 2816
N_EXPERTS = 8
TOP_K = 2
D_FF_EXPERT = 3584
N_EVEN = (DEPTH + 1) // 2
N_ODD = DEPTH // 2

kernel_name = 'hybrid_swa_deltanet_rglru_shortconv_moe'


def split_cols(t, sizes):
    return jnp.split(t, [int(s) for s in np.cumsum(sizes)[:-1]], axis=-1)


def rmsnorm(x, w):
    xf = x.astype(jnp.float32)
    y = xf * lax.rsqrt(jnp.mean(xf * xf, axis=-1, keepdims=True) + EPS)
    return (y * w.astype(jnp.float32)).astype(x.dtype)


def l2norm(x):
    xf = x.astype(jnp.float32)
    return xf * lax.rsqrt(jnp.sum(xf * xf, axis=-1, keepdims=True) + EPS)


def causal_dwconv(x, w, b=None):
    K = w.shape[0]
    T = x.shape[1]
    xp = jnp.pad(x, ((0, 0), (K - 1, 0), (0, 0)))
    y = xp[:, 0:T] * w[0]
    for k in range(1, K):
        y = y + xp[:, k:k + T] * w[k]
    if b is not None:
        y = y + b
    return y


def t5_causal_bucket(dist):
    max_exact = N_BUCKETS // 2
    d = np.maximum(dist, 0)
    large = max_exact + (np.log(np.maximum(d, 1) / max_exact) / math.log(MAX_DISTANCE / max_exact)
                         * (N_BUCKETS - max_exact)).astype(np.int32)
    large = np.minimum(large, N_BUCKETS - 1)
    return np.where(d < max_exact, d, large).astype(np.int32)


def swa_sink_attention(q, k, v, sinks, rel_bias):
    Bsz, T = q.shape[0], q.shape[1]
    nb = T // WINDOW
    qb = q.reshape(Bsz, nb, WINDOW, A_KV_HEADS, A_GROUP, HEAD_DIM)

    def band(t):
        tb = t.reshape(Bsz, nb, WINDOW, A_KV_HEADS, HEAD_DIM)
        prev = jnp.pad(tb[:, :-1], ((0, 0), (1, 0), (0, 0), (0, 0), (0, 0)))
        return jnp.concatenate([prev, tb], axis=2)

    kb, vb = band(k), band(v)
    logits = jnp.einsum('bnqkgd,bnskd->bnkgqs', qb, kb,
                        preferred_element_type=jnp.float32) * (HEAD_DIM ** -0.5)
    qi = np.arange(WINDOW)[:, None]
    s = np.arange(2 * WINDOW)[None, :]
    dist = qi + WINDOW - s
    in_window = (dist >= 0) & (dist < WINDOW)
    bias = rel_bias[t5_causal_bucket(dist)].astype(jnp.float32)
    bias = jnp.transpose(bias, (2, 0, 1)).reshape(A_KV_HEADS, A_GROUP, WINDOW, 2 * WINDOW)
    key_valid = (np.arange(nb)[:, None] * WINDOW - WINDOW + s) >= 0
    mask = in_window[None] & key_valid[:, None, :]
    logits = jnp.where(mask[None, :, None, None], logits + bias, -jnp.inf)
    sink = sinks.astype(jnp.float32).reshape(A_KV_HEADS, A_GROUP)[None, None, :, :, None, None]
    m = jnp.maximum(jnp.max(logits, axis=-1, keepdims=True), sink)
    p = jnp.exp(logits - m)
    p = p / (jnp.sum(p, axis=-1, keepdims=True) + jnp.exp(sink - m))
    out = jnp.einsum('bnkgqs,bnskd->bnqkgd', p.astype(v.dtype), vb)
    return out.reshape(Bsz, T, A_Q_W)


def gated_delta_rule(q, k, v, g, beta):
    Bsz, T, H, dk = q.shape
    dv = v.shape[-1]
    n = T // CHUNK

    def chunks(t):
        t = t.astype(jnp.float32).reshape((Bsz, n, CHUNK, H) + t.shape[3:])
        return jnp.moveaxis(t, 3, 1)

    q, k, v, g, beta = chunks(q), chunks(k), chunks(v), chunks(g), chunks(beta)
    q = q * (dk ** -0.5)
    g = jnp.cumsum(g, axis=-1)
    causal = np.tril(np.ones((CHUNK, CHUNK), dtype=bool))
    strict = np.tril(np.ones((CHUNK, CHUNK), dtype=bool), -1)
    decay = jnp.exp(jnp.where(causal, g[..., :, None] - g[..., None, :], -jnp.inf))
    kk = jnp.einsum('bhncd,bhnsd->bhncs', k, k)
    L = jnp.where(strict, beta[..., None] * kk * decay, 0.0)
    eye = jnp.eye(CHUNK, dtype=jnp.float32)
    Tm = lax.linalg.triangular_solve(eye + L, jnp.broadcast_to(eye, L.shape),
                                     left_side=True, lower=True, unit_diagonal=True)
    u = Tm @ (v * beta[..., None])
    w = Tm @ (k * (beta * jnp.exp(g))[..., None])
    qk = jnp.where(causal, jnp.einsum('bhncd,bhnsd->bhncs', q, k) * decay, 0.0)
    g_last = g[..., -1:]
    k_dec = k * jnp.exp(g_last - g)[..., None]
    q_dec = q * jnp.exp(g)[..., None]

    def step(S, xs):
        q_i, k_i, u_i, w_i, qk_i, gl_i = xs
        v_new = u_i - jnp.einsum('bhcd,bhde->bhce', w_i, S)
        o = jnp.einsum('bhcd,bhde->bhce', q_i, S) + jnp.einsum('bhcs,bhse->bhce', qk_i, v_new)
        S = S * jnp.exp(gl_i)[..., None] + jnp.einsum('bhcd,bhce->bhde', k_i, v_new)
        return S, o

    xs = tuple(jnp.moveaxis(t, 2, 0) for t in (q_dec, k_dec, u, w, qk, g_last))
    S0 = jnp.zeros((Bsz, H, dk, dv), jnp.float32)
    _, o = lax.scan(step, S0, xs)
    return jnp.transpose(o, (1, 0, 3, 2, 4)).reshape(Bsz, T, H, dv)


def mixer_ab(h, w_in, sinks, conv_w, a_log, dt_bias, norm_w, w_out, rel_bias):
    Bsz, T, _ = h.shape
    qa, ka, va, qkv_b, gate_b, beta_b, a_b = split_cols(h @ w_in, AB_SIZES)
    attn = swa_sink_attention(qa.reshape(Bsz, T, A_Q_HEADS, HEAD_DIM),
                              ka.reshape(Bsz, T, A_KV_HEADS, HEAD_DIM),
                              va.reshape(Bsz, T, A_KV_HEADS, HEAD_DIM), sinks, rel_bias)
    qkv_b = jax.nn.silu(causal_dwconv(qkv_b, conv_w))
    qb, kb, vb = split_cols(qkv_b, (B_QK_W, B_QK_W, B_V_W))
    qb = l2norm(qb.reshape(Bsz, T, B_HEADS, B_DK))
    kb = l2norm(kb.reshape(Bsz, T, B_HEADS, B_DK))
    vb = vb.reshape(Bsz, T, B_HEADS, B_DV)
    beta = jax.nn.sigmoid(beta_b.astype(jnp.float32))
    g = -jnp.exp(a_log.astype(jnp.float32)) * jax.nn.softplus(a_b.astype(jnp.float32) + dt_bias.astype(jnp.float32))
    o = gated_delta_rule(qb, kb, vb, g, beta)
    o = rmsnorm(o, norm_w) * jax.nn.silu(gate_b.astype(jnp.float32).reshape(Bsz, T, B_HEADS, B_DV))
    o = o.reshape(Bsz, T, B_V_W).astype(h.dtype)
    return jnp.concatenate([attn, o], axis=-1) @ w_out


def lru_combine(left, right):
    a1, b1 = left
    a2, b2 = right
    return a1 * a2, a2 * b1 + b2


def mixer_cd(h, w_in, conv_w, conv_b, gate_a_w, gate_a_b, gate_x_w, gate_x_b, lam, sconv_w, w_out):
    Bsz, T, _ = h.shape
    xc, yc, bd, cd, hd = split_cols(h @ w_in, CD_SIZES)
    xc = causal_dwconv(xc, conv_w, conv_b)
    xblk = xc.reshape(Bsz, T, LRU_BLOCKS, LRU_BW)
    r = jax.nn.sigmoid((jnp.einsum('btni,nij->btnj', xblk, gate_a_w).reshape(Bsz, T, LRU_WIDTH)
                        + gate_a_b).astype(jnp.float32))
    i = jax.nn.sigmoid((jnp.einsum('btni,nij->btnj', xblk, gate_x_w).reshape(Bsz, T, LRU_WIDTH)
                        + gate_x_b).astype(jnp.float32))
    log_a = -LRU_C * r * jax.nn.softplus(-lam.astype(jnp.float32))
    a = jnp.exp(log_a)
    b = jnp.sqrt(-jnp.expm1(2.0 * log_a)) * (i * xc.astype(jnp.float32))
    _, hs = lax.associative_scan(lru_combine, (a, b), axis=1)
    yc_out = hs.astype(h.dtype) * jax.nn.gelu(yc)
    yd_out = bd * causal_dwconv(cd * hd, sconv_w)
    return jnp.concatenate([yc_out, yd_out], axis=-1) @ w_out


def swiglu(h, wg, wu, wd):
    return (jax.nn.silu(h @ wg) * (h @ wu)) @ wd


def moe_swiglu(h, router_w, router_b, wg, wu, wd):
    logits = (h @ router_w).astype(jnp.float32) + router_b.astype(jnp.float32)
    top_val, top_idx = lax.top_k(logits, TOP_K)
    top_w = jax.nn.softmax(top_val, axis=-1)
    gates = jnp.sum(jax.nn.one_hot(top_idx, N_EXPERTS, dtype=jnp.float32) * top_w[..., None], axis=-2)
    gates = gates.astype(h.dtype)
    out = jnp.zeros_like(h)
    for e in range(N_EXPERTS):
        out = out + gates[..., e:e + 1] * swiglu(h, wg[e], wu[e], wd[e])
    return out


def setup_inputs(seed: int = 0) -> dict:
    key = jax.random.key(seed)
    ks = jax.random.split(key, 33)
    D = D_MODEL

    def nrm(k, shape, scale):
        return jax.random.normal(k, shape, jnp.float32) * scale

    def gain(k, shape):
        return 1.0 + nrm(k, shape, 0.02)

    dt = jnp.exp(jax.random.uniform(ks[12], (N_EVEN, B_HEADS), jnp.float32, math.log(1e-3), math.log(1e-1)))
    u = jax.random.uniform(ks[25], (N_ODD, LRU_WIDTH), jnp.float32, 0.9, 0.999)
    p = u ** (1.0 / LRU_C)
    return {
        'x': nrm(ks[0], (BATCH, SEQ, D), 1.0),
        'c': nrm(ks[1], (BATCH, D), 1.0),
        'rel_bias': nrm(ks[2], (N_BUCKETS, A_Q_HEADS), 0.5),
        'ada_w': nrm(ks[3], (DEPTH, D, 6 * D), 0.5 * D ** -0.5),
        'ada_b': nrm(ks[4], (DEPTH, 6 * D), 0.02),
        'norm_mix_w': gain(ks[5], (DEPTH, D)),
        'norm_ffn_w': gain(ks[6], (DEPTH, D)),
        'final_norm_w': gain(ks[7], (D,)),
        'ab_w_in': nrm(ks[8], (N_EVEN, D, AB_IN), D ** -0.5),
        'attn_sinks': nrm(ks[9], (N_EVEN, A_Q_HEADS), 0.5),
        'dn_conv_w': nrm(ks[10], (N_EVEN, B_CONV, B_QKV_W), B_CONV ** -0.5),
        'dn_a_log': jnp.log(jax.random.uniform(ks[11], (N_EVEN, B_HEADS), jnp.float32, 1.0, 16.0)),
        'dn_dt_bias': dt + jnp.log(-jnp.expm1(-dt)),
        'dn_norm_w': gain(ks[13], (N_EVEN, B_DV)),
        'ab_w_out': nrm(ks[14], (N_EVEN, AB_OUT, D), AB_OUT ** -0.5),
        'ffn_w_gate': nrm(ks[15], (N_EVEN, D, D_FF), D ** -0.5),
        'ffn_w_up': nrm(ks[16], (N_EVEN, D, D_FF), D ** -0.5),
        'ffn_w_down': nrm(ks[17], (N_EVEN, D_FF, D), D_FF ** -0.5),
        'cd_w_in': nrm(ks[18], (N_ODD, D, CD_IN), D ** -0.5),
        'lru_conv_w': nrm(ks[19], (N_ODD, LRU_CONV, LRU_WIDTH), LRU_CONV ** -0.5),
        'lru_conv_b': nrm(ks[20], (N_ODD, LRU_WIDTH), 0.01),
        'lru_gate_a_w': nrm(ks[21], (N_ODD, LRU_BLOCKS, LRU_BW, LRU_BW), LRU_BW ** -0.5),
        'lru_gate_a_b': nrm(ks[22], (N_ODD, LRU_WIDTH), 0.01),
        'lru_gate_x_w': nrm(ks[23], (N_ODD, LRU_BLOCKS, LRU_BW, LRU_BW), LRU_BW ** -0.5),
        'lru_gate_x_b': nrm(ks[24], (N_ODD, LRU_WIDTH), 0.01),
        'lru_lambda': jnp.log(p) - jnp.log1p(-p),
        'sconv_w': nrm(ks[26], (N_ODD, SC_CONV, SC_WIDTH), SC_CONV ** -0.5),
        'cd_w_out': nrm(ks[27], (N_ODD, CD_OUT, D), CD_OUT ** -0.5),
        'moe_router_w': nrm(ks[28], (N_ODD, D, N_EXPERTS), D ** -0.5),
        'moe_router_b': nrm(ks[29], (N_ODD, N_EXPERTS), 0.01),
        'moe_w_gate': nrm(ks[30], (N_ODD, N_EXPERTS, D, D_FF_EXPERT), D ** -0.5),
        'moe_w_up': nrm(ks[31], (N_ODD, N_EXPERTS, D, D_FF_EXPERT), D ** -0.5),
        'moe_w_down': nrm(ks[32], (N_ODD, N_EXPERTS, D_FF_EXPERT, D), D_FF_EXPERT ** -0.5),
    }


def reference(x, c, rel_bias, ada_w, ada_b, norm_mix_w, norm_ffn_w, final_norm_w,
              ab_w_in, attn_sinks, dn_conv_w, dn_a_log, dn_dt_bias, dn_norm_w, ab_w_out,
              ffn_w_gate, ffn_w_up, ffn_w_down,
              cd_w_in, lru_conv_w, lru_conv_b, lru_gate_a_w, lru_gate_a_b, lru_gate_x_w, lru_gate_x_b,
              lru_lambda, sconv_w, cd_w_out, moe_router_w, moe_router_b, moe_w_gate, moe_w_up, moe_w_down):
    cond = jax.nn.silu(c)
    for l in range(DEPTH):
        sh1, sc1, g1, sh2, sc2, g2 = jnp.split(cond @ ada_w[l] + ada_b[l], 6, axis=-1)
        hn = rmsnorm(x, norm_mix_w[l]) * (1.0 + sc1[:, None]) + sh1[:, None]
        if l % 2 == 0:
            e = l // 2
            mix = mixer_ab(hn, ab_w_in[e], attn_sinks[e], dn_conv_w[e], dn_a_log[e], dn_dt_bias[e],
                           dn_norm_w[e], ab_w_out[e], rel_bias)
        else:
            o = l // 2
            mix = mixer_cd(hn, cd_w_in[o], lru_conv_w[o], lru_conv_b[o], lru_gate_a_w[o], lru_gate_a_b[o],
                           lru_gate_x_w[o], lru_gate_x_b[o], lru_lambda[o], sconv_w[o], cd_w_out[o])
        x = x + g1[:, None] * mix
        hn = rmsnorm(x, norm_ffn_w[l]) * (1.0 + sc2[:, None]) + sh2[:, None]
        if l % 2 == 0:
            e = l // 2
            ffn = swiglu(hn, ffn_w_gate[e], ffn_w_up[e], ffn_w_down[e])
        else:
            o = l // 2
            ffn = moe_swiglu(hn, moe_router_w[o], moe_router_b[o], moe_w_gate[o], moe_w_up[o], moe_w_down[o])
        x = x + g2[:, None] * ffn
    return rmsnorm(x, final_norm_w)
```

```cpp
#include <hip/hip_runtime.h>
#include <cstdio>
#include <cstdint>
namespace pg8 {
#define PG8_LAS __attribute__((address_space(3)))
typedef unsigned short bf16_t;
typedef short bf16x8 __attribute__((ext_vector_type(8)));
typedef float f32x4 __attribute__((ext_vector_type(4)));
typedef unsigned u32x4 __attribute__((ext_vector_type(4)));
constexpr int BM = 256, BK = 64, HALF = 128, HTB = HALF * BK * 2  , STAGE_BYTES = 8 * HTB, NXCD = 8, WGM = 8;

__host__ __device__ __forceinline__ int lds_byte(int r, int c) { const int st = (r >> 4) * 2 + (c >> 5), rr = r & 15, cc = c & 31, ob = rr * 64 + cc * 2; return st * 1024 + (ob ^ (((ob >> 9) & 1) << 5)); }
__host__ __device__ __forceinline__ void stage_rc(int b, int& R, int& C) { const int st = b / 1024, sb = b % 1024, swz = sb ^ (((sb >> 9) & 1) << 5); R = (st >> 1) * 16 + swz / 64; C = (st & 1) * 32 + (swz % 64) / 2; }
__host__ __device__ __forceinline__ int perm32(int rho) { const int n = rho >> 4, i = rho & 15; return 8 * (i >> 2) + 4 * n + (i & 3); }

struct Unit { int pm, pn, e; };
struct Gemm { const bf16_t* A; const bf16_t* Bt; int M, N, K; size_t eb; };

struct StaticOrder {
    int nM, nN, nwg, G, c;
    __host__ __device__ void init(int M, int N, int G_, int c_) { nM = M / BM; nN = N / BM; nwg = nM * nN; G = G_; c = c_; }
    __host__ __device__ bool next(int i, Unit& u) const {
        const long L = (long)i * G + c; if (L >= nwg) return false;
        int wgid = (int)L; { const int q = nwg / NXCD, r = nwg % NXCD, xcd = wgid % NXCD, off = wgid / NXCD; wgid = (xcd < r ? xcd * (q + 1) : r * (q + 1) + (xcd - r) * q) + off; }
        const int nig = WGM * nN, gid = wgid / nig, fm = gid * WGM, gsz = (nM - fm) < WGM ? (nM - fm) : WGM;
        u.pm = fm + ((wgid % nig) % gsz); u.pn = (wgid % nig) / gsz; u.e = 0; return true;
    }
    __device__ __forceinline__ void a_ready(const Unit&) const {}
    __device__ __forceinline__ void done(const Unit&) const {}
};

__device__ __forceinline__ unsigned cvt_pk_bf16(float lo, float hi) { unsigned r; asm volatile("v_cvt_pk_bf16_f32 %0, %1, %2" : "=v"(r) : "v"(lo), "v"(hi)); return r; }

__device__ __forceinline__ float fast_silu(float g) { return g * __builtin_amdgcn_rcpf(1.0f + __expf(-g)); }
struct EpiStoreBf16 {
    static constexpr bool PERM = true, AFTER_DRAIN = false;
    bf16_t* O; int ldc; const float* rowscale;
    __device__ __forceinline__ void operator()(const f32x4 (&acc)[2][2][4][2], const Unit& u, int wr, int wc, int fr, int fq) const {
        const int row0 = u.pm * BM + wr * 64 + fr, col0 = u.pn * BM + wc * 32 + 8 * fq;
#pragma unroll
        for (int ai = 0; ai < 2; ++ai)
#pragma unroll
            for (int m = 0; m < 4; ++m) { const int row = row0 + ai * HALF + m * 16; bf16_t* rowp = O + (size_t)row * ldc + col0;
                const float s = rowscale ? rowscale[row] : 1.f;
#pragma unroll
                for (int bj = 0; bj < 2; ++bj) { const f32x4 v0 = acc[ai][bj][m][0] * s, v1 = acc[ai][bj][m][1] * s;
                    u32x4 w; w.x = cvt_pk_bf16(v0[0], v0[1]); w.y = cvt_pk_bf16(v0[2], v0[3]); w.z = cvt_pk_bf16(v1[0], v1[1]); w.w = cvt_pk_bf16(v1[2], v1[3]);
                    *(u32x4*)(rowp + bj * HALF) = w; } }
    }
};
struct EpiSwiglu {
    static constexpr bool PERM = true, AFTER_DRAIN = false;
    bf16_t* O; int ldc;
    __device__ __forceinline__ void operator()(const f32x4 (&acc)[2][2][4][2], const Unit& u, int wr, int wc, int fr, int fq) const {
        const int row0 = u.pm * BM + wr * 64 + fr, col0 = u.pn * HALF + wc * 32 + 8 * fq;
#pragma unroll
        for (int ai = 0; ai < 2; ++ai)
#pragma unroll
            for (int m = 0; m < 4; ++m) { const int row = row0 + ai * HALF + m * 16; bf16_t* rowp = O + (size_t)row * ldc + col0;
                const f32x4 g0 = acc[ai][0][m][0], g1 = acc[ai][0][m][1], u0 = acc[ai][1][m][0], u1 = acc[ai][1][m][1];
                float h[8];
#pragma unroll
                for (int i = 0; i < 4; ++i) { h[i] = fast_silu(g0[i]) * u0[i]; h[4 + i] = fast_silu(g1[i]) * u1[i]; }
                u32x4 w; w.x = cvt_pk_bf16(h[0], h[1]); w.y = cvt_pk_bf16(h[2], h[3]); w.z = cvt_pk_bf16(h[4], h[5]); w.w = cvt_pk_bf16(h[6], h[7]);
                *(u32x4*)rowp = w; }
    }
};
struct EpiRes {
    static constexpr bool PERM = false, AFTER_DRAIN = false;
    const float* base; float* out; int ldc; const float* gate;
    __device__ __forceinline__ void operator()(const f32x4 (&acc)[2][2][4][2], const Unit& u, int wr, int wc, int fr, int fq) const {
        const int row0 = u.pm * BM + wr * 64 + fr, col0 = u.pn * BM + wc * 32 + 4 * fq;
        const float* gp = gate + (size_t)(u.pm >> 4) * 6144 + col0;
        f32x4 gv[2][2];
#pragma unroll
        for (int bj = 0; bj < 2; ++bj)
#pragma unroll
            for (int n = 0; n < 2; ++n) gv[bj][n] = *(const f32x4*)(gp + bj * HALF + n * 16);
#pragma unroll
        for (int ai = 0; ai < 2; ++ai)
#pragma unroll
            for (int m = 0; m < 4; ++m) { const size_t off = (size_t)(row0 + ai * HALF + m * 16) * ldc + col0;
#pragma unroll
                for (int bj = 0; bj < 2; ++bj)
#pragma unroll
                    for (int n = 0; n < 2; ++n) { const f32x4 bs = *(const f32x4*)(base + off + bj * HALF + n * 16);
                        *(f32x4*)(out + off + bj * HALF + n * 16) = bs + gv[bj][n] * acc[ai][bj][m][n]; } }
    }
};
struct GroupedOrder {
    int nM, nN, nwg, G, c; const int* tile_e;
    __device__ void init(int nMt, int N, int G_, int c_, const int* te) { nM = nMt; nN = N / BM; nwg = nM * nN; G = G_; c = c_; tile_e = te; }
    __device__ bool next(int i, Unit& u) const {
        const long L = (long)i * G + c; if (L >= nwg) return false;
        int wgid = (int)L; { const int q = nwg / NXCD, r = nwg % NXCD, xcd = wgid % NXCD, off = wgid / NXCD; wgid = (xcd < r ? xcd * (q + 1) : r * (q + 1) + (xcd - r) * q) + off; }
        const int nig = WGM * nN, gid = wgid / nig, fm = gid * WGM, gsz = (nM - fm) < WGM ? (nM - fm) : WGM;
        u.pm = fm + ((wgid % nig) % gsz); u.pn = (wgid % nig) / gsz; u.e = __builtin_amdgcn_readfirstlane(tile_e[u.pm]); return true;
    }
    __device__ __forceinline__ void a_ready(const Unit&) const {}
    __device__ __forceinline__ void done(const Unit&) const {}
};

template <class Epi, class Sched, bool ALIGN_EPI = false, bool SP2 = false>
__device__ __forceinline__ void gemm_phase(PG8_LAS unsigned char* lds, const Gemm g, const Sched& S, const Epi& E) {
    const int tid = threadIdx.x, wid = __builtin_amdgcn_readfirstlane(tid >> 6), lane = tid & 63, wr = wid >> 2, wc = wid & 3, fr = lane & 15, fq = lane >> 4;
    const int K = g.K, nt = K / BK;
    unsigned voffA[2], voffB[2];
#pragma unroll
    for (int i = 0; i < 2; ++i) { int R, C; stage_rc(tid * 16 + i * 8192, R, C); const int Rb = Epi::PERM ? ((R & ~31) + perm32(R & 31)) : R;
        voffA[i] = (unsigned)(R * K + C) * 2u; voffB[i] = (unsigned)(Rb * K + C) * 2u; }
    const size_t kstep = (size_t)(BK * 2);
    const size_t hstep = (size_t)HALF * K * 2;
    const size_t tstep = 2 * hstep;
    const unsigned ldsw = (unsigned)wid * 1024u;
    const int aoff = lds_byte(wr * 64 + fr, fq * 8), boff = lds_byte(wc * 32 + fr, fq * 8);
#define PG8_SA(b, h) (((b) * 2 + (h)) * HTB)
#define PG8_SB(b, h) ((4 + (b) * 2 + (h)) * HTB)
#define PG8_STAGE(bufoff, gbase, voff) do { _Pragma("unroll") for (int _i = 0; _i < 2; ++_i) \
        __builtin_amdgcn_global_load_lds((const unsigned*)((const char*)(gbase) + (voff)[_i]), (PG8_LAS unsigned*)(lds + (bufoff) + ldsw + _i * 8192), 16, 0, 0); } while (0)
#define PG8_LDA(dst, b, h) do { _Pragma("unroll") for (int m = 0; m < 4; ++m) _Pragma("unroll") for (int k = 0; k < 2; ++k) dst[m][k] = *(const PG8_LAS bf16x8*)(lds + PG8_SA(b, h) + aoff + m * 2048 + k * 1024); } while (0)
#define PG8_LDB(dst, b, h) do { _Pragma("unroll") for (int n = 0; n < 2; ++n) _Pragma("unroll") for (int k = 0; k < 2; ++k) dst[n][k] = *(const PG8_LAS bf16x8*)(lds + PG8_SB(b, h) + boff + n * 2048 + k * 1024); } while (0)
#define PG8_MMA(ai, bj, At, Bt) do { __builtin_amdgcn_s_setprio(1); _Pragma("unroll") for (int m = 0; m < 4; ++m) _Pragma("unroll") for (int n = 0; n < 2; ++n) _Pragma("unroll") for (int k = 0; k < 2; ++k) \
        acc[ai][bj][m][n] = __builtin_amdgcn_mfma_f32_16x16x32_bf16(Bt[n][k], At[m][k], acc[ai][bj][m][n], 0, 0, 0); __builtin_amdgcn_s_setprio(0); } while (0)
#define PG8_WAIT_V(n) asm volatile("s_waitcnt vmcnt(" #n ")" ::: "memory")
#define PG8_WAIT_L(n) asm volatile("s_waitcnt lgkmcnt(" #n ")" ::: "memory")
#define PG8_BAR __builtin_amdgcn_s_barrier()
#define PG8_SCHED __builtin_amdgcn_sched_barrier(0)
    Unit cur, nxt; int ui = 0;
    if (!S.next(0, cur)) return;
    f32x4 acc[2][2][4][2];
#pragma unroll
    for (int a = 0; a < 2; ++a)
#pragma unroll
        for (int b = 0; b < 2; ++b)
#pragma unroll
            for (int m = 0; m < 4; ++m)
#pragma unroll
                for (int n = 0; n < 2; ++n) acc[a][b][m][n] = (f32x4){0.f, 0.f, 0.f, 0.f};
    bf16x8 At[4][2], B0[2][2], B1[2][2];
    const char* cA = (const char*)g.A + (size_t)cur.pm * tstep; const char* cB = (const char*)g.Bt + (size_t)cur.e * g.eb + (size_t)cur.pn * tstep;
    S.a_ready(cur);
    if constexpr (SP2) {
        PG8_STAGE(PG8_SB(0, 0), cB, voffB); PG8_STAGE(PG8_SB(0, 1), cB + hstep, voffB); PG8_STAGE(PG8_SA(0, 0), cA, voffA); PG8_STAGE(PG8_SA(0, 1), cA + hstep, voffA);
        if (wr == 1) PG8_BAR;
        PG8_WAIT_V(2); PG8_BAR;
        PG8_STAGE(PG8_SB(1, 0), cB + kstep, voffB); PG8_STAGE(PG8_SA(1, 0), cA + kstep, voffA); PG8_STAGE(PG8_SB(1, 1), cB + hstep + kstep, voffB);
        PG8_WAIT_V(6); PG8_BAR;
    } else {
        PG8_STAGE(PG8_SB(0, 0), cB, voffB); PG8_STAGE(PG8_SA(0, 0), cA, voffA); PG8_STAGE(PG8_SB(0, 1), cB + hstep, voffB); PG8_STAGE(PG8_SA(0, 1), cA + hstep, voffA);
        if (wr == 1) PG8_BAR;
        PG8_WAIT_V(4); PG8_BAR;
        PG8_STAGE(PG8_SB(1, 0), cB + kstep, voffB); PG8_STAGE(PG8_SA(1, 0), cA + kstep, voffA); PG8_STAGE(PG8_SB(1, 1), cB + hstep + kstep, voffB);
        PG8_WAIT_V(6); PG8_BAR;
    }
    for (;;) {
        const bool has_next = S.next(ui + 1, nxt);
        const char* nA = has_next ? (const char*)g.A + (size_t)nxt.pm * tstep : cA; const char* nB = has_next ? (const char*)g.Bt + (size_t)nxt.e * g.eb + (size_t)nxt.pn * tstep : cB;
        for (int t = 0; t < nt; t += 2) {
            const bool last = (t == nt - 2);
            const char* a1 = cA + (size_t)(t + 1) * kstep;
            const char* a2 = last ? nA : cA + (size_t)(t + 2) * kstep; const char* b2 = last ? nB : cB + (size_t)(t + 2) * kstep;
            const char* a3 = a2 + kstep; const char* b3 = b2 + kstep;
            if (last && has_next) S.a_ready(nxt);
            if constexpr (SP2) {
            PG8_LDB(B0, 0, 0); PG8_LDB(B1, 0, 1); PG8_SCHED; PG8_LDA(At, 0, 0); PG8_STAGE(PG8_SA(1, 1), a1 + hstep, voffA);
            PG8_WAIT_V(8); PG8_WAIT_L(0); PG8_BAR; PG8_MMA(0, 0, At, B0); PG8_MMA(0, 1, At, B1); PG8_BAR; PG8_SCHED;
            PG8_LDA(At, 0, 1); PG8_STAGE(PG8_SB(0, 0), b2, voffB); PG8_STAGE(PG8_SB(0, 1), b2 + hstep, voffB); PG8_STAGE(PG8_SA(0, 0), a2, voffA);
            PG8_WAIT_V(8); PG8_WAIT_L(0); PG8_BAR; PG8_MMA(1, 0, At, B0); PG8_MMA(1, 1, At, B1); PG8_BAR; PG8_SCHED;
            PG8_LDB(B0, 1, 0); PG8_LDB(B1, 1, 1); PG8_SCHED; PG8_LDA(At, 1, 0); PG8_STAGE(PG8_SA(0, 1), a2 + hstep, voffA);
            PG8_WAIT_V(8); PG8_WAIT_L(0); PG8_BAR; PG8_MMA(0, 0, At, B0); PG8_MMA(0, 1, At, B1); PG8_BAR; PG8_SCHED;
            PG8_LDA(At, 1, 1); PG8_STAGE(PG8_SB(1, 0), b3, voffB); PG8_STAGE(PG8_SB(1, 1), b3 + hstep, voffB); PG8_STAGE(PG8_SA(1, 0), a3, voffA);
            PG8_WAIT_V(8); PG8_WAIT_L(0); PG8_BAR; PG8_MMA(1, 0, At, B0); PG8_MMA(1, 1, At, B1); PG8_BAR; PG8_SCHED;
            } else {
            PG8_LDB(B0, 0, 0); PG8_SCHED; PG8_LDA(At, 0, 0); PG8_STAGE(PG8_SA(1, 1), a1 + hstep, voffA);
            PG8_WAIT_L(8); PG8_BAR; PG8_WAIT_L(0); PG8_MMA(0, 0, At, B0); PG8_BAR; PG8_SCHED;
            PG8_LDB(B1, 0, 1); PG8_STAGE(PG8_SB(0, 0), b2, voffB);
            PG8_BAR; PG8_WAIT_L(0); PG8_MMA(0, 1, At, B1); PG8_BAR;
            PG8_LDA(At, 0, 1); PG8_STAGE(PG8_SA(0, 0), a2, voffA);
            PG8_BAR; PG8_WAIT_L(0); PG8_MMA(1, 0, At, B0); PG8_BAR; PG8_SCHED;
            PG8_STAGE(PG8_SB(0, 1), b2 + hstep, voffB);
            PG8_WAIT_V(6); PG8_BAR; PG8_MMA(1, 1, At, B1); PG8_BAR;
            PG8_LDB(B0, 1, 0); PG8_SCHED; PG8_LDA(At, 1, 0); PG8_STAGE(PG8_SA(0, 1), a2 + hstep, voffA);
            PG8_WAIT_L(8); PG8_BAR; PG8_WAIT_L(0); PG8_MMA(0, 0, At, B0); PG8_BAR; PG8_SCHED;
            PG8_LDB(B1, 1, 1); PG8_STAGE(PG8_SB(1, 0), b3, voffB);
            PG8_BAR; PG8_WAIT_L(0); PG8_MMA(0, 1, At, B1); PG8_BAR;
            PG8_LDA(At, 1, 1); PG8_STAGE(PG8_SA(1, 0), a3, voffA);
            PG8_BAR; PG8_WAIT_L(0); PG8_MMA(1, 0, At, B0); PG8_BAR; PG8_SCHED;
            PG8_STAGE(PG8_SB(1, 1), b3 + hstep, voffB);
            PG8_WAIT_V(6); PG8_BAR; PG8_MMA(1, 1, At, B1); PG8_BAR;
            }
        }
        if constexpr (ALIGN_EPI) { if (wr == 0) PG8_BAR; }
        if constexpr (!Epi::AFTER_DRAIN) { E(acc, cur, wr, wc, fr, fq); S.done(cur); }
        if (!has_next) break;
#pragma unroll
        for (int a = 0; a < 2; ++a)
#pragma unroll
            for (int b = 0; b < 2; ++b)
#pragma unroll
                for (int m = 0; m < 4; ++m)
#pragma unroll
                    for (int n = 0; n < 2; ++n) acc[a][b][m][n] = (f32x4){0.f, 0.f, 0.f, 0.f};
        cur = nxt; cA = nA; cB = nB; ++ui;
        if constexpr (ALIGN_EPI) { if (wr == 1) PG8_BAR; }
    }
    PG8_WAIT_V(0);
    if constexpr (!ALIGN_EPI) { if (wr == 0) PG8_BAR; }
    PG8_BAR;
    if constexpr (Epi::AFTER_DRAIN) { E.fused(acc, cur, wr, wc, fr, fq, lds, wid, lane); S.done(cur); }
#undef PG8_SA
#undef PG8_SB
#undef PG8_STAGE
#undef PG8_LDA
#undef PG8_LDB
#undef PG8_MMA
#undef PG8_WAIT_V
#undef PG8_WAIT_L
#undef PG8_BAR
#undef PG8_SCHED
}
}

constexpr int BATCH = 4, T = 4096, D = 1024, M = BATCH * T;
constexpr int NAB = 3072;
constexpr int FF = 2816, NCD = 3584, CDO = 1536, FFE = 3584, NE = 8;
constexpr int MPAD = 2 * M + NE * 256;
constexpr int MAXT = MPAD / 256;
constexpr int C_QA = 0, C_KA = 512, C_VA = 640, C_QKVB = 768, C_GATEB = 2304, C_BETA = 2816, C_AB = 2824;
constexpr int C_XC = 0, C_YC = 1024, C_BD = 2048, C_CD = 2560, C_HD = 3072;
constexpr size_t MiB = 1u << 20;
constexpr size_t WS_CTL = 0, CTL_ZERO_BYTES = 1 * MiB;
constexpr size_t WS_MOD = 1 * MiB;
constexpr size_t WS_ROUTE = 1 * MiB + 256 * 1024;
constexpr size_t WS_WAB_IN = 2 * MiB, WS_WAB_OUT = 8 * MiB, WS_WFFN_GU = 10 * MiB, WS_WFFN_D = 21 * MiB, WS_WCD_IN = 27 * MiB, WS_WCD_OUT = 34 * MiB, WS_WLRU = 37 * MiB;
constexpr size_t WS_WMOE_GU = 38 * MiB, WS_WMOE_D = 150 * MiB;
constexpr size_t WS_ACT = 206 * MiB;
constexpr size_t WS_END = 512 * MiB;
constexpr size_t A_A = 0, A_P = 32 * MiB, A_MIXA = 128 * MiB, A_DNQ = 160 * MiB, A_DNK = 192 * MiB, A_DNV = 224 * MiB, A_DNB = 256 * MiB, A_DNG = 257 * MiB;
constexpr size_t A_H = 160 * MiB;
constexpr size_t A_MIXB = 144 * MiB, A_XC = 192 * MiB;
constexpr size_t A_A3P = 0, A_HM = 68 * MiB, A_Y = 0;
constexpr size_t WS_A3 = 2 * MiB;
constexpr size_t WS_LA = 38 * MiB, WS_LB = 102 * MiB;
constexpr size_t R_IDX = 0, R_W = 128 * 1024, R_SLOT = 256 * 1024, R_GATEW = 384 * 1024, R_TILEE = 528 * 1024, R_OFF = 532 * 1024;
constexpr int CW_CNT = 1024, CW_CUR = 1024 + 64;

typedef unsigned short bf16;
typedef float f32x4 __attribute__((ext_vector_type(4)));
typedef unsigned v4u __attribute__((ext_vector_type(4)));
typedef unsigned v2u __attribute__((ext_vector_type(2)));
__device__ __forceinline__ unsigned f2bf(float f) { unsigned u = __builtin_bit_cast(unsigned, f); return (u + 0x7fffu + ((u >> 16) & 1u)) >> 16; }
__device__ __forceinline__ unsigned pk2(float lo, float hi) { return f2bf(lo) | (f2bf(hi) << 16); }
__device__ __forceinline__ float bf2f(unsigned short b) { return __builtin_bit_cast(float, (unsigned)b << 16); }
__device__ __forceinline__ float bflo(unsigned w) { return __builtin_bit_cast(float, w << 16); }
__device__ __forceinline__ float bfhi(unsigned w) { return __builtin_bit_cast(float, w & 0xffff0000u); }
__device__ __forceinline__ float wave_sum(float v) {
#pragma unroll
    for (int o = 1; o < 64; o <<= 1) v += __shfl_xor(v, o);
    return v;
}
__device__ __forceinline__ float sigmoidf_(float x) { return 1.0f / (1.0f + __expf(-x)); }
__device__ __forceinline__ float siluf_(float x) { return x / (1.0f + __expf(-x)); }
__device__ __forceinline__ float softplusf_(float x) { return fmaxf(x, 0.f) + log1pf(__expf(-fabsf(x))); }
__device__ __forceinline__ float gelu_tanhf_(float x) { const float u = 0.7978845608028654f * (x + 0.044715f * x * x * x); return 0.5f * x * (1.0f + tanhf(u)); }

__device__ const unsigned char T5_BUCKET[128] = {0, 1, 2, 3, 4, 5, 6, 7, 8, 9, 10, 11, 12, 13, 14, 15, 16, 16, 16, 17, 17, 18, 18, 18, 19, 19, 19, 20, 20, 20, 20, 21, 21, 21, 21, 22, 22, 22, 22, 22, 23, 23, 23, 23, 23, 23, 24, 24, 24, 24, 24, 24, 25, 25, 25, 25, 25, 25, 25, 26, 26, 26, 26, 26, 26, 26, 26, 27, 27, 27, 27, 27, 27, 27, 27, 27, 27, 28, 28, 28, 28, 28, 28, 28, 28, 28, 28, 29, 29, 29, 29, 29, 29, 29, 29, 29, 29, 29, 29, 30, 30, 30, 30, 30, 30, 30, 30, 30, 30, 30, 30, 30, 30, 31, 31, 31, 31, 31, 31, 31, 31, 31, 31, 31, 31, 31, 31, 31};

struct Params { const float* in[33]; float* out; unsigned char* ws; };
enum { I_X = 0, I_C, I_RELB, I_ADAW, I_ADAB, I_NMIX, I_NFFN, I_NFIN, I_ABIN, I_SINK, I_DNCONV, I_ALOG, I_DTB, I_DNNORM, I_ABOUT, I_FG, I_FU, I_FD, I_CDIN, I_LCW, I_LCB, I_GAW, I_GAB, I_GXW, I_GXB, I_LAM, I_SCW, I_CDOUT, I_RW, I_RB, I_MG, I_MU, I_MD };

struct ConvDesc { const float* src; bf16* dst; long long sstride, dstride; int K, N, Npad, mode, row_off, nbatch, items_pb, item0; };
struct ConvTab { ConvDesc d[12]; int nd, total, pad0, pad1; };
__device__ __forceinline__ void transpose_item(const float* W, int K, int N, bf16* WT, int mode, int row_off, float* scr, int kb, int nb, int lane) {
    const int k0 = 64 * kb, n0 = 32 * nb; const int nn = n0 + (lane & 31);
#pragma unroll 8
    for (int i = 0; i < 32; ++i) { const int kk = 2 * i + (lane >> 5); scr[kk * 33 + (lane & 31)] = nn < N ? W[(size_t)(k0 + kk) * N + nn] : 0.f; }
    asm volatile("s_waitcnt lgkmcnt(0)" ::: "memory");
    const int c = lane & 7;
#pragma unroll
    for (int j = 0; j < 4; ++j) { const int n = (lane >> 3) + 8 * j; const float* s = scr + (8 * c) * 33 + n;
        v4u o; o.x = pk2(s[0 * 33], s[1 * 33]); o.y = pk2(s[2 * 33], s[3 * 33]); o.z = pk2(s[4 * 33], s[5 * 33]); o.w = pk2(s[6 * 33], s[7 * 33]);
        const int ng = n0 + n; const int drow = (mode == 1 ? ((ng >> 7) << 8) + (ng & 127) : ng) + row_off;
        *(v4u*)(WT + (size_t)drow * K + k0 + 8 * c) = o; }
    asm volatile("s_waitcnt lgkmcnt(0)" ::: "memory");
}
__global__ void __launch_bounds__(256) k_convert(ConvTab tab) {
    __shared__ float scr_all[4][64 * 33];
    const int lane = threadIdx.x & 63, w = threadIdx.x >> 6; float* scr = scr_all[w];
    const int gw = blockIdx.x * 4 + w, NGW = gridDim.x * 4;
    for (int it = gw; it < tab.total; it += NGW) {
        int j = 0;
        for (int q = 1; q < tab.nd; ++q) if (it >= tab.d[q].item0) j = q;
        const ConvDesc& d = tab.d[j]; const int r = it - d.item0; const int batch = r / d.items_pb, item = r % d.items_pb; const int nblk = d.Npad / 32;
        transpose_item(d.src + (size_t)batch * d.sstride, d.K, d.N, d.dst + (size_t)batch * d.dstride, d.mode, d.row_off, scr, item / nblk, item % nblk, lane);
    }
}

__global__ void __launch_bounds__(256) k_ada(Params p) {
    __shared__ float sc[4][1024];
    for (int i = threadIdx.x; i < 4096; i += 256) sc[i >> 10][i & 1023] = siluf_(p.in[I_C][i]);
    __syncthreads();
    const int gj = blockIdx.x * 256 + threadIdx.x; if (gj >= 2 * 6144) return;
    const int l = gj / 6144, j = gj % 6144; const float* w = p.in[I_ADAW] + (size_t)l * 1024 * 6144 + j;
    float a0 = 0.f, a1 = 0.f, a2 = 0.f, a3 = 0.f;
    for (int k = 0; k < 1024; ++k) { const float wv = w[(size_t)k * 6144]; a0 += sc[0][k] * wv; a1 += sc[1][k] * wv; a2 += sc[2][k] * wv; a3 += sc[3][k] * wv; }
    const float bb = p.in[I_ADAB][l * 6144 + j]; float* mod = (float*)(p.ws + WS_MOD) + (size_t)l * 4 * 6144 + j;
    mod[0] = a0 + bb; mod[6144] = a1 + bb; mod[2 * 6144] = a2 + bb; mod[3 * 6144] = a3 + bb;
}

template <bool ROUTER>
__device__ __forceinline__ void norm_row(const float* xrow, bf16* orow, const float* w, const float* sc, const float* sh, int lane, const float* rw, const float* rb, int m, unsigned char* ws) {
    const f32x4* xr = (const f32x4*)xrow + lane; f32x4 v[4]; float s = 0.f;
#pragma unroll
    for (int j = 0; j < 4; ++j) { v[j] = xr[64 * j]; s += (v[j].x * v[j].x + v[j].y * v[j].y) + (v[j].z * v[j].z + v[j].w * v[j].w); }
    const float rstd = 1.0f / sqrtf(wave_sum(s) * (1.f / D) + 1e-6f);
    float lg[8];
    if (ROUTER) {
#pragma unroll
        for (int e = 0; e < 8; ++e) lg[e] = 0.f;
    }
    unsigned long long* o8 = (unsigned long long*)orow + lane;
#pragma unroll
    for (int j = 0; j < 4; ++j) { const int c = 4 * lane + 256 * j; const f32x4 wv = *(const f32x4*)(w + c), scv = *(const f32x4*)(sc + c), shv = *(const f32x4*)(sh + c);
        f32x4 y = v[j] * rstd * wv * (scv + 1.0f) + shv;
        if (ROUTER) {
#pragma unroll
            for (int i = 0; i < 4; ++i) { const f32x4 r0 = *(const f32x4*)(rw + (size_t)(c + i) * 8), r1 = *(const f32x4*)(rw + (size_t)(c + i) * 8 + 4);
                lg[0] += y[i] * r0.x; lg[1] += y[i] * r0.y; lg[2] += y[i] * r0.z; lg[3] += y[i] * r0.w; lg[4] += y[i] * r1.x; lg[5] += y[i] * r1.y; lg[6] += y[i] * r1.z; lg[7] += y[i] * r1.w; }
        }
        o8[64 * j] = (unsigned long long)pk2(y.x, y.y) | ((unsigned long long)pk2(y.z, y.w) << 32); }
    if (ROUTER) {
#pragma unroll
        for (int e = 0; e < 8; ++e) lg[e] = wave_sum(lg[e]) + rb[e];
        int b0 = 0; float v0 = lg[0];
#pragma unroll
        for (int e = 1; e < 8; ++e) if (lg[e] > v0) { v0 = lg[e]; b0 = e; }
        int b1 = -1; float v1 = -3.0e38f;
#pragma unroll
        for (int e = 0; e < 8; ++e) if (e != b0 && lg[e] > v1) { v1 = lg[e]; b1 = e; }
        const float e1 = __expf(v1 - v0), w0 = 1.0f / (1.0f + e1), w1 = e1 / (1.0f + e1);
        if (lane == 0) { int* idx = (int*)(ws + WS_ROUTE + R_IDX); float* tw = (float*)(ws + WS_ROUTE + R_W); idx[2 * m] = b0; idx[2 * m + 1] = b1; tw[2 * m] = w0; tw[2 * m + 1] = w1;
            unsigned* cnt = (unsigned*)(ws + WS_CTL) + CW_CNT; atomicAdd(cnt + b0, 1u); atomicAdd(cnt + b1, 1u); }
    }
}
template <int WHICH>
__global__ void __launch_bounds__(256) k_norm(Params p) {
    const int lane = threadIdx.x & 63, gw = blockIdx.x * 4 + (threadIdx.x >> 6), NGW = gridDim.x * 4;
    const int l = WHICH >> 1, f = WHICH & 1;
    const float* src = WHICH == 0 ? p.in[I_X] : p.out; bf16* dst = (bf16*)(p.ws + (WHICH == 3 ? WS_A3 : WS_ACT + A_A));
    const float* w = p.in[f ? I_NFFN : I_NMIX] + l * D; const float* mod = (const float*)(p.ws + WS_MOD) + (size_t)l * 4 * 6144;
    for (int m = gw; m < M; m += NGW) { const int b = m >> 12; const float* mb = mod + (size_t)b * 6144 + (f ? 3 * D : 0);
        norm_row<WHICH == 3>(src + (size_t)m * D, dst + (size_t)m * D, w, mb + D, mb, lane, p.in[I_RW], p.in[I_RB], m, p.ws); }
}

enum { G_ABIN = 0, G_ABOUT, G_FFNGU, G_FFND, G_CDIN, G_CDOUT, G_MOEGU, G_MOED };
template <int WHICH>
__global__ void __launch_bounds__(512, 2) k_gemm(Params p) {
    extern __shared__ __attribute__((aligned(16))) unsigned char lds_raw[];
    PG8_LAS unsigned char* lds = (PG8_LAS unsigned char*)lds_raw;
    unsigned char* ws = p.ws; unsigned char* act = ws + WS_ACT; const float* mod = (const float*)(ws + WS_MOD);
    const int G = gridDim.x, c = blockIdx.x;
    if constexpr (WHICH == G_ABIN) { pg8::Gemm g{(const bf16*)(act + A_A), (const bf16*)(ws + WS_WAB_IN), M, NAB, D, 0}; pg8::StaticOrder S; S.init(M, NAB, G, c);
        pg8::EpiStoreBf16 E{(bf16*)(act + A_P), NAB, nullptr}; pg8::gemm_phase<pg8::EpiStoreBf16, pg8::StaticOrder, true, true>(lds, g, S, E); }
    if constexpr (WHICH == G_ABOUT) { pg8::Gemm g{(const bf16*)(act + A_MIXA), (const bf16*)(ws + WS_WAB_OUT), M, D, D, 0}; pg8::StaticOrder S; S.init(M, D, G, c);
        pg8::EpiRes E{p.in[I_X], p.out, D, mod + 2 * D}; pg8::gemm_phase<pg8::EpiRes, pg8::StaticOrder, true, true>(lds, g, S, E); }
    if constexpr (WHICH == G_FFNGU) { pg8::Gemm g{(const bf16*)(act + A_A), (const bf16*)(ws + WS_WFFN_GU), M, 2 * FF, D, 0}; pg8::StaticOrder S; S.init(M, 2 * FF, G, c);
        pg8::EpiSwiglu E{(bf16*)(act + A_H), FF}; pg8::gemm_phase<pg8::EpiSwiglu, pg8::StaticOrder, true, true>(lds, g, S, E); }
    if constexpr (WHICH == G_FFND) { pg8::Gemm g{(const bf16*)(act + A_H), (const bf16*)(ws + WS_WFFN_D), M, D, FF, 0}; pg8::StaticOrder S; S.init(M, D, G, c);
        pg8::EpiRes E{p.out, p.out, D, mod + 5 * D}; pg8::gemm_phase<pg8::EpiRes, pg8::StaticOrder, true, true>(lds, g, S, E); }
    if constexpr (WHICH == G_CDIN) { pg8::Gemm g{(const bf16*)(act + A_A), (const bf16*)(ws + WS_WCD_IN), M, NCD, D, 0}; pg8::StaticOrder S; S.init(M, NCD, G, c);
        pg8::EpiStoreBf16 E{(bf16*)(act + A_P), NCD, nullptr}; pg8::gemm_phase<pg8::EpiStoreBf16, pg8::StaticOrder, true, true>(lds, g, S, E); }
    if constexpr (WHICH == G_CDOUT) { pg8::Gemm g{(const bf16*)(act + A_MIXB), (const bf16*)(ws + WS_WCD_OUT), M, D, CDO, 0}; pg8::StaticOrder S; S.init(M, D, G, c);
        pg8::EpiRes E{p.out, p.out, D, mod + 4 * 6144 + 2 * D}; pg8::gemm_phase<pg8::EpiRes, pg8::StaticOrder, true, true>(lds, g, S, E); }
    if constexpr (WHICH == G_MOEGU) { const int* off = (const int*)(ws + WS_ROUTE + R_OFF); const int nMt = __builtin_amdgcn_readfirstlane(off[8]) >> 8;
        pg8::Gemm g{(const bf16*)(act + A_A3P), (const bf16*)(ws + WS_WMOE_GU), nMt * 256, 2 * FFE, D, (size_t)2 * FFE * D * 2}; pg8::GroupedOrder S; S.init(nMt, 2 * FFE, G, c, (const int*)(ws + WS_ROUTE + R_TILEE));
        pg8::EpiSwiglu E{(bf16*)(act + A_HM), FFE}; pg8::gemm_phase<pg8::EpiSwiglu, pg8::GroupedOrder, true, true>(lds, g, S, E); }
    if constexpr (WHICH == G_MOED) { const int* off = (const int*)(ws + WS_ROUTE + R_OFF); const int nMt = __builtin_amdgcn_readfirstlane(off[8]) >> 8;
        pg8::Gemm g{(const bf16*)(act + A_HM), (const bf16*)(ws + WS_WMOE_D), nMt * 256, D, FFE, (size_t)D * FFE * 2}; pg8::GroupedOrder S; S.init(nMt, D, G, c, (const int*)(ws + WS_ROUTE + R_TILEE));
        pg8::EpiStoreBf16 E{(bf16*)(act + A_Y), D, (const float*)(ws + WS_ROUTE + R_GATEW)}; pg8::gemm_phase<pg8::EpiStoreBf16, pg8::GroupedOrder, true, true>(lds, g, S, E); }
}

__global__ void __launch_bounds__(256) k_attn_naive(Params p) {
    const int gid = blockIdx.x * 256 + threadIdx.x; if (gid >= M * 8) return;
    const int m = gid >> 3, h = gid & 7, t = m & (T - 1), kvh = h >> 2;
    const bf16* P0 = (const bf16*)(p.ws + WS_ACT + A_P);
    float q[64], o[64];
    { const v4u* qp = (const v4u*)(P0 + (size_t)m * NAB + C_QA + h * 64);
#pragma unroll
      for (int i = 0; i < 8; ++i) { const v4u w = qp[i]; q[8 * i + 0] = bflo(w.x) * 0.125f; q[8 * i + 1] = bfhi(w.x) * 0.125f; q[8 * i + 2] = bflo(w.y) * 0.125f; q[8 * i + 3] = bfhi(w.y) * 0.125f;
          q[8 * i + 4] = bflo(w.z) * 0.125f; q[8 * i + 5] = bfhi(w.z) * 0.125f; q[8 * i + 6] = bflo(w.w) * 0.125f; q[8 * i + 7] = bfhi(w.w) * 0.125f; } }
#pragma unroll
    for (int i = 0; i < 64; ++i) o[i] = 0.f;
    float mx = p.in[I_SINK][h], l = 1.0f;
    const float* relb = p.in[I_RELB];
    const int nd = t + 1 < 128 ? t + 1 : 128;
    for (int dd = 0; dd < nd; ++dd) {
        const bf16* kr = P0 + (size_t)(m - dd) * NAB + C_KA + kvh * 64; const bf16* vr = P0 + (size_t)(m - dd) * NAB + C_VA + kvh * 64;
        float s = 0.f;
#pragma unroll
        for (int i = 0; i < 8; ++i) { const v4u w = ((const v4u*)kr)[i];
            s += q[8 * i + 0] * bflo(w.x) + q[8 * i + 1] * bfhi(w.x) + q[8 * i + 2] * bflo(w.y) + q[8 * i + 3] * bfhi(w.y) + q[8 * i + 4] * bflo(w.z) + q[8 * i + 5] * bfhi(w.z) + q[8 * i + 6] * bflo(w.w) + q[8 * i + 7] * bfhi(w.w); }
        s += relb[T5_BUCKET[dd] * 8 + h];
        const float mn = fmaxf(mx, s), sc = __expf(mx - mn), pp = __expf(s - mn);
        l = l * sc + pp; mx = mn;
#pragma unroll
        for (int i = 0; i < 8; ++i) { const v4u w = ((const v4u*)vr)[i];
            o[8 * i + 0] = o[8 * i + 0] * sc + pp * bflo(w.x); o[8 * i + 1] = o[8 * i + 1] * sc + pp * bfhi(w.x); o[8 * i + 2] = o[8 * i + 2] * sc + pp * bflo(w.y); o[8 * i + 3] = o[8 * i + 3] * sc + pp * bfhi(w.y);
            o[8 * i + 4] = o[8 * i + 4] * sc + pp * bflo(w.z); o[8 * i + 5] = o[8 * i + 5] * sc + pp * bfhi(w.z); o[8 * i + 6] = o[8 * i + 6] * sc + pp * bflo(w.w); o[8 * i + 7] = o[8 * i + 7] * sc + pp * bfhi(w.w); }
    }
    const float inv = 1.0f / l;
    v4u* op = (v4u*)((bf16*)(p.ws + WS_ACT + A_MIXA) + (size_t)m * D + h * 64);
#pragma unroll
    for (int i = 0; i < 8; ++i) { v4u w; w.x = pk2(o[8 * i] * inv, o[8 * i + 1] * inv); w.y = pk2(o[8 * i + 2] * inv, o[8 * i + 3] * inv); w.z = pk2(o[8 * i + 4] * inv, o[8 * i + 5] * inv); w.w = pk2(o[8 * i + 6] * inv, o[8 * i + 7] * inv); op[i] = w; }
}

__global__ void __launch_bounds__(64) k_dn_prep(Params p) {
    const int m = blockIdx.x >> 3, h = blockIdx.x & 7, lane = threadIdx.x, t = m & (T - 1);
    const bf16* P0 = (const bf16*)(p.ws + WS_ACT + A_P); const float* cw = p.in[I_DNCONV];
    float r[3];
#pragma unroll
    for (int s = 0; s < 3; ++s) { const int ch = s * 512 + h * 64 + lane; float a = 0.f;
#pragma unroll
        for (int k = 0; k < 4; ++k) { const int tt = t - 3 + k; if (tt >= 0) a += cw[k * 1536 + ch] * bf2f(P0[(size_t)(m - 3 + k) * NAB + C_QKVB + ch]); }
        r[s] = siluf_(a); }
    const float nq = 1.0f / sqrtf(wave_sum(r[0] * r[0]) + 1e-6f), nk = 1.0f / sqrtf(wave_sum(r[1] * r[1]) + 1e-6f);
    unsigned char* act = p.ws + WS_ACT;
    ((float*)(act + A_DNQ))[(size_t)m * 512 + h * 64 + lane] = r[0] * nq;
    ((float*)(act + A_DNK))[(size_t)m * 512 + h * 64 + lane] = r[1] * nk;
    ((float*)(act + A_DNV))[(size_t)m * 512 + h * 64 + lane] = r[2];
    if (lane == 0) { const float bb = bf2f(P0[(size_t)m * NAB + C_BETA + h]), ab = bf2f(P0[(size_t)m * NAB + C_AB + h]);
        ((float*)(act + A_DNB))[m * 8 + h] = sigmoidf_(bb);
        ((float*)(act + A_DNG))[m * 8 + h] = -__expf(p.in[I_ALOG][h]) * softplusf_(ab + p.in[I_DTB][h]); }
}
__global__ void __launch_bounds__(64) k_dn_scan(Params p) {
    __shared__ float kq[2][64];
    const int b = blockIdx.x >> 3, h = blockIdx.x & 7, e = threadIdx.x;
    unsigned char* act = p.ws + WS_ACT; const bf16* P0 = (const bf16*)(act + A_P);
    const float* Q = (const float*)(act + A_DNQ); const float* K = (const float*)(act + A_DNK); const float* V = (const float*)(act + A_DNV);
    const float* Bt = (const float*)(act + A_DNB); const float* Gt = (const float*)(act + A_DNG);
    const float nw = p.in[I_DNNORM][e];
    float S[64];
#pragma unroll
    for (int d = 0; d < 64; ++d) S[d] = 0.f;
    for (int t = 0; t < T; ++t) { const int m = b * T + t;
        __syncthreads();
        kq[0][e] = K[(size_t)m * 512 + h * 64 + e]; kq[1][e] = Q[(size_t)m * 512 + h * 64 + e];
        const float v = V[(size_t)m * 512 + h * 64 + e], beta = Bt[m * 8 + h], eg = __expf(Gt[m * 8 + h]);
        __syncthreads();
        float kS = 0.f;
#pragma unroll
        for (int d = 0; d < 64; ++d) { S[d] *= eg; kS += kq[0][d] * S[d]; }
        const float dl = beta * (v - kS); float o = 0.f;
#pragma unroll
        for (int d = 0; d < 64; ++d) { S[d] += kq[0][d] * dl; o += kq[1][d] * S[d]; }
        o *= 0.125f;
        const float rs = 1.0f / sqrtf(wave_sum(o * o) * (1.f / 64.f) + 1e-6f);
        const float gt = bf2f(P0[(size_t)m * NAB + C_GATEB + h * 64 + e]);
        ((bf16*)(act + A_MIXA))[(size_t)m * D + 512 + h * 64 + e] = (bf16)f2bf(o * rs * nw * siluf_(gt));
    }
}

__global__ void __launch_bounds__(256) k_lru_conv(Params p) {
    const size_t gid = (size_t)blockIdx.x * 256 + threadIdx.x; const int m = (int)(gid >> 10), c = (int)(gid & 1023), t = m & (T - 1);
    const bf16* P1 = (const bf16*)(p.ws + WS_ACT + A_P); const float* cw = p.in[I_LCW]; float a = p.in[I_LCB][c];
#pragma unroll
    for (int k = 0; k < 4; ++k) { const int tt = t - 3 + k; if (tt >= 0) a += cw[k * 1024 + c] * bf2f(P1[(size_t)(m - 3 + k) * NCD + C_XC + c]); }
    ((float*)(p.ws + WS_ACT + A_XC))[gid] = a;
}
__global__ void __launch_bounds__(128) k_lru_gates(Params p) {
    __shared__ float xs[128];
    const int m = blockIdx.x >> 3, n = blockIdx.x & 7, j = threadIdx.x, ch = n * 128 + j;
    const float* XC = (const float*)(p.ws + WS_ACT + A_XC);
    xs[j] = XC[(size_t)m * 1024 + ch];
    __syncthreads();
    const float* ga = p.in[I_GAW] + (size_t)n * 128 * 128 + j; const float* gx = p.in[I_GXW] + (size_t)n * 128 * 128 + j;
    float ra = 0.f, rx = 0.f;
    for (int i = 0; i < 128; ++i) { ra += xs[i] * ga[i * 128]; rx += xs[i] * gx[i * 128]; }
    const float r = sigmoidf_(ra + p.in[I_GAB][ch]), ii = sigmoidf_(rx + p.in[I_GXB][ch]);
    const float log_a = -8.0f * r * softplusf_(-p.in[I_LAM][ch]);
    ((float*)(p.ws + WS_LA))[(size_t)m * 1024 + ch] = __expf(log_a);
    ((float*)(p.ws + WS_LB))[(size_t)m * 1024 + ch] = sqrtf(-expm1f(2.0f * log_a)) * (ii * xs[j]);
}
__global__ void __launch_bounds__(64) k_lru_scan(Params p) {
    const int gid = blockIdx.x * 64 + threadIdx.x, b = gid >> 10, ch = gid & 1023;
    const float* LA = (const float*)(p.ws + WS_LA); const float* LB = (const float*)(p.ws + WS_LB);
    const bf16* P1 = (const bf16*)(p.ws + WS_ACT + A_P); bf16* MIXB = (bf16*)(p.ws + WS_ACT + A_MIXB);
    float hs = 0.f;
    for (int t = 0; t < T; ++t) { const size_t m = (size_t)b * T + t; hs = LA[m * 1024 + ch] * hs + LB[m * 1024 + ch];
        MIXB[m * CDO + ch] = (bf16)f2bf(hs * gelu_tanhf_(bf2f(P1[m * NCD + C_YC + ch]))); }
}
__global__ void __launch_bounds__(256) k_sconv(Params p) {
    const size_t gid = (size_t)blockIdx.x * 256 + threadIdx.x; const int m = (int)(gid >> 9), c = (int)(gid & 511), t = m & (T - 1);
    const bf16* P1 = (const bf16*)(p.ws + WS_ACT + A_P); const float* sw = p.in[I_SCW]; float a = 0.f;
#pragma unroll
    for (int k = 0; k < 3; ++k) { const int tt = t - 2 + k; if (tt >= 0) { const size_t r = (size_t)(m - 2 + k) * NCD; a += sw[k * 512 + c] * (bf2f(P1[r + C_CD + c]) * bf2f(P1[r + C_HD + c])); } }
    ((bf16*)(p.ws + WS_ACT + A_MIXB))[(size_t)m * CDO + 1024 + c] = (bf16)f2bf(bf2f(P1[(size_t)m * NCD + C_BD + c]) * a);
}

__global__ void k_route_offsets(Params p) {
    if (threadIdx.x != 0 || blockIdx.x != 0) return;
    const unsigned* cnt = (const unsigned*)(p.ws + WS_CTL) + CW_CNT; int* off = (int*)(p.ws + WS_ROUTE + R_OFF); int* te = (int*)(p.ws + WS_ROUTE + R_TILEE);
    int o = 0;
    for (int e = 0; e < 8; ++e) { off[e] = o; const int n = ((int)cnt[e] + 255) & ~255; for (int t = o >> 8; t < (o + n) >> 8 && t < MAXT; ++t) te[t] = e; o += n; }
    off[8] = o < MPAD ? o : MPAD;
}
__global__ void __launch_bounds__(256) k_route_scatter(Params p) {
    const int lane = threadIdx.x & 63, gw = blockIdx.x * 4 + (threadIdx.x >> 6); if (gw >= 2 * M) return;
    const int m = gw >> 1; const int* idx = (const int*)(p.ws + WS_ROUTE + R_IDX); const float* tw = (const float*)(p.ws + WS_ROUTE + R_W);
    const int* off = (const int*)(p.ws + WS_ROUTE + R_OFF); unsigned* cur = (unsigned*)(p.ws + WS_CTL) + CW_CUR;
    const int e = idx[gw]; int pos = 0;
    if (lane == 0) pos = off[e] + (int)atomicAdd(cur + e, 1u);
    pos = __shfl(pos, 0);
    if (lane == 0) { ((int*)(p.ws + WS_ROUTE + R_SLOT))[gw] = pos; ((float*)(p.ws + WS_ROUTE + R_GATEW))[pos] = tw[gw]; }
    const v4u* src = (const v4u*)((const bf16*)(p.ws + WS_A3) + (size_t)m * D); v4u* dst = (v4u*)((bf16*)(p.ws + WS_ACT + A_A3P) + (size_t)pos * D);
    dst[lane] = src[lane]; dst[lane + 64] = src[lane + 64];
}
__global__ void __launch_bounds__(256) k_final(Params p) {
    const int lane = threadIdx.x & 63, gw = blockIdx.x * 4 + (threadIdx.x >> 6), NGW = gridDim.x * 4;
    const int* slot = (const int*)(p.ws + WS_ROUTE + R_SLOT); const bf16* Y = (const bf16*)(p.ws + WS_ACT + A_Y);
    const float* mod = (const float*)(p.ws + WS_MOD) + 4 * 6144; const float* fw = p.in[I_NFIN];
    for (int m = gw; m < M; m += NGW) { const int b = m >> 12; const float* g2 = mod + (size_t)b * 6144 + 5 * D;
        const int s0 = slot[2 * m], s1 = slot[2 * m + 1];
        f32x4* xr = (f32x4*)(p.out + (size_t)m * D) + lane; const v2u* y0 = (const v2u*)(Y + (size_t)s0 * D) + lane; const v2u* y1 = (const v2u*)(Y + (size_t)s1 * D) + lane;
        f32x4 v[4]; float s = 0.f;
#pragma unroll
        for (int j = 0; j < 4; ++j) { const f32x4 gv = *(const f32x4*)(g2 + 4 * lane + 256 * j); const v2u a = y0[64 * j], c = y1[64 * j];
            f32x4 yy; yy.x = bflo(a.x) + bflo(c.x); yy.y = bfhi(a.x) + bfhi(c.x); yy.z = bflo(a.y) + bflo(c.y); yy.w = bfhi(a.y) + bfhi(c.y);
            v[j] = xr[64 * j] + gv * yy; s += (v[j].x * v[j].x + v[j].y * v[j].y) + (v[j].z * v[j].z + v[j].w * v[j].w); }
        const float rstd = 1.0f / sqrtf(wave_sum(s) * (1.f / D) + 1e-6f);
#pragma unroll
        for (int j = 0; j < 4; ++j) { const f32x4 wv = *(const f32x4*)(fw + 4 * lane + 256 * j); xr[64 * j] = v[j] * rstd * wv; }
    }
}

static void add_desc(ConvTab& t, const float* src, bf16* dst, int K, int N, int Npad, int mode, int row_off, int nbatch, long long sstride, long long dstride) {
    ConvDesc& d = t.d[t.nd]; d.src = src; d.dst = dst; d.sstride = sstride; d.dstride = dstride; d.K = K; d.N = N; d.Npad = Npad; d.mode = mode; d.row_off = row_off; d.nbatch = nbatch;
    d.items_pb = (K / 64) * (Npad / 32); d.item0 = t.total; t.total += d.items_pb * nbatch; t.nd++;
}
template <int W> static void launch_gemm(const Params& p, hipStream_t stream) {
    static bool init = false;
    if (!init) { (void)hipFuncSetAttribute((const void*)k_gemm<W>, hipFuncAttributeMaxDynamicSharedMemorySize, 131072); init = true; }
    hipLaunchKernelGGL(k_gemm<W>, dim3(256), dim3(512), 131072, stream, p);
}
extern "C" void kernel_launch(void* const* d_in, const int* in_sizes, int n_in, void* d_out, int out_size, void* d_ws, size_t ws_size, hipStream_t stream) {
    if (n_in != 33 || out_size != M * D || ws_size < WS_END) { fprintf(stderr, "kernel_launch: unexpected shapes (n_in %d out %d ws %zu)\n", n_in, out_size, ws_size); return; }
    Params p{};
    for (int i = 0; i < 33; ++i) p.in[i] = (const float*)d_in[i];
    p.out = (float*)d_out; p.ws = (unsigned char*)d_ws;
    unsigned char* ws = p.ws;
    (void)hipMemsetAsync(ws + WS_CTL, 0, CTL_ZERO_BYTES, stream);
    ConvTab t1{};
    add_desc(t1, p.in[I_ABIN], (bf16*)(ws + WS_WAB_IN), D, 2832, NAB, 0, 0, 1, 0, 0);
    add_desc(t1, p.in[I_ABOUT], (bf16*)(ws + WS_WAB_OUT), D, D, D, 0, 0, 1, 0, 0);
    add_desc(t1, p.in[I_FG], (bf16*)(ws + WS_WFFN_GU), D, FF, FF, 1, 0, 1, 0, 0);
    add_desc(t1, p.in[I_FU], (bf16*)(ws + WS_WFFN_GU), D, FF, FF, 1, 128, 1, 0, 0);
    add_desc(t1, p.in[I_FD], (bf16*)(ws + WS_WFFN_D), FF, D, D, 0, 0, 1, 0, 0);
    add_desc(t1, p.in[I_CDIN], (bf16*)(ws + WS_WCD_IN), D, NCD, NCD, 0, 0, 1, 0, 0);
    add_desc(t1, p.in[I_CDOUT], (bf16*)(ws + WS_WCD_OUT), CDO, D, D, 0, 0, 1, 0, 0);
    hipLaunchKernelGGL(k_convert, dim3(1024), dim3(256), 0, stream, t1);
    hipLaunchKernelGGL(k_ada, dim3(48), dim3(256), 0, stream, p);
    hipLaunchKernelGGL(k_norm<0>, dim3(1024), dim3(256), 0, stream, p);
    launch_gemm<G_ABIN>(p, stream);
    hipLaunchKernelGGL(k_attn_naive, dim3(M * 8 / 256), dim3(256), 0, stream, p);
    hipLaunchKernelGGL(k_dn_prep, dim3(M * 8), dim3(64), 0, stream, p);
    hipLaunchKernelGGL(k_dn_scan, dim3(32), dim3(64), 0, stream, p);
    launch_gemm<G_ABOUT>(p, stream);
    hipLaunchKernelGGL(k_norm<1>, dim3(1024), dim3(256), 0, stream, p);
    launch_gemm<G_FFNGU>(p, stream);
    launch_gemm<G_FFND>(p, stream);
    hipLaunchKernelGGL(k_norm<2>, dim3(1024), dim3(256), 0, stream, p);
    launch_gemm<G_CDIN>(p, stream);
    hipLaunchKernelGGL(k_lru_conv, dim3(M * 1024 / 256), dim3(256), 0, stream, p);
    hipLaunchKernelGGL(k_lru_gates, dim3(M * 8), dim3(128), 0, stream, p);
    hipLaunchKernelGGL(k_lru_scan, dim3(64), dim3(64), 0, stream, p);
    hipLaunchKernelGGL(k_sconv, dim3(M * 512 / 256), dim3(256), 0, stream, p);
    launch_gemm<G_CDOUT>(p, stream);
    hipLaunchKernelGGL(k_norm<3>, dim3(1024), dim3(256), 0, stream, p);
    ConvTab t2{};
    add_desc(t2, p.in[I_MG], (bf16*)(ws + WS_WMOE_GU), D, FFE, FFE, 1, 0, NE, (long long)D * FFE, (long long)2 * FFE * D);
    add_desc(t2, p.in[I_MU], (bf16*)(ws + WS_WMOE_GU), D, FFE, FFE, 1, 128, NE, (long long)D * FFE, (long long)2 * FFE * D);
    add_desc(t2, p.in[I_MD], (bf16*)(ws + WS_WMOE_D), FFE, D, D, 0, 0, NE, (long long)FFE * D, (long long)D * FFE);
    hipLaunchKernelGGL(k_convert, dim3(1024), dim3(256), 0, stream, t2);
    hipLaunchKernelGGL(k_route_offsets, dim3(1), dim3(64), 0, stream, p);
    hipLaunchKernelGGL(k_route_scatter, dim3(2 * M / 4), dim3(256), 0, stream, p);
    launch_gemm<G_MOEGU>(p, stream);
    launch_gemm<G_MOED>(p, stream);
    hipLaunchKernelGGL(k_final, dim3(1024), dim3(256), 0, stream, p);
}
```

```cpp
#include <hip/hip_runtime.h>
#include <cstdio>
#include <cstdint>
namespace pg8 {
#define PG8_LAS __attribute__((address_space(3)))
typedef unsigned short bf16_t;
typedef short bf16x8 __attribute__((ext_vector_type(8)));
typedef float f32x4 __attribute__((ext_vector_type(4)));
typedef unsigned u32x4 __attribute__((ext_vector_type(4)));
constexpr int BM = 256, BK = 64, HALF = 128, HTB = HALF * BK * 2  , STAGE_BYTES = 8 * HTB, NXCD = 8, WGM = 8;

__host__ __device__ __forceinline__ int lds_byte(int r, int c) { const int st = (r >> 4) * 2 + (c >> 5), rr = r & 15, cc = c & 31, ob = rr * 64 + cc * 2; return st * 1024 + (ob ^ (((ob >> 9) & 1) << 5)); }
__host__ __device__ __forceinline__ void stage_rc(int b, int& R, int& C) { const int st = b / 1024, sb = b % 1024, swz = sb ^ (((sb >> 9) & 1) << 5); R = (st >> 1) * 16 + swz / 64; C = (st & 1) * 32 + (swz % 64) / 2; }
__host__ __device__ __forceinline__ int perm32(int rho) { const int n = rho >> 4, i = rho & 15; return 8 * (i >> 2) + 4 * n + (i & 3); }

struct Unit { int pm, pn, e; };
struct Gemm { const bf16_t* A; const bf16_t* Bt; int M, N, K; size_t eb; };

struct StaticOrder {
    int nM, nN, nwg, G, c;
    __host__ __device__ void init(int M, int N, int G_, int c_) { nM = M / BM; nN = N / BM; nwg = nM * nN; G = G_; c = c_; }
    __host__ __device__ bool next(int i, Unit& u) const {
        const long L = (long)i * G + c; if (L >= nwg) return false;
        int wgid = (int)L; { const int q = nwg / NXCD, r = nwg % NXCD, xcd = wgid % NXCD, off = wgid / NXCD; wgid = (xcd < r ? xcd * (q + 1) : r * (q + 1) + (xcd - r) * q) + off; }
        const int nig = WGM * nN, gid = wgid / nig, fm = gid * WGM, gsz = (nM - fm) < WGM ? (nM - fm) : WGM;
        u.pm = fm + ((wgid % nig) % gsz); u.pn = (wgid % nig) / gsz; u.e = 0; return true;
    }
    __device__ __forceinline__ void a_ready(const Unit&) const {}
    __device__ __forceinline__ void done(const Unit&) const {}
};

__device__ __forceinline__ unsigned cvt_pk_bf16(float lo, float hi) { unsigned r; asm volatile("v_cvt_pk_bf16_f32 %0, %1, %2" : "=v"(r) : "v"(lo), "v"(hi)); return r; }

__device__ __forceinline__ float fast_silu(float g) { return g * __builtin_amdgcn_rcpf(1.0f + __expf(-g)); }
struct EpiStoreBf16 {
    static constexpr bool PERM = true, AFTER_DRAIN = false;
    bf16_t* O; int ldc; const float* rowscale;
    __device__ __forceinline__ void operator()(const f32x4 (&acc)[2][2][4][2], const Unit& u, int wr, int wc, int fr, int fq) const {
        const int row0 = u.pm * BM + wr * 64 + fr, col0 = u.pn * BM + wc * 32 + 8 * fq;
#pragma unroll
        for (int ai = 0; ai < 2; ++ai)
#pragma unroll
            for (int m = 0; m < 4; ++m) { const int row = row0 + ai * HALF + m * 16; bf16_t* rowp = O + (size_t)row * ldc + col0;
                const float s = rowscale ? rowscale[row] : 1.f;
#pragma unroll
                for (int bj = 0; bj < 2; ++bj) { const f32x4 v0 = acc[ai][bj][m][0] * s, v1 = acc[ai][bj][m][1] * s;
                    u32x4 w; w.x = cvt_pk_bf16(v0[0], v0[1]); w.y = cvt_pk_bf16(v0[2], v0[3]); w.z = cvt_pk_bf16(v1[0], v1[1]); w.w = cvt_pk_bf16(v1[2], v1[3]);
                    *(u32x4*)(rowp + bj * HALF) = w; } }
    }
};
struct EpiSwiglu {
    static constexpr bool PERM = true, AFTER_DRAIN = false;
    bf16_t* O; int ldc;
    __device__ __forceinline__ void operator()(const f32x4 (&acc)[2][2][4][2], const Unit& u, int wr, int wc, int fr, int fq) const {
        const int row0 = u.pm * BM + wr * 64 + fr, col0 = u.pn * HALF + wc * 32 + 8 * fq;
#pragma unroll
        for (int ai = 0; ai < 2; ++ai)
#pragma unroll
            for (int m = 0; m < 4; ++m) { const int row = row0 + ai * HALF + m * 16; bf16_t* rowp = O + (size_t)row * ldc + col0;
                const f32x4 g0 = acc[ai][0][m][0], g1 = acc[ai][0][m][1], u0 = acc[ai][1][m][0], u1 = acc[ai][1][m][1];
                float h[8];
#pragma unroll
                for (int i = 0; i < 4; ++i) { h[i] = fast_silu(g0[i]) * u0[i]; h[4 + i] = fast_silu(g1[i]) * u1[i]; }
                u32x4 w; w.x = cvt_pk_bf16(h[0], h[1]); w.y = cvt_pk_bf16(h[2], h[3]); w.z = cvt_pk_bf16(h[4], h[5]); w.w = cvt_pk_bf16(h[6], h[7]);
                *(u32x4*)rowp = w; }
    }
};
struct EpiRes {
    static constexpr bool PERM = false, AFTER_DRAIN = false;
    const float* base; float* out; int ldc; const float* gate;
    __device__ __forceinline__ void operator()(const f32x4 (&acc)[2][2][4][2], const Unit& u, int wr, int wc, int fr, int fq) const {
        const int row0 = u.pm * BM + wr * 64 + fr, col0 = u.pn * BM + wc * 32 + 4 * fq;
        const float* gp = gate + (size_t)(u.pm >> 4) * 6144 + col0;
        f32x4 gv[2][2];
#pragma unroll
        for (int bj = 0; bj < 2; ++bj)
#pragma unroll
            for (int n = 0; n < 2; ++n) gv[bj][n] = *(const f32x4*)(gp + bj * HALF + n * 16);
#pragma unroll
        for (int ai = 0; ai < 2; ++ai)
#pragma unroll
            for (int m = 0; m < 4; ++m) { const size_t off = (size_t)(row0 + ai * HALF + m * 16) * ldc + col0;
#pragma unroll
                for (int bj = 0; bj < 2; ++bj)
#pragma unroll
                    for (int n = 0; n < 2; ++n) { const f32x4 bs = *(const f32x4*)(base + off + bj * HALF + n * 16);
                        *(f32x4*)(out + off + bj * HALF + n * 16) = bs + gv[bj][n] * acc[ai][bj][m][n]; } }
    }
};
struct GroupedOrder {
    int nM, nN, nwg, G, c; const int* tile_e;
    __device__ void init(int nMt, int N, int G_, int c_, const int* te) { nM = nMt; nN = N / BM; nwg = nM * nN; G = G_; c = c_; tile_e = te; }
    __device__ bool next(int i, Unit& u) const {
        const long L = (long)i * G + c; if (L >= nwg) return false;
        int wgid = (int)L; { const int q = nwg / NXCD, r = nwg % NXCD, xcd = wgid % NXCD, off = wgid / NXCD; wgid = (xcd < r ? xcd * (q + 1) : r * (q + 1) + (xcd - r) * q) + off; }
        const int nig = WGM * nN, gid = wgid / nig, fm = gid * WGM, gsz = (nM - fm) < WGM ? (nM - fm) : WGM;
        u.pm = fm + ((wgid % nig) % gsz); u.pn = (wgid % nig) / gsz; u.e = __builtin_amdgcn_readfirstlane(tile_e[u.pm]); return true;
    }
    __device__ __forceinline__ void a_ready(const Unit&) const {}
    __device__ __forceinline__ void done(const Unit&) const {}
};

template <class Epi, class Sched, bool ALIGN_EPI = false, bool SP2 = false>
__device__ __forceinline__ void gemm_phase(PG8_LAS unsigned char* lds, const Gemm g, const Sched& S, const Epi& E) {
    const int tid = threadIdx.x, wid = __builtin_amdgcn_readfirstlane(tid >> 6), lane = tid & 63, wr = wid >> 2, wc = wid & 3, fr = lane & 15, fq = lane >> 4;
    const int K = g.K, nt = K / BK;
    unsigned voffA[2], voffB[2];
#pragma unroll
    for (int i = 0; i < 2; ++i) { int R, C; stage_rc(tid * 16 + i * 8192, R, C); const int Rb = Epi::PERM ? ((R & ~31) + perm32(R & 31)) : R;
        voffA[i] = (unsigned)(R * K + C) * 2u; voffB[i] = (unsigned)(Rb * K + C) * 2u; }
    const size_t kstep = (size_t)(BK * 2);
    const size_t hstep = (size_t)HALF * K * 2;
    const size_t tstep = 2 * hstep;
    const unsigned ldsw = (unsigned)wid * 1024u;
    const int aoff = lds_byte(wr * 64 + fr, fq * 8), boff = lds_byte(wc * 32 + fr, fq * 8);
#define PG8_SA(b, h) (((b) * 2 + (h)) * HTB)
#define PG8_SB(b, h) ((4 + (b) * 2 + (h)) * HTB)
#define PG8_STAGE(bufoff, gbase, voff) do { _Pragma("unroll") for (int _i = 0; _i < 2; ++_i) \
        __builtin_amdgcn_global_load_lds((const unsigned*)((const char*)(gbase) + (voff)[_i]), (PG8_LAS unsigned*)(lds + (bufoff) + ldsw + _i * 8192), 16, 0, 0); } while (0)
#define PG8_LDA(dst, b, h) do { _Pragma("unroll") for (int m = 0; m < 4; ++m) _Pragma("unroll") for (int k = 0; k < 2; ++k) dst[m][k] = *(const PG8_LAS bf16x8*)(lds + PG8_SA(b, h) + aoff + m * 2048 + k * 1024); } while (0)
#define PG8_LDB(dst, b, h) do { _Pragma("unroll") for (int n = 0; n < 2; ++n) _Pragma("unroll") for (int k = 0; k < 2; ++k) dst[n][k] = *(const PG8_LAS bf16x8*)(lds + PG8_SB(b, h) + boff + n * 2048 + k * 1024); } while (0)
#define PG8_MMA(ai, bj, At, Bt) do { __builtin_amdgcn_s_setprio(1); _Pragma("unroll") for (int m = 0; m < 4; ++m) _Pragma("unroll") for (int n = 0; n < 2; ++n) _Pragma("unroll") for (int k = 0; k < 2; ++k) \
        acc[ai][bj][m][n] = __builtin_amdgcn_mfma_f32_16x16x32_bf16(Bt[n][k], At[m][k], acc[ai][bj][m][n], 0, 0, 0); __builtin_amdgcn_s_setprio(0); } while (0)
#define PG8_WAIT_V(n) asm volatile("s_waitcnt vmcnt(" #n ")" ::: "memory")
#define PG8_WAIT_L(n) asm volatile("s_waitcnt lgkmcnt(" #n ")" ::: "memory")
#define PG8_BAR __builtin_amdgcn_s_barrier()
#define PG8_SCHED __builtin_amdgcn_sched_barrier(0)
    Unit cur, nxt; int ui = 0;
    if (!S.next(0, cur)) return;
    f32x4 acc[2][2][4][2];
#pragma unroll
    for (int a = 0; a < 2; ++a)
#pragma unroll
        for (int b = 0; b < 2; ++b)
#pragma unroll
            for (int m = 0; m < 4; ++m)
#pragma unroll
                for (int n = 0; n < 2; ++n) acc[a][b][m][n] = (f32x4){0.f, 0.f, 0.f, 0.f};
    bf16x8 At[4][2], B0[2][2], B1[2][2];
    const char* cA = (const char*)g.A + (size_t)cur.pm * tstep; const char* cB = (const char*)g.Bt + (size_t)cur.e * g.eb + (size_t)cur.pn * tstep;
    S.a_ready(cur);
    if constexpr (SP2) {
        PG8_STAGE(PG8_SB(0, 0), cB, voffB); PG8_STAGE(PG8_SB(0, 1), cB + hstep, voffB); PG8_STAGE(PG8_SA(0, 0), cA, voffA); PG8_STAGE(PG8_SA(0, 1), cA + hstep, voffA);
        if (wr == 1) PG8_BAR;
        PG8_WAIT_V(2); PG8_BAR;
        PG8_STAGE(PG8_SB(1, 0), cB + kstep, voffB); PG8_STAGE(PG8_SA(1, 0), cA + kstep, voffA); PG8_STAGE(PG8_SB(1, 1), cB + hstep + kstep, voffB);
        PG8_WAIT_V(6); PG8_BAR;
    } else {
        PG8_STAGE(PG8_SB(0, 0), cB, voffB); PG8_STAGE(PG8_SA(0, 0), cA, voffA); PG8_STAGE(PG8_SB(0, 1), cB + hstep, voffB); PG8_STAGE(PG8_SA(0, 1), cA + hstep, voffA);
        if (wr == 1) PG8_BAR;
        PG8_WAIT_V(4); PG8_BAR;
        PG8_STAGE(PG8_SB(1, 0), cB + kstep, voffB); PG8_STAGE(PG8_SA(1, 0), cA + kstep, voffA); PG8_STAGE(PG8_SB(1, 1), cB + hstep + kstep, voffB);
        PG8_WAIT_V(6); PG8_BAR;
    }
    for (;;) {
        const bool has_next = S.next(ui + 1, nxt);
        const char* nA = has_next ? (const char*)g.A + (size_t)nxt.pm * tstep : cA; const char* nB = has_next ? (const char*)g.Bt + (size_t)nxt.e * g.eb + (size_t)nxt.pn * tstep : cB;
        for (int t = 0; t < nt; t += 2) {
            const bool last = (t == nt - 2);
            const char* a1 = cA + (size_t)(t + 1) * kstep;
            const char* a2 = last ? nA : cA + (size_t)(t + 2) * kstep; const char* b2 = last ? nB : cB + (size_t)(t + 2) * kstep;
            const char* a3 = a2 + kstep; const char* b3 = b2 + kstep;
            if (last && has_next) S.a_ready(nxt);
            if constexpr (SP2) {
            PG8_LDB(B0, 0, 0); PG8_LDB(B1, 0, 1); PG8_SCHED; PG8_LDA(At, 0, 0); PG8_STAGE(PG8_SA(1, 1), a1 + hstep, voffA);
            PG8_WAIT_V(8); PG8_WAIT_L(0); PG8_BAR; PG8_MMA(0, 0, At, B0); PG8_MMA(0, 1, At, B1); PG8_BAR; PG8_SCHED;
            PG8_LDA(At, 0, 1); PG8_STAGE(PG8_SB(0, 0), b2, voffB); PG8_STAGE(PG8_SB(0, 1), b2 + hstep, voffB); PG8_STAGE(PG8_SA(0, 0), a2, voffA);
            PG8_WAIT_V(8); PG8_WAIT_L(0); PG8_BAR; PG8_MMA(1, 0, At, B0); PG8_MMA(1, 1, At, B1); PG8_BAR; PG8_SCHED;
            PG8_LDB(B0, 1, 0); PG8_LDB(B1, 1, 1); PG8_SCHED; PG8_LDA(At, 1, 0); PG8_STAGE(PG8_SA(0, 1), a2 + hstep, voffA);
            PG8_WAIT_V(8); PG8_WAIT_L(0); PG8_BAR; PG8_MMA(0, 0, At, B0); PG8_MMA(0, 1, At, B1); PG8_BAR; PG8_SCHED;
            PG8_LDA(At, 1, 1); PG8_STAGE(PG8_SB(1, 0), b3, voffB); PG8_STAGE(PG8_SB(1, 1), b3 + hstep, voffB); PG8_STAGE(PG8_SA(1, 0), a3, voffA);
            PG8_WAIT_V(8); PG8_WAIT_L(0); PG8_BAR; PG8_MMA(1, 0, At, B0); PG8_MMA(1, 1, At, B1); PG8_BAR; PG8_SCHED;
            } else {
            PG8_LDB(B0, 0, 0); PG8_SCHED; PG8_LDA(At, 0, 0); PG8_STAGE(PG8_SA(1, 1), a1 + hstep, voffA);
            PG8_WAIT_L(8); PG8_BAR; PG8_WAIT_L(0); PG8_MMA(0, 0, At, B0); PG8_BAR; PG8_SCHED;
            PG8_LDB(B1, 0, 1); PG8_STAGE(PG8_SB(0, 0), b2, voffB);
            PG8_BAR; PG8_WAIT_L(0); PG8_MMA(0, 1, At, B1); PG8_BAR;
            PG8_LDA(At, 0, 1); PG8_STAGE(PG8_SA(0, 0), a2, voffA);
            PG8_BAR; PG8_WAIT_L(0); PG8_MMA(1, 0, At, B0); PG8_BAR; PG8_SCHED;
            PG8_STAGE(PG8_SB(0, 1), b2 + hstep, voffB);
            PG8_WAIT_V(6); PG8_BAR; PG8_MMA(1, 1, At, B1); PG8_BAR;
            PG8_LDB(B0, 1, 0); PG8_SCHED; PG8_LDA(At, 1, 0); PG8_STAGE(PG8_SA(0, 1), a2 + hstep, voffA);
            PG8_WAIT_L(8); PG8_BAR; PG8_WAIT_L(0); PG8_MMA(0, 0, At, B0); PG8_BAR; PG8_SCHED;
            PG8_LDB(B1, 1, 1); PG8_STAGE(PG8_SB(1, 0), b3, voffB);
            PG8_BAR; PG8_WAIT_L(0); PG8_MMA(0, 1, At, B1); PG8_BAR;
            PG8_LDA(At, 1, 1); PG8_STAGE(PG8_SA(1, 0), a3, voffA);
            PG8_BAR; PG8_WAIT_L(0); PG8_MMA(1, 0, At, B0); PG8_BAR; PG8_SCHED;
            PG8_STAGE(PG8_SB(1, 1), b3 + hstep, voffB);
            PG8_WAIT_V(6); PG8_BAR; PG8_MMA(1, 1, At, B1); PG8_BAR;
            }
        }
        if constexpr (ALIGN_EPI) { if (wr == 0) PG8_BAR; }
        if constexpr (!Epi::AFTER_DRAIN) { E(acc, cur, wr, wc, fr, fq); S.done(cur); }
        if (!has_next) break;
#pragma unroll
        for (int a = 0; a < 2; ++a)
#pragma unroll
            for (int b = 0; b < 2; ++b)
#pragma unroll
                for (int m = 0; m < 4; ++m)
#pragma unroll
                    for (int n = 0; n < 2; ++n) acc[a][b][m][n] = (f32x4){0.f, 0.f, 0.f, 0.f};
        cur = nxt; cA = nA; cB = nB; ++ui;
        if constexpr (ALIGN_EPI) { if (wr == 1) PG8_BAR; }
    }
    PG8_WAIT_V(0);
    if constexpr (!ALIGN_EPI) { if (wr == 0) PG8_BAR; }
    PG8_BAR;
    if constexpr (Epi::AFTER_DRAIN) { E.fused(acc, cur, wr, wc, fr, fq, lds, wid, lane); S.done(cur); }
#undef PG8_SA
#undef PG8_SB
#undef PG8_STAGE
#undef PG8_LDA
#undef PG8_LDB
#undef PG8_MMA
#undef PG8_WAIT_V
#undef PG8_WAIT_L
#undef PG8_BAR
#undef PG8_SCHED
}
}

constexpr int BATCH = 4, T = 4096, D = 1024, M = BATCH * T;
constexpr int NAB = 3072;
constexpr int FF = 2816, NCD = 3584, CDO = 1536, FFE = 3584, NE = 8;
constexpr int MPAD = 2 * M + NE * 256;
constexpr int MAXT = MPAD / 256;
constexpr int C_QA = 0, C_KA = 512, C_VA = 640, C_QKVB = 768, C_GATEB = 2304, C_BETA = 2816, C_AB = 2824;
constexpr int C_XC = 0, C_YC = 1024, C_BD = 2048, C_CD = 2560, C_HD = 3072;
constexpr size_t MiB = 1u << 20;
constexpr size_t WS_CTL = 0, CTL_ZERO_BYTES = 1 * MiB;
constexpr size_t WS_MOD = 1 * MiB;
constexpr size_t WS_ROUTE = 1 * MiB + 256 * 1024;
constexpr size_t WS_WAB_IN = 2 * MiB, WS_WAB_OUT = 8 * MiB, WS_WFFN_GU = 10 * MiB, WS_WFFN_D = 21 * MiB, WS_WCD_IN = 27 * MiB, WS_WCD_OUT = 34 * MiB, WS_WLRU = 37 * MiB;
constexpr size_t WS_WMOE_GU = 38 * MiB, WS_WMOE_D = 150 * MiB;
constexpr size_t WS_ACT = 206 * MiB;
constexpr size_t WS_END = 512 * MiB;
constexpr size_t A_A = 0, A_P = 32 * MiB, A_MIXA = 128 * MiB, A_DNQ = 160 * MiB, A_DNK = 192 * MiB, A_DNV = 224 * MiB, A_DNB = 256 * MiB, A_DNG = 257 * MiB;
constexpr size_t A_H = 160 * MiB;
constexpr size_t A_MIXB = 144 * MiB, A_XC = 192 * MiB;
constexpr size_t A_A3P = 0, A_HM = 68 * MiB, A_Y = 0;
constexpr size_t WS_A3 = 2 * MiB;
constexpr size_t WS_LA = 38 * MiB, WS_LB = 102 * MiB;
constexpr size_t R_IDX = 0, R_W = 128 * 1024, R_SLOT = 256 * 1024, R_GATEW = 384 * 1024, R_TILEE = 528 * 1024, R_OFF = 532 * 1024;
constexpr int CW_CNT = 1024, CW_CUR = 1024 + 64;

typedef unsigned short bf16;
typedef float f32x4 __attribute__((ext_vector_type(4)));
typedef unsigned v4u __attribute__((ext_vector_type(4)));
typedef unsigned v2u __attribute__((ext_vector_type(2)));
__device__ __forceinline__ unsigned f2bf(float f) { unsigned u = __builtin_bit_cast(unsigned, f); return (u + 0x7fffu + ((u >> 16) & 1u)) >> 16; }
__device__ __forceinline__ unsigned pk2(float lo, float hi) { return f2bf(lo) | (f2bf(hi) << 16); }
__device__ __forceinline__ float bf2f(unsigned short b) { return __builtin_bit_cast(float, (unsigned)b << 16); }
__device__ __forceinline__ float bflo(unsigned w) { return __builtin_bit_cast(float, w << 16); }
__device__ __forceinline__ float bfhi(unsigned w) { return __builtin_bit_cast(float, w & 0xffff0000u); }
__device__ __forceinline__ float wave_sum(float v) {
#pragma unroll
    for (int o = 1; o < 64; o <<= 1) v += __shfl_xor(v, o);
    return v;
}
__device__ __forceinline__ float sigmoidf_(float x) { return 1.0f / (1.0f + __expf(-x)); }
__device__ __forceinline__ float siluf_(float x) { return x / (1.0f + __expf(-x)); }
__device__ __forceinline__ float softplusf_(float x) { return fmaxf(x, 0.f) + log1pf(__expf(-fabsf(x))); }
__device__ __forceinline__ float gelu_tanhf_(float x) { const float u = 0.7978845608028654f * (x + 0.044715f * x * x * x); return 0.5f * x * (1.0f + tanhf(u)); }

__device__ const unsigned char T5_BUCKET[128] = {0, 1, 2, 3, 4, 5, 6, 7, 8, 9, 10, 11, 12, 13, 14, 15, 16, 16, 16, 17, 17, 18, 18, 18, 19, 19, 19, 20, 20, 20, 20, 21, 21, 21, 21, 22, 22, 22, 22, 22, 23, 23, 23, 23, 23, 23, 24, 24, 24, 24, 24, 24, 25, 25, 25, 25, 25, 25, 25, 26, 26, 26, 26, 26, 26, 26, 26, 27, 27, 27, 27, 27, 27, 27, 27, 27, 27, 28, 28, 28, 28, 28, 28, 28, 28, 28, 28, 29, 29, 29, 29, 29, 29, 29, 29, 29, 29, 29, 29, 30, 30, 30, 30, 30, 30, 30, 30, 30, 30, 30, 30, 30, 30, 31, 31, 31, 31, 31, 31, 31, 31, 31, 31, 31, 31, 31, 31, 31};

struct Params { const float* in[33]; float* out; unsigned char* ws; };
enum { I_X = 0, I_C, I_RELB, I_ADAW, I_ADAB, I_NMIX, I_NFFN, I_NFIN, I_ABIN, I_SINK, I_DNCONV, I_ALOG, I_DTB, I_DNNORM, I_ABOUT, I_FG, I_FU, I_FD, I_CDIN, I_LCW, I_LCB, I_GAW, I_GAB, I_GXW, I_GXB, I_LAM, I_SCW, I_CDOUT, I_RW, I_RB, I_MG, I_MU, I_MD };


#define LAS __attribute__((address_space(3)))
#define XB_TMO      128
#define XB_XCNT(j)  (256  + 64 * (j))
#define XB_XSUB(j)  (1280 + 64 * (j))
#define XB_XGEN(j)  (2304 + 64 * (j))
#define XB_TOP      3328
#define XB_TOPGEN   3392
#define XCD_BAR_WORDS 3456
#define XB_SPIN_CAP (1u << 18)

__device__ __forceinline__ unsigned xb_ld(unsigned* p)              { return __hip_atomic_load(p, __ATOMIC_RELAXED, __HIP_MEMORY_SCOPE_AGENT); }
__device__ __forceinline__ unsigned xb_add(unsigned* p, unsigned v) { return __hip_atomic_fetch_add(p, v, __ATOMIC_RELAXED, __HIP_MEMORY_SCOPE_AGENT); }
__device__ __forceinline__ unsigned xb_xcc_id() { return (unsigned)__builtin_amdgcn_s_getreg((3 << 11) | 20) & 0xFu; }
#define XB_SPIN(cond, bar) do { unsigned _sp = 0; while (cond) { __builtin_amdgcn_s_sleep(1); \
    if ((++_sp & 255u) == 0u) { if (xb_ld(&(bar)[XB_TMO])) break; if (_sp > XB_SPIN_CAP) { atomicAdd(&(bar)[XB_TMO], 1u); break; } } } } while (0)

struct XcdBarrier {
    unsigned* bar; unsigned x;
    volatile LAS unsigned* st;
};
__device__ __forceinline__ XcdBarrier xcd_barrier_post(unsigned* bar, volatile LAS unsigned* st) {
    XcdBarrier b; b.bar = bar; b.x = xb_xcc_id(); b.st = st;
    if (threadIdx.x == 0) (void)xb_add(&bar[XB_XCNT(b.x)], 1u);
    return b;
}
__device__ __forceinline__ void xcd_barrier_complete(unsigned* bar, unsigned x, unsigned& nloc, unsigned& nx) {
    const unsigned G = gridDim.x * gridDim.y * gridDim.z;
    unsigned sum, cnt, mine, sp = 0u;
    for (;;) {
        sum = 0u; cnt = 0u; mine = 0u;
#pragma unroll
        for (unsigned j = 0; j < 16; ++j) { const unsigned c = xb_ld(&bar[XB_XCNT(j)]); sum += c; cnt += (c > 0u) ? 1u : 0u; mine = (j == x) ? c : mine; }
        if (sum == G) break;
        __builtin_amdgcn_s_sleep(1);
        if ((++sp & 255u) == 0u) { if (xb_ld(&bar[XB_TMO])) break; if (sp > XB_SPIN_CAP) { atomicAdd(&bar[XB_TMO], 1u); break; } }
    }
    nloc = mine > 0u ? mine : 1u; nx = cnt > 0u ? cnt : 1u;
}
__device__ __forceinline__ void xcd_barrier(const XcdBarrier& b) {
    asm volatile("s_waitcnt vmcnt(0)" ::: "memory");
    __syncthreads();
    if (threadIdx.x == 0) {
        unsigned* bar = b.bar;
        __builtin_amdgcn_s_waitcnt(0);
        unsigned nloc = b.st[0], nx = b.st[1];
        if (nloc == 0u) { xcd_barrier_complete(bar, b.x, nloc, nx); b.st[0] = nloc; b.st[1] = nx; }
        const unsigned old = xb_add(&bar[XB_XSUB(b.x)], 1u);
        const unsigned gen = old / nloc;
        if (old + 1u == (gen + 1u) * nloc) {
            __builtin_amdgcn_fence(__ATOMIC_RELEASE, "agent");
            asm volatile("s_waitcnt vmcnt(0)" ::: "memory");
            const unsigned og = xb_add(&bar[XB_TOP], 1u);
            const unsigned tg = og / nx;
            if (og + 1u == (tg + 1u) * nx) xb_add(&bar[XB_TOPGEN], 1u);
            else XB_SPIN(xb_ld(&bar[XB_TOPGEN]) == tg, bar);
            __builtin_amdgcn_fence(__ATOMIC_ACQUIRE, "agent");
            xb_add(&bar[XB_XGEN(b.x)], 1u);
            asm volatile("s_waitcnt vmcnt(0)" ::: "memory");
        } else {
            XB_SPIN(xb_ld(&bar[XB_XGEN(b.x)]) == gen, bar);
            __builtin_amdgcn_fence(__ATOMIC_ACQUIRE, "agent");
            asm volatile("s_waitcnt vmcnt(0)" ::: "memory");
        }
    }
    __syncthreads();
}

constexpr int NWAVES = 8, NTHR = 512;
constexpr int LDS_MISC = 131072, LDS_BYTES = 131072 + 1024;
constexpr int CW_BAR = 4096;
struct ConvDesc { const float* src; bf16* dst; long long sstride, dstride; int K, N, Npad, mode, row_off, nbatch, items_pb, item0; };
struct ConvTab { ConvDesc d[8]; int nd, total, pad0, pad1; };
struct MArgs { Params p; ConvTab t1, t2; int ph_lo, ph_hi, pad0, pad1; };
struct Ctx { LAS unsigned char* lds; int tid, lane, wave, G, bid, gw, NGW; };

__device__ __forceinline__ void transpose_item(const float* W, int K, int N, bf16* WT, int mode, int row_off, LAS float* scr, int kb, int nb, int lane) {
    const int k0 = 64 * kb, n0 = 32 * nb; const int nn = n0 + (lane & 31);
#pragma unroll 8
    for (int i = 0; i < 32; ++i) { const int kk = 2 * i + (lane >> 5); scr[kk * 33 + (lane & 31)] = nn < N ? W[(size_t)(k0 + kk) * N + nn] : 0.f; }
    asm volatile("s_waitcnt lgkmcnt(0)" ::: "memory");
    const int c = lane & 7;
#pragma unroll
    for (int j = 0; j < 4; ++j) { const int n = (lane >> 3) + 8 * j; const LAS float* s = scr + (8 * c) * 33 + n;
        v4u o; o.x = pk2(s[0 * 33], s[1 * 33]); o.y = pk2(s[2 * 33], s[3 * 33]); o.z = pk2(s[4 * 33], s[5 * 33]); o.w = pk2(s[6 * 33], s[7 * 33]);
        const int ng = n0 + n; const int drow = (mode == 1 ? ((ng >> 7) << 8) + (ng & 127) : ng) + row_off;
        *(v4u*)(WT + (size_t)drow * K + k0 + 8 * c) = o; }
    asm volatile("s_waitcnt lgkmcnt(0)" ::: "memory");
}
__device__ __forceinline__ void ph_convert(const Ctx& c, const ConvTab& tab) {
    LAS float* scr = (LAS float*)(c.lds + c.wave * 8448);
    for (int it = c.gw; it < tab.total; it += c.NGW) {
        int j = 0;
        for (int q = 1; q < tab.nd; ++q) if (it >= tab.d[q].item0) j = q;
        const ConvDesc& d = tab.d[j]; const int r = it - d.item0; const int batch = r / d.items_pb, item = r % d.items_pb; const int nblk = d.Npad / 32;
        transpose_item(d.src + (size_t)batch * d.sstride, d.K, d.N, d.dst + (size_t)batch * d.dstride, d.mode, d.row_off, scr, item / nblk, item % nblk, c.lane);
    }
}
__device__ __forceinline__ void ph_ada(const Ctx& c, const Params& p) {
    LAS float* part = (LAS float*)(c.lds + 69632);
    for (int it = c.bid; it < 192; it += c.G) {
        const int l = it / 96, j = (it % 96) * 64 + c.lane; const float* w = p.in[I_ADAW] + (size_t)l * 1024 * 6144 + j; const float* cc = p.in[I_C];
        float a0 = 0.f, a1 = 0.f, a2 = 0.f, a3 = 0.f;
        for (int k = c.wave * 128; k < c.wave * 128 + 128; ++k) { const float wv = w[(size_t)k * 6144];
            a0 += siluf_(cc[k]) * wv; a1 += siluf_(cc[1024 + k]) * wv; a2 += siluf_(cc[2048 + k]) * wv; a3 += siluf_(cc[3072 + k]) * wv; }
        part[(c.wave * 4 + 0) * 64 + c.lane] = a0; part[(c.wave * 4 + 1) * 64 + c.lane] = a1; part[(c.wave * 4 + 2) * 64 + c.lane] = a2; part[(c.wave * 4 + 3) * 64 + c.lane] = a3;
        __syncthreads();
        if (c.wave < 4) { float s = 0.f;
#pragma unroll
            for (int w8 = 0; w8 < 8; ++w8) s += part[(w8 * 4 + c.wave) * 64 + c.lane];
            ((float*)(p.ws + WS_MOD))[(size_t)l * 4 * 6144 + (size_t)c.wave * 6144 + j] = s + p.in[I_ADAB][l * 6144 + j]; }
        __syncthreads();
    }
}
template <bool ROUTER>
__device__ __forceinline__ void norm_row(const float* xrow, bf16* orow, const float* w, const float* sc, const float* sh, int lane, const float* rw, const float* rb, int m, unsigned char* ws) {
    const f32x4* xr = (const f32x4*)xrow + lane; f32x4 v[4]; float s = 0.f;
#pragma unroll
    for (int j = 0; j < 4; ++j) { v[j] = xr[64 * j]; s += (v[j].x * v[j].x + v[j].y * v[j].y) + (v[j].z * v[j].z + v[j].w * v[j].w); }
    const float rstd = 1.0f / sqrtf(wave_sum(s) * (1.f / D) + 1e-6f);
    float lg[8];
    if (ROUTER) {
#pragma unroll
        for (int e = 0; e < 8; ++e) lg[e] = 0.f;
    }
    unsigned long long* o8 = (unsigned long long*)orow + lane;
#pragma unroll
    for (int j = 0; j < 4; ++j) { const int c = 4 * lane + 256 * j; const f32x4 wv = *(const f32x4*)(w + c), scv = *(const f32x4*)(sc + c), shv = *(const f32x4*)(sh + c);
        f32x4 y = v[j] * rstd * wv * (scv + 1.0f) + shv;
        if (ROUTER) {
#pragma unroll
            for (int i = 0; i < 4; ++i) { const f32x4 r0 = *(const f32x4*)(rw + (size_t)(c + i) * 8), r1 = *(const f32x4*)(rw + (size_t)(c + i) * 8 + 4);
                lg[0] += y[i] * r0.x; lg[1] += y[i] * r0.y; lg[2] += y[i] * r0.z; lg[3] += y[i] * r0.w; lg[4] += y[i] * r1.x; lg[5] += y[i] * r1.y; lg[6] += y[i] * r1.z; lg[7] += y[i] * r1.w; }
        }
        o8[64 * j] = (unsigned long long)pk2(y.x, y.y) | ((unsigned long long)pk2(y.z, y.w) << 32); }
    if (ROUTER) {
#pragma unroll
        for (int e = 0; e < 8; ++e) lg[e] = wave_sum(lg[e]) + rb[e];
        int b0 = 0; float v0 = lg[0];
#pragma unroll
        for (int e = 1; e < 8; ++e) if (lg[e] > v0) { v0 = lg[e]; b0 = e; }
        int b1 = -1; float v1 = -3.0e38f;
#pragma unroll
        for (int e = 0; e < 8; ++e) if (e != b0 && lg[e] > v1) { v1 = lg[e]; b1 = e; }
        const float e1 = __expf(v1 - v0), w0 = 1.0f / (1.0f + e1), w1 = e1 / (1.0f + e1);
        if (lane == 0) { int* idx = (int*)(ws + WS_ROUTE + R_IDX); float* tw = (float*)(ws + WS_ROUTE + R_W); idx[2 * m] = b0; idx[2 * m + 1] = b1; tw[2 * m] = w0; tw[2 * m + 1] = w1;
            unsigned* cnt = (unsigned*)(ws + WS_CTL) + CW_CNT; atomicAdd(cnt + b0, 1u); atomicAdd(cnt + b1, 1u); }
    }
}
template <int WHICH>
__device__ __forceinline__ void ph_norm(const Ctx& c, const Params& p) {
    const int l = WHICH >> 1, f = WHICH & 1;
    const float* src = WHICH == 0 ? p.in[I_X] : p.out; bf16* dst = (bf16*)(p.ws + (WHICH == 3 ? WS_A3 : WS_ACT + A_A));
    const float* w = p.in[f ? I_NFFN : I_NMIX] + l * D; const float* mod = (const float*)(p.ws + WS_MOD) + (size_t)l * 4 * 6144;
    for (int m = c.gw; m < M; m += c.NGW) { const int b = m >> 12; const float* mb = mod + (size_t)b * 6144 + (f ? 3 * D : 0);
        norm_row<WHICH == 3>(src + (size_t)m * D, dst + (size_t)m * D, w, mb + D, mb, c.lane, p.in[I_RW], p.in[I_RB], m, p.ws); }
}

enum { G_ABIN = 0, G_ABOUT, G_FFNGU, G_FFND, G_CDIN, G_CDOUT, G_MOEGU, G_MOED };
template <int WHICH>
__device__ __forceinline__ void ph_gemm(const Ctx& cx, const Params& p) {
    PG8_LAS unsigned char* lds = (PG8_LAS unsigned char*)cx.lds;
    unsigned char* ws = p.ws; unsigned char* act = ws + WS_ACT; const float* mod = (const float*)(ws + WS_MOD);
    const int G = cx.G, c = cx.bid;
    if constexpr (WHICH == G_ABIN) { pg8::Gemm g{(const bf16*)(act + A_A), (const bf16*)(ws + WS_WAB_IN), M, NAB, D, 0}; pg8::StaticOrder S; S.init(M, NAB, G, c);
        pg8::EpiStoreBf16 E{(bf16*)(act + A_P), NAB, nullptr}; pg8::gemm_phase<pg8::EpiStoreBf16, pg8::StaticOrder, true, true>(lds, g, S, E); }
    if constexpr (WHICH == G_ABOUT) { pg8::Gemm g{(const bf16*)(act + A_MIXA), (const bf16*)(ws + WS_WAB_OUT), M, D, D, 0}; pg8::StaticOrder S; S.init(M, D, G, c);
        pg8::EpiRes E{p.in[I_X], p.out, D, mod + 2 * D}; pg8::gemm_phase<pg8::EpiRes, pg8::StaticOrder, true, true>(lds, g, S, E); }
    if constexpr (WHICH == G_FFNGU) { pg8::Gemm g{(const bf16*)(act + A_A), (const bf16*)(ws + WS_WFFN_GU), M, 2 * FF, D, 0}; pg8::StaticOrder S; S.init(M, 2 * FF, G, c);
        pg8::EpiSwiglu E{(bf16*)(act + A_H), FF}; pg8::gemm_phase<pg8::EpiSwiglu, pg8::StaticOrder, true, true>(lds, g, S, E); }
    if constexpr (WHICH == G_FFND) { pg8::Gemm g{(const bf16*)(act + A_H), (const bf16*)(ws + WS_WFFN_D), M, D, FF, 0}; pg8::StaticOrder S; S.init(M, D, G, c);
        pg8::EpiRes E{p.out, p.out, D, mod + 5 * D}; pg8::gemm_phase<pg8::EpiRes, pg8::StaticOrder, true, true>(lds, g, S, E); }
    if constexpr (WHICH == G_CDIN) { pg8::Gemm g{(const bf16*)(act + A_A), (const bf16*)(ws + WS_WCD_IN), M, NCD, D, 0}; pg8::StaticOrder S; S.init(M, NCD, G, c);
        pg8::EpiStoreBf16 E{(bf16*)(act + A_P), NCD, nullptr}; pg8::gemm_phase<pg8::EpiStoreBf16, pg8::StaticOrder, true, true>(lds, g, S, E); }
    if constexpr (WHICH == G_CDOUT) { pg8::Gemm g{(const bf16*)(act + A_MIXB), (const bf16*)(ws + WS_WCD_OUT), M, D, CDO, 0}; pg8::StaticOrder S; S.init(M, D, G, c);
        pg8::EpiRes E{p.out, p.out, D, mod + 4 * 6144 + 2 * D}; pg8::gemm_phase<pg8::EpiRes, pg8::StaticOrder, true, true>(lds, g, S, E); }
    if constexpr (WHICH == G_MOEGU) { const int* off = (const int*)(ws + WS_ROUTE + R_OFF); const int nMt = __builtin_amdgcn_readfirstlane(off[8]) >> 8;
        pg8::Gemm g{(const bf16*)(act + A_A3P), (const bf16*)(ws + WS_WMOE_GU), nMt * 256, 2 * FFE, D, (size_t)2 * FFE * D * 2}; pg8::GroupedOrder S; S.init(nMt, 2 * FFE, G, c, (const int*)(ws + WS_ROUTE + R_TILEE));
        pg8::EpiSwiglu E{(bf16*)(act + A_HM), FFE}; pg8::gemm_phase<pg8::EpiSwiglu, pg8::GroupedOrder, true, true>(lds, g, S, E); }
    if constexpr (WHICH == G_MOED) { const int* off = (const int*)(ws + WS_ROUTE + R_OFF); const int nMt = __builtin_amdgcn_readfirstlane(off[8]) >> 8;
        pg8::Gemm g{(const bf16*)(act + A_HM), (const bf16*)(ws + WS_WMOE_D), nMt * 256, D, FFE, (size_t)D * FFE * 2}; pg8::GroupedOrder S; S.init(nMt, D, G, c, (const int*)(ws + WS_ROUTE + R_TILEE));
        pg8::EpiStoreBf16 E{(bf16*)(act + A_Y), D, (const float*)(ws + WS_ROUTE + R_GATEW)}; pg8::gemm_phase<pg8::EpiStoreBf16, pg8::GroupedOrder, true, true>(lds, g, S, E); }
}

__device__ __forceinline__ void ph_attn_naive(const Ctx& c, const Params& p) {
    const bf16* P0 = (const bf16*)(p.ws + WS_ACT + A_P); const float* relb = p.in[I_RELB];
    for (int gid = c.bid * NTHR + c.tid; gid < M * 8; gid += c.G * NTHR) {
        const int m = gid >> 3, h = gid & 7, t = m & (T - 1), kvh = h >> 2;
        float q[64], o[64];
        { const v4u* qp = (const v4u*)(P0 + (size_t)m * NAB + C_QA + h * 64);
#pragma unroll
          for (int i = 0; i < 8; ++i) { const v4u w = qp[i]; q[8 * i + 0] = bflo(w.x) * 0.125f; q[8 * i + 1] = bfhi(w.x) * 0.125f; q[8 * i + 2] = bflo(w.y) * 0.125f; q[8 * i + 3] = bfhi(w.y) * 0.125f;
              q[8 * i + 4] = bflo(w.z) * 0.125f; q[8 * i + 5] = bfhi(w.z) * 0.125f; q[8 * i + 6] = bflo(w.w) * 0.125f; q[8 * i + 7] = bfhi(w.w) * 0.125f; } }
#pragma unroll
        for (int i = 0; i < 64; ++i) o[i] = 0.f;
        float mx = p.in[I_SINK][h], l = 1.0f;
        const int nd = t + 1 < 128 ? t + 1 : 128;
        for (int dd = 0; dd < nd; ++dd) {
            const bf16* kr = P0 + (size_t)(m - dd) * NAB + C_KA + kvh * 64; const bf16* vr = P0 + (size_t)(m - dd) * NAB + C_VA + kvh * 64;
            float s = 0.f;
#pragma unroll
            for (int i = 0; i < 8; ++i) { const v4u w = ((const v4u*)kr)[i];
                s += q[8 * i + 0] * bflo(w.x) + q[8 * i + 1] * bfhi(w.x) + q[8 * i + 2] * bflo(w.y) + q[8 * i + 3] * bfhi(w.y) + q[8 * i + 4] * bflo(w.z) + q[8 * i + 5] * bfhi(w.z) + q[8 * i + 6] * bflo(w.w) + q[8 * i + 7] * bfhi(w.w); }
            s += relb[T5_BUCKET[dd] * 8 + h];
            const float mn = fmaxf(mx, s), sc = __expf(mx - mn), pp = __expf(s - mn);
            l = l * sc + pp; mx = mn;
#pragma unroll
            for (int i = 0; i < 8; ++i) { const v4u w = ((const v4u*)vr)[i];
                o[8 * i + 0] = o[8 * i + 0] * sc + pp * bflo(w.x); o[8 * i + 1] = o[8 * i + 1] * sc + pp * bfhi(w.x); o[8 * i + 2] = o[8 * i + 2] * sc + pp * bflo(w.y); o[8 * i + 3] = o[8 * i + 3] * sc + pp * bfhi(w.y);
                o[8 * i + 4] = o[8 * i + 4] * sc + pp * bflo(w.z); o[8 * i + 5] = o[8 * i + 5] * sc + pp * bfhi(w.z); o[8 * i + 6] = o[8 * i + 6] * sc + pp * bflo(w.w); o[8 * i + 7] = o[8 * i + 7] * sc + pp * bfhi(w.w); }
        }
        const float inv = 1.0f / l;
        v4u* op = (v4u*)((bf16*)(p.ws + WS_ACT + A_MIXA) + (size_t)m * D + h * 64);
#pragma unroll
        for (int i = 0; i < 8; ++i) { v4u w; w.x = pk2(o[8 * i] * inv, o[8 * i + 1] * inv); w.y = pk2(o[8 * i + 2] * inv, o[8 * i + 3] * inv); w.z = pk2(o[8 * i + 4] * inv, o[8 * i + 5] * inv); w.w = pk2(o[8 * i + 6] * inv, o[8 * i + 7] * inv); op[i] = w; }
    }
}

__device__ __forceinline__ void ph_dn_prep(const Ctx& c, const Params& p) {
    const bf16* P0 = (const bf16*)(p.ws + WS_ACT + A_P); const float* cw = p.in[I_DNCONV]; unsigned char* act = p.ws + WS_ACT; const int lane = c.lane;
    for (int it = c.gw; it < M * 8; it += c.NGW) {
        const int m = it >> 3, h = it & 7, t = m & (T - 1);
        float r[3];
#pragma unroll
        for (int s = 0; s < 3; ++s) { const int ch = s * 512 + h * 64 + lane; float a = 0.f;
#pragma unroll
            for (int k = 0; k < 4; ++k) { const int tt = t - 3 + k; if (tt >= 0) a += cw[k * 1536 + ch] * bf2f(P0[(size_t)(m - 3 + k) * NAB + C_QKVB + ch]); }
            r[s] = siluf_(a); }
        const float nq = 1.0f / sqrtf(wave_sum(r[0] * r[0]) + 1e-6f), nk = 1.0f / sqrtf(wave_sum(r[1] * r[1]) + 1e-6f);
        ((float*)(act + A_DNQ))[(size_t)m * 512 + h * 64 + lane] = r[0] * nq;
        ((float*)(act + A_DNK))[(size_t)m * 512 + h * 64 + lane] = r[1] * nk;
        ((float*)(act + A_DNV))[(size_t)m * 512 + h * 64 + lane] = r[2];
        if (lane == 0) { const float bb = bf2f(P0[(size_t)m * NAB + C_BETA + h]), ab = bf2f(P0[(size_t)m * NAB + C_AB + h]);
            ((float*)(act + A_DNB))[m * 8 + h] = sigmoidf_(bb);
            ((float*)(act + A_DNG))[m * 8 + h] = -__expf(p.in[I_ALOG][h]) * softplusf_(ab + p.in[I_DTB][h]); }
    }
}
__device__ __forceinline__ void ph_dn_scan(const Ctx& c, const Params& p) {
    if (c.wave != 0 || c.bid >= 32) return;
    LAS float* kq = (LAS float*)c.lds;
    const int b = c.bid >> 3, h = c.bid & 7, e = c.lane;
    unsigned char* act = p.ws + WS_ACT; const bf16* P0 = (const bf16*)(act + A_P);
    const float* Q = (const float*)(act + A_DNQ); const float* K = (const float*)(act + A_DNK); const float* V = (const float*)(act + A_DNV);
    const float* Bt = (const float*)(act + A_DNB); const float* Gt = (const float*)(act + A_DNG);
    const float nw = p.in[I_DNNORM][e];
    float S[64];
#pragma unroll
    for (int d = 0; d < 64; ++d) S[d] = 0.f;
    for (int t = 0; t < T; ++t) { const int m = b * T + t;
        asm volatile("s_waitcnt lgkmcnt(0)" ::: "memory");
        kq[e] = K[(size_t)m * 512 + h * 64 + e]; kq[64 + e] = Q[(size_t)m * 512 + h * 64 + e];
        const float v = V[(size_t)m * 512 + h * 64 + e], beta = Bt[m * 8 + h], eg = __expf(Gt[m * 8 + h]);
        asm volatile("s_waitcnt lgkmcnt(0)" ::: "memory");
        float kS = 0.f;
#pragma unroll
        for (int d = 0; d < 64; ++d) { S[d] *= eg; kS += kq[d] * S[d]; }
        const float dl = beta * (v - kS); float o = 0.f;
#pragma unroll
        for (int d = 0; d < 64; ++d) { S[d] += kq[d] * dl; o += kq[64 + d] * S[d]; }
        o *= 0.125f;
        const float rs = 1.0f / sqrtf(wave_sum(o * o) * (1.f / 64.f) + 1e-6f);
        const float gt = bf2f(P0[(size_t)m * NAB + C_GATEB + h * 64 + e]);
        ((bf16*)(act + A_MIXA))[(size_t)m * D + 512 + h * 64 + e] = (bf16)f2bf(o * rs * nw * siluf_(gt));
    }
}

__device__ __forceinline__ void ph_lru_conv(const Ctx& c, const Params& p) {
    const bf16* P1 = (const bf16*)(p.ws + WS_ACT + A_P); const float* cw = p.in[I_LCW];
    for (size_t gid = (size_t)c.bid * NTHR + c.tid; gid < (size_t)M * 1024; gid += (size_t)c.G * NTHR) {
        const int m = (int)(gid >> 10), ch = (int)(gid & 1023), t = m & (T - 1); float a = p.in[I_LCB][ch];
#pragma unroll
        for (int k = 0; k < 4; ++k) { const int tt = t - 3 + k; if (tt >= 0) a += cw[k * 1024 + ch] * bf2f(P1[(size_t)(m - 3 + k) * NCD + C_XC + ch]); }
        ((float*)(p.ws + WS_ACT + A_XC))[gid] = a; }
}
__device__ __forceinline__ void ph_lru_gates(const Ctx& c, const Params& p) {
    LAS float* xs = (LAS float*)(c.lds + c.wave * 512);
    const float* XC = (const float*)(p.ws + WS_ACT + A_XC);
    for (int it = c.gw; it < M * 8; it += c.NGW) { const int m = it >> 3, n = it & 7;
        asm volatile("s_waitcnt lgkmcnt(0)" ::: "memory");
        xs[c.lane] = XC[(size_t)m * 1024 + n * 128 + c.lane]; xs[64 + c.lane] = XC[(size_t)m * 1024 + n * 128 + 64 + c.lane];
        asm volatile("s_waitcnt lgkmcnt(0)" ::: "memory");
#pragma unroll
        for (int hh = 0; hh < 2; ++hh) { const int j = c.lane + 64 * hh, ch = n * 128 + j;
            const float* ga = p.in[I_GAW] + (size_t)n * 128 * 128 + j; const float* gx = p.in[I_GXW] + (size_t)n * 128 * 128 + j;
            float ra = 0.f, rx = 0.f;
            for (int i = 0; i < 128; ++i) { ra += xs[i] * ga[i * 128]; rx += xs[i] * gx[i * 128]; }
            const float r = sigmoidf_(ra + p.in[I_GAB][ch]), ii = sigmoidf_(rx + p.in[I_GXB][ch]);
            const float log_a = -8.0f * r * softplusf_(-p.in[I_LAM][ch]);
            ((float*)(p.ws + WS_LA))[(size_t)m * 1024 + ch] = __expf(log_a);
            ((float*)(p.ws + WS_LB))[(size_t)m * 1024 + ch] = sqrtf(-expm1f(2.0f * log_a)) * (ii * xs[j]); }
    }
}
__device__ __forceinline__ void ph_lru_scan(const Ctx& c, const Params& p) {
    if (c.wave != 0 || c.bid >= 64) return;
    const int gid = c.bid * 64 + c.lane, b = gid >> 10, ch = gid & 1023;
    const float* LA = (const float*)(p.ws + WS_LA); const float* LB = (const float*)(p.ws + WS_LB);
    const bf16* P1 = (const bf16*)(p.ws + WS_ACT + A_P); bf16* MIXB = (bf16*)(p.ws + WS_ACT + A_MIXB);
    float hs = 0.f;
    for (int t = 0; t < T; ++t) { const size_t m = (size_t)b * T + t; hs = LA[m * 1024 + ch] * hs + LB[m * 1024 + ch];
        MIXB[m * CDO + ch] = (bf16)f2bf(hs * gelu_tanhf_(bf2f(P1[m * NCD + C_YC + ch]))); }
}
__device__ __forceinline__ void ph_sconv(const Ctx& c, const Params& p) {
    const bf16* P1 = (const bf16*)(p.ws + WS_ACT + A_P); const float* sw = p.in[I_SCW];
    for (size_t gid = (size_t)c.bid * NTHR + c.tid; gid < (size_t)M * 512; gid += (size_t)c.G * NTHR) {
        const int m = (int)(gid >> 9), ch = (int)(gid & 511), t = m & (T - 1); float a = 0.f;
#pragma unroll
        for (int k = 0; k < 3; ++k) { const int tt = t - 2 + k; if (tt >= 0) { const size_t r = (size_t)(m - 2 + k) * NCD; a += sw[k * 512 + ch] * (bf2f(P1[r + C_CD + ch]) * bf2f(P1[r + C_HD + ch])); } }
        ((bf16*)(p.ws + WS_ACT + A_MIXB))[(size_t)m * CDO + 1024 + ch] = (bf16)f2bf(bf2f(P1[(size_t)m * NCD + C_BD + ch]) * a); }
}

__device__ __forceinline__ void ph_route(const Ctx& c, const Params& p) {
    LAS int* loff = (LAS int*)c.lds;
    if (c.tid == 0) { const unsigned* cnt = (const unsigned*)(p.ws + WS_CTL) + CW_CNT; int* off = (int*)(p.ws + WS_ROUTE + R_OFF); int* te = (int*)(p.ws + WS_ROUTE + R_TILEE);
        int o = 0;
        for (int e = 0; e < 8; ++e) { loff[e] = o; const int n = ((int)__hip_atomic_load(cnt + e, __ATOMIC_RELAXED, __HIP_MEMORY_SCOPE_AGENT) + 255) & ~255;
            if (c.bid == 0) { off[e] = o; for (int t = o >> 8; t < (o + n) >> 8 && t < MAXT; ++t) te[t] = e; }
            o += n; }
        loff[8] = o; if (c.bid == 0) off[8] = o < MPAD ? o : MPAD; }
    __syncthreads();
    const int* idx = (const int*)(p.ws + WS_ROUTE + R_IDX); const float* tw = (const float*)(p.ws + WS_ROUTE + R_W); unsigned* cur = (unsigned*)(p.ws + WS_CTL) + CW_CUR;
    for (int it = c.gw; it < 2 * M; it += c.NGW) { const int m = it >> 1; const int e = idx[it]; int pos = 0;
        if (c.lane == 0) pos = loff[e] + (int)atomicAdd(cur + e, 1u);
        pos = __shfl(pos, 0);
        if (c.lane == 0) { ((int*)(p.ws + WS_ROUTE + R_SLOT))[it] = pos; ((float*)(p.ws + WS_ROUTE + R_GATEW))[pos] = tw[it]; }
        const v4u* src = (const v4u*)((const bf16*)(p.ws + WS_A3) + (size_t)m * D); v4u* dst = (v4u*)((bf16*)(p.ws + WS_ACT + A_A3P) + (size_t)pos * D);
        dst[c.lane] = src[c.lane]; dst[c.lane + 64] = src[c.lane + 64]; }
}
__device__ __forceinline__ void ph_final(const Ctx& c, const Params& p) {
    const int lane = c.lane;
    const int* slot = (const int*)(p.ws + WS_ROUTE + R_SLOT); const bf16* Y = (const bf16*)(p.ws + WS_ACT + A_Y);
    const float* mod = (const float*)(p.ws + WS_MOD) + 4 * 6144; const float* fw = p.in[I_NFIN];
    for (int m = c.gw; m < M; m += c.NGW) { const int b = m >> 12; const float* g2 = mod + (size_t)b * 6144 + 5 * D;
        const int s0 = slot[2 * m], s1 = slot[2 * m + 1];
        f32x4* xr = (f32x4*)(p.out + (size_t)m * D) + lane; const v2u* y0 = (const v2u*)(Y + (size_t)s0 * D) + lane; const v2u* y1 = (const v2u*)(Y + (size_t)s1 * D) + lane;
        f32x4 v[4]; float s = 0.f;
#pragma unroll
        for (int j = 0; j < 4; ++j) { const f32x4 gv = *(const f32x4*)(g2 + 4 * lane + 256 * j); const v2u a = y0[64 * j], cc = y1[64 * j];
            f32x4 yy; yy.x = bflo(a.x) + bflo(cc.x); yy.y = bfhi(a.x) + bfhi(cc.x); yy.z = bflo(a.y) + bflo(cc.y); yy.w = bfhi(a.y) + bfhi(cc.y);
            v[j] = xr[64 * j] + gv * yy; s += (v[j].x * v[j].x + v[j].y * v[j].y) + (v[j].z * v[j].z + v[j].w * v[j].w); }
        const float rstd = 1.0f / sqrtf(wave_sum(s) * (1.f / D) + 1e-6f);
#pragma unroll
        for (int j = 0; j < 4; ++j) { const f32x4 wv = *(const f32x4*)(fw + 4 * lane + 256 * j); xr[64 * j] = v[j] * rstd * wv; }
    }
}

__global__ void __launch_bounds__(NTHR, 2) mega(MArgs a) {
    extern __shared__ __attribute__((aligned(16))) unsigned char lds_raw[];
    Ctx c; c.lds = (LAS unsigned char*)lds_raw; c.tid = threadIdx.x; c.lane = c.tid & 63; c.wave = __builtin_amdgcn_readfirstlane(c.tid >> 6);
    c.G = gridDim.x; c.bid = blockIdx.x; c.gw = c.bid * NWAVES + c.wave; c.NGW = c.G * NWAVES;
    const Params& p = a.p;
    volatile LAS unsigned* MISC = (volatile LAS unsigned*)(c.lds + LDS_MISC);
    if (c.tid < 64) MISC[c.tid] = 0u;
    __syncthreads();
    XcdBarrier bar = xcd_barrier_post((unsigned*)(p.ws + WS_CTL) + CW_BAR, MISC);
    const int lo = a.ph_lo, hi = a.ph_hi;
#define IN(k) (lo <= (k) && (k) < hi)
#define SEAM(k) do { if (IN(k) && IN((k) + 1)) xcd_barrier(bar); } while (0)
    if (IN(0)) { ph_convert(c, a.t1); ph_ada(c, p); } SEAM(0);
    if (IN(1)) { ph_norm<0>(c, p); } SEAM(1);
    if (IN(2)) { ph_gemm<G_ABIN>(c, p); } SEAM(2);
    if (IN(3)) { ph_attn_naive(c, p); ph_dn_prep(c, p); } SEAM(3);
    if (IN(4)) { ph_dn_scan(c, p); } SEAM(4);
    if (IN(5)) { ph_gemm<G_ABOUT>(c, p); } SEAM(5);
    if (IN(6)) { ph_norm<1>(c, p); } SEAM(6);
    if (IN(7)) { ph_gemm<G_FFNGU>(c, p); } SEAM(7);
    if (IN(8)) { ph_gemm<G_FFND>(c, p); } SEAM(8);
    if (IN(9)) { ph_norm<2>(c, p); } SEAM(9);
    if (IN(10)) { ph_gemm<G_CDIN>(c, p); } SEAM(10);
    if (IN(11)) { ph_lru_conv(c, p); ph_sconv(c, p); } SEAM(11);
    if (IN(12)) { ph_lru_gates(c, p); } SEAM(12);
    if (IN(13)) { ph_lru_scan(c, p); } SEAM(13);
    if (IN(14)) { ph_gemm<G_CDOUT>(c, p); } SEAM(14);
    if (IN(15)) { ph_norm<3>(c, p); ph_convert(c, a.t2); } SEAM(15);
    if (IN(16)) { ph_route(c, p); } SEAM(16);
    if (IN(17)) { ph_gemm<G_MOEGU>(c, p); } SEAM(17);
    if (IN(18)) { ph_gemm<G_MOED>(c, p); } SEAM(18);
    if (IN(19)) { ph_final(c, p); }
#undef IN
#undef SEAM
}

constexpr int N_PHASES = 20;
static void add_desc(ConvTab& t, const float* src, bf16* dst, int K, int N, int Npad, int mode, int row_off, int nbatch, long long sstride, long long dstride) {
    ConvDesc& d = t.d[t.nd]; d.src = src; d.dst = dst; d.sstride = sstride; d.dstride = dstride; d.K = K; d.N = N; d.Npad = Npad; d.mode = mode; d.row_off = row_off; d.nbatch = nbatch;
    d.items_pb = (K / 64) * (Npad / 32); d.item0 = t.total; t.total += d.items_pb * nbatch; t.nd++;
}
extern "C" void kernel_launch(void* const* d_in, const int* in_sizes, int n_in, void* d_out, int out_size, void* d_ws, size_t ws_size, hipStream_t stream) {
    static int grid = 0;
    if (grid == 0) {
        if (n_in != 33 || out_size != M * D || ws_size < WS_END) { fprintf(stderr, "kernel_launch: unexpected shapes (n_in %d out %d ws %zu)\n", n_in, out_size, ws_size); grid = -1; return; }
        int dev = 0, cus = 0;
        if (hipGetDevice(&dev) != hipSuccess || hipDeviceGetAttribute(&cus, hipDeviceAttributeMultiprocessorCount, dev) != hipSuccess) { grid = -1; return; }
        if (hipFuncSetAttribute((const void*)mega, hipFuncAttributeMaxDynamicSharedMemorySize, LDS_BYTES) != hipSuccess) { fprintf(stderr, "kernel_launch: hipFuncSetAttribute failed\n"); grid = -1; return; }
        int per_cu = 0;
        if (hipOccupancyMaxActiveBlocksPerMultiprocessor(&per_cu, (const void*)mega, NTHR, LDS_BYTES) != hipSuccess || per_cu < 1) { fprintf(stderr, "kernel_launch: occupancy query says %d\n", per_cu); }
        (void)hipGetLastError();
        grid = cus;
    }
    if (grid < 0) return;
    MArgs a{};
    for (int i = 0; i < 33; ++i) a.p.in[i] = (const float*)d_in[i];
    a.p.out = (float*)d_out; a.p.ws = (unsigned char*)d_ws;
    unsigned char* ws = a.p.ws; const Params& p = a.p;
    (void)hipMemsetAsync(ws + WS_CTL, 0, CTL_ZERO_BYTES, stream);
    add_desc(a.t1, p.in[I_ABIN], (bf16*)(ws + WS_WAB_IN), D, 2832, NAB, 0, 0, 1, 0, 0);
    add_desc(a.t1, p.in[I_ABOUT], (bf16*)(ws + WS_WAB_OUT), D, D, D, 0, 0, 1, 0, 0);
    add_desc(a.t1, p.in[I_FG], (bf16*)(ws + WS_WFFN_GU), D, FF, FF, 1, 0, 1, 0, 0);
    add_desc(a.t1, p.in[I_FU], (bf16*)(ws + WS_WFFN_GU), D, FF, FF, 1, 128, 1, 0, 0);
    add_desc(a.t1, p.in[I_FD], (bf16*)(ws + WS_WFFN_D), FF, D, D, 0, 0, 1, 0, 0);
    add_desc(a.t1, p.in[I_CDIN], (bf16*)(ws + WS_WCD_IN), D, NCD, NCD, 0, 0, 1, 0, 0);
    add_desc(a.t1, p.in[I_CDOUT], (bf16*)(ws + WS_WCD_OUT), CDO, D, D, 0, 0, 1, 0, 0);
    add_desc(a.t2, p.in[I_MG], (bf16*)(ws + WS_WMOE_GU), D, FFE, FFE, 1, 0, NE, (long long)D * FFE, (long long)2 * FFE * D);
    add_desc(a.t2, p.in[I_MU], (bf16*)(ws + WS_WMOE_GU), D, FFE, FFE, 1, 128, NE, (long long)D * FFE, (long long)2 * FFE * D);
    add_desc(a.t2, p.in[I_MD], (bf16*)(ws + WS_WMOE_D), FFE, D, D, 0, 0, NE, (long long)FFE * D, (long long)D * FFE);
    a.ph_lo = 0; a.ph_hi = N_PHASES;
    hipLaunchKernelGGL(mega, dim3(grid), dim3(NTHR), LDS_BYTES, stream, a);
}
```

```cpp
#include <hip/hip_runtime.h>
#include <cstdio>
#include <cstdint>
namespace pg8 {
#define PG8_LAS __attribute__((address_space(3)))
typedef unsigned short bf16_t;
typedef short bf16x8 __attribute__((ext_vector_type(8)));
typedef float f32x4 __attribute__((ext_vector_type(4)));
typedef unsigned u32x4 __attribute__((ext_vector_type(4)));
constexpr int BM = 256, BK = 64, HALF = 128, HTB = HALF * BK * 2  , STAGE_BYTES = 8 * HTB, NXCD = 8, WGM = 8;

__host__ __device__ __forceinline__ int lds_byte(int r, int c) { const int st = (r >> 4) * 2 + (c >> 5), rr = r & 15, cc = c & 31, ob = rr * 64 + cc * 2; return st * 1024 + (ob ^ (((ob >> 9) & 1) << 5)); }
__host__ __device__ __forceinline__ void stage_rc(int b, int& R, int& C) { const int st = b / 1024, sb = b % 1024, swz = sb ^ (((sb >> 9) & 1) << 5); R = (st >> 1) * 16 + swz / 64; C = (st & 1) * 32 + (swz % 64) / 2; }
__host__ __device__ __forceinline__ int perm32(int rho) { const int n = rho >> 4, i = rho & 15; return 8 * (i >> 2) + 4 * n + (i & 3); }

struct Unit { int pm, pn, e; };
struct Gemm { const bf16_t* A; const bf16_t* Bt; int M, N, K; size_t eb; };

struct StaticOrder {
    int nM, nN, nwg, G, c;
    __host__ __device__ void init(int M, int N, int G_, int c_) { nM = M / BM; nN = N / BM; nwg = nM * nN; G = G_; c = c_; }
    __host__ __device__ bool next(int i, Unit& u) const {
        const long L = (long)i * G + c; if (L >= nwg) return false;
        int wgid = (int)L; { const int q = nwg / NXCD, r = nwg % NXCD, xcd = wgid % NXCD, off = wgid / NXCD; wgid = (xcd < r ? xcd * (q + 1) : r * (q + 1) + (xcd - r) * q) + off; }
        const int nig = WGM * nN, gid = wgid / nig, fm = gid * WGM, gsz = (nM - fm) < WGM ? (nM - fm) : WGM;
        u.pm = fm + ((wgid % nig) % gsz); u.pn = (wgid % nig) / gsz; u.e = 0; return true;
    }
    __device__ __forceinline__ void a_ready(const Unit&) const {}
    __device__ __forceinline__ void done(const Unit&) const {}
};

__device__ __forceinline__ unsigned cvt_pk_bf16(float lo, float hi) { unsigned r; asm volatile("v_cvt_pk_bf16_f32 %0, %1, %2" : "=v"(r) : "v"(lo), "v"(hi)); return r; }

__device__ __forceinline__ float fast_silu(float g) { return g * __builtin_amdgcn_rcpf(1.0f + __expf(-g)); }
struct EpiStoreBf16 {
    static constexpr bool PERM = true, AFTER_DRAIN = false;
    bf16_t* O; int ldc; const float* rowscale;
    __device__ __forceinline__ void operator()(const f32x4 (&acc)[2][2][4][2], const Unit& u, int wr, int wc, int fr, int fq) const {
        const int row0 = u.pm * BM + wr * 64 + fr, col0 = u.pn * BM + wc * 32 + 8 * fq;
#pragma unroll
        for (int ai = 0; ai < 2; ++ai)
#pragma unroll
            for (int m = 0; m < 4; ++m) { const int row = row0 + ai * HALF + m * 16; bf16_t* rowp = O + (size_t)row * ldc + col0;
                const float s = rowscale ? rowscale[row] : 1.f;
#pragma unroll
                for (int bj = 0; bj < 2; ++bj) { const f32x4 v0 = acc[ai][bj][m][0] * s, v1 = acc[ai][bj][m][1] * s;
                    u32x4 w; w.x = cvt_pk_bf16(v0[0], v0[1]); w.y = cvt_pk_bf16(v0[2], v0[3]); w.z = cvt_pk_bf16(v1[0], v1[1]); w.w = cvt_pk_bf16(v1[2], v1[3]);
                    *(u32x4*)(rowp + bj * HALF) = w; } }
    }
};
struct EpiSwiglu {
    static constexpr bool PERM = true, AFTER_DRAIN = false;
    bf16_t* O; int ldc;
    __device__ __forceinline__ void operator()(const f32x4 (&acc)[2][2][4][2], const Unit& u, int wr, int wc, int fr, int fq) const {
        const int row0 = u.pm * BM + wr * 64 + fr, col0 = u.pn * HALF + wc * 32 + 8 * fq;
#pragma unroll
        for (int ai = 0; ai < 2; ++ai)
#pragma unroll
            for (int m = 0; m < 4; ++m) { const int row = row0 + ai * HALF + m * 16; bf16_t* rowp = O + (size_t)row * ldc + col0;
                const f32x4 g0 = acc[ai][0][m][0], g1 = acc[ai][0][m][1], u0 = acc[ai][1][m][0], u1 = acc[ai][1][m][1];
                float h[8];
#pragma unroll
                for (int i = 0; i < 4; ++i) { h[i] = fast_silu(g0[i]) * u0[i]; h[4 + i] = fast_silu(g1[i]) * u1[i]; }
                u32x4 w; w.x = cvt_pk_bf16(h[0], h[1]); w.y = cvt_pk_bf16(h[2], h[3]); w.z = cvt_pk_bf16(h[4], h[5]); w.w = cvt_pk_bf16(h[6], h[7]);
                *(u32x4*)rowp = w; }
    }
};
struct EpiRes {
    static constexpr bool PERM = false, AFTER_DRAIN = false;
    const float* base; float* out; int ldc; const float* gate;
    __device__ __forceinline__ void operator()(const f32x4 (&acc)[2][2][4][2], const Unit& u, int wr, int wc, int fr, int fq) const {
        const int row0 = u.pm * BM + wr * 64 + fr, col0 = u.pn * BM + wc * 32 + 4 * fq;
        const float* gp = gate + (size_t)(u.pm >> 4) * 6144 + col0;
        f32x4 gv[2][2];
#pragma unroll
        for (int bj = 0; bj < 2; ++bj)
#pragma unroll
            for (int n = 0; n < 2; ++n) gv[bj][n] = *(const f32x4*)(gp + bj * HALF + n * 16);
#pragma unroll
        for (int ai = 0; ai < 2; ++ai)
#pragma unroll
            for (int m = 0; m < 4; ++m) { const size_t off = (size_t)(row0 + ai * HALF + m * 16) * ldc + col0;
#pragma unroll
                for (int bj = 0; bj < 2; ++bj)
#pragma unroll
                    for (int n = 0; n < 2; ++n) { const f32x4 bs = *(const f32x4*)(base + off + bj * HALF + n * 16);
                        *(f32x4*)(out + off + bj * HALF + n * 16) = bs + gv[bj][n] * acc[ai][bj][m][n]; } }
    }
};
struct GroupedOrder {
    int nM, nN, nwg, G, c; const int* tile_e;
    __device__ void init(int nMt, int N, int G_, int c_, const int* te) { nM = nMt; nN = N / BM; nwg = nM * nN; G = G_; c = c_; tile_e = te; }
    __device__ bool next(int i, Unit& u) const {
        const long L = (long)i * G + c; if (L >= nwg) return false;
        int wgid = (int)L; { const int q = nwg / NXCD, r = nwg % NXCD, xcd = wgid % NXCD, off = wgid / NXCD; wgid = (xcd < r ? xcd * (q + 1) : r * (q + 1) + (xcd - r) * q) + off; }
        const int nig = WGM * nN, gid = wgid / nig, fm = gid * WGM, gsz = (nM - fm) < WGM ? (nM - fm) : WGM;
        u.pm = fm + ((wgid % nig) % gsz); u.pn = (wgid % nig) / gsz; u.e = __builtin_amdgcn_readfirstlane(tile_e[u.pm]); return true;
    }
    __device__ __forceinline__ void a_ready(const Unit&) const {}
    __device__ __forceinline__ void done(const Unit&) const {}
};

template <class Epi, class Sched, bool ALIGN_EPI = false, bool SP2 = false>
__device__ __forceinline__ void gemm_phase(PG8_LAS unsigned char* lds, const Gemm g, const Sched& S, const Epi& E) {
    const int tid = threadIdx.x, wid = __builtin_amdgcn_readfirstlane(tid >> 6), lane = tid & 63, wr = wid >> 2, wc = wid & 3, fr = lane & 15, fq = lane >> 4;
    const int K = g.K, nt = K / BK;
    unsigned voffA[2], voffB[2];
#pragma unroll
    for (int i = 0; i < 2; ++i) { int R, C; stage_rc(tid * 16 + i * 8192, R, C); const int Rb = Epi::PERM ? ((R & ~31) + perm32(R & 31)) : R;
        voffA[i] = (unsigned)(R * K + C) * 2u; voffB[i] = (unsigned)(Rb * K + C) * 2u; }
    const size_t kstep = (size_t)(BK * 2);
    const size_t hstep = (size_t)HALF * K * 2;
    const size_t tstep = 2 * hstep;
    const unsigned ldsw = (unsigned)wid * 1024u;
    const int aoff = lds_byte(wr * 64 + fr, fq * 8), boff = lds_byte(wc * 32 + fr, fq * 8);
#define PG8_SA(b, h) (((b) * 2 + (h)) * HTB)
#define PG8_SB(b, h) ((4 + (b) * 2 + (h)) * HTB)
#define PG8_STAGE(bufoff, gbase, voff) do { _Pragma("unroll") for (int _i = 0; _i < 2; ++_i) \
        __builtin_amdgcn_global_load_lds((const unsigned*)((const char*)(gbase) + (voff)[_i]), (PG8_LAS unsigned*)(lds + (bufoff) + ldsw + _i * 8192), 16, 0, 0); } while (0)
#define PG8_LDA(dst, b, h) do { _Pragma("unroll") for (int m = 0; m < 4; ++m) _Pragma("unroll") for (int k = 0; k < 2; ++k) dst[m][k] = *(const PG8_LAS bf16x8*)(lds + PG8_SA(b, h) + aoff + m * 2048 + k * 1024); } while (0)
#define PG8_LDB(dst, b, h) do { _Pragma("unroll") for (int n = 0; n < 2; ++n) _Pragma("unroll") for (int k = 0; k < 2; ++k) dst[n][k] = *(const PG8_LAS bf16x8*)(lds + PG8_SB(b, h) + boff + n * 2048 + k * 1024); } while (0)
#define PG8_MMA(ai, bj, At, Bt) do { __builtin_amdgcn_s_setprio(1); _Pragma("unroll") for (int m = 0; m < 4; ++m) _Pragma("unroll") for (int n = 0; n < 2; ++n) _Pragma("unroll") for (int k = 0; k < 2; ++k) \
        acc[ai][bj][m][n] = __builtin_amdgcn_mfma_f32_16x16x32_bf16(Bt[n][k], At[m][k], acc[ai][bj][m][n], 0, 0, 0); __builtin_amdgcn_s_setprio(0); } while (0)
#define PG8_WAIT_V(n) asm volatile("s_waitcnt vmcnt(" #n ")" ::: "memory")
#define PG8_WAIT_L(n) asm volatile("s_waitcnt lgkmcnt(" #n ")" ::: "memory")
#define PG8_BAR __builtin_amdgcn_s_barrier()
#define PG8_SCHED __builtin_amdgcn_sched_barrier(0)
    Unit cur, nxt; int ui = 0;
    if (!S.next(0, cur)) return;
    f32x4 acc[2][2][4][2];
#pragma unroll
    for (int a = 0; a < 2; ++a)
#pragma unroll
        for (int b = 0; b < 2; ++b)
#pragma unroll
            for (int m = 0; m < 4; ++m)
#pragma unroll
                for (int n = 0; n < 2; ++n) acc[a][b][m][n] = (f32x4){0.f, 0.f, 0.f, 0.f};
    bf16x8 At[4][2], B0[2][2], B1[2][2];
    const char* cA = (const char*)g.A + (size_t)cur.pm * tstep; const char* cB = (const char*)g.Bt + (size_t)cur.e * g.eb + (size_t)cur.pn * tstep;
    S.a_ready(cur);
    if constexpr (SP2) {
        PG8_STAGE(PG8_SB(0, 0), cB, voffB); PG8_STAGE(PG8_SB(0, 1), cB + hstep, voffB); PG8_STAGE(PG8_SA(0, 0), cA, voffA); PG8_STAGE(PG8_SA(0, 1), cA + hstep, voffA);
        if (wr == 1) PG8_BAR;
        PG8_WAIT_V(2); PG8_BAR;
        PG8_STAGE(PG8_SB(1, 0), cB + kstep, voffB); PG8_STAGE(PG8_SA(1, 0), cA + kstep, voffA); PG8_STAGE(PG8_SB(1, 1), cB + hstep + kstep, voffB);
        PG8_WAIT_V(6); PG8_BAR;
    } else {
        PG8_STAGE(PG8_SB(0, 0), cB, voffB); PG8_STAGE(PG8_SA(0, 0), cA, voffA); PG8_STAGE(PG8_SB(0, 1), cB + hstep, voffB); PG8_STAGE(PG8_SA(0, 1), cA + hstep, voffA);
        if (wr == 1) PG8_BAR;
        PG8_WAIT_V(4); PG8_BAR;
        PG8_STAGE(PG8_SB(1, 0), cB + kstep, voffB); PG8_STAGE(PG8_SA(1, 0), cA + kstep, voffA); PG8_STAGE(PG8_SB(1, 1), cB + hstep + kstep, voffB);
        PG8_WAIT_V(6); PG8_BAR;
    }
    for (;;) {
        const bool has_next = S.next(ui + 1, nxt);
        const char* nA = has_next ? (const char*)g.A + (size_t)nxt.pm * tstep : cA; const char* nB = has_next ? (const char*)g.Bt + (size_t)nxt.e * g.eb + (size_t)nxt.pn * tstep : cB;
        for (int t = 0; t < nt; t += 2) {
            const bool last = (t == nt - 2);
            const char* a1 = cA + (size_t)(t + 1) * kstep;
            const char* a2 = last ? nA : cA + (size_t)(t + 2) * kstep; const char* b2 = last ? nB : cB + (size_t)(t + 2) * kstep;
            const char* a3 = a2 + kstep; const char* b3 = b2 + kstep;
            if (last && has_next) S.a_ready(nxt);
            if constexpr (SP2) {
            PG8_LDB(B0, 0, 0); PG8_LDB(B1, 0, 1); PG8_SCHED; PG8_LDA(At, 0, 0); PG8_STAGE(PG8_SA(1, 1), a1 + hstep, voffA);
            PG8_WAIT_V(8); PG8_WAIT_L(0); PG8_BAR; PG8_MMA(0, 0, At, B0); PG8_MMA(0, 1, At, B1); PG8_BAR; PG8_SCHED;
            PG8_LDA(At, 0, 1); PG8_STAGE(PG8_SB(0, 0), b2, voffB); PG8_STAGE(PG8_SB(0, 1), b2 + hstep, voffB); PG8_STAGE(PG8_SA(0, 0), a2, voffA);
            PG8_WAIT_V(8); PG8_WAIT_L(0); PG8_BAR; PG8_MMA(1, 0, At, B0); PG8_MMA(1, 1, At, B1); PG8_BAR; PG8_SCHED;
            PG8_LDB(B0, 1, 0); PG8_LDB(B1, 1, 1); PG8_SCHED; PG8_LDA(At, 1, 0); PG8_STAGE(PG8_SA(0, 1), a2 + hstep, voffA);
            PG8_WAIT_V(8); PG8_WAIT_L(0); PG8_BAR; PG8_MMA(0, 0, At, B0); PG8_MMA(0, 1, At, B1); PG8_BAR; PG8_SCHED;
            PG8_LDA(At, 1, 1); PG8_STAGE(PG8_SB(1, 0), b3, voffB); PG8_STAGE(PG8_SB(1, 1), b3 + hstep, voffB); PG8_STAGE(PG8_SA(1, 0), a3, voffA);
            PG8_WAIT_V(8); PG8_WAIT_L(0); PG8_BAR; PG8_MMA(1, 0, At, B0); PG8_MMA(1, 1, At, B1); PG8_BAR; PG8_SCHED;
            } else {
            PG8_LDB(B0, 0, 0); PG8_SCHED; PG8_LDA(At, 0, 0); PG8_STAGE(PG8_SA(1, 1), a1 + hstep, voffA);
            PG8_WAIT_L(8); PG8_BAR; PG8_WAIT_L(0); PG8_MMA(0, 0, At, B0); PG8_BAR; PG8_SCHED;
            PG8_LDB(B1, 0, 1); PG8_STAGE(PG8_SB(0, 0), b2, voffB);
            PG8_BAR; PG8_WAIT_L(0); PG8_MMA(0, 1, At, B1); PG8_BAR;
            PG8_LDA(At, 0, 1); PG8_STAGE(PG8_SA(0, 0), a2, voffA);
            PG8_BAR; PG8_WAIT_L(0); PG8_MMA(1, 0, At, B0); PG8_BAR; PG8_SCHED;
            PG8_STAGE(PG8_SB(0, 1), b2 + hstep, voffB);
            PG8_WAIT_V(6); PG8_BAR; PG8_MMA(1, 1, At, B1); PG8_BAR;
            PG8_LDB(B0, 1, 0); PG8_SCHED; PG8_LDA(At, 1, 0); PG8_STAGE(PG8_SA(0, 1), a2 + hstep, voffA);
            PG8_WAIT_L(8); PG8_BAR; PG8_WAIT_L(0); PG8_MMA(0, 0, At, B0); PG8_BAR; PG8_SCHED;
            PG8_LDB(B1, 1, 1); PG8_STAGE(PG8_SB(1, 0), b3, voffB);
            PG8_BAR; PG8_WAIT_L(0); PG8_MMA(0, 1, At, B1); PG8_BAR;
            PG8_LDA(At, 1, 1); PG8_STAGE(PG8_SA(1, 0), a3, voffA);
            PG8_BAR; PG8_WAIT_L(0); PG8_MMA(1, 0, At, B0); PG8_BAR; PG8_SCHED;
            PG8_STAGE(PG8_SB(1, 1), b3 + hstep, voffB);
            PG8_WAIT_V(6); PG8_BAR; PG8_MMA(1, 1, At, B1); PG8_BAR;
            }
        }
        if constexpr (ALIGN_EPI) { if (wr == 0) PG8_BAR; }
        if constexpr (!Epi::AFTER_DRAIN) { E(acc, cur, wr, wc, fr, fq); S.done(cur); }
        if (!has_next) break;
#pragma unroll
        for (int a = 0; a < 2; ++a)
#pragma unroll
            for (int b = 0; b < 2; ++b)
#pragma unroll
                for (int m = 0; m < 4; ++m)
#pragma unroll
                    for (int n = 0; n < 2; ++n) acc[a][b][m][n] = (f32x4){0.f, 0.f, 0.f, 0.f};
        cur = nxt; cA = nA; cB = nB; ++ui;
        if constexpr (ALIGN_EPI) { if (wr == 1) PG8_BAR; }
    }
    PG8_WAIT_V(0);
    if constexpr (!ALIGN_EPI) { if (wr == 0) PG8_BAR; }
    PG8_BAR;
    if constexpr (Epi::AFTER_DRAIN) { E.fused(acc, cur, wr, wc, fr, fq, lds, wid, lane); S.done(cur); }
#undef PG8_SA
#undef PG8_SB
#undef PG8_STAGE
#undef PG8_LDA
#undef PG8_LDB
#undef PG8_MMA
#undef PG8_WAIT_V
#undef PG8_WAIT_L
#undef PG8_BAR
#undef PG8_SCHED
}
}

constexpr int BATCH = 4, T = 4096, D = 1024, M = BATCH * T;
constexpr int NAB = 3072;
constexpr int FF = 2816, NCD = 3584, CDO = 1536, FFE = 3584, NE = 8;
constexpr int MPAD = 2 * M + NE * 256;
constexpr int MAXT = MPAD / 256;
constexpr int C_QA = 0, C_KA = 512, C_VA = 640, C_QKVB = 768, C_GATEB = 2304, C_BETA = 2816, C_AB = 2824;
constexpr int C_XC = 0, C_YC = 1024, C_BD = 2048, C_CD = 2560, C_HD = 3072;
constexpr size_t MiB = 1u << 20;
constexpr size_t WS_CTL = 0, CTL_ZERO_BYTES = 1 * MiB;
constexpr size_t WS_MOD = 1 * MiB;
constexpr size_t WS_ROUTE = 1 * MiB + 256 * 1024;
constexpr size_t WS_WAB_IN = 2 * MiB, WS_WAB_OUT = 8 * MiB, WS_WFFN_GU = 10 * MiB, WS_WFFN_D = 21 * MiB, WS_WCD_IN = 27 * MiB, WS_WCD_OUT = 34 * MiB, WS_WLRU = 37 * MiB;
constexpr size_t WS_WMOE_GU = 38 * MiB, WS_WMOE_D = 150 * MiB;
constexpr size_t WS_ACT = 206 * MiB;
constexpr size_t WS_END = 512 * MiB;
constexpr size_t A_A = 0, A_P = 32 * MiB, A_MIXA = 128 * MiB, A_DNQ = 160 * MiB, A_DNK = 192 * MiB, A_DNV = 224 * MiB, A_DNB = 256 * MiB, A_DNG = 257 * MiB;
constexpr size_t A_H = 160 * MiB;
constexpr size_t A_MIXB = 144 * MiB, A_XC = 192 * MiB;
constexpr size_t A_A3P = 0, A_HM = 68 * MiB, A_Y = 0;
constexpr size_t WS_A3 = 2 * MiB;
constexpr size_t WS_LA = 38 * MiB, WS_LB = 102 * MiB;
constexpr size_t R_IDX = 0, R_W = 128 * 1024, R_SLOT = 256 * 1024, R_GATEW = 384 * 1024, R_TILEE = 528 * 1024, R_OFF = 532 * 1024;
constexpr int CW_CNT = 1024, CW_CUR = 1024 + 64;

typedef unsigned short bf16;
typedef float f32x4 __attribute__((ext_vector_type(4)));
typedef unsigned v4u __attribute__((ext_vector_type(4)));
typedef unsigned v2u __attribute__((ext_vector_type(2)));
__device__ __forceinline__ unsigned f2bf(float f) { unsigned u = __builtin_bit_cast(unsigned, f); return (u + 0x7fffu + ((u >> 16) & 1u)) >> 16; }
__device__ __forceinline__ unsigned pk2(float lo, float hi) { return f2bf(lo) | (f2bf(hi) << 16); }
__device__ __forceinline__ float bf2f(unsigned short b) { return __builtin_bit_cast(float, (unsigned)b << 16); }
__device__ __forceinline__ float bflo(unsigned w) { return __builtin_bit_cast(float, w << 16); }
__device__ __forceinline__ float bfhi(unsigned w) { return __builtin_bit_cast(float, w & 0xffff0000u); }
__device__ __forceinline__ float wave_sum(float v) {
#pragma unroll
    for (int o = 1; o < 64; o <<= 1) v += __shfl_xor(v, o);
    return v;
}
__device__ __forceinline__ float sigmoidf_(float x) { return __builtin_amdgcn_rcpf(1.0f + __expf(-x)); }
__device__ __forceinline__ float siluf_(float x) { return x * __builtin_amdgcn_rcpf(1.0f + __expf(-x)); }
__device__ __forceinline__ float softplusf_(float x) { return fmaxf(x, 0.f) + log1pf(__expf(-fabsf(x))); }
__device__ __forceinline__ float gelu_tanhf_(float x) { const float u = 0.7978845608028654f * (x + 0.044715f * x * x * x); return 0.5f * x * (1.0f + tanhf(u)); }

__device__ const unsigned char T5_BUCKET[128] = {0, 1, 2, 3, 4, 5, 6, 7, 8, 9, 10, 11, 12, 13, 14, 15, 16, 16, 16, 17, 17, 18, 18, 18, 19, 19, 19, 20, 20, 20, 20, 21, 21, 21, 21, 22, 22, 22, 22, 22, 23, 23, 23, 23, 23, 23, 24, 24, 24, 24, 24, 24, 25, 25, 25, 25, 25, 25, 25, 26, 26, 26, 26, 26, 26, 26, 26, 27, 27, 27, 27, 27, 27, 27, 27, 27, 27, 28, 28, 28, 28, 28, 28, 28, 28, 28, 28, 29, 29, 29, 29, 29, 29, 29, 29, 29, 29, 29, 29, 30, 30, 30, 30, 30, 30, 30, 30, 30, 30, 30, 30, 30, 30, 31, 31, 31, 31, 31, 31, 31, 31, 31, 31, 31, 31, 31, 31, 31};

struct Params { const float* in[33]; float* out; unsigned char* ws; };
enum { I_X = 0, I_C, I_RELB, I_ADAW, I_ADAB, I_NMIX, I_NFFN, I_NFIN, I_ABIN, I_SINK, I_DNCONV, I_ALOG, I_DTB, I_DNNORM, I_ABOUT, I_FG, I_FU, I_FD, I_CDIN, I_LCW, I_LCB, I_GAW, I_GAB, I_GXW, I_GXB, I_LAM, I_SCW, I_CDOUT, I_RW, I_RB, I_MG, I_MU, I_MD };


#define LAS __attribute__((address_space(3)))
#define XB_TMO      128
#define XB_XCNT(j)  (256  + 64 * (j))
#define XB_XSUB(j)  (1280 + 64 * (j))
#define XB_XGEN(j)  (2304 + 64 * (j))
#define XB_TOP      3328
#define XB_TOPGEN   3392
#define XCD_BAR_WORDS 3456
#define XB_SPIN_CAP (1u << 18)

__device__ __forceinline__ unsigned xb_ld(unsigned* p)              { return __hip_atomic_load(p, __ATOMIC_RELAXED, __HIP_MEMORY_SCOPE_AGENT); }
__device__ __forceinline__ unsigned xb_add(unsigned* p, unsigned v) { return __hip_atomic_fetch_add(p, v, __ATOMIC_RELAXED, __HIP_MEMORY_SCOPE_AGENT); }
__device__ __forceinline__ unsigned xb_xcc_id() { return (unsigned)__builtin_amdgcn_s_getreg((3 << 11) | 20) & 0xFu; }
#define XB_SPIN(cond, bar) do { unsigned _sp = 0; while (cond) { __builtin_amdgcn_s_sleep(1); \
    if ((++_sp & 255u) == 0u) { if (xb_ld(&(bar)[XB_TMO])) break; if (_sp > XB_SPIN_CAP) { atomicAdd(&(bar)[XB_TMO], 1u); break; } } } } while (0)

struct XcdBarrier {
    unsigned* bar; unsigned x;
    volatile LAS unsigned* st;
};
__device__ __forceinline__ XcdBarrier xcd_barrier_post(unsigned* bar, volatile LAS unsigned* st) {
    XcdBarrier b; b.bar = bar; b.x = xb_xcc_id(); b.st = st;
    if (threadIdx.x == 0) (void)xb_add(&bar[XB_XCNT(b.x)], 1u);
    return b;
}
__device__ __forceinline__ void xcd_barrier_complete(unsigned* bar, unsigned x, unsigned& nloc, unsigned& nx) {
    const unsigned G = gridDim.x * gridDim.y * gridDim.z;
    unsigned sum, cnt, mine, sp = 0u;
    for (;;) {
        sum = 0u; cnt = 0u; mine = 0u;
#pragma unroll
        for (unsigned j = 0; j < 16; ++j) { const unsigned c = xb_ld(&bar[XB_XCNT(j)]); sum += c; cnt += (c > 0u) ? 1u : 0u; mine = (j == x) ? c : mine; }
        if (sum == G) break;
        __builtin_amdgcn_s_sleep(1);
        if ((++sp & 255u) == 0u) { if (xb_ld(&bar[XB_TMO])) break; if (sp > XB_SPIN_CAP) { atomicAdd(&bar[XB_TMO], 1u); break; } }
    }
    nloc = mine > 0u ? mine : 1u; nx = cnt > 0u ? cnt : 1u;
}
__device__ __forceinline__ void xcd_barrier(const XcdBarrier& b) {
    asm volatile("s_waitcnt vmcnt(0)" ::: "memory");
    __syncthreads();
    if (threadIdx.x == 0) {
        unsigned* bar = b.bar;
        __builtin_amdgcn_s_waitcnt(0);
        unsigned nloc = b.st[0], nx = b.st[1];
        if (nloc == 0u) { xcd_barrier_complete(bar, b.x, nloc, nx); b.st[0] = nloc; b.st[1] = nx; }
        const unsigned old = xb_add(&bar[XB_XSUB(b.x)], 1u);
        const unsigned gen = old / nloc;
        if (old + 1u == (gen + 1u) * nloc) {
            __builtin_amdgcn_fence(__ATOMIC_RELEASE, "agent");
            asm volatile("s_waitcnt vmcnt(0)" ::: "memory");
            const unsigned og = xb_add(&bar[XB_TOP], 1u);
            const unsigned tg = og / nx;
            if (og + 1u == (tg + 1u) * nx) xb_add(&bar[XB_TOPGEN], 1u);
            else XB_SPIN(xb_ld(&bar[XB_TOPGEN]) == tg, bar);
            __builtin_amdgcn_fence(__ATOMIC_ACQUIRE, "agent");
            xb_add(&bar[XB_XGEN(b.x)], 1u);
            asm volatile("s_waitcnt vmcnt(0)" ::: "memory");
        } else {
            XB_SPIN(xb_ld(&bar[XB_XGEN(b.x)]) == gen, bar);
            __builtin_amdgcn_fence(__ATOMIC_ACQUIRE, "agent");
            asm volatile("s_waitcnt vmcnt(0)" ::: "memory");
        }
    }
    __syncthreads();
}

constexpr int NWAVES = 8, NTHR = 512;
constexpr int LDS_MISC = 150528, LDS_BYTES = 150528 + 1024;
constexpr int CW_BAR = 4096;
struct ConvDesc { const float* src; bf16* dst; long long sstride, dstride; int K, N, Npad, mode, row_off, nbatch, items_pb, item0; };
struct ConvTab { ConvDesc d[12]; int nd, total, pad0, pad1; };
struct MArgs { Params p; ConvTab t1, t2; int ph_lo, ph_hi, pad0, pad1; };
struct Ctx { LAS unsigned char* lds; int tid, lane, wave, G, bid, gw, NGW; };

__device__ __forceinline__ void transpose_item(const float* W, int K, int N, bf16* WT, int mode, int row_off, LAS float* scr, int kb, int nb, int lane) {
    const int k0 = 64 * kb, n0 = 32 * nb; const int nn = n0 + (lane & 31);
#pragma unroll 8
    for (int i = 0; i < 32; ++i) { const int kk = 2 * i + (lane >> 5); scr[kk * 33 + (lane & 31)] = nn < N ? W[(size_t)(k0 + kk) * N + nn] : 0.f; }
    asm volatile("s_waitcnt lgkmcnt(0)" ::: "memory");
    const int c = lane & 7;
#pragma unroll
    for (int j = 0; j < 4; ++j) { const int n = (lane >> 3) + 8 * j; const LAS float* s = scr + (8 * c) * 33 + n;
        v4u o; o.x = pk2(s[0 * 33], s[1 * 33]); o.y = pk2(s[2 * 33], s[3 * 33]); o.z = pk2(s[4 * 33], s[5 * 33]); o.w = pk2(s[6 * 33], s[7 * 33]);
        const int ng = n0 + n; const int drow = (mode == 1 ? ((ng >> 7) << 8) + (ng & 127) : ng) + row_off;
        *(v4u*)(WT + (size_t)drow * K + k0 + 8 * c) = o; }
    asm volatile("s_waitcnt lgkmcnt(0)" ::: "memory");
}
__device__ __forceinline__ void ph_convert(const Ctx& c, const ConvTab& tab) {
    LAS float* scr = (LAS float*)(c.lds + c.wave * 8448);
    for (int it = c.gw; it < tab.total; it += c.NGW) {
        int j = 0;
        for (int q = 1; q < tab.nd; ++q) if (it >= tab.d[q].item0) j = q;
        const ConvDesc& d = tab.d[j]; const int r = it - d.item0; const int batch = r / d.items_pb, item = r % d.items_pb; const int nblk = d.Npad / 32;
        transpose_item(d.src + (size_t)batch * d.sstride, d.K, d.N, d.dst + (size_t)batch * d.dstride, d.mode, d.row_off, scr, item / nblk, item % nblk, c.lane);
    }
}
__device__ __forceinline__ void ph_ada(const Ctx& c, const Params& p) {
    LAS float* part = (LAS float*)(c.lds + 69632);
    for (int it = c.bid; it < 192; it += c.G) {
        const int l = it / 96, j = (it % 96) * 64 + c.lane; const float* w = p.in[I_ADAW] + (size_t)l * 1024 * 6144 + j; const float* cc = p.in[I_C];
        float a0 = 0.f, a1 = 0.f, a2 = 0.f, a3 = 0.f;
        for (int k = c.wave * 128; k < c.wave * 128 + 128; ++k) { const float wv = w[(size_t)k * 6144];
            a0 += siluf_(cc[k]) * wv; a1 += siluf_(cc[1024 + k]) * wv; a2 += siluf_(cc[2048 + k]) * wv; a3 += siluf_(cc[3072 + k]) * wv; }
        part[(c.wave * 4 + 0) * 64 + c.lane] = a0; part[(c.wave * 4 + 1) * 64 + c.lane] = a1; part[(c.wave * 4 + 2) * 64 + c.lane] = a2; part[(c.wave * 4 + 3) * 64 + c.lane] = a3;
        __syncthreads();
        if (c.wave < 4) { float s = 0.f;
#pragma unroll
            for (int w8 = 0; w8 < 8; ++w8) s += part[(w8 * 4 + c.wave) * 64 + c.lane];
            ((float*)(p.ws + WS_MOD))[(size_t)l * 4 * 6144 + (size_t)c.wave * 6144 + j] = s + p.in[I_ADAB][l * 6144 + j]; }
        __syncthreads();
    }
}
template <bool ROUTER>
__device__ __forceinline__ void norm_row(const float* xrow, bf16* orow, const float* w, const float* sc, const float* sh, int lane, const float* rw, const float* rb, int m, unsigned char* ws) {
    const f32x4* xr = (const f32x4*)xrow + lane; f32x4 v[4]; float s = 0.f;
#pragma unroll
    for (int j = 0; j < 4; ++j) { v[j] = xr[64 * j]; s += (v[j].x * v[j].x + v[j].y * v[j].y) + (v[j].z * v[j].z + v[j].w * v[j].w); }
    const float rstd = 1.0f / sqrtf(wave_sum(s) * (1.f / D) + 1e-6f);
    float lg[8];
    if (ROUTER) {
#pragma unroll
        for (int e = 0; e < 8; ++e) lg[e] = 0.f;
    }
    unsigned long long* o8 = (unsigned long long*)orow + lane;
#pragma unroll
    for (int j = 0; j < 4; ++j) { const int c = 4 * lane + 256 * j; const f32x4 wv = *(const f32x4*)(w + c), scv = *(const f32x4*)(sc + c), shv = *(const f32x4*)(sh + c);
        f32x4 y = v[j] * rstd * wv * (scv + 1.0f) + shv;
        if (ROUTER) {
#pragma unroll
            for (int i = 0; i < 4; ++i) { const f32x4 r0 = *(const f32x4*)(rw + (size_t)(c + i) * 8), r1 = *(const f32x4*)(rw + (size_t)(c + i) * 8 + 4);
                lg[0] += y[i] * r0.x; lg[1] += y[i] * r0.y; lg[2] += y[i] * r0.z; lg[3] += y[i] * r0.w; lg[4] += y[i] * r1.x; lg[5] += y[i] * r1.y; lg[6] += y[i] * r1.z; lg[7] += y[i] * r1.w; }
        }
        o8[64 * j] = (unsigned long long)pk2(y.x, y.y) | ((unsigned long long)pk2(y.z, y.w) << 32); }
    if (ROUTER) {
#pragma unroll
        for (int e = 0; e < 8; ++e) lg[e] = wave_sum(lg[e]) + rb[e];
        int b0 = 0; float v0 = lg[0];
#pragma unroll
        for (int e = 1; e < 8; ++e) if (lg[e] > v0) { v0 = lg[e]; b0 = e; }
        int b1 = -1; float v1 = -3.0e38f;
#pragma unroll
        for (int e = 0; e < 8; ++e) if (e != b0 && lg[e] > v1) { v1 = lg[e]; b1 = e; }
        const float e1 = __expf(v1 - v0), w0 = 1.0f / (1.0f + e1), w1 = e1 / (1.0f + e1);
        if (lane == 0) { int* idx = (int*)(ws + WS_ROUTE + R_IDX); float* tw = (float*)(ws + WS_ROUTE + R_W); idx[2 * m] = b0; idx[2 * m + 1] = b1; tw[2 * m] = w0; tw[2 * m + 1] = w1;
            unsigned* cnt = (unsigned*)(ws + WS_CTL) + CW_CNT; atomicAdd(cnt + b0, 1u); atomicAdd(cnt + b1, 1u); }
    }
}
template <int WHICH>
__device__ __forceinline__ void ph_norm(const Ctx& c, const Params& p) {
    const int l = WHICH >> 1, f = WHICH & 1;
    const float* src = WHICH == 0 ? p.in[I_X] : p.out; bf16* dst = (bf16*)(p.ws + (WHICH == 3 ? WS_A3 : WS_ACT + A_A));
    const float* w = p.in[f ? I_NFFN : I_NMIX] + l * D; const float* mod = (const float*)(p.ws + WS_MOD) + (size_t)l * 4 * 6144;
    for (int m = c.gw; m < M; m += c.NGW) { const int b = m >> 12; const float* mb = mod + (size_t)b * 6144 + (f ? 3 * D : 0);
        norm_row<WHICH == 3>(src + (size_t)m * D, dst + (size_t)m * D, w, mb + D, mb, c.lane, p.in[I_RW], p.in[I_RB], m, p.ws); }
}

enum { G_ABIN = 0, G_ABOUT, G_FFNGU, G_FFND, G_CDIN, G_CDOUT, G_MOEGU, G_MOED };
template <int WHICH>
__device__ __forceinline__ void ph_gemm(const Ctx& cx, const Params& p) {
    PG8_LAS unsigned char* lds = (PG8_LAS unsigned char*)cx.lds;
    unsigned char* ws = p.ws; unsigned char* act = ws + WS_ACT; const float* mod = (const float*)(ws + WS_MOD);
    const int G = cx.G, c = cx.bid;
    if constexpr (WHICH == G_ABIN) { pg8::Gemm g{(const bf16*)(act + A_A), (const bf16*)(ws + WS_WAB_IN), M, NAB, D, 0}; pg8::StaticOrder S; S.init(M, NAB, G, c);
        pg8::EpiStoreBf16 E{(bf16*)(act + A_P), NAB, nullptr}; pg8::gemm_phase<pg8::EpiStoreBf16, pg8::StaticOrder, true, true>(lds, g, S, E); }
    if constexpr (WHICH == G_ABOUT) { pg8::Gemm g{(const bf16*)(act + A_MIXA), (const bf16*)(ws + WS_WAB_OUT), M, D, D, 0}; pg8::StaticOrder S; S.init(M, D, G, c);
        pg8::EpiRes E{p.in[I_X], p.out, D, mod + 2 * D}; pg8::gemm_phase<pg8::EpiRes, pg8::StaticOrder, true, true>(lds, g, S, E); }
    if constexpr (WHICH == G_FFNGU) { pg8::Gemm g{(const bf16*)(act + A_A), (const bf16*)(ws + WS_WFFN_GU), M, 2 * FF, D, 0}; pg8::StaticOrder S; S.init(M, 2 * FF, G, c);
        pg8::EpiSwiglu E{(bf16*)(act + A_H), FF}; pg8::gemm_phase<pg8::EpiSwiglu, pg8::StaticOrder, true, true>(lds, g, S, E); }
    if constexpr (WHICH == G_FFND) { pg8::Gemm g{(const bf16*)(act + A_H), (const bf16*)(ws + WS_WFFN_D), M, D, FF, 0}; pg8::StaticOrder S; S.init(M, D, G, c);
        pg8::EpiRes E{p.out, p.out, D, mod + 5 * D}; pg8::gemm_phase<pg8::EpiRes, pg8::StaticOrder, true, true>(lds, g, S, E); }
    if constexpr (WHICH == G_CDIN) { pg8::Gemm g{(const bf16*)(act + A_A), (const bf16*)(ws + WS_WCD_IN), M, NCD, D, 0}; pg8::StaticOrder S; S.init(M, NCD, G, c);
        pg8::EpiStoreBf16 E{(bf16*)(act + A_P), NCD, nullptr}; pg8::gemm_phase<pg8::EpiStoreBf16, pg8::StaticOrder, true, true>(lds, g, S, E); }
    if constexpr (WHICH == G_CDOUT) { pg8::Gemm g{(const bf16*)(act + A_MIXB), (const bf16*)(ws + WS_WCD_OUT), M, D, CDO, 0}; pg8::StaticOrder S; S.init(M, D, G, c);
        pg8::EpiRes E{p.out, p.out, D, mod + 4 * 6144 + 2 * D}; pg8::gemm_phase<pg8::EpiRes, pg8::StaticOrder, true, true>(lds, g, S, E); }
    if constexpr (WHICH == G_MOEGU) { const int* off = (const int*)(ws + WS_ROUTE + R_OFF); const int nMt = __builtin_amdgcn_readfirstlane(off[8]) >> 8;
        pg8::Gemm g{(const bf16*)(act + A_A3P), (const bf16*)(ws + WS_WMOE_GU), nMt * 256, 2 * FFE, D, (size_t)2 * FFE * D * 2}; pg8::GroupedOrder S; S.init(nMt, 2 * FFE, G, c, (const int*)(ws + WS_ROUTE + R_TILEE));
        pg8::EpiSwiglu E{(bf16*)(act + A_HM), FFE}; pg8::gemm_phase<pg8::EpiSwiglu, pg8::GroupedOrder, true, true>(lds, g, S, E); }
    if constexpr (WHICH == G_MOED) { const int* off = (const int*)(ws + WS_ROUTE + R_OFF); const int nMt = __builtin_amdgcn_readfirstlane(off[8]) >> 8;
        pg8::Gemm g{(const bf16*)(act + A_HM), (const bf16*)(ws + WS_WMOE_D), nMt * 256, D, FFE, (size_t)D * FFE * 2}; pg8::GroupedOrder S; S.init(nMt, D, G, c, (const int*)(ws + WS_ROUTE + R_TILEE));
        pg8::EpiStoreBf16 E{(bf16*)(act + A_Y), D, (const float*)(ws + WS_ROUTE + R_GATEW)}; pg8::gemm_phase<pg8::EpiStoreBf16, pg8::GroupedOrder, true, true>(lds, g, S, E); }
}

__device__ __forceinline__ void ph_attn_naive(const Ctx& c, const Params& p) {
    const bf16* P0 = (const bf16*)(p.ws + WS_ACT + A_P); const float* relb = p.in[I_RELB];
    for (int gid = c.bid * NTHR + c.tid; gid < M * 8; gid += c.G * NTHR) {
        const int m = gid >> 3, h = gid & 7, t = m & (T - 1), kvh = h >> 2;
        float q[64], o[64];
        { const v4u* qp = (const v4u*)(P0 + (size_t)m * NAB + C_QA + h * 64);
#pragma unroll
          for (int i = 0; i < 8; ++i) { const v4u w = qp[i]; q[8 * i + 0] = bflo(w.x) * 0.125f; q[8 * i + 1] = bfhi(w.x) * 0.125f; q[8 * i + 2] = bflo(w.y) * 0.125f; q[8 * i + 3] = bfhi(w.y) * 0.125f;
              q[8 * i + 4] = bflo(w.z) * 0.125f; q[8 * i + 5] = bfhi(w.z) * 0.125f; q[8 * i + 6] = bflo(w.w) * 0.125f; q[8 * i + 7] = bfhi(w.w) * 0.125f; } }
#pragma unroll
        for (int i = 0; i < 64; ++i) o[i] = 0.f;
        float mx = p.in[I_SINK][h], l = 1.0f;
        const int nd = t + 1 < 128 ? t + 1 : 128;
        for (int dd = 0; dd < nd; ++dd) {
            const bf16* kr = P0 + (size_t)(m - dd) * NAB + C_KA + kvh * 64; const bf16* vr = P0 + (size_t)(m - dd) * NAB + C_VA + kvh * 64;
            float s = 0.f;
#pragma unroll
            for (int i = 0; i < 8; ++i) { const v4u w = ((const v4u*)kr)[i];
                s += q[8 * i + 0] * bflo(w.x) + q[8 * i + 1] * bfhi(w.x) + q[8 * i + 2] * bflo(w.y) + q[8 * i + 3] * bfhi(w.y) + q[8 * i + 4] * bflo(w.z) + q[8 * i + 5] * bfhi(w.z) + q[8 * i + 6] * bflo(w.w) + q[8 * i + 7] * bfhi(w.w); }
            s += relb[T5_BUCKET[dd] * 8 + h];
            const float mn = fmaxf(mx, s), sc = __expf(mx - mn), pp = __expf(s - mn);
            l = l * sc + pp; mx = mn;
#pragma unroll
            for (int i = 0; i < 8; ++i) { const v4u w = ((const v4u*)vr)[i];
                o[8 * i + 0] = o[8 * i + 0] * sc + pp * bflo(w.x); o[8 * i + 1] = o[8 * i + 1] * sc + pp * bfhi(w.x); o[8 * i + 2] = o[8 * i + 2] * sc + pp * bflo(w.y); o[8 * i + 3] = o[8 * i + 3] * sc + pp * bfhi(w.y);
                o[8 * i + 4] = o[8 * i + 4] * sc + pp * bflo(w.z); o[8 * i + 5] = o[8 * i + 5] * sc + pp * bfhi(w.z); o[8 * i + 6] = o[8 * i + 6] * sc + pp * bflo(w.w); o[8 * i + 7] = o[8 * i + 7] * sc + pp * bfhi(w.w); }
        }
        const float inv = 1.0f / l;
        v4u* op = (v4u*)((bf16*)(p.ws + WS_ACT + A_MIXA) + (size_t)m * D + h * 64);
#pragma unroll
        for (int i = 0; i < 8; ++i) { v4u w; w.x = pk2(o[8 * i] * inv, o[8 * i + 1] * inv); w.y = pk2(o[8 * i + 2] * inv, o[8 * i + 3] * inv); w.z = pk2(o[8 * i + 4] * inv, o[8 * i + 5] * inv); w.w = pk2(o[8 * i + 6] * inv, o[8 * i + 7] * inv); op[i] = w; }
    }
}

__device__ __forceinline__ void ph_dn_prep(const Ctx& c, const Params& p) {
    const bf16* P0 = (const bf16*)(p.ws + WS_ACT + A_P); const float* cw = p.in[I_DNCONV]; unsigned char* act = p.ws + WS_ACT; const int lane = c.lane;
    for (int it = c.gw; it < M * 8; it += c.NGW) {
        const int m = it >> 3, h = it & 7, t = m & (T - 1);
        float r[3];
#pragma unroll
        for (int s = 0; s < 3; ++s) { const int ch = s * 512 + h * 64 + lane; float a = 0.f;
#pragma unroll
            for (int k = 0; k < 4; ++k) { const int tt = t - 3 + k; if (tt >= 0) a += cw[k * 1536 + ch] * bf2f(P0[(size_t)(m - 3 + k) * NAB + C_QKVB + ch]); }
            r[s] = siluf_(a); }
        const float nq = 1.0f / sqrtf(wave_sum(r[0] * r[0]) + 1e-6f), nk = 1.0f / sqrtf(wave_sum(r[1] * r[1]) + 1e-6f);
        ((float*)(act + A_DNQ))[(size_t)m * 512 + h * 64 + lane] = r[0] * nq;
        ((float*)(act + A_DNK))[(size_t)m * 512 + h * 64 + lane] = r[1] * nk;
        ((float*)(act + A_DNV))[(size_t)m * 512 + h * 64 + lane] = r[2];
        if (lane == 0) { const float bb = bf2f(P0[(size_t)m * NAB + C_BETA + h]), ab = bf2f(P0[(size_t)m * NAB + C_AB + h]);
            ((float*)(act + A_DNB))[m * 8 + h] = sigmoidf_(bb);
            ((float*)(act + A_DNG))[m * 8 + h] = -__expf(p.in[I_ALOG][h]) * softplusf_(ab + p.in[I_DTB][h]); }
    }
}
__device__ __forceinline__ void ph_dn_scan(const Ctx& c, const Params& p) {
    if (c.wave != 0 || c.bid >= 32) return;
    LAS float* kq = (LAS float*)c.lds;
    const int b = c.bid >> 3, h = c.bid & 7, e = c.lane;
    unsigned char* act = p.ws + WS_ACT; const bf16* P0 = (const bf16*)(act + A_P);
    const float* Q = (const float*)(act + A_DNQ); const float* K = (const float*)(act + A_DNK); const float* V = (const float*)(act + A_DNV);
    const float* Bt = (const float*)(act + A_DNB); const float* Gt = (const float*)(act + A_DNG);
    const float nw = p.in[I_DNNORM][e];
    float S[64];
#pragma unroll
    for (int d = 0; d < 64; ++d) S[d] = 0.f;
    for (int t = 0; t < T; ++t) { const int m = b * T + t;
        asm volatile("s_waitcnt lgkmcnt(0)" ::: "memory");
        kq[e] = K[(size_t)m * 512 + h * 64 + e]; kq[64 + e] = Q[(size_t)m * 512 + h * 64 + e];
        const float v = V[(size_t)m * 512 + h * 64 + e], beta = Bt[m * 8 + h], eg = __expf(Gt[m * 8 + h]);
        asm volatile("s_waitcnt lgkmcnt(0)" ::: "memory");
        float kS = 0.f;
#pragma unroll
        for (int d = 0; d < 64; ++d) { S[d] *= eg; kS += kq[d] * S[d]; }
        const float dl = beta * (v - kS); float o = 0.f;
#pragma unroll
        for (int d = 0; d < 64; ++d) { S[d] += kq[d] * dl; o += kq[64 + d] * S[d]; }
        o *= 0.125f;
        const float rs = 1.0f / sqrtf(wave_sum(o * o) * (1.f / 64.f) + 1e-6f);
        const float gt = bf2f(P0[(size_t)m * NAB + C_GATEB + h * 64 + e]);
        ((bf16*)(act + A_MIXA))[(size_t)m * D + 512 + h * 64 + e] = (bf16)f2bf(o * rs * nw * siluf_(gt));
    }
}

__device__ __forceinline__ void ph_lru_conv(const Ctx& c, const Params& p) {
    const bf16* P1 = (const bf16*)(p.ws + WS_ACT + A_P); const float* cw = p.in[I_LCW];
    for (size_t gid = (size_t)c.bid * NTHR + c.tid; gid < (size_t)M * 1024; gid += (size_t)c.G * NTHR) {
        const int m = (int)(gid >> 10), ch = (int)(gid & 1023), t = m & (T - 1); float a = p.in[I_LCB][ch];
#pragma unroll
        for (int k = 0; k < 4; ++k) { const int tt = t - 3 + k; if (tt >= 0) a += cw[k * 1024 + ch] * bf2f(P1[(size_t)(m - 3 + k) * NCD + C_XC + ch]); }
        ((float*)(p.ws + WS_ACT + A_XC))[gid] = a; }
}
__device__ __forceinline__ void ph_lru_gates(const Ctx& c, const Params& p) {
    LAS float* xs = (LAS float*)(c.lds + c.wave * 512);
    const float* XC = (const float*)(p.ws + WS_ACT + A_XC);
    for (int it = c.gw; it < M * 8; it += c.NGW) { const int m = it >> 3, n = it & 7;
        asm volatile("s_waitcnt lgkmcnt(0)" ::: "memory");
        xs[c.lane] = XC[(size_t)m * 1024 + n * 128 + c.lane]; xs[64 + c.lane] = XC[(size_t)m * 1024 + n * 128 + 64 + c.lane];
        asm volatile("s_waitcnt lgkmcnt(0)" ::: "memory");
#pragma unroll
        for (int hh = 0; hh < 2; ++hh) { const int j = c.lane + 64 * hh, ch = n * 128 + j;
            const float* ga = p.in[I_GAW] + (size_t)n * 128 * 128 + j; const float* gx = p.in[I_GXW] + (size_t)n * 128 * 128 + j;
            float ra = 0.f, rx = 0.f;
            for (int i = 0; i < 128; ++i) { ra += xs[i] * ga[i * 128]; rx += xs[i] * gx[i * 128]; }
            const float r = sigmoidf_(ra + p.in[I_GAB][ch]), ii = sigmoidf_(rx + p.in[I_GXB][ch]);
            const float log_a = -8.0f * r * softplusf_(-p.in[I_LAM][ch]);
            ((float*)(p.ws + WS_LA))[(size_t)m * 1024 + ch] = __expf(log_a);
            ((float*)(p.ws + WS_LB))[(size_t)m * 1024 + ch] = sqrtf(-expm1f(2.0f * log_a)) * (ii * xs[j]); }
    }
}
__device__ __forceinline__ void ph_lru_scan(const Ctx& c, const Params& p) {
    if (c.wave != 0 || c.bid >= 64) return;
    const int gid = c.bid * 64 + c.lane, b = gid >> 10, ch = gid & 1023;
    const float* LA = (const float*)(p.ws + WS_LA); const float* LB = (const float*)(p.ws + WS_LB);
    const bf16* P1 = (const bf16*)(p.ws + WS_ACT + A_P); bf16* MIXB = (bf16*)(p.ws + WS_ACT + A_MIXB);
    float hs = 0.f;
    for (int t = 0; t < T; ++t) { const size_t m = (size_t)b * T + t; hs = LA[m * 1024 + ch] * hs + LB[m * 1024 + ch];
        MIXB[m * CDO + ch] = (bf16)f2bf(hs * gelu_tanhf_(bf2f(P1[m * NCD + C_YC + ch]))); }
}
__device__ __forceinline__ void ph_sconv(const Ctx& c, const Params& p) {
    const bf16* P1 = (const bf16*)(p.ws + WS_ACT + A_P); const float* sw = p.in[I_SCW];
    for (size_t gid = (size_t)c.bid * NTHR + c.tid; gid < (size_t)M * 512; gid += (size_t)c.G * NTHR) {
        const int m = (int)(gid >> 9), ch = (int)(gid & 511), t = m & (T - 1); float a = 0.f;
#pragma unroll
        for (int k = 0; k < 3; ++k) { const int tt = t - 2 + k; if (tt >= 0) { const size_t r = (size_t)(m - 2 + k) * NCD; a += sw[k * 512 + ch] * (bf2f(P1[r + C_CD + ch]) * bf2f(P1[r + C_HD + ch])); } }
        ((bf16*)(p.ws + WS_ACT + A_MIXB))[(size_t)m * CDO + 1024 + ch] = (bf16)f2bf(bf2f(P1[(size_t)m * NCD + C_BD + ch]) * a); }
}

__device__ __forceinline__ void ph_route(const Ctx& c, const Params& p) {
    LAS int* loff = (LAS int*)c.lds;
    if (c.tid == 0) { const unsigned* cnt = (const unsigned*)(p.ws + WS_CTL) + CW_CNT; int* off = (int*)(p.ws + WS_ROUTE + R_OFF); int* te = (int*)(p.ws + WS_ROUTE + R_TILEE);
        int o = 0;
        for (int e = 0; e < 8; ++e) { loff[e] = o; const int n = ((int)__hip_atomic_load(cnt + e, __ATOMIC_RELAXED, __HIP_MEMORY_SCOPE_AGENT) + 255) & ~255;
            if (c.bid == 0) { off[e] = o; for (int t = o >> 8; t < (o + n) >> 8 && t < MAXT; ++t) te[t] = e; }
            o += n; }
        loff[8] = o; if (c.bid == 0) off[8] = o < MPAD ? o : MPAD; }
    __syncthreads();
    const int* idx = (const int*)(p.ws + WS_ROUTE + R_IDX); const float* tw = (const float*)(p.ws + WS_ROUTE + R_W); unsigned* cur = (unsigned*)(p.ws + WS_CTL) + CW_CUR;
    for (int it = c.gw; it < 2 * M; it += c.NGW) { const int m = it >> 1; const int e = idx[it]; int pos = 0;
        if (c.lane == 0) pos = loff[e] + (int)atomicAdd(cur + e, 1u);
        pos = __shfl(pos, 0);
        if (c.lane == 0) { ((int*)(p.ws + WS_ROUTE + R_SLOT))[it] = pos; ((float*)(p.ws + WS_ROUTE + R_GATEW))[pos] = tw[it]; }
        const v4u* src = (const v4u*)((const bf16*)(p.ws + WS_A3) + (size_t)m * D); v4u* dst = (v4u*)((bf16*)(p.ws + WS_ACT + A_A3P) + (size_t)pos * D);
        dst[c.lane] = src[c.lane]; dst[c.lane + 64] = src[c.lane + 64]; }
}
__device__ __forceinline__ void ph_final(const Ctx& c, const Params& p) {
    const int lane = c.lane;
    const int* slot = (const int*)(p.ws + WS_ROUTE + R_SLOT); const bf16* Y = (const bf16*)(p.ws + WS_ACT + A_Y);
    const float* mod = (const float*)(p.ws + WS_MOD) + 4 * 6144; const float* fw = p.in[I_NFIN];
    for (int m = c.gw; m < M; m += c.NGW) { const int b = m >> 12; const float* g2 = mod + (size_t)b * 6144 + 5 * D;
        const int s0 = slot[2 * m], s1 = slot[2 * m + 1];
        f32x4* xr = (f32x4*)(p.out + (size_t)m * D) + lane; const v2u* y0 = (const v2u*)(Y + (size_t)s0 * D) + lane; const v2u* y1 = (const v2u*)(Y + (size_t)s1 * D) + lane;
        f32x4 v[4]; float s = 0.f;
#pragma unroll
        for (int j = 0; j < 4; ++j) { const f32x4 gv = *(const f32x4*)(g2 + 4 * lane + 256 * j); const v2u a = y0[64 * j], cc = y1[64 * j];
            f32x4 yy; yy.x = bflo(a.x) + bflo(cc.x); yy.y = bfhi(a.x) + bfhi(cc.x); yy.z = bflo(a.y) + bflo(cc.y); yy.w = bfhi(a.y) + bfhi(cc.y);
            v[j] = xr[64 * j] + gv * yy; s += (v[j].x * v[j].x + v[j].y * v[j].y) + (v[j].z * v[j].z + v[j].w * v[j].w); }
        const float rstd = 1.0f / sqrtf(wave_sum(s) * (1.f / D) + 1e-6f);
#pragma unroll
        for (int j = 0; j < 4; ++j) { const f32x4 wv = *(const f32x4*)(fw + 4 * lane + 256 * j); xr[64 * j] = v[j] * rstd * wv; }
    }
}


typedef short bf16x8_t __attribute__((ext_vector_type(8)));
typedef short s16x4_t __attribute__((ext_vector_type(4)));
typedef float f32x16 __attribute__((ext_vector_type(16)));
constexpr int AT_KSTR = 144, AT_VSTR = 520, AT_K = 0, AT_V = 256 * AT_KSTR, AT_BIAS = AT_V + 64 * AT_VSTR, AT_END = AT_BIAS + 2048;
typedef float f32x2_c __attribute__((ext_vector_type(2))); typedef __bf16 bf16x2_c __attribute__((ext_vector_type(2)));
__device__ __forceinline__ unsigned pkbf(float lo, float hi) { f32x2_c v = {lo, hi}; bf16x2_c b = __builtin_convertvector(v, bf16x2_c); return __builtin_bit_cast(unsigned, b); }
__device__ __forceinline__ void attn_unit(const Ctx& c, const Params& p, int u) {
    const int qb = u & 31, kvh = (u >> 5) & 1, b = u >> 6;
    const bf16* P0 = (const bf16*)(p.ws + WS_ACT + A_P);
    LAS unsigned char* lds = c.lds;
    __syncthreads();
    {
        const int key = c.tid >> 1, half = c.tid & 1, tk = 128 * (qb - 1) + key;
        v4u kv[4];
        if (tk >= 0) { const v4u* src = (const v4u*)(P0 + (size_t)(b * T + tk) * NAB + C_KA + kvh * 64 + 32 * half);
#pragma unroll
            for (int i = 0; i < 4; ++i) kv[i] = src[i]; }
        else {
#pragma unroll
            for (int i = 0; i < 4; ++i) kv[i] = (v4u){0u, 0u, 0u, 0u}; }
#pragma unroll
        for (int i = 0; i < 4; ++i) *(LAS v4u*)(lds + AT_K + key * AT_KSTR + 64 * half + 16 * i) = kv[i];
    }
    {
        const int kp = c.tid & 127, dq = c.tid >> 7, tk = 128 * (qb - 1) + 2 * kp;
        v4u va[2], vb[2];
        if (tk >= 0) { const v4u* s0 = (const v4u*)(P0 + (size_t)(b * T + tk) * NAB + C_VA + kvh * 64 + 16 * dq); const v4u* s1 = (const v4u*)(P0 + (size_t)(b * T + tk + 1) * NAB + C_VA + kvh * 64 + 16 * dq);
            va[0] = s0[0]; va[1] = s0[1]; vb[0] = s1[0]; vb[1] = s1[1]; }
        else { va[0] = va[1] = vb[0] = vb[1] = (v4u){0u, 0u, 0u, 0u}; }
#pragma unroll
        for (int i = 0; i < 2; ++i)
#pragma unroll
            for (int k = 0; k < 4; ++k) { const unsigned a = va[i][k], bb = vb[i][k]; const int d = 16 * dq + 8 * i + 2 * k;
                *(LAS unsigned*)(lds + AT_V + d * AT_VSTR + 4 * kp) = (a & 0xffffu) | (bb << 16);
                *(LAS unsigned*)(lds + AT_V + (d + 1) * AT_VSTR + 4 * kp) = (a >> 16) | (bb & 0xffff0000u); }
    }
    { const int hl = c.tid >> 7, dist = c.tid & 127; *(LAS float*)(lds + AT_BIAS + c.tid * 4) = p.in[I_RELB][T5_BUCKET[dist] * 8 + kvh * 4 + hl]; }
    __syncthreads();
    const int hl = c.wave >> 1, hq = kvh * 4 + hl, qh = c.wave & 1, qi = c.lane & 31, hh = c.lane >> 5;
    const float sink = p.in[I_SINK][hq];
    const LAS float* biasT = (const LAS float*)(lds + AT_BIAS + hl * 512);
#pragma unroll 1
    for (int s = 0; s < 2; ++s) {
        const int q0 = 64 * qh + 32 * s, kb0 = q0 >> 5, qq = q0 + qi; const size_t m = (size_t)b * T + 128 * qb + qq;
        bf16x8_t bq[4];
#pragma unroll
        for (int ks = 0; ks < 4; ++ks) bq[ks] = *(const bf16x8_t*)(P0 + m * NAB + C_QA + hq * 64 + 16 * ks + 8 * hh);
        f32x16 sacc[5];
#pragma unroll
        for (int kbi = 0; kbi < 5; ++kbi) {
            f32x16 acc;
#pragma unroll
            for (int r = 0; r < 16; ++r) acc[r] = 0.f;
#pragma unroll
            for (int ks = 0; ks < 4; ++ks) { const bf16x8_t ka = *(const LAS bf16x8_t*)(lds + AT_K + (32 * (kb0 + kbi) + qi) * AT_KSTR + 32 * ks + 16 * hh);
                acc = __builtin_amdgcn_mfma_f32_32x32x16_bf16(ka, bq[ks], acc, 0, 0, 0); }
            sacc[kbi] = acc;
        }
        float mx = -1e30f;
#pragma unroll
        for (int kbi = 0; kbi < 5; ++kbi)
#pragma unroll
            for (int r = 0; r < 16; ++r) { const int sidx = 32 * (kb0 + kbi) + (r & 3) + 8 * (r >> 2) + 4 * hh; const int dist = qq + 128 - sidx;
                const bool valid = dist >= 0 && dist < 128 && (qb > 0 || sidx >= 128);
                const float bv = biasT[dist & 127];
                const float sc = valid ? sacc[kbi][r] * 0.125f + bv : -1e30f; sacc[kbi][r] = sc; mx = fmaxf(mx, sc); }
        mx = fmaxf(mx, __shfl_xor(mx, 32)); mx = fmaxf(mx, sink);
        float l = 0.f;
#pragma unroll
        for (int kbi = 0; kbi < 5; ++kbi)
#pragma unroll
            for (int r = 0; r < 16; ++r) { const float pv = __expf(sacc[kbi][r] - mx); sacc[kbi][r] = pv; l += pv; }
        l += __shfl_xor(l, 32); l += __expf(sink - mx);
        const float inv = 1.0f / l;
        f32x16 oacc[2];
#pragma unroll
        for (int db = 0; db < 2; ++db)
#pragma unroll
            for (int r = 0; r < 16; ++r) oacc[db][r] = 0.f;
#pragma unroll
        for (int kbi = 0; kbi < 5; ++kbi)
#pragma unroll
            for (int s2 = 0; s2 < 2; ++s2) {
                v4u pw; pw.x = pkbf(sacc[kbi][8 * s2 + 0], sacc[kbi][8 * s2 + 1]); pw.y = pkbf(sacc[kbi][8 * s2 + 2], sacc[kbi][8 * s2 + 3]); pw.z = pkbf(sacc[kbi][8 * s2 + 4], sacc[kbi][8 * s2 + 5]); pw.w = pkbf(sacc[kbi][8 * s2 + 6], sacc[kbi][8 * s2 + 7]);
                const bf16x8_t pf = __builtin_bit_cast(bf16x8_t, pw);
                const int keyb = 32 * (kb0 + kbi) + 16 * s2 + 4 * hh;
#pragma unroll
                for (int db = 0; db < 2; ++db) { const LAS unsigned char* vp = lds + AT_V + (32 * db + qi) * AT_VSTR + 2 * keyb;
                    const s16x4_t lo = *(const LAS s16x4_t*)vp, hi = *(const LAS s16x4_t*)(vp + 16);
                    const bf16x8_t vf = (bf16x8_t){lo[0], lo[1], lo[2], lo[3], hi[0], hi[1], hi[2], hi[3]};
                    oacc[db] = __builtin_amdgcn_mfma_f32_32x32x16_bf16(vf, pf, oacc[db], 0, 0, 0); }
            }
        bf16* orow = (bf16*)(p.ws + WS_ACT + A_MIXA) + m * D + hq * 64;
#pragma unroll
        for (int db = 0; db < 2; ++db)
#pragma unroll
            for (int g = 0; g < 4; ++g) { v2u w; w.x = pkbf(oacc[db][4 * g] * inv, oacc[db][4 * g + 1] * inv); w.y = pkbf(oacc[db][4 * g + 2] * inv, oacc[db][4 * g + 3] * inv);
                *(v2u*)(orow + 32 * db + 8 * g + 4 * hh) = w; }
    }
}
__device__ __forceinline__ void ph_attn(const Ctx& c, const Params& p) {
    for (int u = c.bid; u < 256; u += c.G) attn_unit(c, p, u);
}


constexpr int LR_XSTR = 272, LR_XT = 0, LR_XF = 64 * LR_XSTR, LR_GA = LR_XF + 32768, LR_CMB = LR_GA + 32768, LR_END = LR_CMB + 4096;
constexpr size_t A_LCA = 192 * MiB, A_LCH = 193 * MiB;
typedef float f32x4_t __attribute__((ext_vector_type(4)));
template <int PASS>
__device__ __forceinline__ void ph_lru(const Ctx& c, const Params& p) {
    LAS unsigned char* lds = c.lds;
    const int n = c.bid & 7, ch = c.tid & 127, tq = c.tid >> 7, gch = n * 128 + ch;
    const bf16* P1 = (const bf16*)(p.ws + WS_ACT + A_P);
    float* CA = (float*)(p.ws + WS_ACT + A_LCA); float* CH = (float*)(p.ws + WS_ACT + A_LCH);
    const float cw0 = p.in[I_LCW][gch], cw1 = p.in[I_LCW][1024 + gch], cw2 = p.in[I_LCW][2048 + gch], cw3 = p.in[I_LCW][3072 + gch], cb = p.in[I_LCB][gch];
    const int jl = c.lane & 15, q = c.lane >> 4, w = c.wave, ech = n * 128 + 16 * w + jl;
    const float gab = p.in[I_GAB][ech], gxb = p.in[I_GXB][ech], sp8 = -8.0f * softplusf_(-p.in[I_LAM][ech]);
    bf16x8_t bfa[4], bfx[4];
    { const bf16* wl = (const bf16*)(p.ws + WS_WLRU) + (size_t)n * 256 * 128;
#pragma unroll
      for (int ks = 0; ks < 4; ++ks) { bfa[ks] = *(const bf16x8_t*)(wl + (size_t)(16 * w + jl) * 128 + 32 * ks + 8 * q); bfx[ks] = *(const bf16x8_t*)(wl + (size_t)(128 + 16 * w + jl) * 128 + 32 * ks + 8 * q); } }
    for (int u = c.bid >> 3; u < 256; u += (c.G >> 3)) {
        const int b = u >> 6, tt = u & 63; const size_t m0 = (size_t)b * T + 64 * tt;
        __syncthreads();
        { float x0, x1, x2; const int tb = 64 * tt + 16 * tq;
          const bf16* col = P1 + C_XC + gch;
          x0 = tb >= 3 ? bf2f(col[(m0 + 16 * tq - 3) * NCD]) : 0.f; x1 = tb >= 2 ? bf2f(col[(m0 + 16 * tq - 2) * NCD]) : 0.f; x2 = tb >= 1 ? bf2f(col[(m0 + 16 * tq - 1) * NCD]) : 0.f;
#pragma unroll
          for (int i = 0; i < 16; ++i) { const int tk = 16 * tq + i; const float x3 = bf2f(col[(m0 + tk) * NCD]);
              const float xc = cb + cw0 * x0 + cw1 * x1 + cw2 * x2 + cw3 * x3;
              *(LAS unsigned short*)(lds + LR_XT + tk * LR_XSTR + 2 * ch) = (unsigned short)f2bf(xc);
              *(LAS float*)(lds + LR_XF + (tk * 128 + ch) * 4) = xc;
              x0 = x1; x1 = x2; x2 = x3; } }
        __syncthreads();
#pragma unroll
        for (int mt = 0; mt < 4; ++mt) {
            f32x4_t aa = {0.f, 0.f, 0.f, 0.f}, ax = {0.f, 0.f, 0.f, 0.f};
#pragma unroll
            for (int ks = 0; ks < 4; ++ks) { const bf16x8_t af = *(const LAS bf16x8_t*)(lds + LR_XT + (16 * mt + jl) * LR_XSTR + 64 * ks + 16 * q);
                aa = __builtin_amdgcn_mfma_f32_16x16x32_bf16(af, bfa[ks], aa, 0, 0, 0); ax = __builtin_amdgcn_mfma_f32_16x16x32_bf16(af, bfx[ks], ax, 0, 0, 0); }
#pragma unroll
            for (int r4 = 0; r4 < 4; ++r4) { const int tk = 16 * mt + 4 * q + r4; LAS float* xf = (LAS float*)(lds + LR_XF + (tk * 128 + 16 * w + jl) * 4);
                const float r = sigmoidf_(aa[r4] + gab), ii = sigmoidf_(ax[r4] + gxb), la = sp8 * r, a = __expf(la);
                const float bb = sqrtf(fmaxf(1.0f - a * a, 0.f)) * (ii * xf[0]);
                *(LAS float*)(lds + LR_GA + (tk * 128 + 16 * w + jl) * 4) = a; xf[0] = bb; }
        }
        __syncthreads();
        float av[16], bv[16];
#pragma unroll
        for (int i = 0; i < 16; ++i) { av[i] = *(const LAS float*)(lds + LR_GA + ((16 * tq + i) * 128 + ch) * 4); bv[i] = *(const LAS float*)(lds + LR_XF + ((16 * tq + i) * 128 + ch) * 4); }
        float Ap = 1.f, h = 0.f;
#pragma unroll
        for (int i = 0; i < 16; ++i) { h = av[i] * h + bv[i]; Ap *= av[i]; }
        *(LAS float*)(lds + LR_CMB + (tq * 128 + ch) * 4) = Ap; *(LAS float*)(lds + LR_CMB + 2048 + (tq * 128 + ch) * 4) = h;
        __syncthreads();
        if (PASS == 1) {
            if (tq == 0) { float A = 1.f, H = 0.f;
#pragma unroll
                for (int g = 0; g < 4; ++g) { const float ag = *(const LAS float*)(lds + LR_CMB + (g * 128 + ch) * 4), hg = *(const LAS float*)(lds + LR_CMB + 2048 + (g * 128 + ch) * 4); H = ag * H + hg; A *= ag; }
                CA[(size_t)(b * 64 + tt) * 1024 + gch] = A; CH[(size_t)(b * 64 + tt) * 1024 + gch] = H; }
        } else {
            float hin = 0.f;
            for (int t2 = 0; t2 < tt; ++t2) hin = CA[(size_t)(b * 64 + t2) * 1024 + gch] * hin + CH[(size_t)(b * 64 + t2) * 1024 + gch];
            for (int g = 0; g < tq; ++g) { const float ag = *(const LAS float*)(lds + LR_CMB + (g * 128 + ch) * 4), hg = *(const LAS float*)(lds + LR_CMB + 2048 + (g * 128 + ch) * 4); hin = ag * hin + hg; }
            bf16* mo = (bf16*)(p.ws + WS_ACT + A_MIXB) + gch; const bf16* yc = P1 + C_YC + gch;
            float hs = hin;
#pragma unroll
            for (int i = 0; i < 16; ++i) { const size_t m = m0 + 16 * tq + i; hs = av[i] * hs + bv[i];
                const float y = bf2f(yc[m * NCD]); const float ge = y * sigmoidf_(1.5957691216057308f * (y + 0.044715f * y * y * y));
                mo[m * CDO] = (bf16)f2bf(hs * ge); }
        }
    }
}


constexpr size_t A_DNX = 160 * MiB, A_DNEG = 256 * MiB;
constexpr int DN_CHB = 49152, DN_W = 0, DN_QD = 8192, DN_QK = 16384, DN_KD = 24576, DN_U = 32768;
constexpr int DN_KS = 144, DN_R = 9216, DN_WAVE = 2 * DN_R;
__device__ __forceinline__ float rdl(float x, int i) { return __builtin_bit_cast(float, __builtin_amdgcn_readlane(__builtin_bit_cast(int, x), i)); }
__device__ __forceinline__ int lrow_off(int i) { const int a = (i - 1) >> 2, b = (i - 1) & 3; return 4 * (a + 1) * (2 * a + b); }
__host__ __device__ constexpr int lrow_off_c(int i) { return 4 * (((i - 1) >> 2) + 1) * (2 * ((i - 1) >> 2) + ((i - 1) & 3)); }

typedef __amdgpu_buffer_rsrc_t rsrc_t;
__device__ __forceinline__ rsrc_t mk_rsrc(const void* base, unsigned bytes) { return __builtin_amdgcn_make_buffer_rsrc((void*)base, 0, bytes, 0x00020000); }
__device__ __forceinline__ void dn_conv_row(rsrc_t rp, const float* cw, int rowoff, int n, int lane, int coffb, int woff, float (&acc)[64]) {
#pragma unroll
    for (int ch = 0; ch < 64; ++ch) acc[ch] = 0.f;
#pragma unroll
    for (int k = 0; k < 4; ++k) { const int tt = 64 * n + lane - 3 + k;
        v4u xr[8];
        if (tt >= 0) {
#pragma unroll
            for (int i = 0; i < 8; ++i) xr[i] = __builtin_amdgcn_raw_buffer_load_b128(rp, rowoff + (k - 3) * (NAB * 2) + 16 * i, coffb, 0); }
        else {
#pragma unroll
            for (int i = 0; i < 8; ++i) xr[i] = (v4u){0u, 0u, 0u, 0u}; }
#pragma unroll
        for (int i = 0; i < 8; ++i)
#pragma unroll
            for (int e = 0; e < 4; ++e) { const unsigned w = xr[i][e]; acc[8 * i + 2 * e] += cw[k * 1536 + woff + 8 * i + 2 * e] * bflo(w); acc[8 * i + 2 * e + 1] += cw[k * 1536 + woff + 8 * i + 2 * e + 1] * bfhi(w); }
        asm volatile("" ::: "memory"); }
#pragma unroll
    for (int ch = 0; ch < 64; ++ch) acc[ch] = siluf_(acc[ch]);
}
__device__ __forceinline__ void fnma(float& acc, float a, float b) { asm volatile("v_fma_f32 %0, -%1, %2, %0" : "+v"(acc) : "v"(a), "v"(b)); }
__device__ __forceinline__ void dn_solve(const LAS unsigned char* R2, float (&x)[64]) {
#pragma unroll
    for (int i = 1; i < 64; ++i) {
        float a0 = x[i], a1 = 0.f;
#pragma unroll
        for (int g = 0; g < (i + 3) / 4; ++g) { const f32x4_t lv = *(const LAS f32x4_t*)(R2 + (lrow_off_c(i) + 4 * g) * 4);
#pragma unroll
            for (int e = 0; e < 4; ++e) if (4 * g + e < i) { if (e & 1) fnma(a1, lv[e], x[4 * g + e]); else fnma(a0, lv[e], x[4 * g + e]); } }
        x[i] = a0 + a1;
    }
}
__device__ __forceinline__ void dn_prep_chunk(const Ctx& c, const Params& p, int ci, size_t xoff) {
    const int n = ci & 63, h = (ci >> 6) & 7, b = ci >> 9, lane = c.lane;
    const int m0 = b * T + 64 * n;
    LAS unsigned char* R1 = c.lds + c.wave * DN_WAVE; LAS unsigned char* R2 = R1 + DN_R;
    const float* cw = p.in[I_DNCONV];
    const rsrc_t rp = mk_rsrc(p.ws + WS_ACT + A_P, (unsigned)((size_t)M * NAB * 2));
    const rsrc_t rx = mk_rsrc(p.ws + xoff + (size_t)ci * DN_CHB, DN_CHB);
    const int rowoff = (m0 + lane) * (NAB * 2);
#pragma unroll
    for (int s = 0; s < 2; ++s) {
        float acc[64]; dn_conv_row(rp, cw, rowoff, n, lane, (C_QKVB + s * 512 + h * 64) * 2, s * 512 + h * 64, acc);
        float ss = 0.f;
#pragma unroll
        for (int ch = 0; ch < 64; ++ch) ss += acc[ch] * acc[ch];
        const float rn = (s == 1 ? 1.0f : 0.125f) / sqrtf(ss + 1e-6f);
        LAS unsigned char* dst = (s == 1 ? R1 : R2) + lane * DN_KS;
#pragma unroll
        for (int i = 0; i < 8; ++i) { v4u w; w.x = pkbf(acc[8 * i] * rn, acc[8 * i + 1] * rn); w.y = pkbf(acc[8 * i + 2] * rn, acc[8 * i + 3] * rn); w.z = pkbf(acc[8 * i + 4] * rn, acc[8 * i + 5] * rn); w.w = pkbf(acc[8 * i + 6] * rn, acc[8 * i + 7] * rn);
            *(LAS v4u*)(dst + 16 * i) = w; }
        asm volatile("" ::: "memory");
    }
    const float beta = sigmoidf_(bf2f(__builtin_amdgcn_raw_buffer_load_b16(rp, rowoff, (C_BETA + h) * 2, 0)));
    float gc = -__expf(p.in[I_ALOG][h]) * softplusf_(bf2f(__builtin_amdgcn_raw_buffer_load_b16(rp, rowoff, (C_AB + h) * 2, 0)) + p.in[I_DTB][h]);
#pragma unroll
    for (int o = 1; o < 64; o <<= 1) { const float t = __shfl_up(gc, o); if (lane >= o) gc += t; }
    const float gl = rdl(gc, 63), egc = __expf(gc), kdsc = __expf(gl - gc), bw = beta * egc;
    if (lane == 0) ((float*)(p.ws + WS_ACT + A_DNEG))[ci] = __expf(gl);
    asm volatile("s_waitcnt lgkmcnt(0)" ::: "memory");
    const int r32 = lane & 31, hh = lane >> 5, l15 = lane & 15, q4 = lane >> 4;
#pragma unroll
    for (int blk = 0; blk < 4; ++blk) { const int I = blk >> 1, J = blk & 1;
        v4u fa = {0u, 0u, 0u, 0u}, fb = {0u, 0u, 0u, 0u};
        if (!(I == 0 && J == 1)) {
            f32x16 acc;
#pragma unroll
            for (int r = 0; r < 16; ++r) acc[r] = 0.f;
#pragma unroll
            for (int ks = 0; ks < 4; ++ks) { const bf16x8_t ka = *(const LAS bf16x8_t*)(R1 + (32 * J + r32) * DN_KS + 32 * ks + 16 * hh), qb = *(const LAS bf16x8_t*)(R2 + (32 * I + r32) * DN_KS + 32 * ks + 16 * hh);
                acc = __builtin_amdgcn_mfma_f32_32x32x16_bf16(ka, qb, acc, 0, 0, 0); }
            const int i = 32 * I + r32; const float gci = __shfl(gc, i);
            float v[16];
#pragma unroll
            for (int r = 0; r < 16; ++r) { const int j = 32 * J + (r & 3) + 8 * (r >> 2) + 4 * hh; const float gcj = __shfl(gc, j); v[r] = j <= i ? acc[r] * __expf(gci - gcj) : 0.f; }
            fa.x = pkbf(v[0], v[1]); fa.y = pkbf(v[2], v[3]); fa.z = pkbf(v[8], v[9]); fa.w = pkbf(v[10], v[11]);
            fb.x = pkbf(v[4], v[5]); fb.y = pkbf(v[6], v[7]); fb.z = pkbf(v[12], v[13]); fb.w = pkbf(v[14], v[15]);
        }
        const int vo = (r32 >> 4) * 2048 + (l15 + 16 * hh) * 16;
        __builtin_amdgcn_raw_buffer_store_b128(fa, rx, (vo) + (DN_QK + 4096 * I + 1024 * J), 0, 0);
        __builtin_amdgcn_raw_buffer_store_b128(fb, rx, (vo) + (DN_QK + 4096 * I + 1024 * J + 512), 0, 0);
    }
#pragma unroll
    for (int mt = 0; mt < 4; ++mt) { const int row = 16 * mt + l15; const float sc = __shfl(egc, row);
#pragma unroll
        for (int ks = 0; ks < 2; ++ks) { const v2u a = *(const LAS v2u*)(R2 + row * DN_KS + 64 * ks + 8 * q4), bq = *(const LAS v2u*)(R2 + row * DN_KS + 64 * ks + 32 + 8 * q4);
            v4u w; w.x = pkbf(bflo(a.x) * sc, bfhi(a.x) * sc); w.y = pkbf(bflo(a.y) * sc, bfhi(a.y) * sc); w.z = pkbf(bflo(bq.x) * sc, bfhi(bq.x) * sc); w.w = pkbf(bflo(bq.y) * sc, bfhi(bq.y) * sc);
            __builtin_amdgcn_raw_buffer_store_b128(w, rx, (lane * 16) + (DN_QD + (mt * 2 + ks) * 1024), 0, 0); } }
    asm volatile("s_waitcnt lgkmcnt(0)" ::: "memory");
#pragma unroll
    for (int blk = 0; blk < 3; ++blk) { const int I = blk == 0 ? 0 : 1, J = blk == 2 ? 1 : 0;
        f32x16 acc;
#pragma unroll
        for (int r = 0; r < 16; ++r) acc[r] = 0.f;
#pragma unroll
        for (int ks = 0; ks < 4; ++ks) { const bf16x8_t ki = *(const LAS bf16x8_t*)(R1 + (32 * I + r32) * DN_KS + 32 * ks + 16 * hh), kj = *(const LAS bf16x8_t*)(R1 + (32 * J + r32) * DN_KS + 32 * ks + 16 * hh);
            acc = __builtin_amdgcn_mfma_f32_32x32x16_bf16(ki, kj, acc, 0, 0, 0); }
        const int j = 32 * J + r32; const float gcj = __shfl(gc, j);
#pragma unroll
        for (int r = 0; r < 16; ++r) { const int i = 32 * I + (r & 3) + 8 * (r >> 2) + 4 * hh; const float gci = __shfl(gc, i), bi = __shfl(beta, i);
            if (i > j) *(LAS float*)(R2 + (lrow_off(i) + j) * 4) = bi * acc[r] * __expf(gci - gcj); }
    }
    asm volatile("s_waitcnt lgkmcnt(0)" ::: "memory");
    {   float xu[64];
        { const int cb = (C_QKVB + 1024 + h * 64) * 2, wo = 1024 + h * 64 + lane;
          const float w0 = cw[wo], w1 = cw[1536 + wo], w2 = cw[2 * 1536 + wo], w3 = cw[3 * 1536 + wo];
          float x0 = 0.f, x1 = 0.f, x2 = 0.f;
          if (n > 0) { x0 = bf2f(__builtin_amdgcn_raw_buffer_load_b16(rp, lane * 2, (m0 - 3) * (NAB * 2) + cb, 0)); x1 = bf2f(__builtin_amdgcn_raw_buffer_load_b16(rp, lane * 2, (m0 - 2) * (NAB * 2) + cb, 0)); x2 = bf2f(__builtin_amdgcn_raw_buffer_load_b16(rp, lane * 2, (m0 - 1) * (NAB * 2) + cb, 0)); }
#pragma unroll
          for (int i = 0; i < 64; ++i) { const float x3 = bf2f(__builtin_amdgcn_raw_buffer_load_b16(rp, lane * 2, (m0 + i) * (NAB * 2) + cb, 0)); xu[i] = siluf_(w0 * x0 + w1 * x1 + w2 * x2 + w3 * x3) * rdl(beta, i); x0 = x1; x1 = x2; x2 = x3; } }
        dn_solve(R2, xu);
        const int vo = q4 * 4096 + l15 * 16;
#pragma unroll
        for (int mt = 0; mt < 4; ++mt)
#pragma unroll
            for (int qq = 0; qq < 4; ++qq) { const int i0 = 16 * mt + 4 * qq; f32x4_t uv = {xu[i0], xu[i0 + 1], xu[i0 + 2], xu[i0 + 3]};
                __builtin_amdgcn_raw_buffer_store_b128(__builtin_bit_cast(v4u, uv), rx, (vo) + (DN_U + mt * 1024 + qq * 256), 0, 0); }
    }
    asm volatile("" ::: "memory");
    float xw[64];
#pragma unroll
    for (int i = 0; i < 64; ++i) xw[i] = bf2f(*(const LAS unsigned short*)(R1 + i * DN_KS + 2 * lane)) * rdl(bw, i);
    asm volatile("s_waitcnt lgkmcnt(0)" ::: "memory");
    { LAS unsigned char* row = R1 + lane * DN_KS;
#pragma unroll
      for (int i = 0; i < 8; ++i) { v4u w = *(LAS v4u*)(row + 16 * i);
          w.x = pkbf(bflo(w.x) * kdsc, bfhi(w.x) * kdsc); w.y = pkbf(bflo(w.y) * kdsc, bfhi(w.y) * kdsc); w.z = pkbf(bflo(w.z) * kdsc, bfhi(w.z) * kdsc); w.w = pkbf(bflo(w.w) * kdsc, bfhi(w.w) * kdsc);
          *(LAS v4u*)(row + 16 * i) = w; } }
    asm volatile("s_waitcnt lgkmcnt(0)" ::: "memory");
#pragma unroll
    for (int dt = 0; dt < 4; ++dt)
#pragma unroll
        for (int ks = 0; ks < 2; ++ks) { unsigned short e[8];
#pragma unroll
            for (int jj = 0; jj < 8; ++jj) e[jj] = *(const LAS unsigned short*)(R1 + (32 * ks + 16 * (jj >> 2) + 4 * q4 + (jj & 3)) * DN_KS + 2 * (16 * dt + l15));
            v4u w; w.x = e[0] | ((unsigned)e[1] << 16); w.y = e[2] | ((unsigned)e[3] << 16); w.z = e[4] | ((unsigned)e[5] << 16); w.w = e[6] | ((unsigned)e[7] << 16);
            __builtin_amdgcn_raw_buffer_store_b128(w, rx, (lane * 16) + (DN_KD + (dt * 2 + ks) * 1024), 0, 0); }
    asm volatile("s_waitcnt lgkmcnt(0)" ::: "memory");
    dn_solve(R2, xw);
#pragma unroll
    for (int i = 0; i < 64; ++i) *(LAS unsigned short*)(R1 + i * DN_KS + 2 * lane) = (unsigned short)(f2bf(xw[i]) ^ 0x8000u);
    asm volatile("s_waitcnt lgkmcnt(0)" ::: "memory");
#pragma unroll
    for (int mt = 0; mt < 4; ++mt)
#pragma unroll
        for (int ks = 0; ks < 2; ++ks) { const int row = 16 * mt + l15; const v2u a = *(const LAS v2u*)(R1 + row * DN_KS + 64 * ks + 8 * q4), bq = *(const LAS v2u*)(R1 + row * DN_KS + 64 * ks + 32 + 8 * q4);
            v4u w; w.x = a.x; w.y = a.y; w.z = bq.x; w.w = bq.y;
            __builtin_amdgcn_raw_buffer_store_b128(w, rx, (lane * 16) + (DN_W + (mt * 2 + ks) * 1024), 0, 0); }
    asm volatile("s_waitcnt lgkmcnt(0)" ::: "memory");
}
__device__ __forceinline__ void ph_dn_prep2(const Ctx& c, const Params& p, size_t xoff) {
    if (c.gw < 2048) dn_prep_chunk(c, p, c.gw, xoff);
}

constexpr int SC_SLOT = DN_CHB, SC_OB = 2 * DN_CHB, SC_OSTR = 272, SC_OBSZ = 64 * SC_OSTR;
__device__ __forceinline__ bf16x8_t pack8(const f32x4_t& a, const f32x4_t& b) { v4u w; w.x = pkbf(a[0], a[1]); w.y = pkbf(a[2], a[3]); w.z = pkbf(b[0], b[1]); w.w = pkbf(b[2], b[3]); return __builtin_bit_cast(bf16x8_t, w); }
__device__ __forceinline__ void ph_dn_scan2(const Ctx& c, const Params& p) {
    if (c.bid >= 32) return;
    const int b = c.bid >> 3, h = c.bid & 7, lane = c.lane;
    LAS unsigned char* lds = c.lds;
    const unsigned char* dnx = p.ws + WS_ACT + A_DNX + (size_t)(c.bid * 64) * DN_CHB; const float* EG = (const float*)(p.ws + WS_ACT + A_DNEG) + c.bid * 64;
    const bf16* P0 = (const bf16*)(p.ws + WS_ACT + A_P);
    if (c.wave >= 4) {
        const int lw = c.wave - 4, il = lane >> 2, qd = lane & 3;
        float nw[16];
#pragma unroll
        for (int k = 0; k < 16; ++k) nw[k] = p.in[I_DNNORM][16 * qd + k];
        v4u ra[12], rb[12], ga[2] = {{0u, 0u, 0u, 0u}, {0u, 0u, 0u, 0u}}, gb[2] = {{0u, 0u, 0u, 0u}, {0u, 0u, 0u, 0u}};
#define DN_LOAD(R, k) do { const v4u* _s = (const v4u*)(dnx + (size_t)(k) * DN_CHB) + lw * 64 + lane; _Pragma("unroll") for (int _i = 0; _i < 12; ++_i) R[_i] = _s[_i * 256]; } while (0)
#define DN_WRITE(R, slot) do { LAS v4u* _d = (LAS v4u*)(lds + (slot) * SC_SLOT) + lw * 64 + lane; _Pragma("unroll") for (int _i = 0; _i < 12; ++_i) _d[_i * 256] = R[_i]; } while (0)
#define DN_GLOAD(G, k) do { const v4u* _g = (const v4u*)(P0 + ((size_t)b * T + 64 * (k) + 16 * lw + il) * NAB + C_GATEB + h * 64 + 16 * qd); G[0] = _g[0]; G[1] = _g[1]; } while (0)
#define DN_EPI(G, k) do { const LAS unsigned char* _ob = lds + SC_OB + ((k) & 1) * SC_OBSZ + (16 * lw + il) * SC_OSTR + 64 * qd; float _o[16]; float _ss = 0.f; \
            _Pragma("unroll") for (int _i = 0; _i < 4; ++_i) { const f32x4_t _v = *(const LAS f32x4_t*)(_ob + 16 * _i); _o[4 * _i] = _v[0]; _o[4 * _i + 1] = _v[1]; _o[4 * _i + 2] = _v[2]; _o[4 * _i + 3] = _v[3]; _ss += (_v[0] * _v[0] + _v[1] * _v[1]) + (_v[2] * _v[2] + _v[3] * _v[3]); } \
            _ss += __shfl_xor(_ss, 1); _ss += __shfl_xor(_ss, 2); const float _rs = 1.0f / sqrtf(_ss * (1.f / 64.f) + 1e-6f); unsigned _w[8]; \
            _Pragma("unroll") for (int _i = 0; _i < 8; ++_i) { const unsigned _gw = G[_i >> 2][_i & 3]; const float _g0 = bflo(_gw), _g1 = bfhi(_gw); _w[_i] = pkbf(_o[2 * _i] * _rs * nw[2 * _i] * siluf_(_g0), _o[2 * _i + 1] * _rs * nw[2 * _i + 1] * siluf_(_g1)); } \
            v4u* _dst = (v4u*)((bf16*)(p.ws + WS_ACT + A_MIXA) + ((size_t)b * T + 64 * (k) + 16 * lw + il) * D + 512 + h * 64 + 16 * qd); _dst[0] = (v4u){_w[0], _w[1], _w[2], _w[3]}; _dst[1] = (v4u){_w[4], _w[5], _w[6], _w[7]}; } while (0)
        DN_LOAD(ra, 0); DN_WRITE(ra, 0); DN_LOAD(rb, 1); DN_LOAD(ra, 2);
        for (int n = 0; n < 64; n += 2) {
            asm volatile("s_waitcnt lgkmcnt(0)" ::: "memory"); __syncthreads();
            DN_WRITE(rb, 1);
            if (n >= 1) DN_EPI(gb, n - 1);
            DN_GLOAD(ga, n);
            if (n + 3 < 64) DN_LOAD(rb, n + 3);
            asm volatile("s_waitcnt lgkmcnt(0)" ::: "memory"); __syncthreads();
            if (n + 2 < 64) DN_WRITE(ra, 0);
            DN_EPI(ga, n);
            DN_GLOAD(gb, n + 1);
            if (n + 4 < 64) DN_LOAD(ra, n + 4);
        }
        asm volatile("s_waitcnt lgkmcnt(0)" ::: "memory"); __syncthreads();
        DN_EPI(gb, 63);
#undef DN_LOAD
#undef DN_WRITE
#undef DN_GLOAD
#undef DN_EPI
    } else {
        const int w = c.wave, e15 = lane & 15, q4 = lane >> 4;
        f32x4_t S[4];
#pragma unroll
        for (int dt = 0; dt < 4; ++dt) S[dt] = (f32x4_t){0.f, 0.f, 0.f, 0.f};
        float egn = EG[0];
#define DN_STEP(n_, slot) do { const LAS unsigned char* sb = lds + (slot) * SC_SLOT; const float eg = egn; egn = EG[(n_) + 1 < 64 ? (n_) + 1 : 63]; \
            const bf16x8_t Bs0 = pack8(S[0], S[1]), Bs1 = pack8(S[2], S[3]); f32x4_t vn[4], oo[4]; \
            _Pragma("unroll") for (int mt = 0; mt < 4; ++mt) { vn[mt] = *(const LAS f32x4_t*)(sb + DN_U + ((w * 4 + mt) * 64 + lane) * 16); \
                vn[mt] = __builtin_amdgcn_mfma_f32_16x16x32_bf16(*(const LAS bf16x8_t*)(sb + DN_W + ((mt * 2 + 0) * 64 + lane) * 16), Bs0, vn[mt], 0, 0, 0); \
                vn[mt] = __builtin_amdgcn_mfma_f32_16x16x32_bf16(*(const LAS bf16x8_t*)(sb + DN_W + ((mt * 2 + 1) * 64 + lane) * 16), Bs1, vn[mt], 0, 0, 0); \
                oo[mt] = (f32x4_t){0.f, 0.f, 0.f, 0.f}; \
                oo[mt] = __builtin_amdgcn_mfma_f32_16x16x32_bf16(*(const LAS bf16x8_t*)(sb + DN_QD + ((mt * 2 + 0) * 64 + lane) * 16), Bs0, oo[mt], 0, 0, 0); \
                oo[mt] = __builtin_amdgcn_mfma_f32_16x16x32_bf16(*(const LAS bf16x8_t*)(sb + DN_QD + ((mt * 2 + 1) * 64 + lane) * 16), Bs1, oo[mt], 0, 0, 0); } \
            const bf16x8_t Bv0 = pack8(vn[0], vn[1]), Bv1 = pack8(vn[2], vn[3]); \
            _Pragma("unroll") for (int mt = 0; mt < 4; ++mt) { \
                oo[mt] = __builtin_amdgcn_mfma_f32_16x16x32_bf16(*(const LAS bf16x8_t*)(sb + DN_QK + ((mt * 2 + 0) * 64 + lane) * 16), Bv0, oo[mt], 0, 0, 0); \
                if (mt >= 2) oo[mt] = __builtin_amdgcn_mfma_f32_16x16x32_bf16(*(const LAS bf16x8_t*)(sb + DN_QK + ((mt * 2 + 1) * 64 + lane) * 16), Bv1, oo[mt], 0, 0, 0); } \
            _Pragma("unroll") for (int dt = 0; dt < 4; ++dt) { S[dt] = S[dt] * eg; \
                S[dt] = __builtin_amdgcn_mfma_f32_16x16x32_bf16(*(const LAS bf16x8_t*)(sb + DN_KD + ((dt * 2 + 0) * 64 + lane) * 16), Bv0, S[dt], 0, 0, 0); \
                S[dt] = __builtin_amdgcn_mfma_f32_16x16x32_bf16(*(const LAS bf16x8_t*)(sb + DN_KD + ((dt * 2 + 1) * 64 + lane) * 16), Bv1, S[dt], 0, 0, 0); } \
            LAS unsigned char* ob = lds + SC_OB + ((n_) & 1) * SC_OBSZ + (16 * w + e15) * 4; \
            _Pragma("unroll") for (int mt = 0; mt < 4; ++mt) _Pragma("unroll") for (int r4 = 0; r4 < 4; ++r4) *(LAS float*)(ob + (16 * mt + 4 * q4 + r4) * SC_OSTR) = oo[mt][r4]; } while (0)
        for (int n = 0; n < 64; n += 2) {
            asm volatile("s_waitcnt lgkmcnt(0)" ::: "memory"); __syncthreads();
            DN_STEP(n, 0);
            asm volatile("s_waitcnt lgkmcnt(0)" ::: "memory"); __syncthreads();
            DN_STEP(n + 1, 1);
        }
        asm volatile("s_waitcnt lgkmcnt(0)" ::: "memory"); __syncthreads();
#undef DN_STEP
    }
}


constexpr size_t A_ODN = 257 * MiB;
__device__ __forceinline__ void ph_dn_scan_simple(const Ctx& c, const Params& p) {
    if (c.bid >= 32 || c.wave >= 4) return;
    const int b = c.bid >> 3, h = c.bid & 7, lane = c.lane, w = c.wave, e15 = lane & 15, q4 = lane >> 4;
    const unsigned char* dnx = p.ws + WS_ACT + A_DNX + (size_t)(c.bid * 64) * DN_CHB; const float* EG = (const float*)(p.ws + WS_ACT + A_DNEG) + c.bid * 64;
    float* ODN = (float*)(p.ws + WS_ACT + A_ODN);
    f32x4_t S[4];
#pragma unroll
    for (int dt = 0; dt < 4; ++dt) S[dt] = (f32x4_t){0.f, 0.f, 0.f, 0.f};
    for (int n = 0; n < 64; ++n) { const unsigned char* sb = dnx + (size_t)n * DN_CHB; const float eg = EG[n];
        const bf16x8_t Bs0 = pack8(S[0], S[1]), Bs1 = pack8(S[2], S[3]); f32x4_t vn[4], oo[4];
#pragma unroll
        for (int mt = 0; mt < 4; ++mt) { vn[mt] = *(const f32x4_t*)(sb + DN_U + ((w * 4 + mt) * 64 + lane) * 16);
            vn[mt] = __builtin_amdgcn_mfma_f32_16x16x32_bf16(*(const bf16x8_t*)(sb + DN_W + ((mt * 2 + 0) * 64 + lane) * 16), Bs0, vn[mt], 0, 0, 0);
            vn[mt] = __builtin_amdgcn_mfma_f32_16x16x32_bf16(*(const bf16x8_t*)(sb + DN_W + ((mt * 2 + 1) * 64 + lane) * 16), Bs1, vn[mt], 0, 0, 0);
            oo[mt] = (f32x4_t){0.f, 0.f, 0.f, 0.f};
            oo[mt] = __builtin_amdgcn_mfma_f32_16x16x32_bf16(*(const bf16x8_t*)(sb + DN_QD + ((mt * 2 + 0) * 64 + lane) * 16), Bs0, oo[mt], 0, 0, 0);
            oo[mt] = __builtin_amdgcn_mfma_f32_16x16x32_bf16(*(const bf16x8_t*)(sb + DN_QD + ((mt * 2 + 1) * 64 + lane) * 16), Bs1, oo[mt], 0, 0, 0); }
        const bf16x8_t Bv0 = pack8(vn[0], vn[1]), Bv1 = pack8(vn[2], vn[3]);
#pragma unroll
        for (int mt = 0; mt < 4; ++mt) {
            oo[mt] = __builtin_amdgcn_mfma_f32_16x16x32_bf16(*(const bf16x8_t*)(sb + DN_QK + ((mt * 2 + 0) * 64 + lane) * 16), Bv0, oo[mt], 0, 0, 0);
            oo[mt] = __builtin_amdgcn_mfma_f32_16x16x32_bf16(*(const bf16x8_t*)(sb + DN_QK + ((mt * 2 + 1) * 64 + lane) * 16), Bv1, oo[mt], 0, 0, 0); }
#pragma unroll
        for (int dt = 0; dt < 4; ++dt) { S[dt] = S[dt] * eg;
            S[dt] = __builtin_amdgcn_mfma_f32_16x16x32_bf16(*(const bf16x8_t*)(sb + DN_KD + ((dt * 2 + 0) * 64 + lane) * 16), Bv0, S[dt], 0, 0, 0);
            S[dt] = __builtin_amdgcn_mfma_f32_16x16x32_bf16(*(const bf16x8_t*)(sb + DN_KD + ((dt * 2 + 1) * 64 + lane) * 16), Bv1, S[dt], 0, 0, 0); }
#pragma unroll
        for (int mt = 0; mt < 4; ++mt)
#pragma unroll
            for (int r4 = 0; r4 < 4; ++r4) ODN[((size_t)b * T + 64 * n + 16 * mt + 4 * q4 + r4) * 512 + h * 64 + 16 * w + e15] = oo[mt][r4];
    }
}
__device__ __forceinline__ void ph_dn_epi_simple(const Ctx& c, const Params& p) {
    const float* ODN = (const float*)(p.ws + WS_ACT + A_ODN); const bf16* P0 = (const bf16*)(p.ws + WS_ACT + A_P);
    for (int it = c.gw; it < M * 8; it += c.NGW) { const int m = it >> 3, h = it & 7;
        const float o = ODN[(size_t)m * 512 + h * 64 + c.lane];
        const float rs = 1.0f / sqrtf(wave_sum(o * o) * (1.f / 64.f) + 1e-6f);
        const float gt = bf2f(P0[(size_t)m * NAB + C_GATEB + h * 64 + c.lane]);
        ((bf16*)(p.ws + WS_ACT + A_MIXA))[(size_t)m * D + 512 + h * 64 + c.lane] = (bf16)f2bf(o * rs * p.in[I_DNNORM][c.lane] * siluf_(gt)); }
}

__global__ void __launch_bounds__(NTHR, 2) mega(MArgs a) {
    extern __shared__ __attribute__((aligned(16))) unsigned char lds_raw[];
    Ctx c; c.lds = (LAS unsigned char*)lds_raw; c.tid = threadIdx.x; c.lane = c.tid & 63; c.wave = __builtin_amdgcn_readfirstlane(c.tid >> 6);
    c.G = gridDim.x; c.bid = blockIdx.x; c.gw = c.bid * NWAVES + c.wave; c.NGW = c.G * NWAVES;
    const Params& p = a.p;
    volatile LAS unsigned* MISC = (volatile LAS unsigned*)(c.lds + LDS_MISC);
    if (c.tid < 64) MISC[c.tid] = 0u;
    __syncthreads();
    XcdBarrier bar = xcd_barrier_post((unsigned*)(p.ws + WS_CTL) + CW_BAR, MISC);
    const int lo = a.ph_lo, hi = a.ph_hi;
#define IN(k) (lo <= (k) && (k) < hi)
#define SEAM(k) do { if (IN(k) && IN((k) + 1)) xcd_barrier(bar); } while (0)
    if (IN(0)) { ph_convert(c, a.t1); ph_ada(c, p); } SEAM(0);
    if (IN(1)) { ph_norm<0>(c, p); } SEAM(1);
    if (IN(2)) { ph_gemm<G_ABIN>(c, p); } SEAM(2);
    if (IN(3)) { ph_dn_prep2(c, p, A_DNX + WS_ACT); } SEAM(3);
    if (IN(4)) { if (c.bid < 32) ph_dn_scan2(c, p); else { for (int u = c.bid - 32; u < 256; u += c.G - 32) attn_unit(c, p, u); } } SEAM(4);
    if (IN(5)) { ph_gemm<G_ABOUT>(c, p); } SEAM(5);
    if (IN(6)) { ph_norm<1>(c, p); } SEAM(6);
    if (IN(7)) { ph_gemm<G_FFNGU>(c, p); } SEAM(7);
    if (IN(8)) { ph_gemm<G_FFND>(c, p); } SEAM(8);
    if (IN(9)) { ph_norm<2>(c, p); } SEAM(9);
    if (IN(10)) { ph_gemm<G_CDIN>(c, p); } SEAM(10);
    if (IN(11)) { ph_lru<1>(c, p); ph_sconv(c, p); } SEAM(11);
    if (IN(12)) { ph_lru<2>(c, p); } SEAM(12);
    if (IN(13)) { ph_gemm<G_CDOUT>(c, p); } SEAM(13);
    if (IN(14)) { ph_norm<3>(c, p); ph_convert(c, a.t2); } SEAM(14);
    if (IN(15)) { ph_route(c, p); } SEAM(15);
    if (IN(16)) { ph_gemm<G_MOEGU>(c, p); } SEAM(16);
    if (IN(17)) { ph_gemm<G_MOED>(c, p); } SEAM(17);
    if (IN(18)) { ph_final(c, p); }
#undef IN
#undef SEAM
}

constexpr int N_PHASES = 19;
static void add_desc(ConvTab& t, const float* src, bf16* dst, int K, int N, int Npad, int mode, int row_off, int nbatch, long long sstride, long long dstride) {
    ConvDesc& d = t.d[t.nd]; d.src = src; d.dst = dst; d.sstride = sstride; d.dstride = dstride; d.K = K; d.N = N; d.Npad = Npad; d.mode = mode; d.row_off = row_off; d.nbatch = nbatch;
    d.items_pb = (K / 64) * (Npad / 32); d.item0 = t.total; t.total += d.items_pb * nbatch; t.nd++;
}
extern "C" void kernel_launch(void* const* d_in, const int* in_sizes, int n_in, void* d_out, int out_size, void* d_ws, size_t ws_size, hipStream_t stream) {
    static int grid = 0;
    if (grid == 0) {
        if (n_in != 33 || out_size != M * D || ws_size < WS_END) { fprintf(stderr, "kernel_launch: unexpected shapes (n_in %d out %d ws %zu)\n", n_in, out_size, ws_size); grid = -1; return; }
        int dev = 0, cus = 0;
        if (hipGetDevice(&dev) != hipSuccess || hipDeviceGetAttribute(&cus, hipDeviceAttributeMultiprocessorCount, dev) != hipSuccess) { grid = -1; return; }
        if (hipFuncSetAttribute((const void*)mega, hipFuncAttributeMaxDynamicSharedMemorySize, LDS_BYTES) != hipSuccess) { fprintf(stderr, "kernel_launch: hipFuncSetAttribute failed\n"); grid = -1; return; }
        int per_cu = 0;
        if (hipOccupancyMaxActiveBlocksPerMultiprocessor(&per_cu, (const void*)mega, NTHR, LDS_BYTES) != hipSuccess || per_cu < 1) { fprintf(stderr, "kernel_launch: occupancy query says %d\n", per_cu); }
        (void)hipGetLastError();
        grid = cus;
    }
    if (grid < 0) return;
    MArgs a{};
    for (int i = 0; i < 33; ++i) a.p.in[i] = (const float*)d_in[i];
    a.p.out = (float*)d_out; a.p.ws = (unsigned char*)d_ws;
    unsigned char* ws = a.p.ws; const Params& p = a.p;
    (void)hipMemsetAsync(ws + WS_CTL, 0, CTL_ZERO_BYTES, stream);
    add_desc(a.t1, p.in[I_ABIN], (bf16*)(ws + WS_WAB_IN), D, 2832, NAB, 0, 0, 1, 0, 0);
    add_desc(a.t1, p.in[I_ABOUT], (bf16*)(ws + WS_WAB_OUT), D, D, D, 0, 0, 1, 0, 0);
    add_desc(a.t1, p.in[I_FG], (bf16*)(ws + WS_WFFN_GU), D, FF, FF, 1, 0, 1, 0, 0);
    add_desc(a.t1, p.in[I_FU], (bf16*)(ws + WS_WFFN_GU), D, FF, FF, 1, 128, 1, 0, 0);
    add_desc(a.t1, p.in[I_FD], (bf16*)(ws + WS_WFFN_D), FF, D, D, 0, 0, 1, 0, 0);
    add_desc(a.t1, p.in[I_CDIN], (bf16*)(ws + WS_WCD_IN), D, NCD, NCD, 0, 0, 1, 0, 0);
    add_desc(a.t1, p.in[I_CDOUT], (bf16*)(ws + WS_WCD_OUT), CDO, D, D, 0, 0, 1, 0, 0);
    add_desc(a.t1, p.in[I_GAW], (bf16*)(ws + WS_WLRU), 128, 128, 128, 0, 0, 8, 128 * 128, 256 * 128);
    add_desc(a.t1, p.in[I_GXW], (bf16*)(ws + WS_WLRU), 128, 128, 128, 0, 128, 8, 128 * 128, 256 * 128);
    add_desc(a.t2, p.in[I_MG], (bf16*)(ws + WS_WMOE_GU), D, FFE, FFE, 1, 0, NE, (long long)D * FFE, (long long)2 * FFE * D);
    add_desc(a.t2, p.in[I_MU], (bf16*)(ws + WS_WMOE_GU), D, FFE, FFE, 1, 128, NE, (long long)D * FFE, (long long)2 * FFE * D);
    add_desc(a.t2, p.in[I_MD], (bf16*)(ws + WS_WMOE_D), FFE, D, D, 0, 0, NE, (long long)FFE * D, (long long)D * FFE);
    a.ph_lo = 0; a.ph_hi = N_PHASES;
    hipLaunchKernelGGL(mega, dim3(grid), dim3(NTHR), LDS_BYTES, stream, a);
}
```

```cpp
#define DUP_MASK 0
#include <hip/hip_runtime.h>
#include <cstdio>
#include <cstdint>
namespace pg8 {
#define PG8_LAS __attribute__((address_space(3)))
typedef unsigned short bf16_t;
typedef short bf16x8 __attribute__((ext_vector_type(8)));
typedef float f32x4 __attribute__((ext_vector_type(4)));
typedef unsigned u32x4 __attribute__((ext_vector_type(4)));
constexpr int BM = 256, BK = 64, HALF = 128, HTB = HALF * BK * 2  , STAGE_BYTES = 8 * HTB, NXCD = 8, WGM = 8;

__host__ __device__ __forceinline__ int lds_byte(int r, int c) { const int st = (r >> 4) * 2 + (c >> 5), rr = r & 15, cc = c & 31, ob = rr * 64 + cc * 2; return st * 1024 + (ob ^ (((ob >> 9) & 1) << 5)); }
__host__ __device__ __forceinline__ void stage_rc(int b, int& R, int& C) { const int st = b / 1024, sb = b % 1024, swz = sb ^ (((sb >> 9) & 1) << 5); R = (st >> 1) * 16 + swz / 64; C = (st & 1) * 32 + (swz % 64) / 2; }
__host__ __device__ __forceinline__ int perm32(int rho) { const int n = rho >> 4, i = rho & 15; return 8 * (i >> 2) + 4 * n + (i & 3); }

struct Unit { int pm, pn, e; };
struct Gemm { const bf16_t* A; const bf16_t* Bt; int M, N, K; size_t eb; };

struct StaticOrder {
    int nM, nN, nwg, G, c;
    __host__ __device__ void init(int M, int N, int G_, int c_) { nM = M / BM; nN = N / BM; nwg = nM * nN; G = G_; c = c_; }
    __host__ __device__ bool next(int i, Unit& u) const {
        const long L = (long)i * G + c; if (L >= nwg) return false;
        int wgid = (int)L; { const int q = nwg / NXCD, r = nwg % NXCD, xcd = wgid % NXCD, off = wgid / NXCD; wgid = (xcd < r ? xcd * (q + 1) : r * (q + 1) + (xcd - r) * q) + off; }
        const int nig = WGM * nN, gid = wgid / nig, fm = gid * WGM, gsz = (nM - fm) < WGM ? (nM - fm) : WGM;
        u.pm = fm + ((wgid % nig) % gsz); u.pn = (wgid % nig) / gsz; u.e = 0; return true;
    }
    __device__ __forceinline__ void a_ready(const Unit&) const {}
    __device__ __forceinline__ void done(const Unit&) const {}
};

__device__ __forceinline__ unsigned cvt_pk_bf16(float lo, float hi) { unsigned r; asm volatile("v_cvt_pk_bf16_f32 %0, %1, %2" : "=v"(r) : "v"(lo), "v"(hi)); return r; }

__device__ __forceinline__ float fast_silu(float g) { return g * __builtin_amdgcn_rcpf(1.0f + __expf(-g)); }
struct EpiStoreBf16 {
    static constexpr bool PERM = true, AFTER_DRAIN = false;
    bf16_t* O; int ldc; const float* rowscale;
    __device__ __forceinline__ void operator()(const f32x4 (&acc)[2][2][4][2], const Unit& u, int wr, int wc, int fr, int fq) const {
        const int row0 = u.pm * BM + wr * 64 + fr, col0 = u.pn * BM + wc * 32 + 8 * fq;
#pragma unroll
        for (int ai = 0; ai < 2; ++ai)
#pragma unroll
            for (int m = 0; m < 4; ++m) { const int row = row0 + ai * HALF + m * 16; bf16_t* rowp = O + (size_t)row * ldc + col0;
                const float s = rowscale ? rowscale[row] : 1.f;
#pragma unroll
                for (int bj = 0; bj < 2; ++bj) { const f32x4 v0 = acc[ai][bj][m][0] * s, v1 = acc[ai][bj][m][1] * s;
                    u32x4 w; w.x = cvt_pk_bf16(v0[0], v0[1]); w.y = cvt_pk_bf16(v0[2], v0[3]); w.z = cvt_pk_bf16(v1[0], v1[1]); w.w = cvt_pk_bf16(v1[2], v1[3]);
                    *(u32x4*)(rowp + bj * HALF) = w; } }
    }
};
struct EpiSwiglu {
    static constexpr bool PERM = true, AFTER_DRAIN = false;
    bf16_t* O; int ldc;
    __device__ __forceinline__ void operator()(const f32x4 (&acc)[2][2][4][2], const Unit& u, int wr, int wc, int fr, int fq) const {
        const int row0 = u.pm * BM + wr * 64 + fr, col0 = u.pn * HALF + wc * 32 + 8 * fq;
#pragma unroll
        for (int ai = 0; ai < 2; ++ai)
#pragma unroll
            for (int m = 0; m < 4; ++m) { const int row = row0 + ai * HALF + m * 16; bf16_t* rowp = O + (size_t)row * ldc + col0;
                const f32x4 g0 = acc[ai][0][m][0], g1 = acc[ai][0][m][1], u0 = acc[ai][1][m][0], u1 = acc[ai][1][m][1];
                float h[8];
#pragma unroll
                for (int i = 0; i < 4; ++i) { h[i] = fast_silu(g0[i]) * u0[i]; h[4 + i] = fast_silu(g1[i]) * u1[i]; }
                u32x4 w; w.x = cvt_pk_bf16(h[0], h[1]); w.y = cvt_pk_bf16(h[2], h[3]); w.z = cvt_pk_bf16(h[4], h[5]); w.w = cvt_pk_bf16(h[6], h[7]);
                *(u32x4*)rowp = w; }
    }
};
struct EpiRes {
    static constexpr bool PERM = false, AFTER_DRAIN = false;
    const float* base; float* out; int ldc; const float* gate;
    __device__ __forceinline__ void operator()(const f32x4 (&acc)[2][2][4][2], const Unit& u, int wr, int wc, int fr, int fq) const {
        const int row0 = u.pm * BM + wr * 64 + fr, col0 = u.pn * BM + wc * 32 + 4 * fq;
        const float* gp = gate + (size_t)(u.pm >> 4) * 6144 + col0;
        f32x4 gv[2][2];
#pragma unroll
        for (int bj = 0; bj < 2; ++bj)
#pragma unroll
            for (int n = 0; n < 2; ++n) gv[bj][n] = *(const f32x4*)(gp + bj * HALF + n * 16);
#pragma unroll
        for (int ai = 0; ai < 2; ++ai)
#pragma unroll
            for (int m = 0; m < 4; ++m) { const size_t off = (size_t)(row0 + ai * HALF + m * 16) * ldc + col0;
#pragma unroll
                for (int bj = 0; bj < 2; ++bj)
#pragma unroll
                    for (int n = 0; n < 2; ++n) { const f32x4 bs = *(const f32x4*)(base + off + bj * HALF + n * 16);
                        *(f32x4*)(out + off + bj * HALF + n * 16) = bs + gv[bj][n] * acc[ai][bj][m][n]; } }
    }
};
struct GroupedOrder {
    int nM, nN, nwg, G, c; const int* tile_e;
    __device__ void init(int nMt, int N, int G_, int c_, const int* te) { nM = nMt; nN = N / BM; nwg = nM * nN; G = G_; c = c_; tile_e = te; }
    __device__ bool next(int i, Unit& u) const {
        const long L = (long)i * G + c; if (L >= nwg) return false;
        int wgid = (int)L; { const int q = nwg / NXCD, r = nwg % NXCD, xcd = wgid % NXCD, off = wgid / NXCD; wgid = (xcd < r ? xcd * (q + 1) : r * (q + 1) + (xcd - r) * q) + off; }
        const int nig = WGM * nN, gid = wgid / nig, fm = gid * WGM, gsz = (nM - fm) < WGM ? (nM - fm) : WGM;
        u.pm = fm + ((wgid % nig) % gsz); u.pn = (wgid % nig) / gsz; u.e = __builtin_amdgcn_readfirstlane(tile_e[u.pm]); return true;
    }
    __device__ __forceinline__ void a_ready(const Unit&) const {}
    __device__ __forceinline__ void done(const Unit&) const {}
};

template <class Epi, class Sched, bool ALIGN_EPI = false, bool SP2 = false>
__device__ __forceinline__ void gemm_phase(PG8_LAS unsigned char* lds, const Gemm g, const Sched& S, const Epi& E) {
    const int tid = threadIdx.x, wid = __builtin_amdgcn_readfirstlane(tid >> 6), lane = tid & 63, wr = wid >> 2, wc = wid & 3, fr = lane & 15, fq = lane >> 4;
    const int K = g.K, nt = K / BK;
    unsigned voffA[2], voffB[2];
#pragma unroll
    for (int i = 0; i < 2; ++i) { int R, C; stage_rc(tid * 16 + i * 8192, R, C); const int Rb = Epi::PERM ? ((R & ~31) + perm32(R & 31)) : R;
        voffA[i] = (unsigned)(R * K + C) * 2u; voffB[i] = (unsigned)(Rb * K + C) * 2u; }
    const size_t kstep = (size_t)(BK * 2);
    const size_t hstep = (size_t)HALF * K * 2;
    const size_t tstep = 2 * hstep;
    const unsigned ldsw = (unsigned)wid * 1024u;
    const int aoff = lds_byte(wr * 64 + fr, fq * 8), boff = lds_byte(wc * 32 + fr, fq * 8);
#define PG8_SA(b, h) (((b) * 2 + (h)) * HTB)
#define PG8_SB(b, h) ((4 + (b) * 2 + (h)) * HTB)
#define PG8_STAGE(bufoff, gbase, voff) do { _Pragma("unroll") for (int _i = 0; _i < 2; ++_i) \
        __builtin_amdgcn_global_load_lds((const unsigned*)((const char*)(gbase) + (voff)[_i]), (PG8_LAS unsigned*)(lds + (bufoff) + ldsw + _i * 8192), 16, 0, 0); } while (0)
#define PG8_LDA(dst, b, h) do { _Pragma("unroll") for (int m = 0; m < 4; ++m) _Pragma("unroll") for (int k = 0; k < 2; ++k) dst[m][k] = *(const PG8_LAS bf16x8*)(lds + PG8_SA(b, h) + aoff + m * 2048 + k * 1024); } while (0)
#define PG8_LDB(dst, b, h) do { _Pragma("unroll") for (int n = 0; n < 2; ++n) _Pragma("unroll") for (int k = 0; k < 2; ++k) dst[n][k] = *(const PG8_LAS bf16x8*)(lds + PG8_SB(b, h) + boff + n * 2048 + k * 1024); } while (0)
#define PG8_MMA(ai, bj, At, Bt) do { __builtin_amdgcn_s_setprio(1); _Pragma("unroll") for (int m = 0; m < 4; ++m) _Pragma("unroll") for (int n = 0; n < 2; ++n) _Pragma("unroll") for (int k = 0; k < 2; ++k) \
        acc[ai][bj][m][n] = __builtin_amdgcn_mfma_f32_16x16x32_bf16(Bt[n][k], At[m][k], acc[ai][bj][m][n], 0, 0, 0); __builtin_amdgcn_s_setprio(0); } while (0)
#define PG8_WAIT_V(n) asm volatile("s_waitcnt vmcnt(" #n ")" ::: "memory")
#define PG8_WAIT_L(n) asm volatile("s_waitcnt lgkmcnt(" #n ")" ::: "memory")
#define PG8_BAR __builtin_amdgcn_s_barrier()
#define PG8_SCHED __builtin_amdgcn_sched_barrier(0)
    Unit cur, nxt; int ui = 0;
    if (!S.next(0, cur)) return;
    f32x4 acc[2][2][4][2];
#pragma unroll
    for (int a = 0; a < 2; ++a)
#pragma unroll
        for (int b = 0; b < 2; ++b)
#pragma unroll
            for (int m = 0; m < 4; ++m)
#pragma unroll
                for (int n = 0; n < 2; ++n) acc[a][b][m][n] = (f32x4){0.f, 0.f, 0.f, 0.f};
    bf16x8 At[4][2], B0[2][2], B1[2][2];
    const char* cA = (const char*)g.A + (size_t)cur.pm * tstep; const char* cB = (const char*)g.Bt + (size_t)cur.e * g.eb + (size_t)cur.pn * tstep;
    S.a_ready(cur);
    if constexpr (SP2) {
        PG8_STAGE(PG8_SB(0, 0), cB, voffB); PG8_STAGE(PG8_SB(0, 1), cB + hstep, voffB); PG8_STAGE(PG8_SA(0, 0), cA, voffA); PG8_STAGE(PG8_SA(0, 1), cA + hstep, voffA);
        if (wr == 1) PG8_BAR;
        PG8_WAIT_V(2); PG8_BAR;
        PG8_STAGE(PG8_SB(1, 0), cB + kstep, voffB); PG8_STAGE(PG8_SA(1, 0), cA + kstep, voffA); PG8_STAGE(PG8_SB(1, 1), cB + hstep + kstep, voffB);
        PG8_WAIT_V(6); PG8_BAR;
    } else {
        PG8_STAGE(PG8_SB(0, 0), cB, voffB); PG8_STAGE(PG8_SA(0, 0), cA, voffA); PG8_STAGE(PG8_SB(0, 1), cB + hstep, voffB); PG8_STAGE(PG8_SA(0, 1), cA + hstep, voffA);
        if (wr == 1) PG8_BAR;
        PG8_WAIT_V(4); PG8_BAR;
        PG8_STAGE(PG8_SB(1, 0), cB + kstep, voffB); PG8_STAGE(PG8_SA(1, 0), cA + kstep, voffA); PG8_STAGE(PG8_SB(1, 1), cB + hstep + kstep, voffB);
        PG8_WAIT_V(6); PG8_BAR;
    }
    for (;;) {
        const bool has_next = S.next(ui + 1, nxt);
        const char* nA = has_next ? (const char*)g.A + (size_t)nxt.pm * tstep : cA; const char* nB = has_next ? (const char*)g.Bt + (size_t)nxt.e * g.eb + (size_t)nxt.pn * tstep : cB;
        for (int t = 0; t < nt; t += 2) {
            const bool last = (t == nt - 2);
            const char* a1 = cA + (size_t)(t + 1) * kstep;
            const char* a2 = last ? nA : cA + (size_t)(t + 2) * kstep; const char* b2 = last ? nB : cB + (size_t)(t + 2) * kstep;
            const char* a3 = a2 + kstep; const char* b3 = b2 + kstep;
            if (last && has_next) S.a_ready(nxt);
            if constexpr (SP2) {
            PG8_LDB(B0, 0, 0); PG8_LDB(B1, 0, 1); PG8_SCHED; PG8_LDA(At, 0, 0); PG8_STAGE(PG8_SA(1, 1), a1 + hstep, voffA);
            PG8_WAIT_V(8); PG8_WAIT_L(0); PG8_BAR; PG8_MMA(0, 0, At, B0); PG8_MMA(0, 1, At, B1); PG8_BAR; PG8_SCHED;
            PG8_LDA(At, 0, 1); PG8_STAGE(PG8_SB(0, 0), b2, voffB); PG8_STAGE(PG8_SB(0, 1), b2 + hstep, voffB); PG8_STAGE(PG8_SA(0, 0), a2, voffA);
            PG8_WAIT_V(8); PG8_WAIT_L(0); PG8_BAR; PG8_MMA(1, 0, At, B0); PG8_MMA(1, 1, At, B1); PG8_BAR; PG8_SCHED;
            PG8_LDB(B0, 1, 0); PG8_LDB(B1, 1, 1); PG8_SCHED; PG8_LDA(At, 1, 0); PG8_STAGE(PG8_SA(0, 1), a2 + hstep, voffA);
            PG8_WAIT_V(8); PG8_WAIT_L(0); PG8_BAR; PG8_MMA(0, 0, At, B0); PG8_MMA(0, 1, At, B1); PG8_BAR; PG8_SCHED;
            PG8_LDA(At, 1, 1); PG8_STAGE(PG8_SB(1, 0), b3, voffB); PG8_STAGE(PG8_SB(1, 1), b3 + hstep, voffB); PG8_STAGE(PG8_SA(1, 0), a3, voffA);
            PG8_WAIT_V(8); PG8_WAIT_L(0); PG8_BAR; PG8_MMA(1, 0, At, B0); PG8_MMA(1, 1, At, B1); PG8_BAR; PG8_SCHED;
            } else {
            PG8_LDB(B0, 0, 0); PG8_SCHED; PG8_LDA(At, 0, 0); PG8_STAGE(PG8_SA(1, 1), a1 + hstep, voffA);
            PG8_WAIT_L(8); PG8_BAR; PG8_WAIT_L(0); PG8_MMA(0, 0, At, B0); PG8_BAR; PG8_SCHED;
            PG8_LDB(B1, 0, 1); PG8_STAGE(PG8_SB(0, 0), b2, voffB);
            PG8_BAR; PG8_WAIT_L(0); PG8_MMA(0, 1, At, B1); PG8_BAR;
            PG8_LDA(At, 0, 1); PG8_STAGE(PG8_SA(0, 0), a2, voffA);
            PG8_BAR; PG8_WAIT_L(0); PG8_MMA(1, 0, At, B0); PG8_BAR; PG8_SCHED;
            PG8_STAGE(PG8_SB(0, 1), b2 + hstep, voffB);
            PG8_WAIT_V(6); PG8_BAR; PG8_MMA(1, 1, At, B1); PG8_BAR;
            PG8_LDB(B0, 1, 0); PG8_SCHED; PG8_LDA(At, 1, 0); PG8_STAGE(PG8_SA(0, 1), a2 + hstep, voffA);
            PG8_WAIT_L(8); PG8_BAR; PG8_WAIT_L(0); PG8_MMA(0, 0, At, B0); PG8_BAR; PG8_SCHED;
            PG8_LDB(B1, 1, 1); PG8_STAGE(PG8_SB(1, 0), b3, voffB);
            PG8_BAR; PG8_WAIT_L(0); PG8_MMA(0, 1, At, B1); PG8_BAR;
            PG8_LDA(At, 1, 1); PG8_STAGE(PG8_SA(1, 0), a3, voffA);
            PG8_BAR; PG8_WAIT_L(0); PG8_MMA(1, 0, At, B0); PG8_BAR; PG8_SCHED;
            PG8_STAGE(PG8_SB(1, 1), b3 + hstep, voffB);
            PG8_WAIT_V(6); PG8_BAR; PG8_MMA(1, 1, At, B1); PG8_BAR;
            }
        }
        if constexpr (ALIGN_EPI) { if (wr == 0) PG8_BAR; }
        if constexpr (!Epi::AFTER_DRAIN) { E(acc, cur, wr, wc, fr, fq); S.done(cur); }
        if (!has_next) break;
#pragma unroll
        for (int a = 0; a < 2; ++a)
#pragma unroll
            for (int b = 0; b < 2; ++b)
#pragma unroll
                for (int m = 0; m < 4; ++m)
#pragma unroll
                    for (int n = 0; n < 2; ++n) acc[a][b][m][n] = (f32x4){0.f, 0.f, 0.f, 0.f};
        cur = nxt; cA = nA; cB = nB; ++ui;
        if constexpr (ALIGN_EPI) { if (wr == 1) PG8_BAR; }
    }
    PG8_WAIT_V(0);
    if constexpr (!ALIGN_EPI) { if (wr == 0) PG8_BAR; }
    PG8_BAR;
    if constexpr (Epi::AFTER_DRAIN) { E.fused(acc, cur, wr, wc, fr, fq, lds, wid, lane); S.done(cur); }
#undef PG8_SA
#undef PG8_SB
#undef PG8_STAGE
#undef PG8_LDA
#undef PG8_LDB
#undef PG8_MMA
#undef PG8_WAIT_V
#undef PG8_WAIT_L
#undef PG8_BAR
#undef PG8_SCHED
}
}

constexpr int BATCH = 4, T = 4096, D = 1024, M = BATCH * T;
constexpr int NAB = 3072;
constexpr int FF = 2816, NCD = 3584, CDO = 1536, FFE = 3584, NE = 8;
constexpr int MPAD = 2 * M + NE * 256;
constexpr int MAXT = MPAD / 256;
constexpr int C_QA = 0, C_KA = 512, C_VA = 640, C_QKVB = 768, C_GATEB = 2304, C_BETA = 2816, C_AB = 2824;
constexpr int C_XC = 0, C_YC = 1024, C_BD = 2048, C_CD = 2560, C_HD = 3072;
constexpr size_t MiB = 1u << 20;
constexpr size_t WS_CTL = 0, CTL_ZERO_BYTES = 1 * MiB;
constexpr size_t WS_MOD = 1 * MiB;
constexpr size_t WS_ROUTE = 1 * MiB + 256 * 1024;
constexpr size_t WS_WAB_IN = 2 * MiB, WS_WAB_OUT = 8 * MiB, WS_WFFN_GU = 10 * MiB, WS_WFFN_D = 21 * MiB, WS_WCD_IN = 27 * MiB, WS_WCD_OUT = 34 * MiB, WS_WLRU = 37 * MiB;
constexpr size_t WS_WMOE_GU = 38 * MiB, WS_WMOE_D = 150 * MiB;
constexpr size_t WS_ACT = 206 * MiB;
constexpr size_t WS_END = 512 * MiB;
constexpr size_t A_A = 0, A_P = 32 * MiB, A_MIXA = 128 * MiB, A_DNQ = 160 * MiB, A_DNK = 192 * MiB, A_DNV = 224 * MiB, A_DNB = 256 * MiB, A_DNG = 257 * MiB;
constexpr size_t A_H = 160 * MiB;
constexpr size_t A_MIXB = 144 * MiB, A_XC = 192 * MiB;
constexpr size_t A_A3P = 0, A_HM = 68 * MiB, A_Y = 0;
constexpr size_t WS_A3 = 2 * MiB;
constexpr size_t WS_LA = 38 * MiB, WS_LB = 102 * MiB;
constexpr size_t R_IDX = 0, R_W = 128 * 1024, R_SLOT = 256 * 1024, R_GATEW = 384 * 1024, R_TILEE = 528 * 1024, R_OFF = 532 * 1024, R_HIST = 536 * 1024;
constexpr int CW_CNT = 1024, CW_CUR = 1024 + 64;

typedef unsigned short bf16;
typedef float f32x4 __attribute__((ext_vector_type(4)));
typedef unsigned v4u __attribute__((ext_vector_type(4)));
typedef unsigned v2u __attribute__((ext_vector_type(2)));
__device__ __forceinline__ unsigned f2bf(float f) { unsigned u = __builtin_bit_cast(unsigned, f); return (u + 0x7fffu + ((u >> 16) & 1u)) >> 16; }
__device__ __forceinline__ unsigned pk2(float lo, float hi) { return f2bf(lo) | (f2bf(hi) << 16); }
__device__ __forceinline__ float bf2f(unsigned short b) { return __builtin_bit_cast(float, (unsigned)b << 16); }
__device__ __forceinline__ float bflo(unsigned w) { return __builtin_bit_cast(float, w << 16); }
__device__ __forceinline__ float bfhi(unsigned w) { return __builtin_bit_cast(float, w & 0xffff0000u); }
__device__ __forceinline__ float wave_sum(float v) {
#pragma unroll
    for (int o = 1; o < 64; o <<= 1) v += __shfl_xor(v, o);
    return v;
}
__device__ __forceinline__ float sigmoidf_(float x) { return __builtin_amdgcn_rcpf(1.0f + __expf(-x)); }
__device__ __forceinline__ float siluf_(float x) { return x * __builtin_amdgcn_rcpf(1.0f + __expf(-x)); }
__device__ __forceinline__ float softplusf_(float x) { return fmaxf(x, 0.f) + log1pf(__expf(-fabsf(x))); }
__device__ __forceinline__ float gelu_tanhf_(float x) { const float u = 0.7978845608028654f * (x + 0.044715f * x * x * x); return 0.5f * x * (1.0f + tanhf(u)); }

__device__ const unsigned char T5_BUCKET[128] = {0, 1, 2, 3, 4, 5, 6, 7, 8, 9, 10, 11, 12, 13, 14, 15, 16, 16, 16, 17, 17, 18, 18, 18, 19, 19, 19, 20, 20, 20, 20, 21, 21, 21, 21, 22, 22, 22, 22, 22, 23, 23, 23, 23, 23, 23, 24, 24, 24, 24, 24, 24, 25, 25, 25, 25, 25, 25, 25, 26, 26, 26, 26, 26, 26, 26, 26, 27, 27, 27, 27, 27, 27, 27, 27, 27, 27, 28, 28, 28, 28, 28, 28, 28, 28, 28, 28, 29, 29, 29, 29, 29, 29, 29, 29, 29, 29, 29, 29, 30, 30, 30, 30, 30, 30, 30, 30, 30, 30, 30, 30, 30, 30, 31, 31, 31, 31, 31, 31, 31, 31, 31, 31, 31, 31, 31, 31, 31};

struct Params { const float* in[33]; float* out; unsigned char* ws; };
enum { I_X = 0, I_C, I_RELB, I_ADAW, I_ADAB, I_NMIX, I_NFFN, I_NFIN, I_ABIN, I_SINK, I_DNCONV, I_ALOG, I_DTB, I_DNNORM, I_ABOUT, I_FG, I_FU, I_FD, I_CDIN, I_LCW, I_LCB, I_GAW, I_GAB, I_GXW, I_GXB, I_LAM, I_SCW, I_CDOUT, I_RW, I_RB, I_MG, I_MU, I_MD };


#define LAS __attribute__((address_space(3)))
#define XB_TMO      128
#define XB_XCNT(j)  (256  + 64 * (j))
#define XB_XSUB(j)  (1280 + 64 * (j))
#define XB_XGEN(j)  (2304 + 64 * (j))
#define XB_TOP      3328
#define XB_TOPGEN   3392
#define XCD_BAR_WORDS 3456
#define XB_SPIN_CAP (1u << 18)

__device__ __forceinline__ unsigned xb_ld(unsigned* p)              { return __hip_atomic_load(p, __ATOMIC_RELAXED, __HIP_MEMORY_SCOPE_AGENT); }
__device__ __forceinline__ unsigned xb_add(unsigned* p, unsigned v) { return __hip_atomic_fetch_add(p, v, __ATOMIC_RELAXED, __HIP_MEMORY_SCOPE_AGENT); }
__device__ __forceinline__ unsigned xb_xcc_id() { return (unsigned)__builtin_amdgcn_s_getreg((3 << 11) | 20) & 0xFu; }
#define XB_SPIN(cond, bar) do { unsigned _sp = 0; while (cond) { __builtin_amdgcn_s_sleep(1); \
    if ((++_sp & 255u) == 0u) { if (xb_ld(&(bar)[XB_TMO])) break; if (_sp > XB_SPIN_CAP) { atomicAdd(&(bar)[XB_TMO], 1u); break; } } } } while (0)

struct XcdBarrier {
    unsigned* bar; unsigned x;
    volatile LAS unsigned* st;
};
__device__ __forceinline__ XcdBarrier xcd_barrier_post(unsigned* bar, volatile LAS unsigned* st) {
    XcdBarrier b; b.bar = bar; b.x = xb_xcc_id(); b.st = st;
    if (threadIdx.x == 0) (void)xb_add(&bar[XB_XCNT(b.x)], 1u);
    return b;
}
__device__ __forceinline__ void xcd_barrier_complete(unsigned* bar, unsigned x, unsigned& nloc, unsigned& nx) {
    const unsigned G = gridDim.x * gridDim.y * gridDim.z;
    unsigned sum, cnt, mine, sp = 0u;
    for (;;) {
        sum = 0u; cnt = 0u; mine = 0u;
#pragma unroll
        for (unsigned j = 0; j < 16; ++j) { const unsigned c = xb_ld(&bar[XB_XCNT(j)]); sum += c; cnt += (c > 0u) ? 1u : 0u; mine = (j == x) ? c : mine; }
        if (sum == G) break;
        __builtin_amdgcn_s_sleep(1);
        if ((++sp & 255u) == 0u) { if (xb_ld(&bar[XB_TMO])) break; if (sp > XB_SPIN_CAP) { atomicAdd(&bar[XB_TMO], 1u); break; } }
    }
    nloc = mine > 0u ? mine : 1u; nx = cnt > 0u ? cnt : 1u;
}
__device__ __forceinline__ void xcd_barrier(const XcdBarrier& b) {
    asm volatile("s_waitcnt vmcnt(0)" ::: "memory");
    __syncthreads();
    if (threadIdx.x == 0) {
        unsigned* bar = b.bar;
        __builtin_amdgcn_s_waitcnt(0);
        unsigned nloc = b.st[0], nx = b.st[1];
        if (nloc == 0u) { xcd_barrier_complete(bar, b.x, nloc, nx); b.st[0] = nloc; b.st[1] = nx; }
        const unsigned old = xb_add(&bar[XB_XSUB(b.x)], 1u);
        const unsigned gen = old / nloc;
        if (old + 1u == (gen + 1u) * nloc) {
            __builtin_amdgcn_fence(__ATOMIC_RELEASE, "agent");
            asm volatile("s_waitcnt vmcnt(0)" ::: "memory");
            const unsigned og = xb_add(&bar[XB_TOP], 1u);
            const unsigned tg = og / nx;
            if (og + 1u == (tg + 1u) * nx) xb_add(&bar[XB_TOPGEN], 1u);
            else XB_SPIN(xb_ld(&bar[XB_TOPGEN]) == tg, bar);
            __builtin_amdgcn_fence(__ATOMIC_ACQUIRE, "agent");
            xb_add(&bar[XB_XGEN(b.x)], 1u);
            asm volatile("s_waitcnt vmcnt(0)" ::: "memory");
        } else {
            XB_SPIN(xb_ld(&bar[XB_XGEN(b.x)]) == gen, bar);
            __builtin_amdgcn_fence(__ATOMIC_ACQUIRE, "agent");
            asm volatile("s_waitcnt vmcnt(0)" ::: "memory");
        }
    }
    __syncthreads();
}

constexpr int NWAVES = 8, NTHR = 512;
constexpr int LDS_MISC = 150528, LDS_BYTES = 150528 + 1024;
constexpr int CW_BAR = 4096;
struct ConvDesc { const float* src; bf16* dst; long long sstride, dstride; int K, N, Npad, mode, row_off, nbatch, items_pb, item0; };
struct ConvTab { ConvDesc d[12]; int nd, total, pad0, pad1; };
struct MArgs { Params p; ConvTab t1, t2; int ph_lo, ph_hi, pad0, pad1; };
struct Ctx { LAS unsigned char* lds; int tid, lane, wave, G, bid, gw, NGW; };

__device__ __forceinline__ void transpose_item(const float* W, int K, int N, bf16* WT, int mode, int row_off, LAS float* scr, int kb, int nb, int lane) {
    const int k0 = 64 * kb, n0 = 32 * nb; const int nn = n0 + (lane & 31);
#pragma unroll 8
    for (int i = 0; i < 32; ++i) { const int kk = 2 * i + (lane >> 5); scr[kk * 33 + (lane & 31)] = nn < N ? W[(size_t)(k0 + kk) * N + nn] : 0.f; }
    asm volatile("s_waitcnt lgkmcnt(0)" ::: "memory");
    const int c = lane & 7;
#pragma unroll
    for (int j = 0; j < 4; ++j) { const int n = (lane >> 3) + 8 * j; const LAS float* s = scr + (8 * c) * 33 + n;
        v4u o; o.x = pk2(s[0 * 33], s[1 * 33]); o.y = pk2(s[2 * 33], s[3 * 33]); o.z = pk2(s[4 * 33], s[5 * 33]); o.w = pk2(s[6 * 33], s[7 * 33]);
        const int ng = n0 + n; const int drow = (mode == 1 ? ((ng >> 7) << 8) + (ng & 127) : ng) + row_off;
        *(v4u*)(WT + (size_t)drow * K + k0 + 8 * c) = o; }
    asm volatile("s_waitcnt lgkmcnt(0)" ::: "memory");
}
__device__ __forceinline__ void ph_convert(const Ctx& c, const ConvTab& tab) {
    LAS float* scr = (LAS float*)(c.lds + c.wave * 8448);
    for (int it = c.gw; it < tab.total; it += c.NGW) {
        int j = 0;
        for (int q = 1; q < tab.nd; ++q) if (it >= tab.d[q].item0) j = q;
        const ConvDesc& d = tab.d[j]; const int r = it - d.item0; const int batch = r / d.items_pb, item = r % d.items_pb; const int nblk = d.Npad / 32;
        transpose_item(d.src + (size_t)batch * d.sstride, d.K, d.N, d.dst + (size_t)batch * d.dstride, d.mode, d.row_off, scr, item / nblk, item % nblk, c.lane);
    }
}
__device__ __forceinline__ void ph_ada(const Ctx& c, const Params& p) {
    LAS float* part = (LAS float*)(c.lds + 69632);
    for (int it = c.bid; it < 192; it += c.G) {
        const int l = it / 96, j = (it % 96) * 64 + c.lane; const float* w = p.in[I_ADAW] + (size_t)l * 1024 * 6144 + j; const float* cc = p.in[I_C];
        float a0 = 0.f, a1 = 0.f, a2 = 0.f, a3 = 0.f;
        for (int k = c.wave * 128; k < c.wave * 128 + 128; ++k) { const float wv = w[(size_t)k * 6144];
            a0 += siluf_(cc[k]) * wv; a1 += siluf_(cc[1024 + k]) * wv; a2 += siluf_(cc[2048 + k]) * wv; a3 += siluf_(cc[3072 + k]) * wv; }
        part[(c.wave * 4 + 0) * 64 + c.lane] = a0; part[(c.wave * 4 + 1) * 64 + c.lane] = a1; part[(c.wave * 4 + 2) * 64 + c.lane] = a2; part[(c.wave * 4 + 3) * 64 + c.lane] = a3;
        __syncthreads();
        if (c.wave < 4) { float s = 0.f;
#pragma unroll
            for (int w8 = 0; w8 < 8; ++w8) s += part[(w8 * 4 + c.wave) * 64 + c.lane];
            ((float*)(p.ws + WS_MOD))[(size_t)l * 4 * 6144 + (size_t)c.wave * 6144 + j] = s + p.in[I_ADAB][l * 6144 + j]; }
        __syncthreads();
    }
}
template <bool ROUTER, bool COUNT = true>
__device__ __forceinline__ void norm_row(const float* xrow, bf16* orow, const float* w, const float* sc, const float* sh, int lane, const float* rw, const float* rb, int m, unsigned char* ws, LAS unsigned* hist) {
    const f32x4* xr = (const f32x4*)xrow + lane; f32x4 v[4]; float s = 0.f;
#pragma unroll
    for (int j = 0; j < 4; ++j) { v[j] = xr[64 * j]; s += (v[j].x * v[j].x + v[j].y * v[j].y) + (v[j].z * v[j].z + v[j].w * v[j].w); }
    const float rstd = 1.0f / sqrtf(wave_sum(s) * (1.f / D) + 1e-6f);
    float lg[8];
    if (ROUTER) {
#pragma unroll
        for (int e = 0; e < 8; ++e) lg[e] = 0.f;
    }
    unsigned long long* o8 = (unsigned long long*)orow + lane;
#pragma unroll
    for (int j = 0; j < 4; ++j) { const int c = 4 * lane + 256 * j; const f32x4 wv = *(const f32x4*)(w + c), scv = *(const f32x4*)(sc + c), shv = *(const f32x4*)(sh + c);
        f32x4 y = v[j] * rstd * wv * (scv + 1.0f) + shv;
        if (ROUTER) {
#pragma unroll
            for (int i = 0; i < 4; ++i) { const f32x4 r0 = *(const f32x4*)(rw + (size_t)(c + i) * 8), r1 = *(const f32x4*)(rw + (size_t)(c + i) * 8 + 4);
                lg[0] += y[i] * r0.x; lg[1] += y[i] * r0.y; lg[2] += y[i] * r0.z; lg[3] += y[i] * r0.w; lg[4] += y[i] * r1.x; lg[5] += y[i] * r1.y; lg[6] += y[i] * r1.z; lg[7] += y[i] * r1.w; }
        }
        o8[64 * j] = (unsigned long long)pk2(y.x, y.y) | ((unsigned long long)pk2(y.z, y.w) << 32); }
    if (ROUTER) {
#pragma unroll
        for (int e = 0; e < 8; ++e) lg[e] = wave_sum(lg[e]) + rb[e];
        int b0 = 0; float v0 = lg[0];
#pragma unroll
        for (int e = 1; e < 8; ++e) if (lg[e] > v0) { v0 = lg[e]; b0 = e; }
        int b1 = -1; float v1 = -3.0e38f;
#pragma unroll
        for (int e = 0; e < 8; ++e) if (e != b0 && lg[e] > v1) { v1 = lg[e]; b1 = e; }
        const float e1 = __expf(v1 - v0), w0 = 1.0f / (1.0f + e1), w1 = e1 / (1.0f + e1);
        if (lane == 0) { int* idx = (int*)(ws + WS_ROUTE + R_IDX); float* tw = (float*)(ws + WS_ROUTE + R_W); idx[2 * m] = b0; idx[2 * m + 1] = b1; tw[2 * m] = w0; tw[2 * m + 1] = w1;
            if (COUNT) { __hip_atomic_fetch_add(hist + b0, 1u, __ATOMIC_RELAXED, __HIP_MEMORY_SCOPE_WORKGROUP); __hip_atomic_fetch_add(hist + b1, 1u, __ATOMIC_RELAXED, __HIP_MEMORY_SCOPE_WORKGROUP); } }
    }
}
template <int WHICH, bool COUNT = true>
__device__ __forceinline__ void ph_norm(const Ctx& c, const Params& p) {
    const int l = WHICH >> 1, f = WHICH & 1;
    const float* src = WHICH == 0 ? p.in[I_X] : p.out; bf16* dst = (bf16*)(p.ws + (WHICH == 3 ? WS_A3 : WS_ACT + A_A));
    const float* w = p.in[f ? I_NFFN : I_NMIX] + l * D; const float* mod = (const float*)(p.ws + WS_MOD) + (size_t)l * 4 * 6144;
    if constexpr (WHICH == 3) {
        LAS unsigned* hist = (LAS unsigned*)(c.lds + 1024);
        if (c.tid < 8) hist[c.tid] = 0u;
        __syncthreads();
        for (int i = 0; i < 8; ++i) { const int m = c.bid * 64 + c.wave * 8 + i; if (m < M) { const int b = m >> 12; const float* mb = mod + (size_t)b * 6144 + 3 * D;
            norm_row<true, COUNT>(src + (size_t)m * D, dst + (size_t)m * D, w, mb + D, mb, c.lane, p.in[I_RW], p.in[I_RB], m, p.ws, hist); } }
        __syncthreads();
        if (COUNT && c.tid < 8) ((unsigned*)(p.ws + WS_ROUTE + R_HIST))[c.bid * 8 + c.tid] = hist[c.tid];
    } else {
    for (int m = c.gw; m < M; m += c.NGW) { const int b = m >> 12; const float* mb = mod + (size_t)b * 6144 + (f ? 3 * D : 0);
        norm_row<false, COUNT>(src + (size_t)m * D, dst + (size_t)m * D, w, mb + D, mb, c.lane, p.in[I_RW], p.in[I_RB], m, p.ws, nullptr); }
    }
}

enum { G_ABIN = 0, G_ABOUT, G_FFNGU, G_FFND, G_CDIN, G_CDOUT, G_MOEGU, G_MOED, G_FFND_PROBE, G_CDOUT_PROBE };
template <int WHICH>
__device__ __forceinline__ void ph_gemm(const Ctx& cx, const Params& p) {
    PG8_LAS unsigned char* lds = (PG8_LAS unsigned char*)cx.lds;
    unsigned char* ws = p.ws; unsigned char* act = ws + WS_ACT; const float* mod = (const float*)(ws + WS_MOD);
    const int G = cx.G, c = cx.bid;
    if constexpr (WHICH == G_ABIN) { pg8::Gemm g{(const bf16*)(act + A_A), (const bf16*)(ws + WS_WAB_IN), M, NAB, D, 0}; pg8::StaticOrder S; S.init(M, NAB, G, c);
        pg8::EpiStoreBf16 E{(bf16*)(act + A_P), NAB, nullptr}; pg8::gemm_phase<pg8::EpiStoreBf16, pg8::StaticOrder, true, true>(lds, g, S, E); }
    if constexpr (WHICH == G_ABOUT) { pg8::Gemm g{(const bf16*)(act + A_MIXA), (const bf16*)(ws + WS_WAB_OUT), M, D, D, 0}; pg8::StaticOrder S; S.init(M, D, G, c);
        pg8::EpiRes E{p.in[I_X], p.out, D, mod + 2 * D}; pg8::gemm_phase<pg8::EpiRes, pg8::StaticOrder, true, true>(lds, g, S, E); }
    if constexpr (WHICH == G_FFNGU) { pg8::Gemm g{(const bf16*)(act + A_A), (const bf16*)(ws + WS_WFFN_GU), M, 2 * FF, D, 0}; pg8::StaticOrder S; S.init(M, 2 * FF, G, c);
        pg8::EpiSwiglu E{(bf16*)(act + A_H), FF}; pg8::gemm_phase<pg8::EpiSwiglu, pg8::StaticOrder, true, true>(lds, g, S, E); }
    if constexpr (WHICH == G_FFND) { pg8::Gemm g{(const bf16*)(act + A_H), (const bf16*)(ws + WS_WFFN_D), M, D, FF, 0}; pg8::StaticOrder S; S.init(M, D, G, c);
        pg8::EpiRes E{p.out, p.out, D, mod + 5 * D}; pg8::gemm_phase<pg8::EpiRes, pg8::StaticOrder, true, true>(lds, g, S, E); }
    if constexpr (WHICH == G_FFND_PROBE) { pg8::Gemm g{(const bf16*)(act + A_H), (const bf16*)(ws + WS_WFFN_D), M, D, FF, 0}; pg8::StaticOrder S; S.init(M, D, G, c);
        pg8::EpiRes E{p.out, (float*)(act + A_P), D, mod + 5 * D}; pg8::gemm_phase<pg8::EpiRes, pg8::StaticOrder, true, true>(lds, g, S, E); }
    if constexpr (WHICH == G_CDOUT_PROBE) { pg8::Gemm g{(const bf16*)(act + A_MIXB), (const bf16*)(ws + WS_WCD_OUT), M, D, CDO, 0}; pg8::StaticOrder S; S.init(M, D, G, c);
        pg8::EpiRes E{p.out, (float*)(act + A_P), D, mod + 4 * 6144 + 2 * D}; pg8::gemm_phase<pg8::EpiRes, pg8::StaticOrder, true, true>(lds, g, S, E); }
    if constexpr (WHICH == G_CDIN) { pg8::Gemm g{(const bf16*)(act + A_A), (const bf16*)(ws + WS_WCD_IN), M, NCD, D, 0}; pg8::StaticOrder S; S.init(M, NCD, G, c);
        pg8::EpiStoreBf16 E{(bf16*)(act + A_P), NCD, nullptr}; pg8::gemm_phase<pg8::EpiStoreBf16, pg8::StaticOrder, true, true>(lds, g, S, E); }
    if constexpr (WHICH == G_CDOUT) { pg8::Gemm g{(const bf16*)(act + A_MIXB), (const bf16*)(ws + WS_WCD_OUT), M, D, CDO, 0}; pg8::StaticOrder S; S.init(M, D, G, c);
        pg8::EpiRes E{p.out, p.out, D, mod + 4 * 6144 + 2 * D}; pg8::gemm_phase<pg8::EpiRes, pg8::StaticOrder, true, true>(lds, g, S, E); }
    if constexpr (WHICH == G_MOEGU) { const int* off = (const int*)(ws + WS_ROUTE + R_OFF); const int nMt = __builtin_amdgcn_readfirstlane(off[8]) >> 8;
        pg8::Gemm g{(const bf16*)(act + A_A3P), (const bf16*)(ws + WS_WMOE_GU), nMt * 256, 2 * FFE, D, (size_t)2 * FFE * D * 2}; pg8::GroupedOrder S; S.init(nMt, 2 * FFE, G, c, (const int*)(ws + WS_ROUTE + R_TILEE));
        pg8::EpiSwiglu E{(bf16*)(act + A_HM), FFE}; pg8::gemm_phase<pg8::EpiSwiglu, pg8::GroupedOrder, true, true>(lds, g, S, E); }
    if constexpr (WHICH == G_MOED) { const int* off = (const int*)(ws + WS_ROUTE + R_OFF); const int nMt = __builtin_amdgcn_readfirstlane(off[8]) >> 8;
        pg8::Gemm g{(const bf16*)(act + A_HM), (const bf16*)(ws + WS_WMOE_D), nMt * 256, D, FFE, (size_t)D * FFE * 2}; pg8::GroupedOrder S; S.init(nMt, D, G, c, (const int*)(ws + WS_ROUTE + R_TILEE));
        pg8::EpiStoreBf16 E{(bf16*)(act + A_Y), D, (const float*)(ws + WS_ROUTE + R_GATEW)}; pg8::gemm_phase<pg8::EpiStoreBf16, pg8::GroupedOrder, true, true>(lds, g, S, E); }
}

__device__ __forceinline__ void ph_attn_naive(const Ctx& c, const Params& p) {
    const bf16* P0 = (const bf16*)(p.ws + WS_ACT + A_P); const float* relb = p.in[I_RELB];
    for (int gid = c.bid * NTHR + c.tid; gid < M * 8; gid += c.G * NTHR) {
        const int m = gid >> 3, h = gid & 7, t = m & (T - 1), kvh = h >> 2;
        float q[64], o[64];
        { const v4u* qp = (const v4u*)(P0 + (size_t)m * NAB + C_QA + h * 64);
#pragma unroll
          for (int i = 0; i < 8; ++i) { const v4u w = qp[i]; q[8 * i + 0] = bflo(w.x) * 0.125f; q[8 * i + 1] = bfhi(w.x) * 0.125f; q[8 * i + 2] = bflo(w.y) * 0.125f; q[8 * i + 3] = bfhi(w.y) * 0.125f;
              q[8 * i + 4] = bflo(w.z) * 0.125f; q[8 * i + 5] = bfhi(w.z) * 0.125f; q[8 * i + 6] = bflo(w.w) * 0.125f; q[8 * i + 7] = bfhi(w.w) * 0.125f; } }
#pragma unroll
        for (int i = 0; i < 64; ++i) o[i] = 0.f;
        float mx = p.in[I_SINK][h], l = 1.0f;
        const int nd = t + 1 < 128 ? t + 1 : 128;
        for (int dd = 0; dd < nd; ++dd) {
            const bf16* kr = P0 + (size_t)(m - dd) * NAB + C_KA + kvh * 64; const bf16* vr = P0 + (size_t)(m - dd) * NAB + C_VA + kvh * 64;
            float s = 0.f;
#pragma unroll
            for (int i = 0; i < 8; ++i) { const v4u w = ((const v4u*)kr)[i];
                s += q[8 * i + 0] * bflo(w.x) + q[8 * i + 1] * bfhi(w.x) + q[8 * i + 2] * bflo(w.y) + q[8 * i + 3] * bfhi(w.y) + q[8 * i + 4] * bflo(w.z) + q[8 * i + 5] * bfhi(w.z) + q[8 * i + 6] * bflo(w.w) + q[8 * i + 7] * bfhi(w.w); }
            s += relb[T5_BUCKET[dd] * 8 + h];
            const float mn = fmaxf(mx, s), sc = __expf(mx - mn), pp = __expf(s - mn);
            l = l * sc + pp; mx = mn;
#pragma unroll
            for (int i = 0; i < 8; ++i) { const v4u w = ((const v4u*)vr)[i];
                o[8 * i + 0] = o[8 * i + 0] * sc + pp * bflo(w.x); o[8 * i + 1] = o[8 * i + 1] * sc + pp * bfhi(w.x); o[8 * i + 2] = o[8 * i + 2] * sc + pp * bflo(w.y); o[8 * i + 3] = o[8 * i + 3] * sc + pp * bfhi(w.y);
                o[8 * i + 4] = o[8 * i + 4] * sc + pp * bflo(w.z); o[8 * i + 5] = o[8 * i + 5] * sc + pp * bfhi(w.z); o[8 * i + 6] = o[8 * i + 6] * sc + pp * bflo(w.w); o[8 * i + 7] = o[8 * i + 7] * sc + pp * bfhi(w.w); }
        }
        const float inv = 1.0f / l;
        v4u* op = (v4u*)((bf16*)(p.ws + WS_ACT + A_MIXA) + (size_t)m * D + h * 64);
#pragma unroll
        for (int i = 0; i < 8; ++i) { v4u w; w.x = pk2(o[8 * i] * inv, o[8 * i + 1] * inv); w.y = pk2(o[8 * i + 2] * inv, o[8 * i + 3] * inv); w.z = pk2(o[8 * i + 4] * inv, o[8 * i + 5] * inv); w.w = pk2(o[8 * i + 6] * inv, o[8 * i + 7] * inv); op[i] = w; }
    }
}

__device__ __forceinline__ void ph_dn_prep(const Ctx& c, const Params& p) {
    const bf16* P0 = (const bf16*)(p.ws + WS_ACT + A_P); const float* cw = p.in[I_DNCONV]; unsigned char* act = p.ws + WS_ACT; const int lane = c.lane;
    for (int it = c.gw; it < M * 8; it += c.NGW) {
        const int m = it >> 3, h = it & 7, t = m & (T - 1);
        float r[3];
#pragma unroll
        for (int s = 0; s < 3; ++s) { const int ch = s * 512 + h * 64 + lane; float a = 0.f;
#pragma unroll
            for (int k = 0; k < 4; ++k) { const int tt = t - 3 + k; if (tt >= 0) a += cw[k * 1536 + ch] * bf2f(P0[(size_t)(m - 3 + k) * NAB + C_QKVB + ch]); }
            r[s] = siluf_(a); }
        const float nq = 1.0f / sqrtf(wave_sum(r[0] * r[0]) + 1e-6f), nk = 1.0f / sqrtf(wave_sum(r[1] * r[1]) + 1e-6f);
        ((float*)(act + A_DNQ))[(size_t)m * 512 + h * 64 + lane] = r[0] * nq;
        ((float*)(act + A_DNK))[(size_t)m * 512 + h * 64 + lane] = r[1] * nk;
        ((float*)(act + A_DNV))[(size_t)m * 512 + h * 64 + lane] = r[2];
        if (lane == 0) { const float bb = bf2f(P0[(size_t)m * NAB + C_BETA + h]), ab = bf2f(P0[(size_t)m * NAB + C_AB + h]);
            ((float*)(act + A_DNB))[m * 8 + h] = sigmoidf_(bb);
            ((float*)(act + A_DNG))[m * 8 + h] = -__expf(p.in[I_ALOG][h]) * softplusf_(ab + p.in[I_DTB][h]); }
    }
}
__device__ __forceinline__ void ph_dn_scan(const Ctx& c, const Params& p) {
    if (c.wave != 0 || c.bid >= 32) return;
    LAS float* kq = (LAS float*)c.lds;
    const int b = c.bid >> 3, h = c.bid & 7, e = c.lane;
    unsigned char* act = p.ws + WS_ACT; const bf16* P0 = (const bf16*)(act + A_P);
    const float* Q = (const float*)(act + A_DNQ); const float* K = (const float*)(act + A_DNK); const float* V = (const float*)(act + A_DNV);
    const float* Bt = (const float*)(act + A_DNB); const float* Gt = (const float*)(act + A_DNG);
    const float nw = p.in[I_DNNORM][e];
    float S[64];
#pragma unroll
    for (int d = 0; d < 64; ++d) S[d] = 0.f;
    for (int t = 0; t < T; ++t) { const int m = b * T + t;
        asm volatile("s_waitcnt lgkmcnt(0)" ::: "memory");
        kq[e] = K[(size_t)m * 512 + h * 64 + e]; kq[64 + e] = Q[(size_t)m * 512 + h * 64 + e];
        const float v = V[(size_t)m * 512 + h * 64 + e], beta = Bt[m * 8 + h], eg = __expf(Gt[m * 8 + h]);
        asm volatile("s_waitcnt lgkmcnt(0)" ::: "memory");
        float kS = 0.f;
#pragma unroll
        for (int d = 0; d < 64; ++d) { S[d] *= eg; kS += kq[d] * S[d]; }
        const float dl = beta * (v - kS); float o = 0.f;
#pragma unroll
        for (int d = 0; d < 64; ++d) { S[d] += kq[d] * dl; o += kq[64 + d] * S[d]; }
        o *= 0.125f;
        const float rs = 1.0f / sqrtf(wave_sum(o * o) * (1.f / 64.f) + 1e-6f);
        const float gt = bf2f(P0[(size_t)m * NAB + C_GATEB + h * 64 + e]);
        ((bf16*)(act + A_MIXA))[(size_t)m * D + 512 + h * 64 + e] = (bf16)f2bf(o * rs * nw * siluf_(gt));
    }
}

__device__ __forceinline__ void ph_lru_conv(const Ctx& c, const Params& p) {
    const bf16* P1 = (const bf16*)(p.ws + WS_ACT + A_P); const float* cw = p.in[I_LCW];
    for (size_t gid = (size_t)c.bid * NTHR + c.tid; gid < (size_t)M * 1024; gid += (size_t)c.G * NTHR) {
        const int m = (int)(gid >> 10), ch = (int)(gid & 1023), t = m & (T - 1); float a = p.in[I_LCB][ch];
#pragma unroll
        for (int k = 0; k < 4; ++k) { const int tt = t - 3 + k; if (tt >= 0) a += cw[k * 1024 + ch] * bf2f(P1[(size_t)(m - 3 + k) * NCD + C_XC + ch]); }
        ((float*)(p.ws + WS_ACT + A_XC))[gid] = a; }
}
__device__ __forceinline__ void ph_lru_gates(const Ctx& c, const Params& p) {
    LAS float* xs = (LAS float*)(c.lds + c.wave * 512);
    const float* XC = (const float*)(p.ws + WS_ACT + A_XC);
    for (int it = c.gw; it < M * 8; it += c.NGW) { const int m = it >> 3, n = it & 7;
        asm volatile("s_waitcnt lgkmcnt(0)" ::: "memory");
        xs[c.lane] = XC[(size_t)m * 1024 + n * 128 + c.lane]; xs[64 + c.lane] = XC[(size_t)m * 1024 + n * 128 + 64 + c.lane];
        asm volatile("s_waitcnt lgkmcnt(0)" ::: "memory");
#pragma unroll
        for (int hh = 0; hh < 2; ++hh) { const int j = c.lane + 64 * hh, ch = n * 128 + j;
            const float* ga = p.in[I_GAW] + (size_t)n * 128 * 128 + j; const float* gx = p.in[I_GXW] + (size_t)n * 128 * 128 + j;
            float ra = 0.f, rx = 0.f;
            for (int i = 0; i < 128; ++i) { ra += xs[i] * ga[i * 128]; rx += xs[i] * gx[i * 128]; }
            const float r = sigmoidf_(ra + p.in[I_GAB][ch]), ii = sigmoidf_(rx + p.in[I_GXB][ch]);
            const float log_a = -8.0f * r * softplusf_(-p.in[I_LAM][ch]);
            ((float*)(p.ws + WS_LA))[(size_t)m * 1024 + ch] = __expf(log_a);
            ((float*)(p.ws + WS_LB))[(size_t)m * 1024 + ch] = sqrtf(-expm1f(2.0f * log_a)) * (ii * xs[j]); }
    }
}
__device__ __forceinline__ void ph_lru_scan(const Ctx& c, const Params& p) {
    if (c.wave != 0 || c.bid >= 64) return;
    const int gid = c.bid * 64 + c.lane, b = gid >> 10, ch = gid & 1023;
    const float* LA = (const float*)(p.ws + WS_LA); const float* LB = (const float*)(p.ws + WS_LB);
    const bf16* P1 = (const bf16*)(p.ws + WS_ACT + A_P); bf16* MIXB = (bf16*)(p.ws + WS_ACT + A_MIXB);
    float hs = 0.f;
    for (int t = 0; t < T; ++t) { const size_t m = (size_t)b * T + t; hs = LA[m * 1024 + ch] * hs + LB[m * 1024 + ch];
        MIXB[m * CDO + ch] = (bf16)f2bf(hs * gelu_tanhf_(bf2f(P1[m * NCD + C_YC + ch]))); }
}
__device__ __forceinline__ void ph_sconv(const Ctx& c, const Params& p) {
    const bf16* P1 = (const bf16*)(p.ws + WS_ACT + A_P); const float* sw = p.in[I_SCW];
    for (size_t gid = (size_t)c.bid * NTHR + c.tid; gid < (size_t)M * 512; gid += (size_t)c.G * NTHR) {
        const int m = (int)(gid >> 9), ch = (int)(gid & 511), t = m & (T - 1); float a = 0.f;
#pragma unroll
        for (int k = 0; k < 3; ++k) { const int tt = t - 2 + k; if (tt >= 0) { const size_t r = (size_t)(m - 2 + k) * NCD; a += sw[k * 512 + ch] * (bf2f(P1[r + C_CD + ch]) * bf2f(P1[r + C_HD + ch])); } }
        ((bf16*)(p.ws + WS_ACT + A_MIXB))[(size_t)m * CDO + 1024 + ch] = (bf16)f2bf(bf2f(P1[(size_t)m * NCD + C_BD + ch]) * a); }
}

__device__ __forceinline__ void ph_route(const Ctx& c, const Params& p, int curoff) {
    LAS int* tot = (LAS int*)c.lds; LAS int* pre = tot + 8; LAS int* loff = tot + 16; LAS int* posl = tot + 32;
    const unsigned* H = (const unsigned*)(p.ws + WS_ROUTE + R_HIST);
    { const int e = c.wave; int t = 0, pr = 0;
      for (int w = c.lane; w < c.G; w += 64) { const int v = (int)H[w * 8 + e]; t += v; pr += (w < c.bid) ? v : 0; }
#pragma unroll
      for (int o = 1; o < 64; o <<= 1) { t += __shfl_xor(t, o); pr += __shfl_xor(pr, o); }
      if (c.lane == 0) { tot[e] = t; pre[e] = pr; } }
    __syncthreads();
    if (c.tid == 0) { int* off = (int*)(p.ws + WS_ROUTE + R_OFF); int* te = (int*)(p.ws + WS_ROUTE + R_TILEE); int o = 0;
        for (int e = 0; e < 8; ++e) { loff[e] = o; const int n = (tot[e] + 255) & ~255;
            if (c.bid == 0) { off[e] = o; for (int t = o >> 8; t < (o + n) >> 8 && t < MAXT; ++t) te[t] = e; }
            o += n; }
        loff[8] = o; if (c.bid == 0) off[8] = o < MPAD ? o : MPAD; }
    __syncthreads();
    const int* idx = (const int*)(p.ws + WS_ROUTE + R_IDX); const float* tw = (const float*)(p.ws + WS_ROUTE + R_W);
    if (c.wave == 0) { int run[8];
#pragma unroll
        for (int e = 0; e < 8; ++e) run[e] = loff[e] + pre[e];
#pragma unroll
        for (int r = 0; r < 2; ++r) { const int it = 64 * r + c.lane; const int e = idx[c.bid * 128 + it]; int pos = 0;
#pragma unroll
            for (int ex = 0; ex < 8; ++ex) { const unsigned long long mk = __ballot(e == ex); if (e == ex) pos = run[ex] + __popcll(mk & ((1ull << c.lane) - 1ull)); run[ex] += __popcll(mk); }
            posl[it] = pos; ((int*)(p.ws + WS_ROUTE + R_SLOT))[c.bid * 128 + it] = pos; ((float*)(p.ws + WS_ROUTE + R_GATEW))[pos] = tw[c.bid * 128 + it]; } }
    __syncthreads();
    for (int i = 0; i < 16; ++i) { const int it = c.wave * 16 + i; const int m = c.bid * 64 + (it >> 1); const int pos = posl[it];
        const v4u* src = (const v4u*)((const bf16*)(p.ws + WS_A3) + (size_t)m * D); v4u* dst = (v4u*)((bf16*)(p.ws + WS_ACT + A_A3P) + (size_t)pos * D);
        dst[c.lane] = src[c.lane]; dst[c.lane + 64] = src[c.lane + 64]; }
}
template <bool PROBE> __device__ __forceinline__ void ph_final(const Ctx& c, const Params& p) {
    const int lane = c.lane;
    const int* slot = (const int*)(p.ws + WS_ROUTE + R_SLOT); const bf16* Y = (const bf16*)(p.ws + WS_ACT + A_Y);
    const float* mod = (const float*)(p.ws + WS_MOD) + 4 * 6144; const float* fw = p.in[I_NFIN];
    for (int m = c.gw; m < M; m += c.NGW) { const int b = m >> 12; const float* g2 = mod + (size_t)b * 6144 + 5 * D;
        const int s0 = slot[2 * m], s1 = slot[2 * m + 1];
        f32x4* xr = (f32x4*)(p.out + (size_t)m * D) + lane; f32x4* xw = PROBE ? (f32x4*)((float*)(p.ws + WS_ACT + A_HM) + (size_t)m * D) + lane : xr; const v2u* y0 = (const v2u*)(Y + (size_t)s0 * D) + lane; const v2u* y1 = (const v2u*)(Y + (size_t)s1 * D) + lane;
        f32x4 v[4]; float s = 0.f;
#pragma unroll
        for (int j = 0; j < 4; ++j) { const f32x4 gv = *(const f32x4*)(g2 + 4 * lane + 256 * j); const v2u a = y0[64 * j], cc = y1[64 * j];
            f32x4 yy; yy.x = bflo(a.x) + bflo(cc.x); yy.y = bfhi(a.x) + bfhi(cc.x); yy.z = bflo(a.y) + bflo(cc.y); yy.w = bfhi(a.y) + bfhi(cc.y);
            v[j] = xr[64 * j] + gv * yy; s += (v[j].x * v[j].x + v[j].y * v[j].y) + (v[j].z * v[j].z + v[j].w * v[j].w); }
        const float rstd = 1.0f / sqrtf(wave_sum(s) * (1.f / D) + 1e-6f);
#pragma unroll
        for (int j = 0; j < 4; ++j) { const f32x4 wv = *(const f32x4*)(fw + 4 * lane + 256 * j); xw[64 * j] = v[j] * rstd * wv; }
    }
}


typedef short bf16x8_t __attribute__((ext_vector_type(8)));
typedef short s16x4_t __attribute__((ext_vector_type(4)));
typedef float f32x16 __attribute__((ext_vector_type(16)));
constexpr int AT_KSTR = 144, AT_VSTR = 520, AT_K = 0, AT_V = 256 * AT_KSTR, AT_BIAS = AT_V + 64 * AT_VSTR, AT_END = AT_BIAS + 2048;
typedef float f32x2_c __attribute__((ext_vector_type(2))); typedef __bf16 bf16x2_c __attribute__((ext_vector_type(2)));
__device__ __forceinline__ unsigned pkbf(float lo, float hi) { f32x2_c v = {lo, hi}; bf16x2_c b = __builtin_convertvector(v, bf16x2_c); return __builtin_bit_cast(unsigned, b); }
__device__ __forceinline__ void attn_unit(const Ctx& c, const Params& p, int u) {
    const int qb = u & 31, kvh = (u >> 5) & 1, b = u >> 6;
    const bf16* P0 = (const bf16*)(p.ws + WS_ACT + A_P);
    LAS unsigned char* lds = c.lds;
    __syncthreads();
    {
        const int key = c.tid >> 1, half = c.tid & 1, tk = 128 * (qb - 1) + key;
        v4u kv[4];
        if (tk >= 0) { const v4u* src = (const v4u*)(P0 + (size_t)(b * T + tk) * NAB + C_KA + kvh * 64 + 32 * half);
#pragma unroll
            for (int i = 0; i < 4; ++i) kv[i] = src[i]; }
        else {
#pragma unroll
            for (int i = 0; i < 4; ++i) kv[i] = (v4u){0u, 0u, 0u, 0u}; }
#pragma unroll
        for (int i = 0; i < 4; ++i) *(LAS v4u*)(lds + AT_K + key * AT_KSTR + 64 * half + 16 * i) = kv[i];
    }
    {
        const int kp = c.tid & 127, dq = c.tid >> 7, tk = 128 * (qb - 1) + 2 * kp;
        v4u va[2], vb[2];
        if (tk >= 0) { const v4u* s0 = (const v4u*)(P0 + (size_t)(b * T + tk) * NAB + C_VA + kvh * 64 + 16 * dq); const v4u* s1 = (const v4u*)(P0 + (size_t)(b * T + tk + 1) * NAB + C_VA + kvh * 64 + 16 * dq);
            va[0] = s0[0]; va[1] = s0[1]; vb[0] = s1[0]; vb[1] = s1[1]; }
        else { va[0] = va[1] = vb[0] = vb[1] = (v4u){0u, 0u, 0u, 0u}; }
#pragma unroll
        for (int i = 0; i < 2; ++i)
#pragma unroll
            for (int k = 0; k < 4; ++k) { const unsigned a = va[i][k], bb = vb[i][k]; const int d = 16 * dq + 8 * i + 2 * k;
                *(LAS unsigned*)(lds + AT_V + d * AT_VSTR + 4 * kp) = (a & 0xffffu) | (bb << 16);
                *(LAS unsigned*)(lds + AT_V + (d + 1) * AT_VSTR + 4 * kp) = (a >> 16) | (bb & 0xffff0000u); }
    }
    { const int hl = c.tid >> 7, dist = c.tid & 127; *(LAS float*)(lds + AT_BIAS + c.tid * 4) = p.in[I_RELB][T5_BUCKET[dist] * 8 + kvh * 4 + hl]; }
    __syncthreads();
    const int hl = c.wave >> 1, hq = kvh * 4 + hl, qh = c.wave & 1, qi = c.lane & 31, hh = c.lane >> 5;
    const float sink = p.in[I_SINK][hq];
    const LAS float* biasT = (const LAS float*)(lds + AT_BIAS + hl * 512);
#pragma unroll 1
    for (int s = 0; s < 2; ++s) {
        const int q0 = 64 * qh + 32 * s, kb0 = q0 >> 5, qq = q0 + qi; const size_t m = (size_t)b * T + 128 * qb + qq;
        bf16x8_t bq[4];
#pragma unroll
        for (int ks = 0; ks < 4; ++ks) bq[ks] = *(const bf16x8_t*)(P0 + m * NAB + C_QA + hq * 64 + 16 * ks + 8 * hh);
        f32x16 sacc[5];
#pragma unroll
        for (int kbi = 0; kbi < 5; ++kbi) {
            f32x16 acc;
#pragma unroll
            for (int r = 0; r < 16; ++r) acc[r] = 0.f;
#pragma unroll
            for (int ks = 0; ks < 4; ++ks) { const bf16x8_t ka = *(const LAS bf16x8_t*)(lds + AT_K + (32 * (kb0 + kbi) + qi) * AT_KSTR + 32 * ks + 16 * hh);
                acc = __builtin_amdgcn_mfma_f32_32x32x16_bf16(ka, bq[ks], acc, 0, 0, 0); }
            sacc[kbi] = acc;
        }
        float mx = -1e30f;
#pragma unroll
        for (int kbi = 0; kbi < 5; ++kbi)
#pragma unroll
            for (int r = 0; r < 16; ++r) { const int sidx = 32 * (kb0 + kbi) + (r & 3) + 8 * (r >> 2) + 4 * hh; const int dist = qq + 128 - sidx;
                const bool valid = dist >= 0 && dist < 128 && (qb > 0 || sidx >= 128);
                const float bv = biasT[dist & 127];
                const float sc = valid ? sacc[kbi][r] * 0.125f + bv : -1e30f; sacc[kbi][r] = sc; mx = fmaxf(mx, sc); }
        mx = fmaxf(mx, __shfl_xor(mx, 32)); mx = fmaxf(mx, sink);
        float l = 0.f;
#pragma unroll
        for (int kbi = 0; kbi < 5; ++kbi)
#pragma unroll
            for (int r = 0; r < 16; ++r) { const float pv = __expf(sacc[kbi][r] - mx); sacc[kbi][r] = pv; l += pv; }
        l += __shfl_xor(l, 32); l += __expf(sink - mx);
        const float inv = 1.0f / l;
        f32x16 oacc[2];
#pragma unroll
        for (int db = 0; db < 2; ++db)
#pragma unroll
            for (int r = 0; r < 16; ++r) oacc[db][r] = 0.f;
#pragma unroll
        for (int kbi = 0; kbi < 5; ++kbi)
#pragma unroll
            for (int s2 = 0; s2 < 2; ++s2) {
                v4u pw; pw.x = pkbf(sacc[kbi][8 * s2 + 0], sacc[kbi][8 * s2 + 1]); pw.y = pkbf(sacc[kbi][8 * s2 + 2], sacc[kbi][8 * s2 + 3]); pw.z = pkbf(sacc[kbi][8 * s2 + 4], sacc[kbi][8 * s2 + 5]); pw.w = pkbf(sacc[kbi][8 * s2 + 6], sacc[kbi][8 * s2 + 7]);
                const bf16x8_t pf = __builtin_bit_cast(bf16x8_t, pw);
                const int keyb = 32 * (kb0 + kbi) + 16 * s2 + 4 * hh;
#pragma unroll
                for (int db = 0; db < 2; ++db) { const LAS unsigned char* vp = lds + AT_V + (32 * db + qi) * AT_VSTR + 2 * keyb;
                    const s16x4_t lo = *(const LAS s16x4_t*)vp, hi = *(const LAS s16x4_t*)(vp + 16);
                    const bf16x8_t vf = (bf16x8_t){lo[0], lo[1], lo[2], lo[3], hi[0], hi[1], hi[2], hi[3]};
                    oacc[db] = __builtin_amdgcn_mfma_f32_32x32x16_bf16(vf, pf, oacc[db], 0, 0, 0); }
            }
        bf16* orow = (bf16*)(p.ws + WS_ACT + A_MIXA) + m * D + hq * 64;
#pragma unroll
        for (int db = 0; db < 2; ++db)
#pragma unroll
            for (int g = 0; g < 4; ++g) { v2u w; w.x = pkbf(oacc[db][4 * g] * inv, oacc[db][4 * g + 1] * inv); w.y = pkbf(oacc[db][4 * g + 2] * inv, oacc[db][4 * g + 3] * inv);
                *(v2u*)(orow + 32 * db + 8 * g + 4 * hh) = w; }
    }
}
__device__ __forceinline__ void ph_attn(const Ctx& c, const Params& p) {
    for (int u = c.bid; u < 256; u += c.G) attn_unit(c, p, u);
}


constexpr int LR_XSTR = 272, LR_XT = 0, LR_XF = 64 * LR_XSTR, LR_GA = LR_XF + 32768, LR_CMB = LR_GA + 32768, LR_END = LR_CMB + 4096;
constexpr size_t A_LCA = 192 * MiB, A_LCH = 193 * MiB;
typedef float f32x4_t __attribute__((ext_vector_type(4)));
template <int PASS>
__device__ __forceinline__ void ph_lru(const Ctx& c, const Params& p) {
    LAS unsigned char* lds = c.lds;
    const int n = c.bid & 7, ch = c.tid & 127, tq = c.tid >> 7, gch = n * 128 + ch;
    const bf16* P1 = (const bf16*)(p.ws + WS_ACT + A_P);
    float* CA = (float*)(p.ws + WS_ACT + A_LCA); float* CH = (float*)(p.ws + WS_ACT + A_LCH);
    const float cw0 = p.in[I_LCW][gch], cw1 = p.in[I_LCW][1024 + gch], cw2 = p.in[I_LCW][2048 + gch], cw3 = p.in[I_LCW][3072 + gch], cb = p.in[I_LCB][gch];
    const int jl = c.lane & 15, q = c.lane >> 4, w = c.wave, ech = n * 128 + 16 * w + jl;
    const float gab = p.in[I_GAB][ech], gxb = p.in[I_GXB][ech], sp8 = -8.0f * softplusf_(-p.in[I_LAM][ech]);
    bf16x8_t bfa[4], bfx[4];
    { const bf16* wl = (const bf16*)(p.ws + WS_WLRU) + (size_t)n * 256 * 128;
#pragma unroll
      for (int ks = 0; ks < 4; ++ks) { bfa[ks] = *(const bf16x8_t*)(wl + (size_t)(16 * w + jl) * 128 + 32 * ks + 8 * q); bfx[ks] = *(const bf16x8_t*)(wl + (size_t)(128 + 16 * w + jl) * 128 + 32 * ks + 8 * q); } }
    for (int u = c.bid >> 3; u < 256; u += (c.G >> 3)) {
        const int b = u >> 6, tt = u & 63; const size_t m0 = (size_t)b * T + 64 * tt;
        __syncthreads();
        { float x0, x1, x2; const int tb = 64 * tt + 16 * tq;
          const bf16* col = P1 + C_XC + gch;
          x0 = tb >= 3 ? bf2f(col[(m0 + 16 * tq - 3) * NCD]) : 0.f; x1 = tb >= 2 ? bf2f(col[(m0 + 16 * tq - 2) * NCD]) : 0.f; x2 = tb >= 1 ? bf2f(col[(m0 + 16 * tq - 1) * NCD]) : 0.f;
#pragma unroll
          for (int i = 0; i < 16; ++i) { const int tk = 16 * tq + i; const float x3 = bf2f(col[(m0 + tk) * NCD]);
              const float xc = cb + cw0 * x0 + cw1 * x1 + cw2 * x2 + cw3 * x3;
              *(LAS unsigned short*)(lds + LR_XT + tk * LR_XSTR + 2 * ch) = (unsigned short)f2bf(xc);
              *(LAS float*)(lds + LR_XF + (tk * 128 + ch) * 4) = xc;
              x0 = x1; x1 = x2; x2 = x3; } }
        __syncthreads();
#pragma unroll
        for (int mt = 0; mt < 4; ++mt) {
            f32x4_t aa = {0.f, 0.f, 0.f, 0.f}, ax = {0.f, 0.f, 0.f, 0.f};
#pragma unroll
            for (int ks = 0; ks < 4; ++ks) { const bf16x8_t af = *(const LAS bf16x8_t*)(lds + LR_XT + (16 * mt + jl) * LR_XSTR + 64 * ks + 16 * q);
                aa = __builtin_amdgcn_mfma_f32_16x16x32_bf16(af, bfa[ks], aa, 0, 0, 0); ax = __builtin_amdgcn_mfma_f32_16x16x32_bf16(af, bfx[ks], ax, 0, 0, 0); }
#pragma unroll
            for (int r4 = 0; r4 < 4; ++r4) { const int tk = 16 * mt + 4 * q + r4; LAS float* xf = (LAS float*)(lds + LR_XF + (tk * 128 + 16 * w + jl) * 4);
                const float r = sigmoidf_(aa[r4] + gab), ii = sigmoidf_(ax[r4] + gxb), la = sp8 * r, a = __expf(la);
                const float bb = sqrtf(fmaxf(1.0f - a * a, 0.f)) * (ii * xf[0]);
                *(LAS float*)(lds + LR_GA + (tk * 128 + 16 * w + jl) * 4) = a; xf[0] = bb; }
        }
        __syncthreads();
        float av[16], bv[16];
#pragma unroll
        for (int i = 0; i < 16; ++i) { av[i] = *(const LAS float*)(lds + LR_GA + ((16 * tq + i) * 128 + ch) * 4); bv[i] = *(const LAS float*)(lds + LR_XF + ((16 * tq + i) * 128 + ch) * 4); }
        float Ap = 1.f, h = 0.f;
#pragma unroll
        for (int i = 0; i < 16; ++i) { h = av[i] * h + bv[i]; Ap *= av[i]; }
        *(LAS float*)(lds + LR_CMB + (tq * 128 + ch) * 4) = Ap; *(LAS float*)(lds + LR_CMB + 2048 + (tq * 128 + ch) * 4) = h;
        __syncthreads();
        if (PASS == 1) {
            if (tq == 0) { float A = 1.f, H = 0.f;
#pragma unroll
                for (int g = 0; g < 4; ++g) { const float ag = *(const LAS float*)(lds + LR_CMB + (g * 128 + ch) * 4), hg = *(const LAS float*)(lds + LR_CMB + 2048 + (g * 128 + ch) * 4); H = ag * H + hg; A *= ag; }
                CA[(size_t)(b * 64 + tt) * 1024 + gch] = A; CH[(size_t)(b * 64 + tt) * 1024 + gch] = H; }
        } else {
            float hin = 0.f;
            for (int t2 = 0; t2 < tt; ++t2) hin = CA[(size_t)(b * 64 + t2) * 1024 + gch] * hin + CH[(size_t)(b * 64 + t2) * 1024 + gch];
            for (int g = 0; g < tq; ++g) { const float ag = *(const LAS float*)(lds + LR_CMB + (g * 128 + ch) * 4), hg = *(const LAS float*)(lds + LR_CMB + 2048 + (g * 128 + ch) * 4); hin = ag * hin + hg; }
            bf16* mo = (bf16*)(p.ws + WS_ACT + A_MIXB) + gch; const bf16* yc = P1 + C_YC + gch;
            float hs = hin;
#pragma unroll
            for (int i = 0; i < 16; ++i) { const size_t m = m0 + 16 * tq + i; hs = av[i] * hs + bv[i];
                const float y = bf2f(yc[m * NCD]); const float ge = y * sigmoidf_(1.5957691216057308f * (y + 0.044715f * y * y * y));
                mo[m * CDO] = (bf16)f2bf(hs * ge); }
        }
    }
}


constexpr size_t A_DNX = 160 * MiB, A_DNEG = 256 * MiB;
constexpr int DN_CHB = 49152, DN_W = 0, DN_QD = 8192, DN_QK = 16384, DN_KD = 24576, DN_U = 32768;
constexpr int DN_KS = 144, DN_R = 9216, DN_WAVE = 2 * DN_R;
__device__ __forceinline__ float rdl(float x, int i) { return __builtin_bit_cast(float, __builtin_amdgcn_readlane(__builtin_bit_cast(int, x), i)); }
__device__ __forceinline__ int lrow_off(int i) { const int a = (i - 1) >> 2, b = (i - 1) & 3; return 4 * (a + 1) * (2 * a + b); }
__host__ __device__ constexpr int lrow_off_c(int i) { return 4 * (((i - 1) >> 2) + 1) * (2 * ((i - 1) >> 2) + ((i - 1) & 3)); }

typedef __amdgpu_buffer_rsrc_t rsrc_t;
__device__ __forceinline__ rsrc_t mk_rsrc(const void* base, unsigned bytes) { return __builtin_amdgcn_make_buffer_rsrc((void*)base, 0, bytes, 0x00020000); }
__device__ __forceinline__ void dn_conv_row(rsrc_t rp, const float* cw, int rowoff, int n, int lane, int coffb, int woff, float (&acc)[64]) {
#pragma unroll
    for (int ch = 0; ch < 64; ++ch) acc[ch] = 0.f;
#pragma unroll
    for (int k = 0; k < 4; ++k) { const int tt = 64 * n + lane - 3 + k;
        v4u xr[8];
        if (tt >= 0) {
#pragma unroll
            for (int i = 0; i < 8; ++i) xr[i] = __builtin_amdgcn_raw_buffer_load_b128(rp, rowoff + (k - 3) * (NAB * 2) + 16 * i, coffb, 0); }
        else {
#pragma unroll
            for (int i = 0; i < 8; ++i) xr[i] = (v4u){0u, 0u, 0u, 0u}; }
#pragma unroll
        for (int i = 0; i < 8; ++i)
#pragma unroll
            for (int e = 0; e < 4; ++e) { const unsigned w = xr[i][e]; acc[8 * i + 2 * e] += cw[k * 1536 + woff + 8 * i + 2 * e] * bflo(w); acc[8 * i + 2 * e + 1] += cw[k * 1536 + woff + 8 * i + 2 * e + 1] * bfhi(w); }
        asm volatile("" ::: "memory"); }
#pragma unroll
    for (int ch = 0; ch < 64; ++ch) acc[ch] = siluf_(acc[ch]);
}
__device__ __forceinline__ void fnma(float& acc, float a, float b) { asm volatile("v_fma_f32 %0, -%1, %2, %0" : "+v"(acc) : "v"(a), "v"(b)); }
__device__ __forceinline__ void dn_solve(const LAS unsigned char* R2, float (&x)[64]) {
#pragma unroll
    for (int i = 1; i < 64; ++i) {
        float a0 = x[i], a1 = 0.f;
#pragma unroll
        for (int g = 0; g < (i + 3) / 4; ++g) { const f32x4_t lv = *(const LAS f32x4_t*)(R2 + (lrow_off_c(i) + 4 * g) * 4);
#pragma unroll
            for (int e = 0; e < 4; ++e) if (4 * g + e < i) { if (e & 1) fnma(a1, lv[e], x[4 * g + e]); else fnma(a0, lv[e], x[4 * g + e]); } }
        x[i] = a0 + a1;
    }
}
__device__ __forceinline__ void dn_prep_chunk(const Ctx& c, const Params& p, int ci, size_t xoff) {
    const int n = ci & 63, h = (ci >> 6) & 7, b = ci >> 9, lane = c.lane;
    const int m0 = b * T + 64 * n;
    LAS unsigned char* R1 = c.lds + c.wave * DN_WAVE; LAS unsigned char* R2 = R1 + DN_R;
    const float* cw = p.in[I_DNCONV];
    const rsrc_t rp = mk_rsrc(p.ws + WS_ACT + A_P, (unsigned)((size_t)M * NAB * 2));
    const rsrc_t rx = mk_rsrc(p.ws + xoff + (size_t)ci * DN_CHB, DN_CHB);
    const int rowoff = (m0 + lane) * (NAB * 2);
#pragma unroll
    for (int s = 0; s < 2; ++s) {
        float acc[64]; dn_conv_row(rp, cw, rowoff, n, lane, (C_QKVB + s * 512 + h * 64) * 2, s * 512 + h * 64, acc);
        float ss = 0.f;
#pragma unroll
        for (int ch = 0; ch < 64; ++ch) ss += acc[ch] * acc[ch];
        const float rn = (s == 1 ? 1.0f : 0.125f) / sqrtf(ss + 1e-6f);
        LAS unsigned char* dst = (s == 1 ? R1 : R2) + lane * DN_KS;
#pragma unroll
        for (int i = 0; i < 8; ++i) { v4u w; w.x = pkbf(acc[8 * i] * rn, acc[8 * i + 1] * rn); w.y = pkbf(acc[8 * i + 2] * rn, acc[8 * i + 3] * rn); w.z = pkbf(acc[8 * i + 4] * rn, acc[8 * i + 5] * rn); w.w = pkbf(acc[8 * i + 6] * rn, acc[8 * i + 7] * rn);
            *(LAS v4u*)(dst + 16 * i) = w; }
        asm volatile("" ::: "memory");
    }
    const float beta = sigmoidf_(bf2f(__builtin_amdgcn_raw_buffer_load_b16(rp, rowoff, (C_BETA + h) * 2, 0)));
    float gc = -__expf(p.in[I_ALOG][h]) * softplusf_(bf2f(__builtin_amdgcn_raw_buffer_load_b16(rp, rowoff, (C_AB + h) * 2, 0)) + p.in[I_DTB][h]);
#pragma unroll
    for (int o = 1; o < 64; o <<= 1) { const float t = __shfl_up(gc, o); if (lane >= o) gc += t; }
    const float gl = rdl(gc, 63), egc = __expf(gc), kdsc = __expf(gl - gc), bw = beta * egc;
    if (lane == 0) ((float*)(p.ws + WS_ACT + A_DNEG))[ci] = __expf(gl);
    asm volatile("s_waitcnt lgkmcnt(0)" ::: "memory");
    const int r32 = lane & 31, hh = lane >> 5, l15 = lane & 15, q4 = lane >> 4;
#pragma unroll
    for (int blk = 0; blk < 4; ++blk) { const int I = blk >> 1, J = blk & 1;
        v4u fa = {0u, 0u, 0u, 0u}, fb = {0u, 0u, 0u, 0u};
        if (!(I == 0 && J == 1)) {
            f32x16 acc;
#pragma unroll
            for (int r = 0; r < 16; ++r) acc[r] = 0.f;
#pragma unroll
            for (int ks = 0; ks < 4; ++ks) { const bf16x8_t ka = *(const LAS bf16x8_t*)(R1 + (32 * J + r32) * DN_KS + 32 * ks + 16 * hh), qb = *(const LAS bf16x8_t*)(R2 + (32 * I + r32) * DN_KS + 32 * ks + 16 * hh);
                acc = __builtin_amdgcn_mfma_f32_32x32x16_bf16(ka, qb, acc, 0, 0, 0); }
            const int i = 32 * I + r32; const float gci = __shfl(gc, i);
            float v[16];
#pragma unroll
            for (int r = 0; r < 16; ++r) { const int j = 32 * J + (r & 3) + 8 * (r >> 2) + 4 * hh; const float gcj = __shfl(gc, j); v[r] = j <= i ? acc[r] * __expf(gci - gcj) : 0.f; }
            fa.x = pkbf(v[0], v[1]); fa.y = pkbf(v[2], v[3]); fa.z = pkbf(v[8], v[9]); fa.w = pkbf(v[10], v[11]);
            fb.x = pkbf(v[4], v[5]); fb.y = pkbf(v[6], v[7]); fb.z = pkbf(v[12], v[13]); fb.w = pkbf(v[14], v[15]);
        }
        const int vo = (r32 >> 4) * 2048 + (l15 + 16 * hh) * 16;
        __builtin_amdgcn_raw_buffer_store_b128(fa, rx, (vo) + (DN_QK + 4096 * I + 1024 * J), 0, 0);
        __builtin_amdgcn_raw_buffer_store_b128(fb, rx, (vo) + (DN_QK + 4096 * I + 1024 * J + 512), 0, 0);
    }
#pragma unroll
    for (int mt = 0; mt < 4; ++mt) { const int row = 16 * mt + l15; const float sc = __shfl(egc, row);
#pragma unroll
        for (int ks = 0; ks < 2; ++ks) { const v2u a = *(const LAS v2u*)(R2 + row * DN_KS + 64 * ks + 8 * q4), bq = *(const LAS v2u*)(R2 + row * DN_KS + 64 * ks + 32 + 8 * q4);
            v4u w; w.x = pkbf(bflo(a.x) * sc, bfhi(a.x) * sc); w.y = pkbf(bflo(a.y) * sc, bfhi(a.y) * sc); w.z = pkbf(bflo(bq.x) * sc, bfhi(bq.x) * sc); w.w = pkbf(bflo(bq.y) * sc, bfhi(bq.y) * sc);
            __builtin_amdgcn_raw_buffer_store_b128(w, rx, (lane * 16) + (DN_QD + (mt * 2 + ks) * 1024), 0, 0); } }
    asm volatile("s_waitcnt lgkmcnt(0)" ::: "memory");
#pragma unroll
    for (int blk = 0; blk < 3; ++blk) { const int I = blk == 0 ? 0 : 1, J = blk == 2 ? 1 : 0;
        f32x16 acc;
#pragma unroll
        for (int r = 0; r < 16; ++r) acc[r] = 0.f;
#pragma unroll
        for (int ks = 0; ks < 4; ++ks) { const bf16x8_t ki = *(const LAS bf16x8_t*)(R1 + (32 * I + r32) * DN_KS + 32 * ks + 16 * hh), kj = *(const LAS bf16x8_t*)(R1 + (32 * J + r32) * DN_KS + 32 * ks + 16 * hh);
            acc = __builtin_amdgcn_mfma_f32_32x32x16_bf16(ki, kj, acc, 0, 0, 0); }
        const int j = 32 * J + r32; const float gcj = __shfl(gc, j);
#pragma unroll
        for (int r = 0; r < 16; ++r) { const int i = 32 * I + (r & 3) + 8 * (r >> 2) + 4 * hh; const float gci = __shfl(gc, i), bi = __shfl(beta, i);
            if (i > j) *(LAS float*)(R2 + (lrow_off(i) + j) * 4) = bi * acc[r] * __expf(gci - gcj); }
    }
    asm volatile("s_waitcnt lgkmcnt(0)" ::: "memory");
    {   float xu[64];
        { const int cb = (C_QKVB + 1024 + h * 64) * 2, wo = 1024 + h * 64 + lane;
          const float w0 = cw[wo], w1 = cw[1536 + wo], w2 = cw[2 * 1536 + wo], w3 = cw[3 * 1536 + wo];
          float x0 = 0.f, x1 = 0.f, x2 = 0.f;
          if (n > 0) { x0 = bf2f(__builtin_amdgcn_raw_buffer_load_b16(rp, lane * 2, (m0 - 3) * (NAB * 2) + cb, 0)); x1 = bf2f(__builtin_amdgcn_raw_buffer_load_b16(rp, lane * 2, (m0 - 2) * (NAB * 2) + cb, 0)); x2 = bf2f(__builtin_amdgcn_raw_buffer_load_b16(rp, lane * 2, (m0 - 1) * (NAB * 2) + cb, 0)); }
#pragma unroll
          for (int i = 0; i < 64; ++i) { const float x3 = bf2f(__builtin_amdgcn_raw_buffer_load_b16(rp, lane * 2, (m0 + i) * (NAB * 2) + cb, 0)); xu[i] = siluf_(w0 * x0 + w1 * x1 + w2 * x2 + w3 * x3) * rdl(beta, i); x0 = x1; x1 = x2; x2 = x3; } }
        dn_solve(R2, xu);
        const int vo = q4 * 4096 + l15 * 16;
#pragma unroll
        for (int mt = 0; mt < 4; ++mt)
#pragma unroll
            for (int qq = 0; qq < 4; ++qq) { const int i0 = 16 * mt + 4 * qq; f32x4_t uv = {xu[i0], xu[i0 + 1], xu[i0 + 2], xu[i0 + 3]};
                __builtin_amdgcn_raw_buffer_store_b128(__builtin_bit_cast(v4u, uv), rx, (vo) + (DN_U + mt * 1024 + qq * 256), 0, 0); }
    }
    asm volatile("" ::: "memory");
    float xw[64];
#pragma unroll
    for (int i = 0; i < 64; ++i) xw[i] = bf2f(*(const LAS unsigned short*)(R1 + i * DN_KS + 2 * lane)) * rdl(bw, i);
    asm volatile("s_waitcnt lgkmcnt(0)" ::: "memory");
    { LAS unsigned char* row = R1 + lane * DN_KS;
#pragma unroll
      for (int i = 0; i < 8; ++i) { v4u w = *(LAS v4u*)(row + 16 * i);
          w.x = pkbf(bflo(w.x) * kdsc, bfhi(w.x) * kdsc); w.y = pkbf(bflo(w.y) * kdsc, bfhi(w.y) * kdsc); w.z = pkbf(bflo(w.z) * kdsc, bfhi(w.z) * kdsc); w.w = pkbf(bflo(w.w) * kdsc, bfhi(w.w) * kdsc);
          *(LAS v4u*)(row + 16 * i) = w; } }
    asm volatile("s_waitcnt lgkmcnt(0)" ::: "memory");
#pragma unroll
    for (int dt = 0; dt < 4; ++dt)
#pragma unroll
        for (int ks = 0; ks < 2; ++ks) { unsigned short e[8];
#pragma unroll
            for (int jj = 0; jj < 8; ++jj) e[jj] = *(const LAS unsigned short*)(R1 + (32 * ks + 16 * (jj >> 2) + 4 * q4 + (jj & 3)) * DN_KS + 2 * (16 * dt + l15));
            v4u w; w.x = e[0] | ((unsigned)e[1] << 16); w.y = e[2] | ((unsigned)e[3] << 16); w.z = e[4] | ((unsigned)e[5] << 16); w.w = e[6] | ((unsigned)e[7] << 16);
            __builtin_amdgcn_raw_buffer_store_b128(w, rx, (lane * 16) + (DN_KD + (dt * 2 + ks) * 1024), 0, 0); }
    asm volatile("s_waitcnt lgkmcnt(0)" ::: "memory");
    dn_solve(R2, xw);
#pragma unroll
    for (int i = 0; i < 64; ++i) *(LAS unsigned short*)(R1 + i * DN_KS + 2 * lane) = (unsigned short)(f2bf(xw[i]) ^ 0x8000u);
    asm volatile("s_waitcnt lgkmcnt(0)" ::: "memory");
#pragma unroll
    for (int mt = 0; mt < 4; ++mt)
#pragma unroll
        for (int ks = 0; ks < 2; ++ks) { const int row = 16 * mt + l15; const v2u a = *(const LAS v2u*)(R1 + row * DN_KS + 64 * ks + 8 * q4), bq = *(const LAS v2u*)(R1 + row * DN_KS + 64 * ks + 32 + 8 * q4);
            v4u w; w.x = a.x; w.y = a.y; w.z = bq.x; w.w = bq.y;
            __builtin_amdgcn_raw_buffer_store_b128(w, rx, (lane * 16) + (DN_W + (mt * 2 + ks) * 1024), 0, 0); }
    asm volatile("s_waitcnt lgkmcnt(0)" ::: "memory");
}
__device__ __forceinline__ void ph_dn_prep2(const Ctx& c, const Params& p, size_t xoff) {
    if (c.gw < 2048) dn_prep_chunk(c, p, c.gw, xoff);
}

constexpr int SC_SLOT = DN_CHB, SC_OB = 2 * DN_CHB, SC_OSTR = 272, SC_OBSZ = 64 * SC_OSTR;
__device__ __forceinline__ bf16x8_t pack8(const f32x4_t& a, const f32x4_t& b) { v4u w; w.x = pkbf(a[0], a[1]); w.y = pkbf(a[2], a[3]); w.z = pkbf(b[0], b[1]); w.w = pkbf(b[2], b[3]); return __builtin_bit_cast(bf16x8_t, w); }
__device__ __forceinline__ void ph_dn_scan2(const Ctx& c, const Params& p) {
    if (c.bid >= 32) return;
    const int b = c.bid >> 3, h = c.bid & 7, lane = c.lane;
    LAS unsigned char* lds = c.lds;
    const unsigned char* dnx = p.ws + WS_ACT + A_DNX + (size_t)(c.bid * 64) * DN_CHB; const float* EG = (const float*)(p.ws + WS_ACT + A_DNEG) + c.bid * 64;
    const bf16* P0 = (const bf16*)(p.ws + WS_ACT + A_P);
    if (c.wave >= 4) {
        const int lw = c.wave - 4, il = lane >> 2, qd = lane & 3;
        float nw[16];
#pragma unroll
        for (int k = 0; k < 16; ++k) nw[k] = p.in[I_DNNORM][16 * qd + k];
        v4u ra[12], rb[12], ga[2] = {{0u, 0u, 0u, 0u}, {0u, 0u, 0u, 0u}}, gb[2] = {{0u, 0u, 0u, 0u}, {0u, 0u, 0u, 0u}};
#define DN_LOAD(R, k) do { const v4u* _s = (const v4u*)(dnx + (size_t)(k) * DN_CHB) + lw * 64 + lane; _Pragma("unroll") for (int _i = 0; _i < 12; ++_i) R[_i] = _s[_i * 256]; } while (0)
#define DN_WRITE(R, slot) do { LAS v4u* _d = (LAS v4u*)(lds + (slot) * SC_SLOT) + lw * 64 + lane; _Pragma("unroll") for (int _i = 0; _i < 12; ++_i) _d[_i * 256] = R[_i]; } while (0)
#define DN_GLOAD(G, k) do { const v4u* _g = (const v4u*)(P0 + ((size_t)b * T + 64 * (k) + 16 * lw + il) * NAB + C_GATEB + h * 64 + 16 * qd); G[0] = _g[0]; G[1] = _g[1]; } while (0)
#define DN_EPI(G, k) do { const LAS unsigned char* _ob = lds + SC_OB + ((k) & 1) * SC_OBSZ + (16 * lw + il) * SC_OSTR + 64 * qd; float _o[16]; float _ss = 0.f; \
            _Pragma("unroll") for (int _i = 0; _i < 4; ++_i) { const f32x4_t _v = *(const LAS f32x4_t*)(_ob + 16 * _i); _o[4 * _i] = _v[0]; _o[4 * _i + 1] = _v[1]; _o[4 * _i + 2] = _v[2]; _o[4 * _i + 3] = _v[3]; _ss += (_v[0] * _v[0] + _v[1] * _v[1]) + (_v[2] * _v[2] + _v[3] * _v[3]); } \
            _ss += __shfl_xor(_ss, 1); _ss += __shfl_xor(_ss, 2); const float _rs = 1.0f / sqrtf(_ss * (1.f / 64.f) + 1e-6f); unsigned _w[8]; \
            _Pragma("unroll") for (int _i = 0; _i < 8; ++_i) { const unsigned _gw = G[_i >> 2][_i & 3]; const float _g0 = bflo(_gw), _g1 = bfhi(_gw); _w[_i] = pkbf(_o[2 * _i] * _rs * nw[2 * _i] * siluf_(_g0), _o[2 * _i + 1] * _rs * nw[2 * _i + 1] * siluf_(_g1)); } \
            v4u* _dst = (v4u*)((bf16*)(p.ws + WS_ACT + A_MIXA) + ((size_t)b * T + 64 * (k) + 16 * lw + il) * D + 512 + h * 64 + 16 * qd); _dst[0] = (v4u){_w[0], _w[1], _w[2], _w[3]}; _dst[1] = (v4u){_w[4], _w[5], _w[6], _w[7]}; } while (0)
        DN_LOAD(ra, 0); DN_WRITE(ra, 0); DN_LOAD(rb, 1); DN_LOAD(ra, 2);
        for (int n = 0; n < 64; n += 2) {
            asm volatile("s_waitcnt lgkmcnt(0)" ::: "memory"); __syncthreads();
            DN_WRITE(rb, 1);
            if (n >= 1) DN_EPI(gb, n - 1);
            DN_GLOAD(ga, n);
            if (n + 3 < 64) DN_LOAD(rb, n + 3);
            asm volatile("s_waitcnt lgkmcnt(0)" ::: "memory"); __syncthreads();
            if (n + 2 < 64) DN_WRITE(ra, 0);
            DN_EPI(ga, n);
            DN_GLOAD(gb, n + 1);
            if (n + 4 < 64) DN_LOAD(ra, n + 4);
        }
        asm volatile("s_waitcnt lgkmcnt(0)" ::: "memory"); __syncthreads();
        DN_EPI(gb, 63);
#undef DN_LOAD
#undef DN_WRITE
#undef DN_GLOAD
#undef DN_EPI
    } else {
        const int w = c.wave, e15 = lane & 15, q4 = lane >> 4;
        f32x4_t S[4];
#pragma unroll
        for (int dt = 0; dt < 4; ++dt) S[dt] = (f32x4_t){0.f, 0.f, 0.f, 0.f};
        float egn = EG[0];
#define DN_STEP(n_, slot) do { const LAS unsigned char* sb = lds + (slot) * SC_SLOT; const float eg = egn; egn = EG[(n_) + 1 < 64 ? (n_) + 1 : 63]; \
            const bf16x8_t Bs0 = pack8(S[0], S[1]), Bs1 = pack8(S[2], S[3]); f32x4_t vn[4], oo[4]; \
            _Pragma("unroll") for (int mt = 0; mt < 4; ++mt) { vn[mt] = *(const LAS f32x4_t*)(sb + DN_U + ((w * 4 + mt) * 64 + lane) * 16); \
                vn[mt] = __builtin_amdgcn_mfma_f32_16x16x32_bf16(*(const LAS bf16x8_t*)(sb + DN_W + ((mt * 2 + 0) * 64 + lane) * 16), Bs0, vn[mt], 0, 0, 0); \
                vn[mt] = __builtin_amdgcn_mfma_f32_16x16x32_bf16(*(const LAS bf16x8_t*)(sb + DN_W + ((mt * 2 + 1) * 64 + lane) * 16), Bs1, vn[mt], 0, 0, 0); \
                oo[mt] = (f32x4_t){0.f, 0.f, 0.f, 0.f}; \
                oo[mt] = __builtin_amdgcn_mfma_f32_16x16x32_bf16(*(const LAS bf16x8_t*)(sb + DN_QD + ((mt * 2 + 0) * 64 + lane) * 16), Bs0, oo[mt], 0, 0, 0); \
                oo[mt] = __builtin_amdgcn_mfma_f32_16x16x32_bf16(*(const LAS bf16x8_t*)(sb + DN_QD + ((mt * 2 + 1) * 64 + lane) * 16), Bs1, oo[mt], 0, 0, 0); } \
            const bf16x8_t Bv0 = pack8(vn[0], vn[1]), Bv1 = pack8(vn[2], vn[3]); \
            _Pragma("unroll") for (int mt = 0; mt < 4; ++mt) { \
                oo[mt] = __builtin_amdgcn_mfma_f32_16x16x32_bf16(*(const LAS bf16x8_t*)(sb + DN_QK + ((mt * 2 + 0) * 64 + lane) * 16), Bv0, oo[mt], 0, 0, 0); \
                if (mt >= 2) oo[mt] = __builtin_amdgcn_mfma_f32_16x16x32_bf16(*(const LAS bf16x8_t*)(sb + DN_QK + ((mt * 2 + 1) * 64 + lane) * 16), Bv1, oo[mt], 0, 0, 0); } \
            _Pragma("unroll") for (int dt = 0; dt < 4; ++dt) { S[dt] = S[dt] * eg; \
                S[dt] = __builtin_amdgcn_mfma_f32_16x16x32_bf16(*(const LAS bf16x8_t*)(sb + DN_KD + ((dt * 2 + 0) * 64 + lane) * 16), Bv0, S[dt], 0, 0, 0); \
                S[dt] = __builtin_amdgcn_mfma_f32_16x16x32_bf16(*(const LAS bf16x8_t*)(sb + DN_KD + ((dt * 2 + 1) * 64 + lane) * 16), Bv1, S[dt], 0, 0, 0); } \
            LAS unsigned char* ob = lds + SC_OB + ((n_) & 1) * SC_OBSZ + (16 * w + e15) * 4; \
            _Pragma("unroll") for (int mt = 0; mt < 4; ++mt) _Pragma("unroll") for (int r4 = 0; r4 < 4; ++r4) *(LAS float*)(ob + (16 * mt + 4 * q4 + r4) * SC_OSTR) = oo[mt][r4]; } while (0)
        for (int n = 0; n < 64; n += 2) {
            asm volatile("s_waitcnt lgkmcnt(0)" ::: "memory"); __syncthreads();
            DN_STEP(n, 0);
            asm volatile("s_waitcnt lgkmcnt(0)" ::: "memory"); __syncthreads();
            DN_STEP(n + 1, 1);
        }
        asm volatile("s_waitcnt lgkmcnt(0)" ::: "memory"); __syncthreads();
#undef DN_STEP
    }
}


constexpr size_t A_ODN = 257 * MiB;
__device__ __forceinline__ void ph_dn_scan_simple(const Ctx& c, const Params& p) {
    if (c.bid >= 32 || c.wave >= 4) return;
    const int b = c.bid >> 3, h = c.bid & 7, lane = c.lane, w = c.wave, e15 = lane & 15, q4 = lane >> 4;
    const unsigned char* dnx = p.ws + WS_ACT + A_DNX + (size_t)(c.bid * 64) * DN_CHB; const float* EG = (const float*)(p.ws + WS_ACT + A_DNEG) + c.bid * 64;
    float* ODN = (float*)(p.ws + WS_ACT + A_ODN);
    f32x4_t S[4];
#pragma unroll
    for (int dt = 0; dt < 4; ++dt) S[dt] = (f32x4_t){0.f, 0.f, 0.f, 0.f};
    for (int n = 0; n < 64; ++n) { const unsigned char* sb = dnx + (size_t)n * DN_CHB; const float eg = EG[n];
        const bf16x8_t Bs0 = pack8(S[0], S[1]), Bs1 = pack8(S[2], S[3]); f32x4_t vn[4], oo[4];
#pragma unroll
        for (int mt = 0; mt < 4; ++mt) { vn[mt] = *(const f32x4_t*)(sb + DN_U + ((w * 4 + mt) * 64 + lane) * 16);
            vn[mt] = __builtin_amdgcn_mfma_f32_16x16x32_bf16(*(const bf16x8_t*)(sb + DN_W + ((mt * 2 + 0) * 64 + lane) * 16), Bs0, vn[mt], 0, 0, 0);
            vn[mt] = __builtin_amdgcn_mfma_f32_16x16x32_bf16(*(const bf16x8_t*)(sb + DN_W + ((mt * 2 + 1) * 64 + lane) * 16), Bs1, vn[mt], 0, 0, 0);
            oo[mt] = (f32x4_t){0.f, 0.f, 0.f, 0.f};
            oo[mt] = __builtin_amdgcn_mfma_f32_16x16x32_bf16(*(const bf16x8_t*)(sb + DN_QD + ((mt * 2 + 0) * 64 + lane) * 16), Bs0, oo[mt], 0, 0, 0);
            oo[mt] = __builtin_amdgcn_mfma_f32_16x16x32_bf16(*(const bf16x8_t*)(sb + DN_QD + ((mt * 2 + 1) * 64 + lane) * 16), Bs1, oo[mt], 0, 0, 0); }
        const bf16x8_t Bv0 = pack8(vn[0], vn[1]), Bv1 = pack8(vn[2], vn[3]);
#pragma unroll
        for (int mt = 0; mt < 4; ++mt) {
            oo[mt] = __builtin_amdgcn_mfma_f32_16x16x32_bf16(*(const bf16x8_t*)(sb + DN_QK + ((mt * 2 + 0) * 64 + lane) * 16), Bv0, oo[mt], 0, 0, 0);
            oo[mt] = __builtin_amdgcn_mfma_f32_16x16x32_bf16(*(const bf16x8_t*)(sb + DN_QK + ((mt * 2 + 1) * 64 + lane) * 16), Bv1, oo[mt], 0, 0, 0); }
#pragma unroll
        for (int dt = 0; dt < 4; ++dt) { S[dt] = S[dt] * eg;
            S[dt] = __builtin_amdgcn_mfma_f32_16x16x32_bf16(*(const bf16x8_t*)(sb + DN_KD + ((dt * 2 + 0) * 64 + lane) * 16), Bv0, S[dt], 0, 0, 0);
            S[dt] = __builtin_amdgcn_mfma_f32_16x16x32_bf16(*(const bf16x8_t*)(sb + DN_KD + ((dt * 2 + 1) * 64 + lane) * 16), Bv1, S[dt], 0, 0, 0); }
#pragma unroll
        for (int mt = 0; mt < 4; ++mt)
#pragma unroll
            for (int r4 = 0; r4 < 4; ++r4) ODN[((size_t)b * T + 64 * n + 16 * mt + 4 * q4 + r4) * 512 + h * 64 + 16 * w + e15] = oo[mt][r4];
    }
}
__device__ __forceinline__ void ph_dn_epi_simple(const Ctx& c, const Params& p) {
    const float* ODN = (const float*)(p.ws + WS_ACT + A_ODN); const bf16* P0 = (const bf16*)(p.ws + WS_ACT + A_P);
    for (int it = c.gw; it < M * 8; it += c.NGW) { const int m = it >> 3, h = it & 7;
        const float o = ODN[(size_t)m * 512 + h * 64 + c.lane];
        const float rs = 1.0f / sqrtf(wave_sum(o * o) * (1.f / 64.f) + 1e-6f);
        const float gt = bf2f(P0[(size_t)m * NAB + C_GATEB + h * 64 + c.lane]);
        ((bf16*)(p.ws + WS_ACT + A_MIXA))[(size_t)m * D + 512 + h * 64 + c.lane] = (bf16)f2bf(o * rs * p.in[I_DNNORM][c.lane] * siluf_(gt)); }
}

__global__ void __launch_bounds__(NTHR, 2) mega(MArgs a) {
    extern __shared__ __attribute__((aligned(16))) unsigned char lds_raw[];
    Ctx c; c.lds = (LAS unsigned char*)lds_raw; c.tid = threadIdx.x; c.lane = c.tid & 63; c.wave = __builtin_amdgcn_readfirstlane(c.tid >> 6);
    c.G = gridDim.x; c.bid = blockIdx.x; c.gw = c.bid * NWAVES + c.wave; c.NGW = c.G * NWAVES;
    const Params& p = a.p;
    volatile LAS unsigned* MISC = (volatile LAS unsigned*)(c.lds + LDS_MISC);
    if (c.tid < 64) MISC[c.tid] = 0u;
    __syncthreads();
    XcdBarrier bar = xcd_barrier_post((unsigned*)(p.ws + WS_CTL) + CW_BAR, MISC);
    const int lo = a.ph_lo, hi = a.ph_hi;
#define IN(k) (lo <= (k) && (k) < hi)
#define SEAM(k) do { if (IN(k) && IN((k) + 1)) xcd_barrier(bar); } while (0)
#ifndef DUP_MASK
#define DUP_MASK 0
#endif
#define DUP(k) ((DUP_MASK >> (k)) & 1)
    if (IN(0)) { ph_convert(c, a.t1); ph_ada(c, p); if (DUP(0)) { xcd_barrier(bar); ph_convert(c, a.t1); ph_ada(c, p); } } SEAM(0);
    if (IN(1)) { ph_norm<0>(c, p); if (DUP(1)) { xcd_barrier(bar); ph_norm<0>(c, p); } } SEAM(1);
    if (IN(2)) { ph_gemm<G_ABIN>(c, p); if (DUP(2)) { xcd_barrier(bar); ph_gemm<G_ABIN>(c, p); } } SEAM(2);
    if (IN(3)) { ph_dn_prep2(c, p, A_DNX + WS_ACT); if (DUP(3)) { xcd_barrier(bar); ph_dn_prep2(c, p, A_DNX + WS_ACT); } } SEAM(3);
    if (IN(4)) { if (c.bid < 32) ph_dn_scan2(c, p); else { for (int u = c.bid - 32; u < 256; u += c.G - 32) attn_unit(c, p, u); } if (DUP(4)) { xcd_barrier(bar); if (c.bid < 32) ph_dn_scan2(c, p); else { for (int u = c.bid - 32; u < 256; u += c.G - 32) attn_unit(c, p, u); } } } SEAM(4);
    if (IN(5)) { ph_gemm<G_ABOUT>(c, p); if (DUP(5)) { xcd_barrier(bar); ph_gemm<G_ABOUT>(c, p); } } SEAM(5);
    if (IN(6)) { ph_norm<1>(c, p); if (DUP(6)) { xcd_barrier(bar); ph_norm<1>(c, p); } } SEAM(6);
    if (IN(7)) { ph_gemm<G_FFNGU>(c, p); if (DUP(7)) { xcd_barrier(bar); ph_gemm<G_FFNGU>(c, p); } } SEAM(7);
    if (IN(8)) { if (DUP(8)) { ph_gemm<G_FFND_PROBE>(c, p); xcd_barrier(bar); } ph_gemm<G_FFND>(c, p); } SEAM(8);
    if (IN(9)) { ph_norm<2>(c, p); if (DUP(9)) { xcd_barrier(bar); ph_norm<2>(c, p); } } SEAM(9);
    if (IN(10)) { ph_gemm<G_CDIN>(c, p); if (DUP(10)) { xcd_barrier(bar); ph_gemm<G_CDIN>(c, p); } } SEAM(10);
    if (IN(11)) { ph_lru<1>(c, p); ph_sconv(c, p); if (DUP(11)) { xcd_barrier(bar); ph_lru<1>(c, p); ph_sconv(c, p); } } SEAM(11);
    if (IN(12)) { ph_lru<2>(c, p); if (DUP(12)) { xcd_barrier(bar); ph_lru<2>(c, p); } } SEAM(12);
    if (IN(13)) { if (DUP(13)) { ph_gemm<G_CDOUT_PROBE>(c, p); xcd_barrier(bar); } ph_gemm<G_CDOUT>(c, p); } SEAM(13);
    if (IN(14)) { ph_norm<3>(c, p); ph_convert(c, a.t2); if (DUP(14)) { xcd_barrier(bar); ph_convert(c, a.t2); } if (DUP(19)) { xcd_barrier(bar); ph_norm<3, false>(c, p); } } SEAM(14);
    if (IN(15)) { ph_route(c, p, 0); if (DUP(15)) { xcd_barrier(bar); ph_route(c, p, 64); } } SEAM(15);
    if (IN(16)) { ph_gemm<G_MOEGU>(c, p); if (DUP(16)) { xcd_barrier(bar); ph_gemm<G_MOEGU>(c, p); } } SEAM(16);
    if (IN(17)) { ph_gemm<G_MOED>(c, p); if (DUP(17)) { xcd_barrier(bar); ph_gemm<G_MOED>(c, p); } } SEAM(17);
    if (IN(18)) { if (DUP(18)) { ph_final<true>(c, p); xcd_barrier(bar); } ph_final<false>(c, p); }
#undef IN
#undef SEAM
}

constexpr int N_PHASES = 19;
static void add_desc(ConvTab& t, const float* src, bf16* dst, int K, int N, int Npad, int mode, int row_off, int nbatch, long long sstride, long long dstride) {
    ConvDesc& d = t.d[t.nd]; d.src = src; d.dst = dst; d.sstride = sstride; d.dstride = dstride; d.K = K; d.N = N; d.Npad = Npad; d.mode = mode; d.row_off = row_off; d.nbatch = nbatch;
    d.items_pb = (K / 64) * (Npad / 32); d.item0 = t.total; t.total += d.items_pb * nbatch; t.nd++;
}
extern "C" void kernel_launch(void* const* d_in, const int* in_sizes, int n_in, void* d_out, int out_size, void* d_ws, size_t ws_size, hipStream_t stream) {
    static int grid = 0;
    if (grid == 0) {
        if (n_in != 33 || out_size != M * D || ws_size < WS_END) { fprintf(stderr, "kernel_launch: unexpected shapes (n_in %d out %d ws %zu)\n", n_in, out_size, ws_size); grid = -1; return; }
        int dev = 0, cus = 0;
        if (hipGetDevice(&dev) != hipSuccess || hipDeviceGetAttribute(&cus, hipDeviceAttributeMultiprocessorCount, dev) != hipSuccess) { grid = -1; return; }
        if (hipFuncSetAttribute((const void*)mega, hipFuncAttributeMaxDynamicSharedMemorySize, LDS_BYTES) != hipSuccess) { fprintf(stderr, "kernel_launch: hipFuncSetAttribute failed\n"); grid = -1; return; }
        int per_cu = 0;
        if (hipOccupancyMaxActiveBlocksPerMultiprocessor(&per_cu, (const void*)mega, NTHR, LDS_BYTES) != hipSuccess || per_cu < 1) { fprintf(stderr, "kernel_launch: occupancy query says %d\n", per_cu); }
        (void)hipGetLastError();
        grid = cus;
    }
    if (grid < 0) return;
    MArgs a{};
    for (int i = 0; i < 33; ++i) a.p.in[i] = (const float*)d_in[i];
    a.p.out = (float*)d_out; a.p.ws = (unsigned char*)d_ws;
    unsigned char* ws = a.p.ws; const Params& p = a.p;
    (void)hipMemsetAsync(ws + WS_CTL, 0, CTL_ZERO_BYTES, stream);
    add_desc(a.t1, p.in[I_ABIN], (bf16*)(ws + WS_WAB_IN), D, 2832, NAB, 0, 0, 1, 0, 0);
    add_desc(a.t1, p.in[I_ABOUT], (bf16*)(ws + WS_WAB_OUT), D, D, D, 0, 0, 1, 0, 0);
    add_desc(a.t1, p.in[I_FG], (bf16*)(ws + WS_WFFN_GU), D, FF, FF, 1, 0, 1, 0, 0);
    add_desc(a.t1, p.in[I_FU], (bf16*)(ws + WS_WFFN_GU), D, FF, FF, 1, 128, 1, 0, 0);
    add_desc(a.t1, p.in[I_FD], (bf16*)(ws + WS_WFFN_D), FF, D, D, 0, 0, 1, 0, 0);
    add_desc(a.t1, p.in[I_CDIN], (bf16*)(ws + WS_WCD_IN), D, NCD, NCD, 0, 0, 1, 0, 0);
    add_desc(a.t1, p.in[I_CDOUT], (bf16*)(ws + WS_WCD_OUT), CDO, D, D, 0, 0, 1, 0, 0);
    add_desc(a.t1, p.in[I_GAW], (bf16*)(ws + WS_WLRU), 128, 128, 128, 0, 0, 8, 128 * 128, 256 * 128);
    add_desc(a.t1, p.in[I_GXW], (bf16*)(ws + WS_WLRU), 128, 128, 128, 0, 128, 8, 128 * 128, 256 * 128);
    add_desc(a.t2, p.in[I_MG], (bf16*)(ws + WS_WMOE_GU), D, FFE, FFE, 1, 0, NE, (long long)D * FFE, (long long)2 * FFE * D);
    add_desc(a.t2, p.in[I_MU], (bf16*)(ws + WS_WMOE_GU), D, FFE, FFE, 1, 128, NE, (long long)D * FFE, (long long)2 * FFE * D);
    add_desc(a.t2, p.in[I_MD], (bf16*)(ws + WS_WMOE_D), FFE, D, D, 0, 0, NE, (long long)FFE * D, (long long)D * FFE);
    a.ph_lo = 0; a.ph_hi = N_PHASES;
    hipLaunchKernelGGL(mega, dim3(grid), dim3(NTHR), LDS_BYTES, stream, a);
}
```

```cpp
#define DUP_MASK 4096
#include <hip/hip_runtime.h>
#include <cstdio>
#include <cstdint>
namespace pg8 {
#define PG8_LAS __attribute__((address_space(3)))
typedef unsigned short bf16_t;
typedef short bf16x8 __attribute__((ext_vector_type(8)));
typedef float f32x4 __attribute__((ext_vector_type(4)));
typedef unsigned u32x4 __attribute__((ext_vector_type(4)));
constexpr int BM = 256, BK = 64, HALF = 128, HTB = HALF * BK * 2  , STAGE_BYTES = 8 * HTB, NXCD = 8, WGM = 8;

__host__ __device__ __forceinline__ int lds_byte(int r, int c) { const int st = (r >> 4) * 2 + (c >> 5), rr = r & 15, cc = c & 31, ob = rr * 64 + cc * 2; return st * 1024 + (ob ^ (((ob >> 9) & 1) << 5)); }
__host__ __device__ __forceinline__ void stage_rc(int b, int& R, int& C) { const int st = b / 1024, sb = b % 1024, swz = sb ^ (((sb >> 9) & 1) << 5); R = (st >> 1) * 16 + swz / 64; C = (st & 1) * 32 + (swz % 64) / 2; }
__host__ __device__ __forceinline__ int perm32(int rho) { const int n = rho >> 4, i = rho & 15; return 8 * (i >> 2) + 4 * n + (i & 3); }

struct Unit { int pm, pn, e; };
struct Gemm { const bf16_t* A; const bf16_t* Bt; int M, N, K; size_t eb; };

struct StaticOrder {
    int nM, nN, nwg, G, c;
    __host__ __device__ void init(int M, int N, int G_, int c_) { nM = M / BM; nN = N / BM; nwg = nM * nN; G = G_; c = c_; }
    __host__ __device__ bool next(int i, Unit& u) const {
        const long L = (long)i * G + c; if (L >= nwg) return false;
        int wgid = (int)L; { const int q = nwg / NXCD, r = nwg % NXCD, xcd = wgid % NXCD, off = wgid / NXCD; wgid = (xcd < r ? xcd * (q + 1) : r * (q + 1) + (xcd - r) * q) + off; }
        const int nig = WGM * nN, gid = wgid / nig, fm = gid * WGM, gsz = (nM - fm) < WGM ? (nM - fm) : WGM;
        u.pm = fm + ((wgid % nig) % gsz); u.pn = (wgid % nig) / gsz; u.e = 0; return true;
    }
    __device__ __forceinline__ void a_ready(const Unit&) const {}
    __device__ __forceinline__ void done(const Unit&) const {}
};

__device__ __forceinline__ unsigned cvt_pk_bf16(float lo, float hi) { unsigned r; asm volatile("v_cvt_pk_bf16_f32 %0, %1, %2" : "=v"(r) : "v"(lo), "v"(hi)); return r; }

__device__ __forceinline__ float fast_silu(float g) { return g * __builtin_amdgcn_rcpf(1.0f + __expf(-g)); }
struct EpiStoreBf16 {
    static constexpr bool PERM = true, AFTER_DRAIN = false;
    bf16_t* O; int ldc; const float* rowscale;
    __device__ __forceinline__ void operator()(const f32x4 (&acc)[2][2][4][2], const Unit& u, int wr, int wc, int fr, int fq) const {
        const int row0 = u.pm * BM + wr * 64 + fr, col0 = u.pn * BM + wc * 32 + 8 * fq;
#pragma unroll
        for (int ai = 0; ai < 2; ++ai)
#pragma unroll
            for (int m = 0; m < 4; ++m) { const int row = row0 + ai * HALF + m * 16; bf16_t* rowp = O + (size_t)row * ldc + col0;
                const float s = rowscale ? rowscale[row] : 1.f;
#pragma unroll
                for (int bj = 0; bj < 2; ++bj) { const f32x4 v0 = acc[ai][bj][m][0] * s, v1 = acc[ai][bj][m][1] * s;
                    u32x4 w; w.x = cvt_pk_bf16(v0[0], v0[1]); w.y = cvt_pk_bf16(v0[2], v0[3]); w.z = cvt_pk_bf16(v1[0], v1[1]); w.w = cvt_pk_bf16(v1[2], v1[3]);
                    *(u32x4*)(rowp + bj * HALF) = w; } }
    }
};
struct EpiSwiglu {
    static constexpr bool PERM = true, AFTER_DRAIN = false;
    bf16_t* O; int ldc;
    __device__ __forceinline__ void operator()(const f32x4 (&acc)[2][2][4][2], const Unit& u, int wr, int wc, int fr, int fq) const {
        const int row0 = u.pm * BM + wr * 64 + fr, col0 = u.pn * HALF + wc * 32 + 8 * fq;
#pragma unroll
        for (int ai = 0; ai < 2; ++ai)
#pragma unroll
            for (int m = 0; m < 4; ++m) { const int row = row0 + ai * HALF + m * 16; bf16_t* rowp = O + (size_t)row * ldc + col0;
                const f32x4 g0 = acc[ai][0][m][0], g1 = acc[ai][0][m][1], u0 = acc[ai][1][m][0], u1 = acc[ai][1][m][1];
                float h[8];
#pragma unroll
                for (int i = 0; i < 4; ++i) { h[i] = fast_silu(g0[i]) * u0[i]; h[4 + i] = fast_silu(g1[i]) * u1[i]; }
                u32x4 w; w.x = cvt_pk_bf16(h[0], h[1]); w.y = cvt_pk_bf16(h[2], h[3]); w.z = cvt_pk_bf16(h[4], h[5]); w.w = cvt_pk_bf16(h[6], h[7]);
                *(u32x4*)rowp = w; }
    }
};
struct EpiRes {
    static constexpr bool PERM = false, AFTER_DRAIN = false;
    const float* base; float* out; int ldc; const float* gate;
    __device__ __forceinline__ void operator()(const f32x4 (&acc)[2][2][4][2], const Unit& u, int wr, int wc, int fr, int fq) const {
        const int row0 = u.pm * BM + wr * 64 + fr, col0 = u.pn * BM + wc * 32 + 4 * fq;
        const float* gp = gate + (size_t)(u.pm >> 4) * 6144 + col0;
        f32x4 gv[2][2];
#pragma unroll
        for (int bj = 0; bj < 2; ++bj)
#pragma unroll
            for (int n = 0; n < 2; ++n) gv[bj][n] = *(const f32x4*)(gp + bj * HALF + n * 16);
#pragma unroll
        for (int ai = 0; ai < 2; ++ai)
#pragma unroll
            for (int m = 0; m < 4; ++m) { const size_t off = (size_t)(row0 + ai * HALF + m * 16) * ldc + col0;
#pragma unroll
                for (int bj = 0; bj < 2; ++bj)
#pragma unroll
                    for (int n = 0; n < 2; ++n) { const f32x4 bs = *(const f32x4*)(base + off + bj * HALF + n * 16);
                        *(f32x4*)(out + off + bj * HALF + n * 16) = bs + gv[bj][n] * acc[ai][bj][m][n]; } }
    }
};
struct GroupedOrder {
    int nM, nN, nwg, G, c; const int* tile_e;
    __device__ void init(int nMt, int N, int G_, int c_, const int* te) { nM = nMt; nN = N / BM; nwg = nM * nN; G = G_; c = c_; tile_e = te; }
    __device__ bool next(int i, Unit& u) const {
        const long L = (long)i * G + c; if (L >= nwg) return false;
        int wgid = (int)L; { const int q = nwg / NXCD, r = nwg % NXCD, xcd = wgid % NXCD, off = wgid / NXCD; wgid = (xcd < r ? xcd * (q + 1) : r * (q + 1) + (xcd - r) * q) + off; }
        const int nig = WGM * nN, gid = wgid / nig, fm = gid * WGM, gsz = (nM - fm) < WGM ? (nM - fm) : WGM;
        u.pm = fm + ((wgid % nig) % gsz); u.pn = (wgid % nig) / gsz; u.e = __builtin_amdgcn_readfirstlane(tile_e[u.pm]); return true;
    }
    __device__ __forceinline__ void a_ready(const Unit&) const {}
    __device__ __forceinline__ void done(const Unit&) const {}
};

template <class Epi, class Sched, bool ALIGN_EPI = false, bool SP2 = false>
__device__ __forceinline__ void gemm_phase(PG8_LAS unsigned char* lds, const Gemm g, const Sched& S, const Epi& E) {
    const int tid = threadIdx.x, wid = __builtin_amdgcn_readfirstlane(tid >> 6), lane = tid & 63, wr = wid >> 2, wc = wid & 3, fr = lane & 15, fq = lane >> 4;
    const int K = g.K, nt = K / BK;
    unsigned voffA[2], voffB[2];
#pragma unroll
    for (int i = 0; i < 2; ++i) { int R, C; stage_rc(tid * 16 + i * 8192, R, C); const int Rb = Epi::PERM ? ((R & ~31) + perm32(R & 31)) : R;
        voffA[i] = (unsigned)(R * K + C) * 2u; voffB[i] = (unsigned)(Rb * K + C) * 2u; }
    const size_t kstep = (size_t)(BK * 2);
    const size_t hstep = (size_t)HALF * K * 2;
    const size_t tstep = 2 * hstep;
    const unsigned ldsw = (unsigned)wid * 1024u;
    const int aoff = lds_byte(wr * 64 + fr, fq * 8), boff = lds_byte(wc * 32 + fr, fq * 8);
#define PG8_SA(b, h) (((b) * 2 + (h)) * HTB)
#define PG8_SB(b, h) ((4 + (b) * 2 + (h)) * HTB)
#define PG8_STAGE(bufoff, gbase, voff) do { _Pragma("unroll") for (int _i = 0; _i < 2; ++_i) \
        __builtin_amdgcn_global_load_lds((const unsigned*)((const char*)(gbase) + (voff)[_i]), (PG8_LAS unsigned*)(lds + (bufoff) + ldsw + _i * 8192), 16, 0, 0); } while (0)
#define PG8_LDA(dst, b, h) do { _Pragma("unroll") for (int m = 0; m < 4; ++m) _Pragma("unroll") for (int k = 0; k < 2; ++k) dst[m][k] = *(const PG8_LAS bf16x8*)(lds + PG8_SA(b, h) + aoff + m * 2048 + k * 1024); } while (0)
#define PG8_LDB(dst, b, h) do { _Pragma("unroll") for (int n = 0; n < 2; ++n) _Pragma("unroll") for (int k = 0; k < 2; ++k) dst[n][k] = *(const PG8_LAS bf16x8*)(lds + PG8_SB(b, h) + boff + n * 2048 + k * 1024); } while (0)
#define PG8_MMA(ai, bj, At, Bt) do { __builtin_amdgcn_s_setprio(1); _Pragma("unroll") for (int m = 0; m < 4; ++m) _Pragma("unroll") for (int n = 0; n < 2; ++n) _Pragma("unroll") for (int k = 0; k < 2; ++k) \
        acc[ai][bj][m][n] = __builtin_amdgcn_mfma_f32_16x16x32_bf16(Bt[n][k], At[m][k], acc[ai][bj][m][n], 0, 0, 0); __builtin_amdgcn_s_setprio(0); } while (0)
#define PG8_WAIT_V(n) asm volatile("s_waitcnt vmcnt(" #n ")" ::: "memory")
#define PG8_WAIT_L(n) asm volatile("s_waitcnt lgkmcnt(" #n ")" ::: "memory")
#define PG8_BAR __builtin_amdgcn_s_barrier()
#define PG8_SCHED __builtin_amdgcn_sched_barrier(0)
    Unit cur, nxt; int ui = 0;
    if (!S.next(0, cur)) return;
    f32x4 acc[2][2][4][2];
#pragma unroll
    for (int a = 0; a < 2; ++a)
#pragma unroll
        for (int b = 0; b < 2; ++b)
#pragma unroll
            for (int m = 0; m < 4; ++m)
#pragma unroll
                for (int n = 0; n < 2; ++n) acc[a][b][m][n] = (f32x4){0.f, 0.f, 0.f, 0.f};
    bf16x8 At[4][2], B0[2][2], B1[2][2];
    const char* cA = (const char*)g.A + (size_t)cur.pm * tstep; const char* cB = (const char*)g.Bt + (size_t)cur.e * g.eb + (size_t)cur.pn * tstep;
    S.a_ready(cur);
    if constexpr (SP2) {
        PG8_STAGE(PG8_SB(0, 0), cB, voffB); PG8_STAGE(PG8_SB(0, 1), cB + hstep, voffB); PG8_STAGE(PG8_SA(0, 0), cA, voffA); PG8_STAGE(PG8_SA(0, 1), cA + hstep, voffA);
        if (wr == 1) PG8_BAR;
        PG8_WAIT_V(2); PG8_BAR;
        PG8_STAGE(PG8_SB(1, 0), cB + kstep, voffB); PG8_STAGE(PG8_SA(1, 0), cA + kstep, voffA); PG8_STAGE(PG8_SB(1, 1), cB + hstep + kstep, voffB);
        PG8_WAIT_V(6); PG8_BAR;
    } else {
        PG8_STAGE(PG8_SB(0, 0), cB, voffB); PG8_STAGE(PG8_SA(0, 0), cA, voffA); PG8_STAGE(PG8_SB(0, 1), cB + hstep, voffB); PG8_STAGE(PG8_SA(0, 1), cA + hstep, voffA);
        if (wr == 1) PG8_BAR;
        PG8_WAIT_V(4); PG8_BAR;
        PG8_STAGE(PG8_SB(1, 0), cB + kstep, voffB); PG8_STAGE(PG8_SA(1, 0), cA + kstep, voffA); PG8_STAGE(PG8_SB(1, 1), cB + hstep + kstep, voffB);
        PG8_WAIT_V(6); PG8_BAR;
    }
    for (;;) {
        const bool has_next = S.next(ui + 1, nxt);
        const char* nA = has_next ? (const char*)g.A + (size_t)nxt.pm * tstep : cA; const char* nB = has_next ? (const char*)g.Bt + (size_t)nxt.e * g.eb + (size_t)nxt.pn * tstep : cB;
        for (int t = 0; t < nt; t += 2) {
            const bool last = (t == nt - 2);
            const char* a1 = cA + (size_t)(t + 1) * kstep;
            const char* a2 = last ? nA : cA + (size_t)(t + 2) * kstep; const char* b2 = last ? nB : cB + (size_t)(t + 2) * kstep;
            const char* a3 = a2 + kstep; const char* b3 = b2 + kstep;
            if (last && has_next) S.a_ready(nxt);
            if constexpr (SP2) {
            PG8_LDB(B0, 0, 0); PG8_LDB(B1, 0, 1); PG8_SCHED; PG8_LDA(At, 0, 0); PG8_STAGE(PG8_SA(1, 1), a1 + hstep, voffA);
            PG8_WAIT_V(8); PG8_WAIT_L(0); PG8_BAR; PG8_MMA(0, 0, At, B0); PG8_MMA(0, 1, At, B1); PG8_BAR; PG8_SCHED;
            PG8_LDA(At, 0, 1); PG8_STAGE(PG8_SB(0, 0), b2, voffB); PG8_STAGE(PG8_SB(0, 1), b2 + hstep, voffB); PG8_STAGE(PG8_SA(0, 0), a2, voffA);
            PG8_WAIT_V(8); PG8_WAIT_L(0); PG8_BAR; PG8_MMA(1, 0, At, B0); PG8_MMA(1, 1, At, B1); PG8_BAR; PG8_SCHED;
            PG8_LDB(B0, 1, 0); PG8_LDB(B1, 1, 1); PG8_SCHED; PG8_LDA(At, 1, 0); PG8_STAGE(PG8_SA(0, 1), a2 + hstep, voffA);
            PG8_WAIT_V(8); PG8_WAIT_L(0); PG8_BAR; PG8_MMA(0, 0, At, B0); PG8_MMA(0, 1, At, B1); PG8_BAR; PG8_SCHED;
            PG8_LDA(At, 1, 1); PG8_STAGE(PG8_SB(1, 0), b3, voffB); PG8_STAGE(PG8_SB(1, 1), b3 + hstep, voffB); PG8_STAGE(PG8_SA(1, 0), a3, voffA);
            PG8_WAIT_V(8); PG8_WAIT_L(0); PG8_BAR; PG8_MMA(1, 0, At, B0); PG8_MMA(1, 1, At, B1); PG8_BAR; PG8_SCHED;
            } else {
            PG8_LDB(B0, 0, 0); PG8_SCHED; PG8_LDA(At, 0, 0); PG8_STAGE(PG8_SA(1, 1), a1 + hstep, voffA);
            PG8_WAIT_L(8); PG8_BAR; PG8_WAIT_L(0); PG8_MMA(0, 0, At, B0); PG8_BAR; PG8_SCHED;
            PG8_LDB(B1, 0, 1); PG8_STAGE(PG8_SB(0, 0), b2, voffB);
            PG8_BAR; PG8_WAIT_L(0); PG8_MMA(0, 1, At, B1); PG8_BAR;
            PG8_LDA(At, 0, 1); PG8_STAGE(PG8_SA(0, 0), a2, voffA);
            PG8_BAR; PG8_WAIT_L(0); PG8_MMA(1, 0, At, B0); PG8_BAR; PG8_SCHED;
            PG8_STAGE(PG8_SB(0, 1), b2 + hstep, voffB);
            PG8_WAIT_V(6); PG8_BAR; PG8_MMA(1, 1, At, B1); PG8_BAR;
            PG8_LDB(B0, 1, 0); PG8_SCHED; PG8_LDA(At, 1, 0); PG8_STAGE(PG8_SA(0, 1), a2 + hstep, voffA);
            PG8_WAIT_L(8); PG8_BAR; PG8_WAIT_L(0); PG8_MMA(0, 0, At, B0); PG8_BAR; PG8_SCHED;
            PG8_LDB(B1, 1, 1); PG8_STAGE(PG8_SB(1, 0), b3, voffB);
            PG8_BAR; PG8_WAIT_L(0); PG8_MMA(0, 1, At, B1); PG8_BAR;
            PG8_LDA(At, 1, 1); PG8_STAGE(PG8_SA(1, 0), a3, voffA);
            PG8_BAR; PG8_WAIT_L(0); PG8_MMA(1, 0, At, B0); PG8_BAR; PG8_SCHED;
            PG8_STAGE(PG8_SB(1, 1), b3 + hstep, voffB);
            PG8_WAIT_V(6); PG8_BAR; PG8_MMA(1, 1, At, B1); PG8_BAR;
            }
        }
        if constexpr (ALIGN_EPI) { if (wr == 0) PG8_BAR; }
        if constexpr (!Epi::AFTER_DRAIN) { E(acc, cur, wr, wc, fr, fq); S.done(cur); }
        if (!has_next) break;
#pragma unroll
        for (int a = 0; a < 2; ++a)
#pragma unroll
            for (int b = 0; b < 2; ++b)
#pragma unroll
                for (int m = 0; m < 4; ++m)
#pragma unroll
                    for (int n = 0; n < 2; ++n) acc[a][b][m][n] = (f32x4){0.f, 0.f, 0.f, 0.f};
        cur = nxt; cA = nA; cB = nB; ++ui;
        if constexpr (ALIGN_EPI) { if (wr == 1) PG8_BAR; }
    }
    PG8_WAIT_V(0);
    if constexpr (!ALIGN_EPI) { if (wr == 0) PG8_BAR; }
    PG8_BAR;
    if constexpr (Epi::AFTER_DRAIN) { E.fused(acc, cur, wr, wc, fr, fq, lds, wid, lane); S.done(cur); }
#undef PG8_SA
#undef PG8_SB
#undef PG8_STAGE
#undef PG8_LDA
#undef PG8_LDB
#undef PG8_MMA
#undef PG8_WAIT_V
#undef PG8_WAIT_L
#undef PG8_BAR
#undef PG8_SCHED
}
}

constexpr int BATCH = 4, T = 4096, D = 1024, M = BATCH * T;
constexpr int NAB = 3072;
constexpr int FF = 2816, NCD = 3584, CDO = 1536, FFE = 3584, NE = 8;
constexpr int MPAD = 2 * M + NE * 256;
constexpr int MAXT = MPAD / 256;
constexpr int C_QA = 0, C_KA = 512, C_VA = 640, C_QKVB = 768, C_GATEB = 2304, C_BETA = 2816, C_AB = 2824;
constexpr int C_XC = 0, C_YC = 1024, C_BD = 2048, C_CD = 2560, C_HD = 3072;
constexpr size_t MiB = 1u << 20;
constexpr size_t WS_CTL = 0, CTL_ZERO_BYTES = 1 * MiB;
constexpr size_t WS_MOD = 1 * MiB;
constexpr size_t WS_ROUTE = 1 * MiB + 256 * 1024;
constexpr size_t WS_WAB_IN = 2 * MiB, WS_WAB_OUT = 8 * MiB, WS_WFFN_GU = 10 * MiB, WS_WFFN_D = 21 * MiB, WS_WCD_IN = 27 * MiB, WS_WCD_OUT = 34 * MiB, WS_WLRU = 37 * MiB;
constexpr size_t WS_WMOE_GU = 38 * MiB, WS_WMOE_D = 150 * MiB;
constexpr size_t WS_ACT = 206 * MiB;
constexpr size_t WS_END = 512 * MiB;
constexpr size_t A_A = 0, A_P = 32 * MiB, A_MIXA = 128 * MiB, A_DNQ = 160 * MiB, A_DNK = 192 * MiB, A_DNV = 224 * MiB, A_DNB = 256 * MiB, A_DNG = 257 * MiB;
constexpr size_t A_H = 160 * MiB;
constexpr size_t A_MIXB = 144 * MiB, A_XC = 192 * MiB;
constexpr size_t A_A3P = 0, A_HM = 68 * MiB, A_Y = 0;
constexpr size_t WS_A3 = 2 * MiB;
constexpr size_t WS_LA = 38 * MiB, WS_LB = 102 * MiB;
constexpr size_t R_IDX = 0, R_W = 128 * 1024, R_SLOT = 256 * 1024, R_GATEW = 384 * 1024, R_TILEE = 528 * 1024, R_OFF = 532 * 1024, R_HIST = 536 * 1024;
constexpr int CW_CNT = 1024, CW_CUR = 1024 + 64;

typedef unsigned short bf16;
typedef float f32x4 __attribute__((ext_vector_type(4)));
typedef unsigned v4u __attribute__((ext_vector_type(4)));
typedef unsigned v2u __attribute__((ext_vector_type(2)));
__device__ __forceinline__ unsigned f2bf(float f) { unsigned u = __builtin_bit_cast(unsigned, f); return (u + 0x7fffu + ((u >> 16) & 1u)) >> 16; }
__device__ __forceinline__ unsigned pk2(float lo, float hi) { return f2bf(lo) | (f2bf(hi) << 16); }
__device__ __forceinline__ float bf2f(unsigned short b) { return __builtin_bit_cast(float, (unsigned)b << 16); }
__device__ __forceinline__ float bflo(unsigned w) { return __builtin_bit_cast(float, w << 16); }
__device__ __forceinline__ float bfhi(unsigned w) { return __builtin_bit_cast(float, w & 0xffff0000u); }
__device__ __forceinline__ float wave_sum(float v) {
#pragma unroll
    for (int o = 1; o < 64; o <<= 1) v += __shfl_xor(v, o);
    return v;
}
__device__ __forceinline__ float sigmoidf_(float x) { return __builtin_amdgcn_rcpf(1.0f + __expf(-x)); }
__device__ __forceinline__ float siluf_(float x) { return x * __builtin_amdgcn_rcpf(1.0f + __expf(-x)); }
__device__ __forceinline__ float softplusf_(float x) { return fmaxf(x, 0.f) + log1pf(__expf(-fabsf(x))); }
__device__ __forceinline__ float gelu_tanhf_(float x) { const float u = 0.7978845608028654f * (x + 0.044715f * x * x * x); return 0.5f * x * (1.0f + tanhf(u)); }

__device__ const unsigned char T5_BUCKET[128] = {0, 1, 2, 3, 4, 5, 6, 7, 8, 9, 10, 11, 12, 13, 14, 15, 16, 16, 16, 17, 17, 18, 18, 18, 19, 19, 19, 20, 20, 20, 20, 21, 21, 21, 21, 22, 22, 22, 22, 22, 23, 23, 23, 23, 23, 23, 24, 24, 24, 24, 24, 24, 25, 25, 25, 25, 25, 25, 25, 26, 26, 26, 26, 26, 26, 26, 26, 27, 27, 27, 27, 27, 27, 27, 27, 27, 27, 28, 28, 28, 28, 28, 28, 28, 28, 28, 28, 29, 29, 29, 29, 29, 29, 29, 29, 29, 29, 29, 29, 30, 30, 30, 30, 30, 30, 30, 30, 30, 30, 30, 30, 30, 30, 31, 31, 31, 31, 31, 31, 31, 31, 31, 31, 31, 31, 31, 31, 31};

struct Params { const float* in[33]; float* out; unsigned char* ws; };
enum { I_X = 0, I_C, I_RELB, I_ADAW, I_ADAB, I_NMIX, I_NFFN, I_NFIN, I_ABIN, I_SINK, I_DNCONV, I_ALOG, I_DTB, I_DNNORM, I_ABOUT, I_FG, I_FU, I_FD, I_CDIN, I_LCW, I_LCB, I_GAW, I_GAB, I_GXW, I_GXB, I_LAM, I_SCW, I_CDOUT, I_RW, I_RB, I_MG, I_MU, I_MD };


#define LAS __attribute__((address_space(3)))
#define XB_TMO      128
#define XB_XCNT(j)  (256  + 64 * (j))
#define XB_XSUB(j)  (1280 + 64 * (j))
#define XB_XGEN(j)  (2304 + 64 * (j))
#define XB_TOP      3328
#define XB_TOPGEN   3392
#define XCD_BAR_WORDS 3456
#define XB_SPIN_CAP (1u << 18)

__device__ __forceinline__ unsigned xb_ld(unsigned* p)              { return __hip_atomic_load(p, __ATOMIC_RELAXED, __HIP_MEMORY_SCOPE_AGENT); }
__device__ __forceinline__ unsigned xb_add(unsigned* p, unsigned v) { return __hip_atomic_fetch_add(p, v, __ATOMIC_RELAXED, __HIP_MEMORY_SCOPE_AGENT); }
__device__ __forceinline__ unsigned xb_xcc_id() { return (unsigned)__builtin_amdgcn_s_getreg((3 << 11) | 20) & 0xFu; }
#define XB_SPIN(cond, bar) do { unsigned _sp = 0; while (cond) { __builtin_amdgcn_s_sleep(1); \
    if ((++_sp & 255u) == 0u) { if (xb_ld(&(bar)[XB_TMO])) break; if (_sp > XB_SPIN_CAP) { atomicAdd(&(bar)[XB_TMO], 1u); break; } } } } while (0)

struct XcdBarrier {
    unsigned* bar; unsigned x;
    volatile LAS unsigned* st;
};
__device__ __forceinline__ XcdBarrier xcd_barrier_post(unsigned* bar, volatile LAS unsigned* st) {
    XcdBarrier b; b.bar = bar; b.x = xb_xcc_id(); b.st = st;
    if (threadIdx.x == 0) (void)xb_add(&bar[XB_XCNT(b.x)], 1u);
    return b;
}
__device__ __forceinline__ void xcd_barrier_complete(unsigned* bar, unsigned x, unsigned& nloc, unsigned& nx) {
    const unsigned G = gridDim.x * gridDim.y * gridDim.z;
    unsigned sum, cnt, mine, sp = 0u;
    for (;;) {
        sum = 0u; cnt = 0u; mine = 0u;
#pragma unroll
        for (unsigned j = 0; j < 16; ++j) { const unsigned c = xb_ld(&bar[XB_XCNT(j)]); sum += c; cnt += (c > 0u) ? 1u : 0u; mine = (j == x) ? c : mine; }
        if (sum == G) break;
        __builtin_amdgcn_s_sleep(1);
        if ((++sp & 255u) == 0u) { if (xb_ld(&bar[XB_TMO])) break; if (sp > XB_SPIN_CAP) { atomicAdd(&bar[XB_TMO], 1u); break; } }
    }
    nloc = mine > 0u ? mine : 1u; nx = cnt > 0u ? cnt : 1u;
}
__device__ __forceinline__ void xcd_barrier(const XcdBarrier& b) {
    asm volatile("s_waitcnt vmcnt(0)" ::: "memory");
    __syncthreads();
    if (threadIdx.x == 0) {
        unsigned* bar = b.bar;
        __builtin_amdgcn_s_waitcnt(0);
        unsigned nloc = b.st[0], nx = b.st[1];
        if (nloc == 0u) { xcd_barrier_complete(bar, b.x, nloc, nx); b.st[0] = nloc; b.st[1] = nx; }
        const unsigned old = xb_add(&bar[XB_XSUB(b.x)], 1u);
        const unsigned gen = old / nloc;
        if (old + 1u == (gen + 1u) * nloc) {
            __builtin_amdgcn_fence(__ATOMIC_RELEASE, "agent");
            asm volatile("s_waitcnt vmcnt(0)" ::: "memory");
            const unsigned og = xb_add(&bar[XB_TOP], 1u);
            const unsigned tg = og / nx;
            if (og + 1u == (tg + 1u) * nx) xb_add(&bar[XB_TOPGEN], 1u);
            else XB_SPIN(xb_ld(&bar[XB_TOPGEN]) == tg, bar);
            __builtin_amdgcn_fence(__ATOMIC_ACQUIRE, "agent");
            xb_add(&bar[XB_XGEN(b.x)], 1u);
            asm volatile("s_waitcnt vmcnt(0)" ::: "memory");
        } else {
            XB_SPIN(xb_ld(&bar[XB_XGEN(b.x)]) == gen, bar);
            __builtin_amdgcn_fence(__ATOMIC_ACQUIRE, "agent");
            asm volatile("s_waitcnt vmcnt(0)" ::: "memory");
        }
    }
    __syncthreads();
}

constexpr int NWAVES = 8, NTHR = 512;
constexpr int LDS_MISC = 150528, LDS_BYTES = 150528 + 1024;
constexpr int CW_BAR = 4096;
struct ConvDesc { const float* src; bf16* dst; long long sstride, dstride; int K, N, Npad, mode, row_off, nbatch, items_pb, item0; };
struct ConvTab { ConvDesc d[12]; int nd, total, pad0, pad1; };
struct MArgs { Params p; ConvTab t1, t2; int ph_lo, ph_hi, pad0, pad1; };
struct Ctx { LAS unsigned char* lds; int tid, lane, wave, G, bid, gw, NGW; };

constexpr int CV_S = 65, CV_WAVE = 64 * CV_S * 4;
__device__ __forceinline__ void transpose_item(const float* W, int K, int N, bf16* WT, int mode, int row_off, LAS float* scr, int kb, int nb, int lane) {
    const int k0 = 64 * kb, n0 = 64 * nb, kr = lane >> 4, nq = lane & 15; const int nn = n0 + 4 * nq;
    f32x4 v[16];
#pragma unroll
    for (int i = 0; i < 16; ++i) v[i] = nn < N ? *(const f32x4*)(W + (size_t)(k0 + 4 * i + kr) * N + nn) : (f32x4){0.f, 0.f, 0.f, 0.f};
#pragma unroll
    for (int i = 0; i < 16; ++i) { LAS float* d = scr + (4 * i + kr) * CV_S + 4 * nq; d[0] = v[i].x; d[1] = v[i].y; d[2] = v[i].z; d[3] = v[i].w; }
    asm volatile("s_waitcnt lgkmcnt(0)" ::: "memory");
    const int c = lane & 7;
#pragma unroll
    for (int j = 0; j < 8; ++j) { const int n = (lane >> 3) + 8 * j; const LAS float* s = scr + (8 * c) * CV_S + n;
        v4u o; o.x = pk2(s[0 * CV_S], s[1 * CV_S]); o.y = pk2(s[2 * CV_S], s[3 * CV_S]); o.z = pk2(s[4 * CV_S], s[5 * CV_S]); o.w = pk2(s[6 * CV_S], s[7 * CV_S]);
        const int ng = n0 + n; const int drow = (mode == 1 ? ((ng >> 7) << 8) + (ng & 127) : ng) + row_off;
        *(v4u*)(WT + (size_t)drow * K + k0 + 8 * c) = o; }
    asm volatile("s_waitcnt lgkmcnt(0)" ::: "memory");
}
__device__ __forceinline__ void ph_convert(const Ctx& c, const ConvTab& tab, int wk, int nworkers) {
    LAS float* scr = (LAS float*)(c.lds + c.wave * CV_WAVE);
    for (int it = wk; it < tab.total; it += nworkers) {
        int j = 0;
        for (int q = 1; q < tab.nd; ++q) if (it >= tab.d[q].item0) j = q;
        const ConvDesc& d = tab.d[j]; const int r = it - d.item0; const int batch = r / d.items_pb, item = r % d.items_pb; const int nblk = d.Npad / 64;
        transpose_item(d.src + (size_t)batch * d.sstride, d.K, d.N, d.dst + (size_t)batch * d.dstride, d.mode, d.row_off, scr, item / nblk, item % nblk, c.lane);
    }
}
__device__ __forceinline__ void ph_ada(const Ctx& c, const Params& p) {
    LAS float* part = (LAS float*)(c.lds + 8 * CV_WAVE);
    for (int it = c.bid; it < 192; it += c.G) {
        const int l = it / 96, j = (it % 96) * 64 + c.lane; const float* w = p.in[I_ADAW] + (size_t)l * 1024 * 6144 + j; const float* cc = p.in[I_C];
        float a0 = 0.f, a1 = 0.f, a2 = 0.f, a3 = 0.f;
        for (int k = c.wave * 128; k < c.wave * 128 + 128; ++k) { const float wv = w[(size_t)k * 6144];
            a0 += siluf_(cc[k]) * wv; a1 += siluf_(cc[1024 + k]) * wv; a2 += siluf_(cc[2048 + k]) * wv; a3 += siluf_(cc[3072 + k]) * wv; }
        part[(c.wave * 4 + 0) * 64 + c.lane] = a0; part[(c.wave * 4 + 1) * 64 + c.lane] = a1; part[(c.wave * 4 + 2) * 64 + c.lane] = a2; part[(c.wave * 4 + 3) * 64 + c.lane] = a3;
        __syncthreads();
        if (c.wave < 4) { float s = 0.f;
#pragma unroll
            for (int w8 = 0; w8 < 8; ++w8) s += part[(w8 * 4 + c.wave) * 64 + c.lane];
            ((float*)(p.ws + WS_MOD))[(size_t)l * 4 * 6144 + (size_t)c.wave * 6144 + j] = s + p.in[I_ADAB][l * 6144 + j]; }
        __syncthreads();
    }
}
template <bool ROUTER, bool COUNT = true>
__device__ __forceinline__ void norm_row(const float* xrow, bf16* orow, const float* w, const float* sc, const float* sh, int lane, const float* rw, const float* rb, int m, unsigned char* ws, LAS unsigned* hist) {
    const f32x4* xr = (const f32x4*)xrow + lane; f32x4 v[4]; float s = 0.f;
#pragma unroll
    for (int j = 0; j < 4; ++j) { v[j] = xr[64 * j]; s += (v[j].x * v[j].x + v[j].y * v[j].y) + (v[j].z * v[j].z + v[j].w * v[j].w); }
    const float rstd = 1.0f / sqrtf(wave_sum(s) * (1.f / D) + 1e-6f);
    float lg[8];
    if (ROUTER) {
#pragma unroll
        for (int e = 0; e < 8; ++e) lg[e] = 0.f;
    }
    unsigned long long* o8 = (unsigned long long*)orow + lane;
#pragma unroll
    for (int j = 0; j < 4; ++j) { const int c = 4 * lane + 256 * j; const f32x4 wv = *(const f32x4*)(w + c), scv = *(const f32x4*)(sc + c), shv = *(const f32x4*)(sh + c);
        f32x4 y = v[j] * rstd * wv * (scv + 1.0f) + shv;
        if (ROUTER) {
#pragma unroll
            for (int i = 0; i < 4; ++i) { const f32x4 r0 = *(const f32x4*)(rw + (size_t)(c + i) * 8), r1 = *(const f32x4*)(rw + (size_t)(c + i) * 8 + 4);
                lg[0] += y[i] * r0.x; lg[1] += y[i] * r0.y; lg[2] += y[i] * r0.z; lg[3] += y[i] * r0.w; lg[4] += y[i] * r1.x; lg[5] += y[i] * r1.y; lg[6] += y[i] * r1.z; lg[7] += y[i] * r1.w; }
        }
        o8[64 * j] = (unsigned long long)pk2(y.x, y.y) | ((unsigned long long)pk2(y.z, y.w) << 32); }
    if (ROUTER) {
#pragma unroll
        for (int e = 0; e < 8; ++e) lg[e] = wave_sum(lg[e]) + rb[e];
        int b0 = 0; float v0 = lg[0];
#pragma unroll
        for (int e = 1; e < 8; ++e) if (lg[e] > v0) { v0 = lg[e]; b0 = e; }
        int b1 = -1; float v1 = -3.0e38f;
#pragma unroll
        for (int e = 0; e < 8; ++e) if (e != b0 && lg[e] > v1) { v1 = lg[e]; b1 = e; }
        const float e1 = __expf(v1 - v0), w0 = 1.0f / (1.0f + e1), w1 = e1 / (1.0f + e1);
        if (lane == 0) { int* idx = (int*)(ws + WS_ROUTE + R_IDX); float* tw = (float*)(ws + WS_ROUTE + R_W); idx[2 * m] = b0; idx[2 * m + 1] = b1; tw[2 * m] = w0; tw[2 * m + 1] = w1;
            if (COUNT) { __hip_atomic_fetch_add(hist + b0, 1u, __ATOMIC_RELAXED, __HIP_MEMORY_SCOPE_WORKGROUP); __hip_atomic_fetch_add(hist + b1, 1u, __ATOMIC_RELAXED, __HIP_MEMORY_SCOPE_WORKGROUP); } }
    }
}
template <int WHICH, bool COUNT = true>
__device__ __forceinline__ void ph_norm(const Ctx& c, const Params& p) {
    const int l = WHICH >> 1, f = WHICH & 1;
    const float* src = WHICH == 0 ? p.in[I_X] : p.out; bf16* dst = (bf16*)(p.ws + (WHICH == 3 ? WS_A3 : WS_ACT + A_A));
    const float* w = p.in[f ? I_NFFN : I_NMIX] + l * D; const float* mod = (const float*)(p.ws + WS_MOD) + (size_t)l * 4 * 6144;
    if constexpr (WHICH == 3) {
        LAS unsigned* hist = (LAS unsigned*)(c.lds + 1024);
        if (c.tid < 8) hist[c.tid] = 0u;
        __syncthreads();
        for (int i = 0; i < 8; ++i) { const int m = c.bid * 64 + c.wave * 8 + i; if (m < M) { const int b = m >> 12; const float* mb = mod + (size_t)b * 6144 + 3 * D;
            norm_row<true, COUNT>(src + (size_t)m * D, dst + (size_t)m * D, w, mb + D, mb, c.lane, p.in[I_RW], p.in[I_RB], m, p.ws, hist); } }
        __syncthreads();
        if (COUNT && c.tid < 8) ((unsigned*)(p.ws + WS_ROUTE + R_HIST))[c.bid * 8 + c.tid] = hist[c.tid];
    } else {
    for (int m = c.gw; m < M; m += c.NGW) { const int b = m >> 12; const float* mb = mod + (size_t)b * 6144 + (f ? 3 * D : 0);
        norm_row<false, COUNT>(src + (size_t)m * D, dst + (size_t)m * D, w, mb + D, mb, c.lane, p.in[I_RW], p.in[I_RB], m, p.ws, nullptr); }
    }
}

enum { G_ABIN = 0, G_ABOUT, G_FFNGU, G_FFND, G_CDIN, G_CDOUT, G_MOEGU, G_MOED, G_FFND_PROBE, G_CDOUT_PROBE };
template <int WHICH>
__device__ __forceinline__ void ph_gemm(const Ctx& cx, const Params& p) {
    PG8_LAS unsigned char* lds = (PG8_LAS unsigned char*)cx.lds;
    unsigned char* ws = p.ws; unsigned char* act = ws + WS_ACT; const float* mod = (const float*)(ws + WS_MOD);
    const int G = cx.G, c = cx.bid;
    if constexpr (WHICH == G_ABIN) { pg8::Gemm g{(const bf16*)(act + A_A), (const bf16*)(ws + WS_WAB_IN), M, NAB, D, 0}; pg8::StaticOrder S; S.init(M, NAB, G, c);
        pg8::EpiStoreBf16 E{(bf16*)(act + A_P), NAB, nullptr}; pg8::gemm_phase<pg8::EpiStoreBf16, pg8::StaticOrder, true, true>(lds, g, S, E); }
    if constexpr (WHICH == G_ABOUT) { pg8::Gemm g{(const bf16*)(act + A_MIXA), (const bf16*)(ws + WS_WAB_OUT), M, D, D, 0}; pg8::StaticOrder S; S.init(M, D, G, c);
        pg8::EpiRes E{p.in[I_X], p.out, D, mod + 2 * D}; pg8::gemm_phase<pg8::EpiRes, pg8::StaticOrder, true, true>(lds, g, S, E); }
    if constexpr (WHICH == G_FFNGU) { pg8::Gemm g{(const bf16*)(act + A_A), (const bf16*)(ws + WS_WFFN_GU), M, 2 * FF, D, 0}; pg8::StaticOrder S; S.init(M, 2 * FF, G, c);
        pg8::EpiSwiglu E{(bf16*)(act + A_H), FF}; pg8::gemm_phase<pg8::EpiSwiglu, pg8::StaticOrder, true, true>(lds, g, S, E); }
    if constexpr (WHICH == G_FFND) { pg8::Gemm g{(const bf16*)(act + A_H), (const bf16*)(ws + WS_WFFN_D), M, D, FF, 0}; pg8::StaticOrder S; S.init(M, D, G, c);
        pg8::EpiRes E{p.out, p.out, D, mod + 5 * D}; pg8::gemm_phase<pg8::EpiRes, pg8::StaticOrder, true, true>(lds, g, S, E); }
    if constexpr (WHICH == G_FFND_PROBE) { pg8::Gemm g{(const bf16*)(act + A_H), (const bf16*)(ws + WS_WFFN_D), M, D, FF, 0}; pg8::StaticOrder S; S.init(M, D, G, c);
        pg8::EpiRes E{p.out, (float*)(act + A_P), D, mod + 5 * D}; pg8::gemm_phase<pg8::EpiRes, pg8::StaticOrder, true, true>(lds, g, S, E); }
    if constexpr (WHICH == G_CDOUT_PROBE) { pg8::Gemm g{(const bf16*)(act + A_MIXB), (const bf16*)(ws + WS_WCD_OUT), M, D, CDO, 0}; pg8::StaticOrder S; S.init(M, D, G, c);
        pg8::EpiRes E{p.out, (float*)(act + A_P), D, mod + 4 * 6144 + 2 * D}; pg8::gemm_phase<pg8::EpiRes, pg8::StaticOrder, true, true>(lds, g, S, E); }
    if constexpr (WHICH == G_CDIN) { pg8::Gemm g{(const bf16*)(act + A_A), (const bf16*)(ws + WS_WCD_IN), M, NCD, D, 0}; pg8::StaticOrder S; S.init(M, NCD, G, c);
        pg8::EpiStoreBf16 E{(bf16*)(act + A_P), NCD, nullptr}; pg8::gemm_phase<pg8::EpiStoreBf16, pg8::StaticOrder, true, true>(lds, g, S, E); }
    if constexpr (WHICH == G_CDOUT) { pg8::Gemm g{(const bf16*)(act + A_MIXB), (const bf16*)(ws + WS_WCD_OUT), M, D, CDO, 0}; pg8::StaticOrder S; S.init(M, D, G, c);
        pg8::EpiRes E{p.out, p.out, D, mod + 4 * 6144 + 2 * D}; pg8::gemm_phase<pg8::EpiRes, pg8::StaticOrder, true, true>(lds, g, S, E); }
    if constexpr (WHICH == G_MOEGU) { const int* off = (const int*)(ws + WS_ROUTE + R_OFF); const int nMt = __builtin_amdgcn_readfirstlane(off[8]) >> 8;
        pg8::Gemm g{(const bf16*)(act + A_A3P), (const bf16*)(ws + WS_WMOE_GU), nMt * 256, 2 * FFE, D, (size_t)2 * FFE * D * 2}; pg8::GroupedOrder S; S.init(nMt, 2 * FFE, G, c, (const int*)(ws + WS_ROUTE + R_TILEE));
        pg8::EpiSwiglu E{(bf16*)(act + A_HM), FFE}; pg8::gemm_phase<pg8::EpiSwiglu, pg8::GroupedOrder, true, true>(lds, g, S, E); }
    if constexpr (WHICH == G_MOED) { const int* off = (const int*)(ws + WS_ROUTE + R_OFF); const int nMt = __builtin_amdgcn_readfirstlane(off[8]) >> 8;
        pg8::Gemm g{(const bf16*)(act + A_HM), (const bf16*)(ws + WS_WMOE_D), nMt * 256, D, FFE, (size_t)D * FFE * 2}; pg8::GroupedOrder S; S.init(nMt, D, G, c, (const int*)(ws + WS_ROUTE + R_TILEE));
        pg8::EpiStoreBf16 E{(bf16*)(act + A_Y), D, (const float*)(ws + WS_ROUTE + R_GATEW)}; pg8::gemm_phase<pg8::EpiStoreBf16, pg8::GroupedOrder, true, true>(lds, g, S, E); }
}

__device__ __forceinline__ void ph_attn_naive(const Ctx& c, const Params& p) {
    const bf16* P0 = (const bf16*)(p.ws + WS_ACT + A_P); const float* relb = p.in[I_RELB];
    for (int gid = c.bid * NTHR + c.tid; gid < M * 8; gid += c.G * NTHR) {
        const int m = gid >> 3, h = gid & 7, t = m & (T - 1), kvh = h >> 2;
        float q[64], o[64];
        { const v4u* qp = (const v4u*)(P0 + (size_t)m * NAB + C_QA + h * 64);
#pragma unroll
          for (int i = 0; i < 8; ++i) { const v4u w = qp[i]; q[8 * i + 0] = bflo(w.x) * 0.125f; q[8 * i + 1] = bfhi(w.x) * 0.125f; q[8 * i + 2] = bflo(w.y) * 0.125f; q[8 * i + 3] = bfhi(w.y) * 0.125f;
              q[8 * i + 4] = bflo(w.z) * 0.125f; q[8 * i + 5] = bfhi(w.z) * 0.125f; q[8 * i + 6] = bflo(w.w) * 0.125f; q[8 * i + 7] = bfhi(w.w) * 0.125f; } }
#pragma unroll
        for (int i = 0; i < 64; ++i) o[i] = 0.f;
        float mx = p.in[I_SINK][h], l = 1.0f;
        const int nd = t + 1 < 128 ? t + 1 : 128;
        for (int dd = 0; dd < nd; ++dd) {
            const bf16* kr = P0 + (size_t)(m - dd) * NAB + C_KA + kvh * 64; const bf16* vr = P0 + (size_t)(m - dd) * NAB + C_VA + kvh * 64;
            float s = 0.f;
#pragma unroll
            for (int i = 0; i < 8; ++i) { const v4u w = ((const v4u*)kr)[i];
                s += q[8 * i + 0] * bflo(w.x) + q[8 * i + 1] * bfhi(w.x) + q[8 * i + 2] * bflo(w.y) + q[8 * i + 3] * bfhi(w.y) + q[8 * i + 4] * bflo(w.z) + q[8 * i + 5] * bfhi(w.z) + q[8 * i + 6] * bflo(w.w) + q[8 * i + 7] * bfhi(w.w); }
            s += relb[T5_BUCKET[dd] * 8 + h];
            const float mn = fmaxf(mx, s), sc = __expf(mx - mn), pp = __expf(s - mn);
            l = l * sc + pp; mx = mn;
#pragma unroll
            for (int i = 0; i < 8; ++i) { const v4u w = ((const v4u*)vr)[i];
                o[8 * i + 0] = o[8 * i + 0] * sc + pp * bflo(w.x); o[8 * i + 1] = o[8 * i + 1] * sc + pp * bfhi(w.x); o[8 * i + 2] = o[8 * i + 2] * sc + pp * bflo(w.y); o[8 * i + 3] = o[8 * i + 3] * sc + pp * bfhi(w.y);
                o[8 * i + 4] = o[8 * i + 4] * sc + pp * bflo(w.z); o[8 * i + 5] = o[8 * i + 5] * sc + pp * bfhi(w.z); o[8 * i + 6] = o[8 * i + 6] * sc + pp * bflo(w.w); o[8 * i + 7] = o[8 * i + 7] * sc + pp * bfhi(w.w); }
        }
        const float inv = 1.0f / l;
        v4u* op = (v4u*)((bf16*)(p.ws + WS_ACT + A_MIXA) + (size_t)m * D + h * 64);
#pragma unroll
        for (int i = 0; i < 8; ++i) { v4u w; w.x = pk2(o[8 * i] * inv, o[8 * i + 1] * inv); w.y = pk2(o[8 * i + 2] * inv, o[8 * i + 3] * inv); w.z = pk2(o[8 * i + 4] * inv, o[8 * i + 5] * inv); w.w = pk2(o[8 * i + 6] * inv, o[8 * i + 7] * inv); op[i] = w; }
    }
}

__device__ __forceinline__ void ph_dn_prep(const Ctx& c, const Params& p) {
    const bf16* P0 = (const bf16*)(p.ws + WS_ACT + A_P); const float* cw = p.in[I_DNCONV]; unsigned char* act = p.ws + WS_ACT; const int lane = c.lane;
    for (int it = c.gw; it < M * 8; it += c.NGW) {
        const int m = it >> 3, h = it & 7, t = m & (T - 1);
        float r[3];
#pragma unroll
        for (int s = 0; s < 3; ++s) { const int ch = s * 512 + h * 64 + lane; float a = 0.f;
#pragma unroll
            for (int k = 0; k < 4; ++k) { const int tt = t - 3 + k; if (tt >= 0) a += cw[k * 1536 + ch] * bf2f(P0[(size_t)(m - 3 + k) * NAB + C_QKVB + ch]); }
            r[s] = siluf_(a); }
        const float nq = 1.0f / sqrtf(wave_sum(r[0] * r[0]) + 1e-6f), nk = 1.0f / sqrtf(wave_sum(r[1] * r[1]) + 1e-6f);
        ((float*)(act + A_DNQ))[(size_t)m * 512 + h * 64 + lane] = r[0] * nq;
        ((float*)(act + A_DNK))[(size_t)m * 512 + h * 64 + lane] = r[1] * nk;
        ((float*)(act + A_DNV))[(size_t)m * 512 + h * 64 + lane] = r[2];
        if (lane == 0) { const float bb = bf2f(P0[(size_t)m * NAB + C_BETA + h]), ab = bf2f(P0[(size_t)m * NAB + C_AB + h]);
            ((float*)(act + A_DNB))[m * 8 + h] = sigmoidf_(bb);
            ((float*)(act + A_DNG))[m * 8 + h] = -__expf(p.in[I_ALOG][h]) * softplusf_(ab + p.in[I_DTB][h]); }
    }
}
__device__ __forceinline__ void ph_dn_scan(const Ctx& c, const Params& p) {
    if (c.wave != 0 || c.bid >= 32) return;
    LAS float* kq = (LAS float*)c.lds;
    const int b = c.bid >> 3, h = c.bid & 7, e = c.lane;
    unsigned char* act = p.ws + WS_ACT; const bf16* P0 = (const bf16*)(act + A_P);
    const float* Q = (const float*)(act + A_DNQ); const float* K = (const float*)(act + A_DNK); const float* V = (const float*)(act + A_DNV);
    const float* Bt = (const float*)(act + A_DNB); const float* Gt = (const float*)(act + A_DNG);
    const float nw = p.in[I_DNNORM][e];
    float S[64];
#pragma unroll
    for (int d = 0; d < 64; ++d) S[d] = 0.f;
    for (int t = 0; t < T; ++t) { const int m = b * T + t;
        asm volatile("s_waitcnt lgkmcnt(0)" ::: "memory");
        kq[e] = K[(size_t)m * 512 + h * 64 + e]; kq[64 + e] = Q[(size_t)m * 512 + h * 64 + e];
        const float v = V[(size_t)m * 512 + h * 64 + e], beta = Bt[m * 8 + h], eg = __expf(Gt[m * 8 + h]);
        asm volatile("s_waitcnt lgkmcnt(0)" ::: "memory");
        float kS = 0.f;
#pragma unroll
        for (int d = 0; d < 64; ++d) { S[d] *= eg; kS += kq[d] * S[d]; }
        const float dl = beta * (v - kS); float o = 0.f;
#pragma unroll
        for (int d = 0; d < 64; ++d) { S[d] += kq[d] * dl; o += kq[64 + d] * S[d]; }
        o *= 0.125f;
        const float rs = 1.0f / sqrtf(wave_sum(o * o) * (1.f / 64.f) + 1e-6f);
        const float gt = bf2f(P0[(size_t)m * NAB + C_GATEB + h * 64 + e]);
        ((bf16*)(act + A_MIXA))[(size_t)m * D + 512 + h * 64 + e] = (bf16)f2bf(o * rs * nw * siluf_(gt));
    }
}

__device__ __forceinline__ void ph_route(const Ctx& c, const Params& p, int curoff) {
    LAS int* tot = (LAS int*)c.lds; LAS int* pre = tot + 8; LAS int* loff = tot + 16; LAS int* posl = tot + 32;
    const unsigned* H = (const unsigned*)(p.ws + WS_ROUTE + R_HIST);
    { const int e = c.wave; int t = 0, pr = 0;
      for (int w = c.lane; w < c.G; w += 64) { const int v = (int)H[w * 8 + e]; t += v; pr += (w < c.bid) ? v : 0; }
#pragma unroll
      for (int o = 1; o < 64; o <<= 1) { t += __shfl_xor(t, o); pr += __shfl_xor(pr, o); }
      if (c.lane == 0) { tot[e] = t; pre[e] = pr; } }
    __syncthreads();
    if (c.tid == 0) { int* off = (int*)(p.ws + WS_ROUTE + R_OFF); int* te = (int*)(p.ws + WS_ROUTE + R_TILEE); int o = 0;
        for (int e = 0; e < 8; ++e) { loff[e] = o; const int n = (tot[e] + 255) & ~255;
            if (c.bid == 0) { off[e] = o; for (int t = o >> 8; t < (o + n) >> 8 && t < MAXT; ++t) te[t] = e; }
            o += n; }
        loff[8] = o; if (c.bid == 0) off[8] = o < MPAD ? o : MPAD; }
    __syncthreads();
    const int* idx = (const int*)(p.ws + WS_ROUTE + R_IDX); const float* tw = (const float*)(p.ws + WS_ROUTE + R_W);
    if (c.wave == 0) { int run[8];
#pragma unroll
        for (int e = 0; e < 8; ++e) run[e] = loff[e] + pre[e];
#pragma unroll
        for (int r = 0; r < 2; ++r) { const int it = 64 * r + c.lane; const int e = idx[c.bid * 128 + it]; int pos = 0;
#pragma unroll
            for (int ex = 0; ex < 8; ++ex) { const unsigned long long mk = __ballot(e == ex); if (e == ex) pos = run[ex] + __popcll(mk & ((1ull << c.lane) - 1ull)); run[ex] += __popcll(mk); }
            posl[it] = pos; ((int*)(p.ws + WS_ROUTE + R_SLOT))[c.bid * 128 + it] = pos; ((float*)(p.ws + WS_ROUTE + R_GATEW))[pos] = tw[c.bid * 128 + it]; } }
    __syncthreads();
    for (int i = 0; i < 16; ++i) { const int it = c.wave * 16 + i; const int m = c.bid * 64 + (it >> 1); const int pos = posl[it];
        const v4u* src = (const v4u*)((const bf16*)(p.ws + WS_A3) + (size_t)m * D); v4u* dst = (v4u*)((bf16*)(p.ws + WS_ACT + A_A3P) + (size_t)pos * D);
        dst[c.lane] = src[c.lane]; dst[c.lane + 64] = src[c.lane + 64]; }
}
template <bool PROBE> __device__ __forceinline__ void ph_final(const Ctx& c, const Params& p) {
    const int lane = c.lane;
    const int* slot = (const int*)(p.ws + WS_ROUTE + R_SLOT); const bf16* Y = (const bf16*)(p.ws + WS_ACT + A_Y);
    const float* mod = (const float*)(p.ws + WS_MOD) + 4 * 6144; const float* fw = p.in[I_NFIN];
    for (int m = c.gw; m < M; m += c.NGW) { const int b = m >> 12; const float* g2 = mod + (size_t)b * 6144 + 5 * D;
        const int s0 = slot[2 * m], s1 = slot[2 * m + 1];
        f32x4* xr = (f32x4*)(p.out + (size_t)m * D) + lane; f32x4* xw = PROBE ? (f32x4*)((float*)(p.ws + WS_ACT + A_HM) + (size_t)m * D) + lane : xr; const v2u* y0 = (const v2u*)(Y + (size_t)s0 * D) + lane; const v2u* y1 = (const v2u*)(Y + (size_t)s1 * D) + lane;
        f32x4 v[4]; float s = 0.f;
#pragma unroll
        for (int j = 0; j < 4; ++j) { const f32x4 gv = *(const f32x4*)(g2 + 4 * lane + 256 * j); const v2u a = y0[64 * j], cc = y1[64 * j];
            f32x4 yy; yy.x = bflo(a.x) + bflo(cc.x); yy.y = bfhi(a.x) + bfhi(cc.x); yy.z = bflo(a.y) + bflo(cc.y); yy.w = bfhi(a.y) + bfhi(cc.y);
            v[j] = xr[64 * j] + gv * yy; s += (v[j].x * v[j].x + v[j].y * v[j].y) + (v[j].z * v[j].z + v[j].w * v[j].w); }
        const float rstd = 1.0f / sqrtf(wave_sum(s) * (1.f / D) + 1e-6f);
#pragma unroll
        for (int j = 0; j < 4; ++j) { const f32x4 wv = *(const f32x4*)(fw + 4 * lane + 256 * j); xw[64 * j] = v[j] * rstd * wv; }
    }
}


typedef short bf16x8_t __attribute__((ext_vector_type(8)));
typedef short s16x4_t __attribute__((ext_vector_type(4)));
typedef float f32x16 __attribute__((ext_vector_type(16)));
constexpr int AT_KSTR = 144, AT_VSTR = 520, AT_K = 0, AT_V = 256 * AT_KSTR, AT_BIAS = AT_V + 64 * AT_VSTR, AT_END = AT_BIAS + 2048;
typedef float f32x2_c __attribute__((ext_vector_type(2))); typedef __bf16 bf16x2_c __attribute__((ext_vector_type(2)));
__device__ __forceinline__ unsigned pkbf(float lo, float hi) { f32x2_c v = {lo, hi}; bf16x2_c b = __builtin_convertvector(v, bf16x2_c); return __builtin_bit_cast(unsigned, b); }
__device__ __forceinline__ void attn_unit(const Ctx& c, const Params& p, int u) {
    const int qb = u & 31, kvh = (u >> 5) & 1, b = u >> 6;
    const bf16* P0 = (const bf16*)(p.ws + WS_ACT + A_P);
    LAS unsigned char* lds = c.lds;
    __syncthreads();
    {
        const int key = c.tid >> 1, half = c.tid & 1, tk = 128 * (qb - 1) + key;
        v4u kv[4];
        if (tk >= 0) { const v4u* src = (const v4u*)(P0 + (size_t)(b * T + tk) * NAB + C_KA + kvh * 64 + 32 * half);
#pragma unroll
            for (int i = 0; i < 4; ++i) kv[i] = src[i]; }
        else {
#pragma unroll
            for (int i = 0; i < 4; ++i) kv[i] = (v4u){0u, 0u, 0u, 0u}; }
#pragma unroll
        for (int i = 0; i < 4; ++i) *(LAS v4u*)(lds + AT_K + key * AT_KSTR + 64 * half + 16 * i) = kv[i];
    }
    {
        const int kp = c.tid & 127, dq = c.tid >> 7, tk = 128 * (qb - 1) + 2 * kp;
        v4u va[2], vb[2];
        if (tk >= 0) { const v4u* s0 = (const v4u*)(P0 + (size_t)(b * T + tk) * NAB + C_VA + kvh * 64 + 16 * dq); const v4u* s1 = (const v4u*)(P0 + (size_t)(b * T + tk + 1) * NAB + C_VA + kvh * 64 + 16 * dq);
            va[0] = s0[0]; va[1] = s0[1]; vb[0] = s1[0]; vb[1] = s1[1]; }
        else { va[0] = va[1] = vb[0] = vb[1] = (v4u){0u, 0u, 0u, 0u}; }
#pragma unroll
        for (int i = 0; i < 2; ++i)
#pragma unroll
            for (int k = 0; k < 4; ++k) { const unsigned a = va[i][k], bb = vb[i][k]; const int d = 16 * dq + 8 * i + 2 * k;
                *(LAS unsigned*)(lds + AT_V + d * AT_VSTR + 4 * kp) = (a & 0xffffu) | (bb << 16);
                *(LAS unsigned*)(lds + AT_V + (d + 1) * AT_VSTR + 4 * kp) = (a >> 16) | (bb & 0xffff0000u); }
    }
    { const int hl = c.tid >> 7, dist = c.tid & 127; *(LAS float*)(lds + AT_BIAS + c.tid * 4) = p.in[I_RELB][T5_BUCKET[dist] * 8 + kvh * 4 + hl]; }
    __syncthreads();
    const int hl = c.wave >> 1, hq = kvh * 4 + hl, qh = c.wave & 1, qi = c.lane & 31, hh = c.lane >> 5;
    const float sink = p.in[I_SINK][hq];
    const LAS float* biasT = (const LAS float*)(lds + AT_BIAS + hl * 512);
#pragma unroll 1
    for (int s = 0; s < 2; ++s) {
        const int q0 = 64 * qh + 32 * s, kb0 = q0 >> 5, qq = q0 + qi; const size_t m = (size_t)b * T + 128 * qb + qq;
        bf16x8_t bq[4];
#pragma unroll
        for (int ks = 0; ks < 4; ++ks) bq[ks] = *(const bf16x8_t*)(P0 + m * NAB + C_QA + hq * 64 + 16 * ks + 8 * hh);
        f32x16 sacc[5];
#pragma unroll
        for (int kbi = 0; kbi < 5; ++kbi) {
            f32x16 acc;
#pragma unroll
            for (int r = 0; r < 16; ++r) acc[r] = 0.f;
#pragma unroll
            for (int ks = 0; ks < 4; ++ks) { const bf16x8_t ka = *(const LAS bf16x8_t*)(lds + AT_K + (32 * (kb0 + kbi) + qi) * AT_KSTR + 32 * ks + 16 * hh);
                acc = __builtin_amdgcn_mfma_f32_32x32x16_bf16(ka, bq[ks], acc, 0, 0, 0); }
            sacc[kbi] = acc;
        }
        float mx = -1e30f;
#pragma unroll
        for (int kbi = 0; kbi < 5; ++kbi)
#pragma unroll
            for (int r = 0; r < 16; ++r) { const int sidx = 32 * (kb0 + kbi) + (r & 3) + 8 * (r >> 2) + 4 * hh; const int dist = qq + 128 - sidx;
                const bool valid = dist >= 0 && dist < 128 && (qb > 0 || sidx >= 128);
                const float bv = biasT[dist & 127];
                const float sc = valid ? sacc[kbi][r] * 0.125f + bv : -1e30f; sacc[kbi][r] = sc; mx = fmaxf(mx, sc); }
        mx = fmaxf(mx, __shfl_xor(mx, 32)); mx = fmaxf(mx, sink);
        float l = 0.f;
#pragma unroll
        for (int kbi = 0; kbi < 5; ++kbi)
#pragma unroll
            for (int r = 0; r < 16; ++r) { const float pv = __expf(sacc[kbi][r] - mx); sacc[kbi][r] = pv; l += pv; }
        l += __shfl_xor(l, 32); l += __expf(sink - mx);
        const float inv = 1.0f / l;
        f32x16 oacc[2];
#pragma unroll
        for (int db = 0; db < 2; ++db)
#pragma unroll
            for (int r = 0; r < 16; ++r) oacc[db][r] = 0.f;
#pragma unroll
        for (int kbi = 0; kbi < 5; ++kbi)
#pragma unroll
            for (int s2 = 0; s2 < 2; ++s2) {
                v4u pw; pw.x = pkbf(sacc[kbi][8 * s2 + 0], sacc[kbi][8 * s2 + 1]); pw.y = pkbf(sacc[kbi][8 * s2 + 2], sacc[kbi][8 * s2 + 3]); pw.z = pkbf(sacc[kbi][8 * s2 + 4], sacc[kbi][8 * s2 + 5]); pw.w = pkbf(sacc[kbi][8 * s2 + 6], sacc[kbi][8 * s2 + 7]);
                const bf16x8_t pf = __builtin_bit_cast(bf16x8_t, pw);
                const int keyb = 32 * (kb0 + kbi) + 16 * s2 + 4 * hh;
#pragma unroll
                for (int db = 0; db < 2; ++db) { const LAS unsigned char* vp = lds + AT_V + (32 * db + qi) * AT_VSTR + 2 * keyb;
                    const s16x4_t lo = *(const LAS s16x4_t*)vp, hi = *(const LAS s16x4_t*)(vp + 16);
                    const bf16x8_t vf = (bf16x8_t){lo[0], lo[1], lo[2], lo[3], hi[0], hi[1], hi[2], hi[3]};
                    oacc[db] = __builtin_amdgcn_mfma_f32_32x32x16_bf16(vf, pf, oacc[db], 0, 0, 0); }
            }
        bf16* orow = (bf16*)(p.ws + WS_ACT + A_MIXA) + m * D + hq * 64;
#pragma unroll
        for (int db = 0; db < 2; ++db)
#pragma unroll
            for (int g = 0; g < 4; ++g) { v2u w; w.x = pkbf(oacc[db][4 * g] * inv, oacc[db][4 * g + 1] * inv); w.y = pkbf(oacc[db][4 * g + 2] * inv, oacc[db][4 * g + 3] * inv);
                *(v2u*)(orow + 32 * db + 8 * g + 4 * hh) = w; }
    }
}
__device__ __forceinline__ void ph_attn(const Ctx& c, const Params& p) {
    for (int u = c.bid; u < 256; u += c.G) attn_unit(c, p, u);
}


constexpr int LR_XSTR = 272, LR_XT = 0, LR_XF = 64 * LR_XSTR, LR_GA = LR_XF + 32768, LR_CMB = LR_GA + 32768, LR_XR = LR_CMB + 4096, LR_END = LR_XR + 67 * LR_XSTR;
constexpr size_t A_AB = 192 * MiB, A_SA = 256 * MiB, A_SH = 260 * MiB, A_TA = 264 * MiB, A_TH = 265 * MiB, A_GA = 266 * MiB, A_GH = 266 * MiB + 512 * 1024;
typedef float f32x4_t __attribute__((ext_vector_type(4)));
__device__ __forceinline__ void ph_lru1(const Ctx& c, const Params& p) {
    LAS unsigned char* lds = c.lds; unsigned char* act = p.ws + WS_ACT;
    const int n = c.bid & 7, bg = c.bid >> 3, b = bg >> 3, grp = bg & 7, ch = c.tid & 127, tq = c.tid >> 7, gch = n * 128 + ch;
    const bf16* P1 = (const bf16*)(act + A_P);
    const float cw0 = p.in[I_LCW][gch], cw1 = p.in[I_LCW][1024 + gch], cw2 = p.in[I_LCW][2048 + gch], cw3 = p.in[I_LCW][3072 + gch], cb = p.in[I_LCB][gch];
    const int jl = c.lane & 15, q = c.lane >> 4, w = c.wave, ech = n * 128 + 16 * w + jl;
    const float gab = p.in[I_GAB][ech], gxb = p.in[I_GXB][ech], sp8 = -8.0f * softplusf_(-p.in[I_LAM][ech]);
    bf16x8_t bfa[4], bfx[4];
    { const bf16* wl = (const bf16*)(p.ws + WS_WLRU) + (size_t)n * 256 * 128;
#pragma unroll
      for (int ks = 0; ks < 4; ++ks) { bfa[ks] = *(const bf16x8_t*)(wl + (size_t)(16 * w + jl) * 128 + 32 * ks + 8 * q); bfx[ks] = *(const bf16x8_t*)(wl + (size_t)(128 + 16 * w + jl) * 128 + 32 * ks + 8 * q); } }
    v4u xr[3];
#define LR_FETCH(tile_) do { const int t0_ = 64 * (tile_); _Pragma("unroll") for (int i_ = 0; i_ < 3; ++i_) { const int pc_ = c.tid + 512 * i_; const int row_ = pc_ >> 4, cg_ = pc_ & 15; const int tk_ = t0_ - 3 + row_; \
        xr[i_] = (pc_ < 1072 && tk_ >= 0) ? *(const v4u*)(P1 + ((size_t)b * T + tk_) * NCD + C_XC + n * 128 + 8 * cg_) : (v4u){0u, 0u, 0u, 0u}; } } while (0)
    LR_FETCH(grp * 8);
    float Ag = 1.f, Hg = 0.f;
    for (int r = 0; r < 8; ++r) {
        const int tt = grp * 8 + r; const size_t m0 = (size_t)b * T + 64 * tt;
        __syncthreads();
#pragma unroll
        for (int i = 0; i < 3; ++i) { const int pc = c.tid + 512 * i; if (pc < 1072) *(LAS v4u*)(lds + LR_XR + (pc >> 4) * LR_XSTR + 16 * (pc & 15)) = xr[i]; }
        if (r < 7) LR_FETCH(tt + 1);
        __syncthreads();
        { const LAS unsigned char* xc0 = lds + LR_XR + 2 * ch; float x0 = bf2f(*(const LAS unsigned short*)(xc0 + (16 * tq) * LR_XSTR)), x1 = bf2f(*(const LAS unsigned short*)(xc0 + (16 * tq + 1) * LR_XSTR)), x2 = bf2f(*(const LAS unsigned short*)(xc0 + (16 * tq + 2) * LR_XSTR));
#pragma unroll
          for (int i = 0; i < 16; ++i) { const int tk = 16 * tq + i; const float x3 = bf2f(*(const LAS unsigned short*)(xc0 + (tk + 3) * LR_XSTR));
              const float xc = cb + cw0 * x0 + cw1 * x1 + cw2 * x2 + cw3 * x3;
              *(LAS unsigned short*)(lds + LR_XT + tk * LR_XSTR + 2 * ch) = (unsigned short)f2bf(xc);
              *(LAS float*)(lds + LR_XF + (tk * 128 + ch) * 4) = xc;
              x0 = x1; x1 = x2; x2 = x3; } }
        __syncthreads();
#pragma unroll
        for (int mt = 0; mt < 4; ++mt) {
            f32x4_t aa = {0.f, 0.f, 0.f, 0.f}, ax = {0.f, 0.f, 0.f, 0.f};
#pragma unroll
            for (int ks = 0; ks < 4; ++ks) { const bf16x8_t af = *(const LAS bf16x8_t*)(lds + LR_XT + (16 * mt + jl) * LR_XSTR + 64 * ks + 16 * q);
                aa = __builtin_amdgcn_mfma_f32_16x16x32_bf16(af, bfa[ks], aa, 0, 0, 0); ax = __builtin_amdgcn_mfma_f32_16x16x32_bf16(af, bfx[ks], ax, 0, 0, 0); }
#pragma unroll
            for (int r4 = 0; r4 < 4; ++r4) { const int tk = 16 * mt + 4 * q + r4; LAS float* xf = (LAS float*)(lds + LR_XF + (tk * 128 + 16 * w + jl) * 4);
                const float rr = sigmoidf_(aa[r4] + gab), ii = sigmoidf_(ax[r4] + gxb), la = sp8 * rr, a = __expf(la);
                const float bb = sqrtf(fmaxf(1.0f - a * a, 0.f)) * (ii * xf[0]);
                *(LAS float*)(lds + LR_GA + (tk * 128 + 16 * w + jl) * 4) = 1.0f - a; xf[0] = bb; }
        }
        __syncthreads();
        float Ap = 1.f, h = 0.f; unsigned* AB = (unsigned*)(act + A_AB) + (m0 + 16 * tq) * 1024 + gch;
#pragma unroll
        for (int i = 0; i < 16; ++i) { const float oma = *(const LAS float*)(lds + LR_GA + ((16 * tq + i) * 128 + ch) * 4), bv = *(const LAS float*)(lds + LR_XF + ((16 * tq + i) * 128 + ch) * 4);
            const unsigned pk = pk2(oma, bv); AB[(size_t)i * 1024] = pk;
            const float a = 1.0f - bflo(pk), bq = bfhi(pk); h = a * h + bq; Ap *= a; }
        { const size_t si = (m0 >> 4) + tq; ((float*)(act + A_SA))[si * 1024 + gch] = Ap; ((float*)(act + A_SH))[si * 1024 + gch] = h; }
        *(LAS float*)(lds + LR_CMB + (tq * 128 + ch) * 4) = Ap; *(LAS float*)(lds + LR_CMB + 2048 + (tq * 128 + ch) * 4) = h;
        __syncthreads();
        if (tq == 0) { float A = 1.f, H = 0.f;
#pragma unroll
            for (int g = 0; g < 4; ++g) { const float ag = *(const LAS float*)(lds + LR_CMB + (g * 128 + ch) * 4), hg = *(const LAS float*)(lds + LR_CMB + 2048 + (g * 128 + ch) * 4); H = ag * H + hg; A *= ag; }
            ((float*)(act + A_TA))[(size_t)(b * 64 + tt) * 1024 + gch] = A; ((float*)(act + A_TH))[(size_t)(b * 64 + tt) * 1024 + gch] = H;
            Hg = A * Hg + H; Ag *= A; }
    }
    if (tq == 0) { ((float*)(act + A_GA))[(size_t)(b * 8 + grp) * 1024 + gch] = Ag; ((float*)(act + A_GH))[(size_t)(b * 8 + grp) * 1024 + gch] = Hg; }
#undef LR_FETCH
}
__device__ __forceinline__ void ph_lru2(const Ctx& c, const Params& p) {
    unsigned char* act = p.ws + WS_ACT;
    const int n = c.bid & 7, bg = c.bid >> 3, b = bg >> 3, grp = bg & 7, ch = c.tid & 127, tq = c.tid >> 7, gch = n * 128 + ch;
    const float* GA = (const float*)(act + A_GA); const float* GH = (const float*)(act + A_GH); const float* TA = (const float*)(act + A_TA); const float* TH = (const float*)(act + A_TH);
    const float* SA = (const float*)(act + A_SA); const float* SH = (const float*)(act + A_SH);
    const bf16* yc = (const bf16*)(act + A_P) + C_YC + gch; bf16* mo = (bf16*)(act + A_MIXB) + gch;
    float ht = 0.f;
    for (int g = 0; g < grp; ++g) ht = GA[(size_t)(b * 8 + g) * 1024 + gch] * ht + GH[(size_t)(b * 8 + g) * 1024 + gch];
    for (int r = 0; r < 8; ++r) { const int tt = grp * 8 + r; const size_t m0 = (size_t)b * T + 64 * tt;
        float hs = ht;
        for (int s = 0; s < tq; ++s) { const size_t si = (m0 >> 4) + s; hs = SA[si * 1024 + gch] * hs + SH[si * 1024 + gch]; }
        const unsigned* AB = (const unsigned*)(act + A_AB) + (m0 + 16 * tq) * 1024 + gch;
        unsigned ab[16]; unsigned short yv[16];
#pragma unroll
        for (int i = 0; i < 16; ++i) { ab[i] = AB[(size_t)i * 1024]; yv[i] = yc[(m0 + 16 * tq + i) * NCD]; }
#pragma unroll
        for (int i = 0; i < 16; ++i) { hs = (1.0f - bflo(ab[i])) * hs + bfhi(ab[i]);
            const float y = bf2f(yv[i]); const float ge = y * sigmoidf_(1.5957691216057308f * (y + 0.044715f * y * y * y));
            mo[(m0 + 16 * tq + i) * CDO] = (bf16)f2bf(hs * ge); }
        ht = TA[(size_t)(b * 64 + tt) * 1024 + gch] * ht + TH[(size_t)(b * 64 + tt) * 1024 + gch];
    }
}
__device__ __forceinline__ void ph_sconv(const Ctx& c, const Params& p) {
    const bf16* P1 = (const bf16*)(p.ws + WS_ACT + A_P); const float* sw = p.in[I_SCW];
    for (int it = c.bid * NTHR + c.tid; it < M * 64; it += c.G * NTHR) {
        const int m = it >> 6, cg = it & 63, t = m & (T - 1), c0 = 8 * cg; float acc[8];
#pragma unroll
        for (int e = 0; e < 8; ++e) acc[e] = 0.f;
#pragma unroll
        for (int k = 0; k < 3; ++k) { const int tt = t - 2 + k; if (tt >= 0) { const size_t r = (size_t)(m - 2 + k) * NCD; const v4u cv = *(const v4u*)(P1 + r + C_CD + c0), hv = *(const v4u*)(P1 + r + C_HD + c0);
#pragma unroll
            for (int e = 0; e < 4; ++e) { acc[2 * e] += sw[k * 512 + c0 + 2 * e] * (bflo(cv[e]) * bflo(hv[e])); acc[2 * e + 1] += sw[k * 512 + c0 + 2 * e + 1] * (bfhi(cv[e]) * bfhi(hv[e])); } } }
        const v4u bv = *(const v4u*)(P1 + (size_t)m * NCD + C_BD + c0); v4u o;
#pragma unroll
        for (int e = 0; e < 4; ++e) o[e] = pk2(bflo(bv[e]) * acc[2 * e], bfhi(bv[e]) * acc[2 * e + 1]);
        *(v4u*)((bf16*)(p.ws + WS_ACT + A_MIXB) + (size_t)m * CDO + 1024 + c0) = o; }
}


constexpr size_t A_DNX = 160 * MiB, A_DNEG = 256 * MiB;
constexpr int DN_CHB = 49152, DN_W = 0, DN_QD = 8192, DN_QK = 16384, DN_KD = 24576, DN_U = 32768;
constexpr int DN_KS = 144, DN_R = 9216, DN_WAVE = 2 * DN_R;
__device__ __forceinline__ float rdl(float x, int i) { return __builtin_bit_cast(float, __builtin_amdgcn_readlane(__builtin_bit_cast(int, x), i)); }
__device__ __forceinline__ int lrow_off(int i) { const int a = (i - 1) >> 2, b = (i - 1) & 3; return 4 * (a + 1) * (2 * a + b); }
__host__ __device__ constexpr int lrow_off_c(int i) { return 4 * (((i - 1) >> 2) + 1) * (2 * ((i - 1) >> 2) + ((i - 1) & 3)); }

typedef __amdgpu_buffer_rsrc_t rsrc_t;
__device__ __forceinline__ rsrc_t mk_rsrc(const void* base, unsigned bytes) { return __builtin_amdgcn_make_buffer_rsrc((void*)base, 0, bytes, 0x00020000); }
__device__ __forceinline__ void dn_conv_row(rsrc_t rp, const float* cw, int rowoff, int n, int lane, int coffb, int woff, float (&acc)[64]) {
#pragma unroll
    for (int ch = 0; ch < 64; ++ch) acc[ch] = 0.f;
#pragma unroll
    for (int k = 0; k < 4; ++k) { const int tt = 64 * n + lane - 3 + k;
        v4u xr[8];
        if (tt >= 0) {
#pragma unroll
            for (int i = 0; i < 8; ++i) xr[i] = __builtin_amdgcn_raw_buffer_load_b128(rp, rowoff + (k - 3) * (NAB * 2) + 16 * i, coffb, 0); }
        else {
#pragma unroll
            for (int i = 0; i < 8; ++i) xr[i] = (v4u){0u, 0u, 0u, 0u}; }
#pragma unroll
        for (int i = 0; i < 8; ++i)
#pragma unroll
            for (int e = 0; e < 4; ++e) { const unsigned w = xr[i][e]; acc[8 * i + 2 * e] += cw[k * 1536 + woff + 8 * i + 2 * e] * bflo(w); acc[8 * i + 2 * e + 1] += cw[k * 1536 + woff + 8 * i + 2 * e + 1] * bfhi(w); }
        asm volatile("" ::: "memory"); }
#pragma unroll
    for (int ch = 0; ch < 64; ++ch) acc[ch] = siluf_(acc[ch]);
}
__device__ __forceinline__ void fnma(float& acc, float a, float b) { asm volatile("v_fma_f32 %0, -%1, %2, %0" : "+v"(acc) : "v"(a), "v"(b)); }
__device__ __forceinline__ void dn_solve(const LAS unsigned char* R2, float (&x)[64]) {
#pragma unroll
    for (int i = 1; i < 64; ++i) {
        float a0 = x[i], a1 = 0.f;
#pragma unroll
        for (int g = 0; g < (i + 3) / 4; ++g) { const f32x4_t lv = *(const LAS f32x4_t*)(R2 + (lrow_off_c(i) + 4 * g) * 4);
#pragma unroll
            for (int e = 0; e < 4; ++e) if (4 * g + e < i) { if (e & 1) fnma(a1, lv[e], x[4 * g + e]); else fnma(a0, lv[e], x[4 * g + e]); } }
        x[i] = a0 + a1;
    }
}
__device__ __forceinline__ void dn_prep_chunk(const Ctx& c, const Params& p, int ci, size_t xoff) {
    const int n = ci & 63, h = (ci >> 6) & 7, b = ci >> 9, lane = c.lane;
    const int m0 = b * T + 64 * n;
    LAS unsigned char* R1 = c.lds + c.wave * DN_WAVE; LAS unsigned char* R2 = R1 + DN_R;
    const float* cw = p.in[I_DNCONV];
    const rsrc_t rp = mk_rsrc(p.ws + WS_ACT + A_P, (unsigned)((size_t)M * NAB * 2));
    const rsrc_t rx = mk_rsrc(p.ws + xoff + (size_t)ci * DN_CHB, DN_CHB);
    const int rowoff = (m0 + lane) * (NAB * 2);
#pragma unroll
    for (int s = 0; s < 2; ++s) {
        float acc[64]; dn_conv_row(rp, cw, rowoff, n, lane, (C_QKVB + s * 512 + h * 64) * 2, s * 512 + h * 64, acc);
        float ss = 0.f;
#pragma unroll
        for (int ch = 0; ch < 64; ++ch) ss += acc[ch] * acc[ch];
        const float rn = (s == 1 ? 1.0f : 0.125f) / sqrtf(ss + 1e-6f);
        LAS unsigned char* dst = (s == 1 ? R1 : R2) + lane * DN_KS;
#pragma unroll
        for (int i = 0; i < 8; ++i) { v4u w; w.x = pkbf(acc[8 * i] * rn, acc[8 * i + 1] * rn); w.y = pkbf(acc[8 * i + 2] * rn, acc[8 * i + 3] * rn); w.z = pkbf(acc[8 * i + 4] * rn, acc[8 * i + 5] * rn); w.w = pkbf(acc[8 * i + 6] * rn, acc[8 * i + 7] * rn);
            *(LAS v4u*)(dst + 16 * i) = w; }
        asm volatile("" ::: "memory");
    }
    const float beta = sigmoidf_(bf2f(__builtin_amdgcn_raw_buffer_load_b16(rp, rowoff, (C_BETA + h) * 2, 0)));
    float gc = -__expf(p.in[I_ALOG][h]) * softplusf_(bf2f(__builtin_amdgcn_raw_buffer_load_b16(rp, rowoff, (C_AB + h) * 2, 0)) + p.in[I_DTB][h]);
#pragma unroll
    for (int o = 1; o < 64; o <<= 1) { const float t = __shfl_up(gc, o); if (lane >= o) gc += t; }
    const float gl = rdl(gc, 63), egc = __expf(gc), kdsc = __expf(gl - gc), bw = beta * egc;
    if (lane == 0) ((float*)(p.ws + WS_ACT + A_DNEG))[ci] = __expf(gl);
    asm volatile("s_waitcnt lgkmcnt(0)" ::: "memory");
    const int r32 = lane & 31, hh = lane >> 5, l15 = lane & 15, q4 = lane >> 4;
#pragma unroll
    for (int blk = 0; blk < 4; ++blk) { const int I = blk >> 1, J = blk & 1;
        v4u fa = {0u, 0u, 0u, 0u}, fb = {0u, 0u, 0u, 0u};
        if (!(I == 0 && J == 1)) {
            f32x16 acc;
#pragma unroll
            for (int r = 0; r < 16; ++r) acc[r] = 0.f;
#pragma unroll
            for (int ks = 0; ks < 4; ++ks) { const bf16x8_t ka = *(const LAS bf16x8_t*)(R1 + (32 * J + r32) * DN_KS + 32 * ks + 16 * hh), qb = *(const LAS bf16x8_t*)(R2 + (32 * I + r32) * DN_KS + 32 * ks + 16 * hh);
                acc = __builtin_amdgcn_mfma_f32_32x32x16_bf16(ka, qb, acc, 0, 0, 0); }
            const int i = 32 * I + r32; const float gci = __shfl(gc, i);
            float v[16];
#pragma unroll
            for (int r = 0; r < 16; ++r) { const int j = 32 * J + (r & 3) + 8 * (r >> 2) + 4 * hh; const float gcj = __shfl(gc, j); v[r] = j <= i ? acc[r] * __expf(gci - gcj) : 0.f; }
            fa.x = pkbf(v[0], v[1]); fa.y = pkbf(v[2], v[3]); fa.z = pkbf(v[8], v[9]); fa.w = pkbf(v[10], v[11]);
            fb.x = pkbf(v[4], v[5]); fb.y = pkbf(v[6], v[7]); fb.z = pkbf(v[12], v[13]); fb.w = pkbf(v[14], v[15]);
        }
        const int vo = (r32 >> 4) * 2048 + (l15 + 16 * hh) * 16;
        __builtin_amdgcn_raw_buffer_store_b128(fa, rx, (vo) + (DN_QK + 4096 * I + 1024 * J), 0, 0);
        __builtin_amdgcn_raw_buffer_store_b128(fb, rx, (vo) + (DN_QK + 4096 * I + 1024 * J + 512), 0, 0);
    }
#pragma unroll
    for (int mt = 0; mt < 4; ++mt) { const int row = 16 * mt + l15; const float sc = __shfl(egc, row);
#pragma unroll
        for (int ks = 0; ks < 2; ++ks) { const v2u a = *(const LAS v2u*)(R2 + row * DN_KS + 64 * ks + 8 * q4), bq = *(const LAS v2u*)(R2 + row * DN_KS + 64 * ks + 32 + 8 * q4);
            v4u w; w.x = pkbf(bflo(a.x) * sc, bfhi(a.x) * sc); w.y = pkbf(bflo(a.y) * sc, bfhi(a.y) * sc); w.z = pkbf(bflo(bq.x) * sc, bfhi(bq.x) * sc); w.w = pkbf(bflo(bq.y) * sc, bfhi(bq.y) * sc);
            __builtin_amdgcn_raw_buffer_store_b128(w, rx, (lane * 16) + (DN_QD + (mt * 2 + ks) * 1024), 0, 0); } }
    asm volatile("s_waitcnt lgkmcnt(0)" ::: "memory");
#pragma unroll
    for (int blk = 0; blk < 3; ++blk) { const int I = blk == 0 ? 0 : 1, J = blk == 2 ? 1 : 0;
        f32x16 acc;
#pragma unroll
        for (int r = 0; r < 16; ++r) acc[r] = 0.f;
#pragma unroll
        for (int ks = 0; ks < 4; ++ks) { const bf16x8_t ki = *(const LAS bf16x8_t*)(R1 + (32 * I + r32) * DN_KS + 32 * ks + 16 * hh), kj = *(const LAS bf16x8_t*)(R1 + (32 * J + r32) * DN_KS + 32 * ks + 16 * hh);
            acc = __builtin_amdgcn_mfma_f32_32x32x16_bf16(ki, kj, acc, 0, 0, 0); }
        const int j = 32 * J + r32; const float gcj = __shfl(gc, j);
#pragma unroll
        for (int r = 0; r < 16; ++r) { const int i = 32 * I + (r & 3) + 8 * (r >> 2) + 4 * hh; const float gci = __shfl(gc, i), bi = __shfl(beta, i);
            if (i > j) *(LAS float*)(R2 + (lrow_off(i) + j) * 4) = bi * acc[r] * __expf(gci - gcj); }
    }
    asm volatile("s_waitcnt lgkmcnt(0)" ::: "memory");
    {   float xu[64];
        { const int cb = (C_QKVB + 1024 + h * 64) * 2, wo = 1024 + h * 64 + lane;
          const float w0 = cw[wo], w1 = cw[1536 + wo], w2 = cw[2 * 1536 + wo], w3 = cw[3 * 1536 + wo];
          float x0 = 0.f, x1 = 0.f, x2 = 0.f;
          if (n > 0) { x0 = bf2f(__builtin_amdgcn_raw_buffer_load_b16(rp, lane * 2, (m0 - 3) * (NAB * 2) + cb, 0)); x1 = bf2f(__builtin_amdgcn_raw_buffer_load_b16(rp, lane * 2, (m0 - 2) * (NAB * 2) + cb, 0)); x2 = bf2f(__builtin_amdgcn_raw_buffer_load_b16(rp, lane * 2, (m0 - 1) * (NAB * 2) + cb, 0)); }
#pragma unroll
          for (int i = 0; i < 64; ++i) { const float x3 = bf2f(__builtin_amdgcn_raw_buffer_load_b16(rp, lane * 2, (m0 + i) * (NAB * 2) + cb, 0)); xu[i] = siluf_(w0 * x0 + w1 * x1 + w2 * x2 + w3 * x3) * rdl(beta, i); x0 = x1; x1 = x2; x2 = x3; } }
        dn_solve(R2, xu);
        const int vo = q4 * 4096 + l15 * 16;
#pragma unroll
        for (int mt = 0; mt < 4; ++mt)
#pragma unroll
            for (int qq = 0; qq < 4; ++qq) { const int i0 = 16 * mt + 4 * qq; f32x4_t uv = {xu[i0], xu[i0 + 1], xu[i0 + 2], xu[i0 + 3]};
                __builtin_amdgcn_raw_buffer_store_b128(__builtin_bit_cast(v4u, uv), rx, (vo) + (DN_U + mt * 1024 + qq * 256), 0, 0); }
    }
    asm volatile("" ::: "memory");
    float xw[64];
#pragma unroll
    for (int i = 0; i < 64; ++i) xw[i] = bf2f(*(const LAS unsigned short*)(R1 + i * DN_KS + 2 * lane)) * rdl(bw, i);
    asm volatile("s_waitcnt lgkmcnt(0)" ::: "memory");
    { LAS unsigned char* row = R1 + lane * DN_KS;
#pragma unroll
      for (int i = 0; i < 8; ++i) { v4u w = *(LAS v4u*)(row + 16 * i);
          w.x = pkbf(bflo(w.x) * kdsc, bfhi(w.x) * kdsc); w.y = pkbf(bflo(w.y) * kdsc, bfhi(w.y) * kdsc); w.z = pkbf(bflo(w.z) * kdsc, bfhi(w.z) * kdsc); w.w = pkbf(bflo(w.w) * kdsc, bfhi(w.w) * kdsc);
          *(LAS v4u*)(row + 16 * i) = w; } }
    asm volatile("s_waitcnt lgkmcnt(0)" ::: "memory");
#pragma unroll
    for (int dt = 0; dt < 4; ++dt)
#pragma unroll
        for (int ks = 0; ks < 2; ++ks) { unsigned short e[8];
#pragma unroll
            for (int jj = 0; jj < 8; ++jj) e[jj] = *(const LAS unsigned short*)(R1 + (32 * ks + 16 * (jj >> 2) + 4 * q4 + (jj & 3)) * DN_KS + 2 * (16 * dt + l15));
            v4u w; w.x = e[0] | ((unsigned)e[1] << 16); w.y = e[2] | ((unsigned)e[3] << 16); w.z = e[4] | ((unsigned)e[5] << 16); w.w = e[6] | ((unsigned)e[7] << 16);
            __builtin_amdgcn_raw_buffer_store_b128(w, rx, (lane * 16) + (DN_KD + (dt * 2 + ks) * 1024), 0, 0); }
    asm volatile("s_waitcnt lgkmcnt(0)" ::: "memory");
    dn_solve(R2, xw);
#pragma unroll
    for (int i = 0; i < 64; ++i) *(LAS unsigned short*)(R1 + i * DN_KS + 2 * lane) = (unsigned short)(f2bf(xw[i]) ^ 0x8000u);
    asm volatile("s_waitcnt lgkmcnt(0)" ::: "memory");
#pragma unroll
    for (int mt = 0; mt < 4; ++mt)
#pragma unroll
        for (int ks = 0; ks < 2; ++ks) { const int row = 16 * mt + l15; const v2u a = *(const LAS v2u*)(R1 + row * DN_KS + 64 * ks + 8 * q4), bq = *(const LAS v2u*)(R1 + row * DN_KS + 64 * ks + 32 + 8 * q4);
            v4u w; w.x = a.x; w.y = a.y; w.z = bq.x; w.w = bq.y;
            __builtin_amdgcn_raw_buffer_store_b128(w, rx, (lane * 16) + (DN_W + (mt * 2 + ks) * 1024), 0, 0); }
    asm volatile("s_waitcnt lgkmcnt(0)" ::: "memory");
}
__device__ __forceinline__ void ph_dn_prep2(const Ctx& c, const Params& p, size_t xoff) {
    if (c.gw < 2048) dn_prep_chunk(c, p, c.gw, xoff);
}

constexpr int SC_SLOT = DN_CHB, SC_OB = 2 * DN_CHB, SC_OSTR = 272, SC_OBSZ = 64 * SC_OSTR;
__device__ __forceinline__ bf16x8_t pack8(const f32x4_t& a, const f32x4_t& b) { v4u w; w.x = pkbf(a[0], a[1]); w.y = pkbf(a[2], a[3]); w.z = pkbf(b[0], b[1]); w.w = pkbf(b[2], b[3]); return __builtin_bit_cast(bf16x8_t, w); }
__device__ __forceinline__ void ph_dn_scan2(const Ctx& c, const Params& p) {
    if (c.bid >= 32) return;
    const int b = c.bid >> 3, h = c.bid & 7, lane = c.lane;
    LAS unsigned char* lds = c.lds;
    const unsigned char* dnx = p.ws + WS_ACT + A_DNX + (size_t)(c.bid * 64) * DN_CHB; const float* EG = (const float*)(p.ws + WS_ACT + A_DNEG) + c.bid * 64;
    const bf16* P0 = (const bf16*)(p.ws + WS_ACT + A_P);
    if (c.wave >= 4) {
        const int lw = c.wave - 4, il = lane >> 2, qd = lane & 3;
        float nw[16];
#pragma unroll
        for (int k = 0; k < 16; ++k) nw[k] = p.in[I_DNNORM][16 * qd + k];
        v4u ra[12], rb[12], ga[2] = {{0u, 0u, 0u, 0u}, {0u, 0u, 0u, 0u}}, gb[2] = {{0u, 0u, 0u, 0u}, {0u, 0u, 0u, 0u}};
#define DN_LOAD(R, k) do { const v4u* _s = (const v4u*)(dnx + (size_t)(k) * DN_CHB) + lw * 64 + lane; _Pragma("unroll") for (int _i = 0; _i < 12; ++_i) R[_i] = _s[_i * 256]; } while (0)
#define DN_WRITE(R, slot) do { LAS v4u* _d = (LAS v4u*)(lds + (slot) * SC_SLOT) + lw * 64 + lane; _Pragma("unroll") for (int _i = 0; _i < 12; ++_i) _d[_i * 256] = R[_i]; } while (0)
#define DN_GLOAD(G, k) do { const v4u* _g = (const v4u*)(P0 + ((size_t)b * T + 64 * (k) + 16 * lw + il) * NAB + C_GATEB + h * 64 + 16 * qd); G[0] = _g[0]; G[1] = _g[1]; } while (0)
#define DN_EPI(G, k) do { const LAS unsigned char* _ob = lds + SC_OB + ((k) & 1) * SC_OBSZ + (16 * lw + il) * SC_OSTR + 64 * qd; float _o[16]; float _ss = 0.f; \
            _Pragma("unroll") for (int _i = 0; _i < 4; ++_i) { const f32x4_t _v = *(const LAS f32x4_t*)(_ob + 16 * _i); _o[4 * _i] = _v[0]; _o[4 * _i + 1] = _v[1]; _o[4 * _i + 2] = _v[2]; _o[4 * _i + 3] = _v[3]; _ss += (_v[0] * _v[0] + _v[1] * _v[1]) + (_v[2] * _v[2] + _v[3] * _v[3]); } \
            _ss += __shfl_xor(_ss, 1); _ss += __shfl_xor(_ss, 2); const float _rs = 1.0f / sqrtf(_ss * (1.f / 64.f) + 1e-6f); unsigned _w[8]; \
            _Pragma("unroll") for (int _i = 0; _i < 8; ++_i) { const unsigned _gw = G[_i >> 2][_i & 3]; const float _g0 = bflo(_gw), _g1 = bfhi(_gw); _w[_i] = pkbf(_o[2 * _i] * _rs * nw[2 * _i] * siluf_(_g0), _o[2 * _i + 1] * _rs * nw[2 * _i + 1] * siluf_(_g1)); } \
            v4u* _dst = (v4u*)((bf16*)(p.ws + WS_ACT + A_MIXA) + ((size_t)b * T + 64 * (k) + 16 * lw + il) * D + 512 + h * 64 + 16 * qd); _dst[0] = (v4u){_w[0], _w[1], _w[2], _w[3]}; _dst[1] = (v4u){_w[4], _w[5], _w[6], _w[7]}; } while (0)
        DN_LOAD(ra, 0); DN_WRITE(ra, 0); DN_LOAD(rb, 1); DN_LOAD(ra, 2);
        for (int n = 0; n < 64; n += 2) {
            asm volatile("s_waitcnt lgkmcnt(0)" ::: "memory"); __syncthreads();
            DN_WRITE(rb, 1);
            if (n >= 1) DN_EPI(gb, n - 1);
            DN_GLOAD(ga, n);
            if (n + 3 < 64) DN_LOAD(rb, n + 3);
            asm volatile("s_waitcnt lgkmcnt(0)" ::: "memory"); __syncthreads();
            if (n + 2 < 64) DN_WRITE(ra, 0);
            DN_EPI(ga, n);
            DN_GLOAD(gb, n + 1);
            if (n + 4 < 64) DN_LOAD(ra, n + 4);
        }
        asm volatile("s_waitcnt lgkmcnt(0)" ::: "memory"); __syncthreads();
        DN_EPI(gb, 63);
#undef DN_LOAD
#undef DN_WRITE
#undef DN_GLOAD
#undef DN_EPI
    } else {
        const int w = c.wave, e15 = lane & 15, q4 = lane >> 4;
        f32x4_t S[4];
#pragma unroll
        for (int dt = 0; dt < 4; ++dt) S[dt] = (f32x4_t){0.f, 0.f, 0.f, 0.f};
        float egn = EG[0];
#define DN_STEP(n_, slot) do { const LAS unsigned char* sb = lds + (slot) * SC_SLOT; const float eg = egn; egn = EG[(n_) + 1 < 64 ? (n_) + 1 : 63]; \
            const bf16x8_t Bs0 = pack8(S[0], S[1]), Bs1 = pack8(S[2], S[3]); f32x4_t vn[4], oo[4]; \
            _Pragma("unroll") for (int mt = 0; mt < 4; ++mt) { vn[mt] = *(const LAS f32x4_t*)(sb + DN_U + ((w * 4 + mt) * 64 + lane) * 16); \
                vn[mt] = __builtin_amdgcn_mfma_f32_16x16x32_bf16(*(const LAS bf16x8_t*)(sb + DN_W + ((mt * 2 + 0) * 64 + lane) * 16), Bs0, vn[mt], 0, 0, 0); \
                vn[mt] = __builtin_amdgcn_mfma_f32_16x16x32_bf16(*(const LAS bf16x8_t*)(sb + DN_W + ((mt * 2 + 1) * 64 + lane) * 16), Bs1, vn[mt], 0, 0, 0); \
                oo[mt] = (f32x4_t){0.f, 0.f, 0.f, 0.f}; \
                oo[mt] = __builtin_amdgcn_mfma_f32_16x16x32_bf16(*(const LAS bf16x8_t*)(sb + DN_QD + ((mt * 2 + 0) * 64 + lane) * 16), Bs0, oo[mt], 0, 0, 0); \
                oo[mt] = __builtin_amdgcn_mfma_f32_16x16x32_bf16(*(const LAS bf16x8_t*)(sb + DN_QD + ((mt * 2 + 1) * 64 + lane) * 16), Bs1, oo[mt], 0, 0, 0); } \
            const bf16x8_t Bv0 = pack8(vn[0], vn[1]), Bv1 = pack8(vn[2], vn[3]); \
            _Pragma("unroll") for (int mt = 0; mt < 4; ++mt) { \
                oo[mt] = __builtin_amdgcn_mfma_f32_16x16x32_bf16(*(const LAS bf16x8_t*)(sb + DN_QK + ((mt * 2 + 0) * 64 + lane) * 16), Bv0, oo[mt], 0, 0, 0); \
                if (mt >= 2) oo[mt] = __builtin_amdgcn_mfma_f32_16x16x32_bf16(*(const LAS bf16x8_t*)(sb + DN_QK + ((mt * 2 + 1) * 64 + lane) * 16), Bv1, oo[mt], 0, 0, 0); } \
            _Pragma("unroll") for (int dt = 0; dt < 4; ++dt) { S[dt] = S[dt] * eg; \
                S[dt] = __builtin_amdgcn_mfma_f32_16x16x32_bf16(*(const LAS bf16x8_t*)(sb + DN_KD + ((dt * 2 + 0) * 64 + lane) * 16), Bv0, S[dt], 0, 0, 0); \
                S[dt] = __builtin_amdgcn_mfma_f32_16x16x32_bf16(*(const LAS bf16x8_t*)(sb + DN_KD + ((dt * 2 + 1) * 64 + lane) * 16), Bv1, S[dt], 0, 0, 0); } \
            LAS unsigned char* ob = lds + SC_OB + ((n_) & 1) * SC_OBSZ + (16 * w + e15) * 4; \
            _Pragma("unroll") for (int mt = 0; mt < 4; ++mt) _Pragma("unroll") for (int r4 = 0; r4 < 4; ++r4) *(LAS float*)(ob + (16 * mt + 4 * q4 + r4) * SC_OSTR) = oo[mt][r4]; } while (0)
        for (int n = 0; n < 64; n += 2) {
            asm volatile("s_waitcnt lgkmcnt(0)" ::: "memory"); __syncthreads();
            DN_STEP(n, 0);
            asm volatile("s_waitcnt lgkmcnt(0)" ::: "memory"); __syncthreads();
            DN_STEP(n + 1, 1);
        }
        asm volatile("s_waitcnt lgkmcnt(0)" ::: "memory"); __syncthreads();
#undef DN_STEP
    }
}


constexpr size_t A_ODN = 257 * MiB;
__device__ __forceinline__ void ph_dn_scan_simple(const Ctx& c, const Params& p) {
    if (c.bid >= 32 || c.wave >= 4) return;
    const int b = c.bid >> 3, h = c.bid & 7, lane = c.lane, w = c.wave, e15 = lane & 15, q4 = lane >> 4;
    const unsigned char* dnx = p.ws + WS_ACT + A_DNX + (size_t)(c.bid * 64) * DN_CHB; const float* EG = (const float*)(p.ws + WS_ACT + A_DNEG) + c.bid * 64;
    float* ODN = (float*)(p.ws + WS_ACT + A_ODN);
    f32x4_t S[4];
#pragma unroll
    for (int dt = 0; dt < 4; ++dt) S[dt] = (f32x4_t){0.f, 0.f, 0.f, 0.f};
    for (int n = 0; n < 64; ++n) { const unsigned char* sb = dnx + (size_t)n * DN_CHB; const float eg = EG[n];
        const bf16x8_t Bs0 = pack8(S[0], S[1]), Bs1 = pack8(S[2], S[3]); f32x4_t vn[4], oo[4];
#pragma unroll
        for (int mt = 0; mt < 4; ++mt) { vn[mt] = *(const f32x4_t*)(sb + DN_U + ((w * 4 + mt) * 64 + lane) * 16);
            vn[mt] = __builtin_amdgcn_mfma_f32_16x16x32_bf16(*(const bf16x8_t*)(sb + DN_W + ((mt * 2 + 0) * 64 + lane) * 16), Bs0, vn[mt], 0, 0, 0);
            vn[mt] = __builtin_amdgcn_mfma_f32_16x16x32_bf16(*(const bf16x8_t*)(sb + DN_W + ((mt * 2 + 1) * 64 + lane) * 16), Bs1, vn[mt], 0, 0, 0);
            oo[mt] = (f32x4_t){0.f, 0.f, 0.f, 0.f};
            oo[mt] = __builtin_amdgcn_mfma_f32_16x16x32_bf16(*(const bf16x8_t*)(sb + DN_QD + ((mt * 2 + 0) * 64 + lane) * 16), Bs0, oo[mt], 0, 0, 0);
            oo[mt] = __builtin_amdgcn_mfma_f32_16x16x32_bf16(*(const bf16x8_t*)(sb + DN_QD + ((mt * 2 + 1) * 64 + lane) * 16), Bs1, oo[mt], 0, 0, 0); }
        const bf16x8_t Bv0 = pack8(vn[0], vn[1]), Bv1 = pack8(vn[2], vn[3]);
#pragma unroll
        for (int mt = 0; mt < 4; ++mt) {
            oo[mt] = __builtin_amdgcn_mfma_f32_16x16x32_bf16(*(const bf16x8_t*)(sb + DN_QK + ((mt * 2 + 0) * 64 + lane) * 16), Bv0, oo[mt], 0, 0, 0);
            oo[mt] = __builtin_amdgcn_mfma_f32_16x16x32_bf16(*(const bf16x8_t*)(sb + DN_QK + ((mt * 2 + 1) * 64 + lane) * 16), Bv1, oo[mt], 0, 0, 0); }
#pragma unroll
        for (int dt = 0; dt < 4; ++dt) { S[dt] = S[dt] * eg;
            S[dt] = __builtin_amdgcn_mfma_f32_16x16x32_bf16(*(const bf16x8_t*)(sb + DN_KD + ((dt * 2 + 0) * 64 + lane) * 16), Bv0, S[dt], 0, 0, 0);
            S[dt] = __builtin_amdgcn_mfma_f32_16x16x32_bf16(*(const bf16x8_t*)(sb + DN_KD + ((dt * 2 + 1) * 64 + lane) * 16), Bv1, S[dt], 0, 0, 0); }
#pragma unroll
        for (int mt = 0; mt < 4; ++mt)
#pragma unroll
            for (int r4 = 0; r4 < 4; ++r4) ODN[((size_t)b * T + 64 * n + 16 * mt + 4 * q4 + r4) * 512 + h * 64 + 16 * w + e15] = oo[mt][r4];
    }
}
__device__ __forceinline__ void ph_dn_epi_simple(const Ctx& c, const Params& p) {
    const float* ODN = (const float*)(p.ws + WS_ACT + A_ODN); const bf16* P0 = (const bf16*)(p.ws + WS_ACT + A_P);
    for (int it = c.gw; it < M * 8; it += c.NGW) { const int m = it >> 3, h = it & 7;
        const float o = ODN[(size_t)m * 512 + h * 64 + c.lane];
        const float rs = 1.0f / sqrtf(wave_sum(o * o) * (1.f / 64.f) + 1e-6f);
        const float gt = bf2f(P0[(size_t)m * NAB + C_GATEB + h * 64 + c.lane]);
        ((bf16*)(p.ws + WS_ACT + A_MIXA))[(size_t)m * D + 512 + h * 64 + c.lane] = (bf16)f2bf(o * rs * p.in[I_DNNORM][c.lane] * siluf_(gt)); }
}

__global__ void __launch_bounds__(NTHR, 2) mega(MArgs a) {
    extern __shared__ __attribute__((aligned(16))) unsigned char lds_raw[];
    Ctx c; c.lds = (LAS unsigned char*)lds_raw; c.tid = threadIdx.x; c.lane = c.tid & 63; c.wave = __builtin_amdgcn_readfirstlane(c.tid >> 6);
    c.G = gridDim.x; c.bid = blockIdx.x; c.gw = c.bid * NWAVES + c.wave; c.NGW = c.G * NWAVES;
    const Params& p = a.p;
    volatile LAS unsigned* MISC = (volatile LAS unsigned*)(c.lds + LDS_MISC);
    if (c.tid < 64) MISC[c.tid] = 0u;
    __syncthreads();
    XcdBarrier bar = xcd_barrier_post((unsigned*)(p.ws + WS_CTL) + CW_BAR, MISC);
    const int lo = a.ph_lo, hi = a.ph_hi;
#define IN(k) (lo <= (k) && (k) < hi)
#define SEAM(k) do { if (IN(k) && IN((k) + 1)) xcd_barrier(bar); } while (0)
#ifndef DUP_MASK
#define DUP_MASK 0
#endif
#define DUP(k) ((DUP_MASK >> (k)) & 1)
    if (IN(0)) { ph_convert(c, a.t1, c.gw, c.NGW); ph_ada(c, p); if (DUP(0)) { xcd_barrier(bar); ph_convert(c, a.t1, c.gw, c.NGW); ph_ada(c, p); } } SEAM(0);
    if (IN(1)) { ph_norm<0>(c, p); if (DUP(1)) { xcd_barrier(bar); ph_norm<0>(c, p); } } SEAM(1);
    if (IN(2)) { ph_gemm<G_ABIN>(c, p); if (DUP(2)) { xcd_barrier(bar); ph_gemm<G_ABIN>(c, p); } } SEAM(2);
    if (IN(3)) { ph_dn_prep2(c, p, A_DNX + WS_ACT); if (DUP(3)) { xcd_barrier(bar); ph_dn_prep2(c, p, A_DNX + WS_ACT); } } SEAM(3);
    if (IN(4)) { if (c.bid < 32) ph_dn_scan2(c, p); else { for (int u = c.bid - 32; u < 256; u += c.G - 32) attn_unit(c, p, u); __syncthreads(); ph_convert(c, a.t2, (c.bid - 32) * NWAVES + c.wave, (c.G - 32) * NWAVES); } if (DUP(4)) { xcd_barrier(bar); if (c.bid < 32) ph_dn_scan2(c, p); else { for (int u = c.bid - 32; u < 256; u += c.G - 32) attn_unit(c, p, u); __syncthreads(); ph_convert(c, a.t2, (c.bid - 32) * NWAVES + c.wave, (c.G - 32) * NWAVES); } } if (DUP(20)) { xcd_barrier(bar); if (c.bid < 32) ph_dn_scan2(c, p); } } SEAM(4);
    if (IN(5)) { ph_gemm<G_ABOUT>(c, p); if (DUP(5)) { xcd_barrier(bar); ph_gemm<G_ABOUT>(c, p); } } SEAM(5);
    if (IN(6)) { ph_norm<1>(c, p); if (DUP(6)) { xcd_barrier(bar); ph_norm<1>(c, p); } } SEAM(6);
    if (IN(7)) { ph_gemm<G_FFNGU>(c, p); if (DUP(7)) { xcd_barrier(bar); ph_gemm<G_FFNGU>(c, p); } } SEAM(7);
    if (IN(8)) { if (DUP(8)) { ph_gemm<G_FFND_PROBE>(c, p); xcd_barrier(bar); } ph_gemm<G_FFND>(c, p); } SEAM(8);
    if (IN(9)) { ph_norm<2>(c, p); if (DUP(9)) { xcd_barrier(bar); ph_norm<2>(c, p); } } SEAM(9);
    if (IN(10)) { ph_gemm<G_CDIN>(c, p); if (DUP(10)) { xcd_barrier(bar); ph_gemm<G_CDIN>(c, p); } } SEAM(10);
    if (IN(11)) { ph_lru1(c, p); ph_sconv(c, p); if (DUP(11)) { xcd_barrier(bar); ph_lru1(c, p); ph_sconv(c, p); } } SEAM(11);
    if (IN(12)) { ph_lru2(c, p); if (DUP(12)) { xcd_barrier(bar); ph_lru2(c, p); } } SEAM(12);
    if (IN(13)) { if (DUP(13)) { ph_gemm<G_CDOUT_PROBE>(c, p); xcd_barrier(bar); } ph_gemm<G_CDOUT>(c, p); } SEAM(13);
    if (IN(14)) { ph_norm<3>(c, p); } SEAM(14);
    if (IN(15)) { ph_route(c, p, 0); if (DUP(15)) { xcd_barrier(bar); ph_route(c, p, 64); } } SEAM(15);
    if (IN(16)) { ph_gemm<G_MOEGU>(c, p); if (DUP(16)) { xcd_barrier(bar); ph_gemm<G_MOEGU>(c, p); } } SEAM(16);
    if (IN(17)) { ph_gemm<G_MOED>(c, p); if (DUP(17)) { xcd_barrier(bar); ph_gemm<G_MOED>(c, p); } } SEAM(17);
    if (IN(18)) { if (DUP(18)) { ph_final<true>(c, p); xcd_barrier(bar); } ph_final<false>(c, p); }
#undef IN
#undef SEAM
}

constexpr int N_PHASES = 19;
static void add_desc(ConvTab& t, const float* src, bf16* dst, int K, int N, int Npad, int mode, int row_off, int nbatch, long long sstride, long long dstride) {
    ConvDesc& d = t.d[t.nd]; d.src = src; d.dst = dst; d.sstride = sstride; d.dstride = dstride; d.K = K; d.N = N; d.Npad = Npad; d.mode = mode; d.row_off = row_off; d.nbatch = nbatch;
    d.items_pb = (K / 64) * (Npad / 64); d.item0 = t.total; t.total += d.items_pb * nbatch; t.nd++;
}
extern "C" void kernel_launch(void* const* d_in, const int* in_sizes, int n_in, void* d_out, int out_size, void* d_ws, size_t ws_size, hipStream_t stream) {
    static int grid = 0;
    if (grid == 0) {
        if (n_in != 33 || out_size != M * D || ws_size < WS_END) { fprintf(stderr, "kernel_launch: unexpected shapes (n_in %d out %d ws %zu)\n", n_in, out_size, ws_size); grid = -1; return; }
        int dev = 0, cus = 0;
        if (hipGetDevice(&dev) != hipSuccess || hipDeviceGetAttribute(&cus, hipDeviceAttributeMultiprocessorCount, dev) != hipSuccess) { grid = -1; return; }
        if (hipFuncSetAttribute((const void*)mega, hipFuncAttributeMaxDynamicSharedMemorySize, LDS_BYTES) != hipSuccess) { fprintf(stderr, "kernel_launch: hipFuncSetAttribute failed\n"); grid = -1; return; }
        int per_cu = 0;
        if (hipOccupancyMaxActiveBlocksPerMultiprocessor(&per_cu, (const void*)mega, NTHR, LDS_BYTES) != hipSuccess || per_cu < 1) { fprintf(stderr, "kernel_launch: occupancy query says %d\n", per_cu); }
        (void)hipGetLastError();
        grid = cus;
    }
    if (grid < 0) return;
    MArgs a{};
    for (int i = 0; i < 33; ++i) a.p.in[i] = (const float*)d_in[i];
    a.p.out = (float*)d_out; a.p.ws = (unsigned char*)d_ws;
    unsigned char* ws = a.p.ws; const Params& p = a.p;
    (void)hipMemsetAsync(ws + WS_CTL, 0, CTL_ZERO_BYTES, stream);
    add_desc(a.t1, p.in[I_ABIN], (bf16*)(ws + WS_WAB_IN), D, 2832, NAB, 0, 0, 1, 0, 0);
    add_desc(a.t1, p.in[I_ABOUT], (bf16*)(ws + WS_WAB_OUT), D, D, D, 0, 0, 1, 0, 0);
    add_desc(a.t1, p.in[I_FG], (bf16*)(ws + WS_WFFN_GU), D, FF, FF, 1, 0, 1, 0, 0);
    add_desc(a.t1, p.in[I_FU], (bf16*)(ws + WS_WFFN_GU), D, FF, FF, 1, 128, 1, 0, 0);
    add_desc(a.t1, p.in[I_FD], (bf16*)(ws + WS_WFFN_D), FF, D, D, 0, 0, 1, 0, 0);
    add_desc(a.t1, p.in[I_CDIN], (bf16*)(ws + WS_WCD_IN), D, NCD, NCD, 0, 0, 1, 0, 0);
    add_desc(a.t1, p.in[I_CDOUT], (bf16*)(ws + WS_WCD_OUT), CDO, D, D, 0, 0, 1, 0, 0);
    add_desc(a.t1, p.in[I_GAW], (bf16*)(ws + WS_WLRU), 128, 128, 128, 0, 0, 8, 128 * 128, 256 * 128);
    add_desc(a.t1, p.in[I_GXW], (bf16*)(ws + WS_WLRU), 128, 128, 128, 0, 128, 8, 128 * 128, 256 * 128);
    add_desc(a.t2, p.in[I_MG], (bf16*)(ws + WS_WMOE_GU), D, FFE, FFE, 1, 0, NE, (long long)D * FFE, (long long)2 * FFE * D);
    add_desc(a.t2, p.in[I_MU], (bf16*)(ws + WS_WMOE_GU), D, FFE, FFE, 1, 128, NE, (long long)D * FFE, (long long)2 * FFE * D);
    add_desc(a.t2, p.in[I_MD], (bf16*)(ws + WS_WMOE_D), FFE, D, D, 0, 0, NE, (long long)FFE * D, (long long)D * FFE);
    a.ph_lo = 0; a.ph_hi = N_PHASES;
    hipLaunchKernelGGL(mega, dim3(grid), dim3(NTHR), LDS_BYTES, stream, a);
}
```

```cpp
#define DUP_MASK 0
#include <hip/hip_runtime.h>
#include <cstdio>
#include <cstdint>
namespace pg8 {
#define PG8_LAS __attribute__((address_space(3)))
typedef unsigned short bf16_t;
typedef short bf16x8 __attribute__((ext_vector_type(8)));
typedef float f32x4 __attribute__((ext_vector_type(4)));
typedef unsigned u32x4 __attribute__((ext_vector_type(4)));
constexpr int BM = 256, BK = 64, HALF = 128, HTB = HALF * BK * 2  , STAGE_BYTES = 8 * HTB, NXCD = 8, WGM = 8;

__host__ __device__ __forceinline__ int lds_byte(int r, int c) { const int st = (r >> 4) * 2 + (c >> 5), rr = r & 15, cc = c & 31, ob = rr * 64 + cc * 2; return st * 1024 + (ob ^ (((ob >> 9) & 1) << 5)); }
__host__ __device__ __forceinline__ void stage_rc(int b, int& R, int& C) { const int st = b / 1024, sb = b % 1024, swz = sb ^ (((sb >> 9) & 1) << 5); R = (st >> 1) * 16 + swz / 64; C = (st & 1) * 32 + (swz % 64) / 2; }
__host__ __device__ __forceinline__ int perm32(int rho) { const int n = rho >> 4, i = rho & 15; return 8 * (i >> 2) + 4 * n + (i & 3); }

struct Unit { int pm, pn, e; };
struct Gemm { const bf16_t* A; const bf16_t* Bt; int M, N, K; size_t eb; };

struct StaticOrder {
    int nM, nN, nwg, G, c;
    __host__ __device__ void init(int M, int N, int G_, int c_) { nM = M / BM; nN = N / BM; nwg = nM * nN; G = G_; c = c_; }
    __host__ __device__ bool next(int i, Unit& u) const {
        const long L = (long)i * G + c; if (L >= nwg) return false;
        int wgid = (int)L; { const int q = nwg / NXCD, r = nwg % NXCD, xcd = wgid % NXCD, off = wgid / NXCD; wgid = (xcd < r ? xcd * (q + 1) : r * (q + 1) + (xcd - r) * q) + off; }
        const int nig = WGM * nN, gid = wgid / nig, fm = gid * WGM, gsz = (nM - fm) < WGM ? (nM - fm) : WGM;
        u.pm = fm + ((wgid % nig) % gsz); u.pn = (wgid % nig) / gsz; u.e = 0; return true;
    }
    __device__ __forceinline__ void a_ready(const Unit&) const {}
    __device__ __forceinline__ void done(const Unit&) const {}
};

__device__ __forceinline__ unsigned cvt_pk_bf16(float lo, float hi) { unsigned r; asm volatile("v_cvt_pk_bf16_f32 %0, %1, %2" : "=v"(r) : "v"(lo), "v"(hi)); return r; }

__device__ __forceinline__ float fast_silu(float g) { return g * __builtin_amdgcn_rcpf(1.0f + __expf(-g)); }
struct EpiStoreBf16 {
    static constexpr bool PERM = true, AFTER_DRAIN = false;
    bf16_t* O; int ldc; const float* rowscale;
    __device__ __forceinline__ void operator()(const f32x4 (&acc)[2][2][4][2], const Unit& u, int wr, int wc, int fr, int fq) const {
        const int row0 = u.pm * BM + wr * 64 + fr, col0 = u.pn * BM + wc * 32 + 8 * fq;
#pragma unroll
        for (int ai = 0; ai < 2; ++ai)
#pragma unroll
            for (int m = 0; m < 4; ++m) { const int row = row0 + ai * HALF + m * 16; bf16_t* rowp = O + (size_t)row * ldc + col0;
                const float s = rowscale ? rowscale[row] : 1.f;
#pragma unroll
                for (int bj = 0; bj < 2; ++bj) { const f32x4 v0 = acc[ai][bj][m][0] * s, v1 = acc[ai][bj][m][1] * s;
                    u32x4 w; w.x = cvt_pk_bf16(v0[0], v0[1]); w.y = cvt_pk_bf16(v0[2], v0[3]); w.z = cvt_pk_bf16(v1[0], v1[1]); w.w = cvt_pk_bf16(v1[2], v1[3]);
                    *(u32x4*)(rowp + bj * HALF) = w; } }
    }
};
struct EpiSwiglu {
    static constexpr bool PERM = true, AFTER_DRAIN = false;
    bf16_t* O; int ldc;
    __device__ __forceinline__ void operator()(const f32x4 (&acc)[2][2][4][2], const Unit& u, int wr, int wc, int fr, int fq) const {
        const int row0 = u.pm * BM + wr * 64 + fr, col0 = u.pn * HALF + wc * 32 + 8 * fq;
#pragma unroll
        for (int ai = 0; ai < 2; ++ai)
#pragma unroll
            for (int m = 0; m < 4; ++m) { const int row = row0 + ai * HALF + m * 16; bf16_t* rowp = O + (size_t)row * ldc + col0;
                const f32x4 g0 = acc[ai][0][m][0], g1 = acc[ai][0][m][1], u0 = acc[ai][1][m][0], u1 = acc[ai][1][m][1];
                float h[8];
#pragma unroll
                for (int i = 0; i < 4; ++i) { h[i] = fast_silu(g0[i]) * u0[i]; h[4 + i] = fast_silu(g1[i]) * u1[i]; }
                u32x4 w; w.x = cvt_pk_bf16(h[0], h[1]); w.y = cvt_pk_bf16(h[2], h[3]); w.z = cvt_pk_bf16(h[4], h[5]); w.w = cvt_pk_bf16(h[6], h[7]);
                *(u32x4*)rowp = w; }
    }
};
struct EpiRes {
    static constexpr bool PERM = false, AFTER_DRAIN = false;
    const float* base; float* out; int ldc; const float* gate;
    __device__ __forceinline__ void operator()(const f32x4 (&acc)[2][2][4][2], const Unit& u, int wr, int wc, int fr, int fq) const {
        const int row0 = u.pm * BM + wr * 64 + fr, col0 = u.pn * BM + wc * 32 + 4 * fq;
        const float* gp = gate + (size_t)(u.pm >> 4) * 6144 + col0;
        f32x4 gv[2][2];
#pragma unroll
        for (int bj = 0; bj < 2; ++bj)
#pragma unroll
            for (int n = 0; n < 2; ++n) gv[bj][n] = *(const f32x4*)(gp + bj * HALF + n * 16);
#pragma unroll
        for (int ai = 0; ai < 2; ++ai)
#pragma unroll
            for (int m = 0; m < 4; ++m) { const size_t off = (size_t)(row0 + ai * HALF + m * 16) * ldc + col0;
#pragma unroll
                for (int bj = 0; bj < 2; ++bj)
#pragma unroll
                    for (int n = 0; n < 2; ++n) { const f32x4 bs = *(const f32x4*)(base + off + bj * HALF + n * 16);
                        *(f32x4*)(out + off + bj * HALF + n * 16) = bs + gv[bj][n] * acc[ai][bj][m][n]; } }
    }
};

__device__ __forceinline__ unsigned pk_fp8x4(float a, float b, float c, float d) { int w = 0; w = __builtin_amdgcn_cvt_pk_fp8_f32(a, b, w, false); w = __builtin_amdgcn_cvt_pk_fp8_f32(c, d, w, true); return (unsigned)w; }
constexpr float WSCALE = 1.0f / 64.0f;
typedef unsigned u32x2 __attribute__((ext_vector_type(2)));
struct EpiSwiglu8 {
    static constexpr bool PERM = true, AFTER_DRAIN = false;
    unsigned char* O; int ldc;
    __device__ __forceinline__ void operator()(const f32x4 (&acc)[2][2][4][2], const Unit& u, int wr, int wc, int fr, int fq) const {
        const unsigned off0 = (unsigned)(u.pm * BM + wr * 64 + fr) * (unsigned)ldc + (unsigned)(u.pn * HALF + wc * 32 + 8 * fq);
#pragma unroll
        for (int ai = 0; ai < 2; ++ai)
#pragma unroll
            for (int m = 0; m < 4; ++m) { unsigned char* rowp = O + (size_t)(off0 + (unsigned)((ai * HALF + m * 16) * ldc));
#pragma unroll
                for (int n = 0; n < 2; ++n) { const f32x4 g = acc[ai][0][m][n], uu = acc[ai][1][m][n];
                    *(unsigned*)(rowp + 4 * n) = pk_fp8x4(fast_silu(g[0]) * uu[0], fast_silu(g[1]) * uu[1], fast_silu(g[2]) * uu[2], fast_silu(g[3]) * uu[3]); } }
    }
};
struct EpiStoreBf16S {
    static constexpr bool PERM = true, AFTER_DRAIN = false;
    bf16_t* O; int ldc; const float* rowscale;
    __device__ __forceinline__ void operator()(const f32x4 (&acc)[2][2][4][2], const Unit& u, int wr, int wc, int fr, int fq) const {
        asm volatile("" : "+v"(fr), "+v"(fq));
        const int row0 = u.pm * BM + wr * 64 + fr, col0 = u.pn * BM + wc * 32 + 8 * fq;
#pragma unroll
        for (int ai = 0; ai < 2; ++ai)
#pragma unroll
            for (int m = 0; m < 4; ++m) { const int row = row0 + ai * HALF + m * 16; bf16_t* rowp = O + (size_t)row * ldc + col0;
                const float s = rowscale[row];
#pragma unroll
                for (int bj = 0; bj < 2; ++bj) { const f32x4 v0 = acc[ai][bj][m][0] * s, v1 = acc[ai][bj][m][1] * s;
                    u32x4 w; w.x = cvt_pk_bf16(v0[0], v0[1]); w.y = cvt_pk_bf16(v0[2], v0[3]); w.z = cvt_pk_bf16(v1[0], v1[1]); w.w = cvt_pk_bf16(v1[2], v1[3]);
                    *(u32x4*)(rowp + bj * HALF) = w; } }
    }
};
struct GroupedOrder {
    int nM, nN, nwg, G, c; const int* tile_e;
    __device__ void init(int nMt, int N, int G_, int c_, const int* te) { nM = nMt; nN = N / BM; nwg = nM * nN; G = G_; c = c_; tile_e = te; }
    __device__ bool next(int i, Unit& u) const {
        const int L = i * G + c; if (L >= nwg) return false;
        u.pm = L / nN; u.pn = L - u.pm * nN; u.e = __builtin_amdgcn_readfirstlane(tile_e[u.pm]); return true;
    }
    __device__ __forceinline__ void a_ready(const Unit&) const {}
    __device__ __forceinline__ void done(const Unit&) const {}
};

template <class Epi, class Sched, bool ALIGN_EPI = false, bool SP2 = false>
__device__ __forceinline__ void gemm_phase(PG8_LAS unsigned char* lds, const Gemm g, const Sched& S, const Epi& E) {
    const int tid = threadIdx.x, wid = __builtin_amdgcn_readfirstlane(tid >> 6), lane = tid & 63, wr = wid >> 2, wc = wid & 3, fr = lane & 15, fq = lane >> 4;
    const int K = g.K, nt = K / BK;
    unsigned voffA[2], voffB[2];
#pragma unroll
    for (int i = 0; i < 2; ++i) { int R, C; stage_rc(tid * 16 + i * 8192, R, C); const int Rb = Epi::PERM ? ((R & ~31) + perm32(R & 31)) : R;
        voffA[i] = (unsigned)(R * K + C) * 2u; voffB[i] = (unsigned)(Rb * K + C) * 2u; }
    const size_t kstep = (size_t)(BK * 2);
    const size_t hstep = (size_t)HALF * K * 2;
    const size_t tstep = 2 * hstep;
    const unsigned ldsw = (unsigned)wid * 1024u;
    const int aoff = lds_byte(wr * 64 + fr, fq * 8), boff = lds_byte(wc * 32 + fr, fq * 8);
#define PG8_SA(b, h) (((b) * 2 + (h)) * HTB)
#define PG8_SB(b, h) ((4 + (b) * 2 + (h)) * HTB)
#define PG8_STAGE(bufoff, gbase, voff) do { _Pragma("unroll") for (int _i = 0; _i < 2; ++_i) \
        __builtin_amdgcn_global_load_lds((const unsigned*)((const char*)(gbase) + (voff)[_i]), (PG8_LAS unsigned*)(lds + (bufoff) + ldsw + _i * 8192), 16, 0, 0); } while (0)
#define PG8_LDA(dst, b, h) do { _Pragma("unroll") for (int m = 0; m < 4; ++m) _Pragma("unroll") for (int k = 0; k < 2; ++k) dst[m][k] = *(const PG8_LAS bf16x8*)(lds + PG8_SA(b, h) + aoff + m * 2048 + k * 1024); } while (0)
#define PG8_LDB(dst, b, h) do { _Pragma("unroll") for (int n = 0; n < 2; ++n) _Pragma("unroll") for (int k = 0; k < 2; ++k) dst[n][k] = *(const PG8_LAS bf16x8*)(lds + PG8_SB(b, h) + boff + n * 2048 + k * 1024); } while (0)
#define PG8_MMA(ai, bj, At, Bt) do { __builtin_amdgcn_s_setprio(1); _Pragma("unroll") for (int m = 0; m < 4; ++m) _Pragma("unroll") for (int n = 0; n < 2; ++n) _Pragma("unroll") for (int k = 0; k < 2; ++k) \
        acc[ai][bj][m][n] = __builtin_amdgcn_mfma_f32_16x16x32_bf16(Bt[n][k], At[m][k], acc[ai][bj][m][n], 0, 0, 0); __builtin_amdgcn_s_setprio(0); } while (0)
#define PG8_WAIT_V(n) asm volatile("s_waitcnt vmcnt(" #n ")" ::: "memory")
#define PG8_WAIT_L(n) asm volatile("s_waitcnt lgkmcnt(" #n ")" ::: "memory")
#define PG8_BAR __builtin_amdgcn_s_barrier()
#define PG8_SCHED __builtin_amdgcn_sched_barrier(0)
    Unit cur, nxt; int ui = 0;
    if (!S.next(0, cur)) return;
    f32x4 acc[2][2][4][2];
#pragma unroll
    for (int a = 0; a < 2; ++a)
#pragma unroll
        for (int b = 0; b < 2; ++b)
#pragma unroll
            for (int m = 0; m < 4; ++m)
#pragma unroll
                for (int n = 0; n < 2; ++n) acc[a][b][m][n] = (f32x4){0.f, 0.f, 0.f, 0.f};
    bf16x8 At[4][2], B0[2][2], B1[2][2];
    const char* cA = (const char*)g.A + (size_t)cur.pm * tstep; const char* cB = (const char*)g.Bt + (size_t)cur.e * g.eb + (size_t)cur.pn * tstep;
    S.a_ready(cur);
    if constexpr (SP2) {
        PG8_STAGE(PG8_SB(0, 0), cB, voffB); PG8_STAGE(PG8_SB(0, 1), cB + hstep, voffB); PG8_STAGE(PG8_SA(0, 0), cA, voffA); PG8_STAGE(PG8_SA(0, 1), cA + hstep, voffA);
        if (wr == 1) PG8_BAR;
        PG8_WAIT_V(2); PG8_BAR;
        PG8_STAGE(PG8_SB(1, 0), cB + kstep, voffB); PG8_STAGE(PG8_SA(1, 0), cA + kstep, voffA); PG8_STAGE(PG8_SB(1, 1), cB + hstep + kstep, voffB);
        PG8_WAIT_V(6); PG8_BAR;
    } else {
        PG8_STAGE(PG8_SB(0, 0), cB, voffB); PG8_STAGE(PG8_SA(0, 0), cA, voffA); PG8_STAGE(PG8_SB(0, 1), cB + hstep, voffB); PG8_STAGE(PG8_SA(0, 1), cA + hstep, voffA);
        if (wr == 1) PG8_BAR;
        PG8_WAIT_V(4); PG8_BAR;
        PG8_STAGE(PG8_SB(1, 0), cB + kstep, voffB); PG8_STAGE(PG8_SA(1, 0), cA + kstep, voffA); PG8_STAGE(PG8_SB(1, 1), cB + hstep + kstep, voffB);
        PG8_WAIT_V(6); PG8_BAR;
    }
    for (;;) {
        const bool has_next = S.next(ui + 1, nxt);
        const char* nA = has_next ? (const char*)g.A + (size_t)nxt.pm * tstep : cA; const char* nB = has_next ? (const char*)g.Bt + (size_t)nxt.e * g.eb + (size_t)nxt.pn * tstep : cB;
        for (int t = 0; t < nt; t += 2) {
            const bool last = (t == nt - 2);
            const char* a1 = cA + (size_t)(t + 1) * kstep;
            const char* a2 = last ? nA : cA + (size_t)(t + 2) * kstep; const char* b2 = last ? nB : cB + (size_t)(t + 2) * kstep;
            const char* a3 = a2 + kstep; const char* b3 = b2 + kstep;
            if (last && has_next) S.a_ready(nxt);
            if constexpr (SP2) {
            PG8_LDB(B0, 0, 0); PG8_LDB(B1, 0, 1); PG8_SCHED; PG8_LDA(At, 0, 0); PG8_STAGE(PG8_SA(1, 1), a1 + hstep, voffA);
            PG8_WAIT_V(8); PG8_WAIT_L(0); PG8_BAR; PG8_MMA(0, 0, At, B0); PG8_MMA(0, 1, At, B1); PG8_BAR; PG8_SCHED;
            PG8_LDA(At, 0, 1); PG8_STAGE(PG8_SB(0, 0), b2, voffB); PG8_STAGE(PG8_SB(0, 1), b2 + hstep, voffB); PG8_STAGE(PG8_SA(0, 0), a2, voffA);
            PG8_WAIT_V(8); PG8_WAIT_L(0); PG8_BAR; PG8_MMA(1, 0, At, B0); PG8_MMA(1, 1, At, B1); PG8_BAR; PG8_SCHED;
            PG8_LDB(B0, 1, 0); PG8_LDB(B1, 1, 1); PG8_SCHED; PG8_LDA(At, 1, 0); PG8_STAGE(PG8_SA(0, 1), a2 + hstep, voffA);
            PG8_WAIT_V(8); PG8_WAIT_L(0); PG8_BAR; PG8_MMA(0, 0, At, B0); PG8_MMA(0, 1, At, B1); PG8_BAR; PG8_SCHED;
            PG8_LDA(At, 1, 1); PG8_STAGE(PG8_SB(1, 0), b3, voffB); PG8_STAGE(PG8_SB(1, 1), b3 + hstep, voffB); PG8_STAGE(PG8_SA(1, 0), a3, voffA);
            PG8_WAIT_V(8); PG8_WAIT_L(0); PG8_BAR; PG8_MMA(1, 0, At, B0); PG8_MMA(1, 1, At, B1); PG8_BAR; PG8_SCHED;
            } else {
            PG8_LDB(B0, 0, 0); PG8_SCHED; PG8_LDA(At, 0, 0); PG8_STAGE(PG8_SA(1, 1), a1 + hstep, voffA);
            PG8_WAIT_L(8); PG8_BAR; PG8_WAIT_L(0); PG8_MMA(0, 0, At, B0); PG8_BAR; PG8_SCHED;
            PG8_LDB(B1, 0, 1); PG8_STAGE(PG8_SB(0, 0), b2, voffB);
            PG8_BAR; PG8_WAIT_L(0); PG8_MMA(0, 1, At, B1); PG8_BAR;
            PG8_LDA(At, 0, 1); PG8_STAGE(PG8_SA(0, 0), a2, voffA);
            PG8_BAR; PG8_WAIT_L(0); PG8_MMA(1, 0, At, B0); PG8_BAR; PG8_SCHED;
            PG8_STAGE(PG8_SB(0, 1), b2 + hstep, voffB);
            PG8_WAIT_V(6); PG8_BAR; PG8_MMA(1, 1, At, B1); PG8_BAR;
            PG8_LDB(B0, 1, 0); PG8_SCHED; PG8_LDA(At, 1, 0); PG8_STAGE(PG8_SA(0, 1), a2 + hstep, voffA);
            PG8_WAIT_L(8); PG8_BAR; PG8_WAIT_L(0); PG8_MMA(0, 0, At, B0); PG8_BAR; PG8_SCHED;
            PG8_LDB(B1, 1, 1); PG8_STAGE(PG8_SB(1, 0), b3, voffB);
            PG8_BAR; PG8_WAIT_L(0); PG8_MMA(0, 1, At, B1); PG8_BAR;
            PG8_LDA(At, 1, 1); PG8_STAGE(PG8_SA(1, 0), a3, voffA);
            PG8_BAR; PG8_WAIT_L(0); PG8_MMA(1, 0, At, B0); PG8_BAR; PG8_SCHED;
            PG8_STAGE(PG8_SB(1, 1), b3 + hstep, voffB);
            PG8_WAIT_V(6); PG8_BAR; PG8_MMA(1, 1, At, B1); PG8_BAR;
            }
        }
        if constexpr (ALIGN_EPI) { if (wr == 0) PG8_BAR; }
        if constexpr (!Epi::AFTER_DRAIN) { E(acc, cur, wr, wc, fr, fq); S.done(cur); }
        if (!has_next) break;
#pragma unroll
        for (int a = 0; a < 2; ++a)
#pragma unroll
            for (int b = 0; b < 2; ++b)
#pragma unroll
                for (int m = 0; m < 4; ++m)
#pragma unroll
                    for (int n = 0; n < 2; ++n) acc[a][b][m][n] = (f32x4){0.f, 0.f, 0.f, 0.f};
        cur = nxt; cA = nA; cB = nB; ++ui;
        if constexpr (ALIGN_EPI) { if (wr == 1) PG8_BAR; }
    }
    PG8_WAIT_V(0);
    if constexpr (!ALIGN_EPI) { if (wr == 0) PG8_BAR; }
    PG8_BAR;
    if constexpr (Epi::AFTER_DRAIN) { E.fused(acc, cur, wr, wc, fr, fq, lds, wid, lane); S.done(cur); }
#undef PG8_SA
#undef PG8_SB
#undef PG8_STAGE
#undef PG8_LDA
#undef PG8_LDB
#undef PG8_MMA
#undef PG8_WAIT_V
#undef PG8_WAIT_L
#undef PG8_BAR
#undef PG8_SCHED
}
__host__ __device__ __forceinline__ int lds_byte8(int r, int cb) { const int st = (r >> 4) * 2 + (cb >> 6), rr = r & 15, ob = rr * 64 + (cb & 63); return st * 1024 + (ob ^ (((ob >> 9) & 1) << 4)); }
__host__ __device__ __forceinline__ void stage_rc8(int b, int& R, int& C) { const int st = b / 1024, sb = b % 1024, swz = sb ^ (((sb >> 9) & 1) << 4); R = (st >> 1) * 16 + swz / 64; C = (st & 1) * 64 + (swz % 64); }
typedef int i32x8 __attribute__((ext_vector_type(8))); typedef int i32x4v __attribute__((ext_vector_type(4)));
__device__ __forceinline__ i32x8 cat8(bf16x8 lo, bf16x8 hi) { const i32x4v a = __builtin_bit_cast(i32x4v, lo), b = __builtin_bit_cast(i32x4v, hi); return __builtin_shufflevector(a, b, 0, 1, 2, 3, 4, 5, 6, 7); }
template <class Epi, class Sched, bool ALIGN_EPI = false, bool SP2 = false>
__device__ __forceinline__ void gemm_phase8(PG8_LAS unsigned char* lds, const Gemm g, const Sched& S, const Epi& E) {
    const int tid = threadIdx.x, wid = __builtin_amdgcn_readfirstlane(tid >> 6), lane = tid & 63, wr = wid >> 2, wc = wid & 3, fr = lane & 15, fq = lane >> 4;
    const int K = g.K, nt = K / 128;
    unsigned voffA[2], voffB[2];
#pragma unroll
    for (int i = 0; i < 2; ++i) { int R, C; stage_rc(tid * 16 + i * 8192, R, C); const int Rb = Epi::PERM ? ((R & ~31) + perm32(R & 31)) : R;
        voffA[i] = (unsigned)(R * K + 2 * C); voffB[i] = (unsigned)(Rb * K + 2 * C); }
    const unsigned kstep = (unsigned)(BK * 2);
    const unsigned hstep = (unsigned)HALF * (unsigned)K;
    const unsigned tstep = 2u * hstep;
    const unsigned ldsw = (unsigned)wid * 1024u;
    const int aoff = lds_byte(wr * 64 + fr, fq * 16), boff = lds_byte(wc * 32 + fr, fq * 16);
#define PG8_SA(b, h) (((b) * 2 + (h)) * HTB)
#define PG8_SB(b, h) ((4 + (b) * 2 + (h)) * HTB)
#define PG8_STAGEA(bufoff, goff, voff) do { _Pragma("unroll") for (int _i = 0; _i < 2; ++_i) \
        __builtin_amdgcn_global_load_lds((const unsigned*)(gA_base + (size_t)((unsigned)(goff) + (voff)[_i])), (PG8_LAS unsigned*)(lds + (bufoff) + ldsw + _i * 8192), 16, 0, 0); } while (0)
#define PG8_STAGEB(bufoff, goff, voff) do { _Pragma("unroll") for (int _i = 0; _i < 2; ++_i) \
        __builtin_amdgcn_global_load_lds((const unsigned*)(gB_base + (size_t)((unsigned)(goff) + (voff)[_i])), (PG8_LAS unsigned*)(lds + (bufoff) + ldsw + _i * 8192), 16, 0, 0); } while (0)
#define PG8_LDA(dst, b, h) do { _Pragma("unroll") for (int m = 0; m < 4; ++m) { const i32x4v lo_ = *(const PG8_LAS i32x4v*)(lds + PG8_SA(b, h) + aoff + m * 2048), hi_ = *(const PG8_LAS i32x4v*)(lds + PG8_SA(b, h) + aoff + 16 + m * 2048); dst[m] = __builtin_shufflevector(lo_, hi_, 0, 1, 2, 3, 4, 5, 6, 7); } } while (0)
#define PG8_LDB(dst, b, h) do { _Pragma("unroll") for (int n = 0; n < 2; ++n) { const i32x4v lo_ = *(const PG8_LAS i32x4v*)(lds + PG8_SB(b, h) + boff + n * 2048), hi_ = *(const PG8_LAS i32x4v*)(lds + PG8_SB(b, h) + boff + 16 + n * 2048); dst[n] = __builtin_shufflevector(lo_, hi_, 0, 1, 2, 3, 4, 5, 6, 7); } } while (0)
#define PG8_MMA(ai, bj, At, Bt) do { __builtin_amdgcn_s_setprio(1); _Pragma("unroll") for (int m = 0; m < 4; ++m) _Pragma("unroll") for (int n = 0; n < 2; ++n) \
        asm volatile("v_mfma_scale_f32_16x16x128_f8f6f4 %0, %1, %2, %0, %3, %4 op_sel_hi:[0,0,0]" : "+v"(acc[ai][bj][m][n]) : "v"(Bt[n]), "v"(At[m]), "v"(sc_w), "v"(sc_1));     __builtin_amdgcn_s_setprio(0); } while (0)
#define PG8_WAIT_V(n) asm volatile("s_waitcnt vmcnt(" #n ")" ::: "memory")
#define PG8_WAIT_L(n) asm volatile("s_waitcnt lgkmcnt(" #n ")" ::: "memory")
#define PG8_BAR __builtin_amdgcn_s_barrier()
#define PG8_SCHED __builtin_amdgcn_sched_barrier(0)
    Unit cur, nxt; int ui = 0;
    if (!S.next(0, cur)) return;
    f32x4 acc[2][2][4][2];
#pragma unroll
    for (int a = 0; a < 2; ++a)
#pragma unroll
        for (int b = 0; b < 2; ++b)
#pragma unroll
            for (int m = 0; m < 4; ++m)
#pragma unroll
                for (int n = 0; n < 2; ++n) acc[a][b][m][n] = (f32x4){0.f, 0.f, 0.f, 0.f};
    i32x8 At[4], B0[2], B1[2]; const int sc_w = 0x79797979, sc_1 = 0x7f7f7f7f;
    const char* gA_base = (const char*)g.A; const char* gB_base = (const char*)g.Bt; const unsigned eb32 = (unsigned)g.eb;
    unsigned cA = (unsigned)cur.pm * tstep, cB = (unsigned)cur.e * eb32 + (unsigned)cur.pn * tstep;
    S.a_ready(cur);
    if constexpr (SP2) {
        PG8_STAGEB(PG8_SB(0, 0), cB, voffB); PG8_STAGEB(PG8_SB(0, 1), cB + hstep, voffB); PG8_STAGEA(PG8_SA(0, 0), cA, voffA); PG8_STAGEA(PG8_SA(0, 1), cA + hstep, voffA);
        if (wr == 1) PG8_BAR;
        PG8_WAIT_V(2); PG8_BAR;
        PG8_STAGEB(PG8_SB(1, 0), cB + kstep, voffB); PG8_STAGEA(PG8_SA(1, 0), cA + kstep, voffA); PG8_STAGEB(PG8_SB(1, 1), cB + hstep + kstep, voffB);
        PG8_WAIT_V(6); PG8_BAR;
    } else {
        PG8_STAGEB(PG8_SB(0, 0), cB, voffB); PG8_STAGEA(PG8_SA(0, 0), cA, voffA); PG8_STAGEB(PG8_SB(0, 1), cB + hstep, voffB); PG8_STAGEA(PG8_SA(0, 1), cA + hstep, voffA);
        if (wr == 1) PG8_BAR;
        PG8_WAIT_V(4); PG8_BAR;
        PG8_STAGEB(PG8_SB(1, 0), cB + kstep, voffB); PG8_STAGEA(PG8_SA(1, 0), cA + kstep, voffA); PG8_STAGEB(PG8_SB(1, 1), cB + hstep + kstep, voffB);
        PG8_WAIT_V(6); PG8_BAR;
    }
    for (;;) {
        const bool has_next = S.next(ui + 1, nxt);
        const unsigned nA = has_next ? (unsigned)nxt.pm * tstep : cA; const unsigned nB = has_next ? (unsigned)nxt.e * eb32 + (unsigned)nxt.pn * tstep : cB;
        for (int t = 0; t < nt; t += 2) {
            const bool last = (t == nt - 2);
            const unsigned a1 = cA + (unsigned)(t + 1) * kstep;
            const unsigned a2 = last ? nA : cA + (unsigned)(t + 2) * kstep; const unsigned b2 = last ? nB : cB + (unsigned)(t + 2) * kstep;
            const unsigned a3 = a2 + kstep; const unsigned b3 = b2 + kstep;
            if (last && has_next) S.a_ready(nxt);
            if constexpr (SP2) {
            PG8_LDB(B0, 0, 0); PG8_LDB(B1, 0, 1); PG8_SCHED; PG8_LDA(At, 0, 0); PG8_STAGEA(PG8_SA(1, 1), a1 + hstep, voffA);
            PG8_WAIT_V(8); PG8_WAIT_L(0); PG8_BAR; PG8_MMA(0, 0, At, B0); PG8_MMA(0, 1, At, B1); PG8_BAR; PG8_SCHED;
            PG8_LDA(At, 0, 1); PG8_STAGEB(PG8_SB(0, 0), b2, voffB); PG8_STAGEB(PG8_SB(0, 1), b2 + hstep, voffB); PG8_STAGEA(PG8_SA(0, 0), a2, voffA);
            PG8_WAIT_V(8); PG8_WAIT_L(0); PG8_BAR; PG8_MMA(1, 0, At, B0); PG8_MMA(1, 1, At, B1); PG8_BAR; PG8_SCHED;
            PG8_LDB(B0, 1, 0); PG8_LDB(B1, 1, 1); PG8_SCHED; PG8_LDA(At, 1, 0); PG8_STAGEA(PG8_SA(0, 1), a2 + hstep, voffA);
            PG8_WAIT_V(8); PG8_WAIT_L(0); PG8_BAR; PG8_MMA(0, 0, At, B0); PG8_MMA(0, 1, At, B1); PG8_BAR; PG8_SCHED;
            PG8_LDA(At, 1, 1); PG8_STAGEB(PG8_SB(1, 0), b3, voffB); PG8_STAGEB(PG8_SB(1, 1), b3 + hstep, voffB); PG8_STAGEA(PG8_SA(1, 0), a3, voffA);
            PG8_WAIT_V(8); PG8_WAIT_L(0); PG8_BAR; PG8_MMA(1, 0, At, B0); PG8_MMA(1, 1, At, B1); PG8_BAR; PG8_SCHED;
            } else {
            PG8_LDB(B0, 0, 0); PG8_SCHED; PG8_LDA(At, 0, 0); PG8_STAGEA(PG8_SA(1, 1), a1 + hstep, voffA);
            PG8_WAIT_L(8); PG8_BAR; PG8_WAIT_L(0); PG8_MMA(0, 0, At, B0); PG8_BAR; PG8_SCHED;
            PG8_LDB(B1, 0, 1); PG8_STAGEB(PG8_SB(0, 0), b2, voffB);
            PG8_BAR; PG8_WAIT_L(0); PG8_MMA(0, 1, At, B1); PG8_BAR;
            PG8_LDA(At, 0, 1); PG8_STAGEA(PG8_SA(0, 0), a2, voffA);
            PG8_BAR; PG8_WAIT_L(0); PG8_MMA(1, 0, At, B0); PG8_BAR; PG8_SCHED;
            PG8_STAGEB(PG8_SB(0, 1), b2 + hstep, voffB);
            PG8_WAIT_V(6); PG8_BAR; PG8_MMA(1, 1, At, B1); PG8_BAR;
            PG8_LDB(B0, 1, 0); PG8_SCHED; PG8_LDA(At, 1, 0); PG8_STAGEA(PG8_SA(0, 1), a2 + hstep, voffA);
            PG8_WAIT_L(8); PG8_BAR; PG8_WAIT_L(0); PG8_MMA(0, 0, At, B0); PG8_BAR; PG8_SCHED;
            PG8_LDB(B1, 1, 1); PG8_STAGEB(PG8_SB(1, 0), b3, voffB);
            PG8_BAR; PG8_WAIT_L(0); PG8_MMA(0, 1, At, B1); PG8_BAR;
            PG8_LDA(At, 1, 1); PG8_STAGEA(PG8_SA(1, 0), a3, voffA);
            PG8_BAR; PG8_WAIT_L(0); PG8_MMA(1, 0, At, B0); PG8_BAR; PG8_SCHED;
            PG8_STAGEB(PG8_SB(1, 1), b3 + hstep, voffB);
            PG8_WAIT_V(6); PG8_BAR; PG8_MMA(1, 1, At, B1); PG8_BAR;
            }
        }
        if constexpr (ALIGN_EPI) { if (wr == 0) PG8_BAR; }
        asm volatile("s_nop 15\n\ts_nop 15" ::: "memory");
        if constexpr (!Epi::AFTER_DRAIN) { E(acc, cur, wr, wc, fr, fq); S.done(cur); }
        if (!has_next) break;
#pragma unroll
        for (int a = 0; a < 2; ++a)
#pragma unroll
            for (int b = 0; b < 2; ++b)
#pragma unroll
                for (int m = 0; m < 4; ++m)
#pragma unroll
                    for (int n = 0; n < 2; ++n) acc[a][b][m][n] = (f32x4){0.f, 0.f, 0.f, 0.f};
        cur = nxt; cA = nA; cB = nB; ++ui;
        if constexpr (ALIGN_EPI) { if (wr == 1) PG8_BAR; }
    }
    PG8_WAIT_V(0);
    if constexpr (!ALIGN_EPI) { if (wr == 0) PG8_BAR; }
    PG8_BAR;
    if constexpr (Epi::AFTER_DRAIN) { E.fused(acc, cur, wr, wc, fr, fq, lds, wid, lane); S.done(cur); }
#undef PG8_SA
#undef PG8_SB
#undef PG8_STAGEA
#undef PG8_STAGEB
#undef PG8_LDA
#undef PG8_LDB
#undef PG8_MMA
#undef PG8_WAIT_V
#undef PG8_WAIT_L
#undef PG8_BAR
#undef PG8_SCHED
}
}

constexpr int BATCH = 4, T = 4096, D = 1024, M = BATCH * T;
constexpr int NAB = 3072;
constexpr int FF = 2816, NCD = 3584, CDO = 1536, FFE = 3584, NE = 8;
constexpr int MPAD = 2 * M + NE * 256;
constexpr int MAXT = MPAD / 256;
constexpr int C_QA = 0, C_KA = 512, C_VA = 640, C_QKVB = 768, C_GATEB = 2304, C_BETA = 2816, C_AB = 2824;
constexpr int C_XC = 0, C_YC = 1024, C_BD = 2048, C_CD = 2560, C_HD = 3072;
constexpr size_t MiB = 1u << 20;
constexpr size_t WS_CTL = 0, CTL_ZERO_BYTES = 1 * MiB;
constexpr size_t WS_MOD = 1 * MiB;
constexpr size_t WS_ROUTE = 1 * MiB + 256 * 1024;
constexpr size_t WS_WAB_IN = 2 * MiB, WS_WAB_OUT = 8 * MiB, WS_WFFN_GU = 10 * MiB, WS_WFFN_D = 21 * MiB, WS_WCD_IN = 27 * MiB, WS_WCD_OUT = 34 * MiB, WS_WLRU = 37 * MiB;
constexpr size_t WS_WMOE_GU = 38 * MiB, WS_WMOE_D = 150 * MiB;
constexpr size_t WS_ACT = 206 * MiB;
constexpr size_t WS_END = 512 * MiB;
constexpr size_t A_A = 0, A_P = 32 * MiB, A_MIXA = 128 * MiB, A_DNQ = 160 * MiB, A_DNK = 192 * MiB, A_DNV = 224 * MiB, A_DNB = 256 * MiB, A_DNG = 257 * MiB;
constexpr size_t A_H = 160 * MiB;
constexpr size_t A_MIXB = 144 * MiB, A_XC = 192 * MiB;
constexpr size_t A_A3P = 0, A_HM = 68 * MiB, A_Y = 0;
constexpr size_t WS_A3 = 2 * MiB;
constexpr size_t WS_LA = 38 * MiB, WS_LB = 102 * MiB;
constexpr size_t R_IDX = 0, R_W = 128 * 1024, R_SLOT = 256 * 1024, R_GATEW = 384 * 1024, R_TILEE = 528 * 1024, R_OFF = 532 * 1024, R_HIST = 536 * 1024;
constexpr int CW_CNT = 1024, CW_CUR = 1024 + 64;

typedef unsigned short bf16;
typedef float f32x4 __attribute__((ext_vector_type(4)));
typedef unsigned v4u __attribute__((ext_vector_type(4)));
typedef unsigned v2u __attribute__((ext_vector_type(2)));
__device__ __forceinline__ unsigned f2bf(float f) { unsigned u = __builtin_bit_cast(unsigned, f); return (u + 0x7fffu + ((u >> 16) & 1u)) >> 16; }
__device__ __forceinline__ unsigned pk2(float lo, float hi) { return f2bf(lo) | (f2bf(hi) << 16); }
__device__ __forceinline__ float bf2f(unsigned short b) { return __builtin_bit_cast(float, (unsigned)b << 16); }
__device__ __forceinline__ float bflo(unsigned w) { return __builtin_bit_cast(float, w << 16); }
__device__ __forceinline__ float bfhi(unsigned w) { return __builtin_bit_cast(float, w & 0xffff0000u); }
__device__ __forceinline__ float wave_sum(float v) {
#pragma unroll
    for (int o = 1; o < 64; o <<= 1) v += __shfl_xor(v, o);
    return v;
}
__device__ __forceinline__ float sigmoidf_(float x) { return __builtin_amdgcn_rcpf(1.0f + __expf(-x)); }
__device__ __forceinline__ float siluf_(float x) { return x * __builtin_amdgcn_rcpf(1.0f + __expf(-x)); }
__device__ __forceinline__ float softplusf_(float x) { return fmaxf(x, 0.f) + log1pf(__expf(-fabsf(x))); }
__device__ __forceinline__ float gelu_tanhf_(float x) { const float u = 0.7978845608028654f * (x + 0.044715f * x * x * x); return 0.5f * x * (1.0f + tanhf(u)); }

__device__ const unsigned char T5_BUCKET[128] = {0, 1, 2, 3, 4, 5, 6, 7, 8, 9, 10, 11, 12, 13, 14, 15, 16, 16, 16, 17, 17, 18, 18, 18, 19, 19, 19, 20, 20, 20, 20, 21, 21, 21, 21, 22, 22, 22, 22, 22, 23, 23, 23, 23, 23, 23, 24, 24, 24, 24, 24, 24, 25, 25, 25, 25, 25, 25, 25, 26, 26, 26, 26, 26, 26, 26, 26, 27, 27, 27, 27, 27, 27, 27, 27, 27, 27, 28, 28, 28, 28, 28, 28, 28, 28, 28, 28, 29, 29, 29, 29, 29, 29, 29, 29, 29, 29, 29, 29, 30, 30, 30, 30, 30, 30, 30, 30, 30, 30, 30, 30, 30, 30, 31, 31, 31, 31, 31, 31, 31, 31, 31, 31, 31, 31, 31, 31, 31};

struct Params { const float* in[33]; float* out; unsigned char* ws; };
enum { I_X = 0, I_C, I_RELB, I_ADAW, I_ADAB, I_NMIX, I_NFFN, I_NFIN, I_ABIN, I_SINK, I_DNCONV, I_ALOG, I_DTB, I_DNNORM, I_ABOUT, I_FG, I_FU, I_FD, I_CDIN, I_LCW, I_LCB, I_GAW, I_GAB, I_GXW, I_GXB, I_LAM, I_SCW, I_CDOUT, I_RW, I_RB, I_MG, I_MU, I_MD };


#define LAS __attribute__((address_space(3)))
#define XB_TMO      128
#define XB_XCNT(j)  (256  + 64 * (j))
#define XB_XSUB(j)  (1280 + 64 * (j))
#define XB_XGEN(j)  (2304 + 64 * (j))
#define XB_TOP      3328
#define XB_TOPGEN   3392
#define XCD_BAR_WORDS 3456
#define XB_SPIN_CAP (1u << 18)

__device__ __forceinline__ unsigned xb_ld(unsigned* p)              { return __hip_atomic_load(p, __ATOMIC_RELAXED, __HIP_MEMORY_SCOPE_AGENT); }
__device__ __forceinline__ unsigned xb_add(unsigned* p, unsigned v) { return __hip_atomic_fetch_add(p, v, __ATOMIC_RELAXED, __HIP_MEMORY_SCOPE_AGENT); }
__device__ __forceinline__ unsigned xb_xcc_id() { return (unsigned)__builtin_amdgcn_s_getreg((3 << 11) | 20) & 0xFu; }
#define XB_SPIN(cond, bar) do { unsigned _sp = 0; while (cond) { __builtin_amdgcn_s_sleep(1); \
    if ((++_sp & 255u) == 0u) { if (xb_ld(&(bar)[XB_TMO])) break; if (_sp > XB_SPIN_CAP) { atomicAdd(&(bar)[XB_TMO], 1u); break; } } } } while (0)

struct XcdBarrier {
    unsigned* bar; unsigned x;
    volatile LAS unsigned* st;
};
__device__ __forceinline__ XcdBarrier xcd_barrier_post(unsigned* bar, volatile LAS unsigned* st) {
    XcdBarrier b; b.bar = bar; b.x = xb_xcc_id(); b.st = st;
    if (threadIdx.x == 0) (void)xb_add(&bar[XB_XCNT(b.x)], 1u);
    return b;
}
__device__ __forceinline__ void xcd_barrier_complete(unsigned* bar, unsigned x, unsigned& nloc, unsigned& nx) {
    const unsigned G = gridDim.x * gridDim.y * gridDim.z;
    unsigned sum, cnt, mine, sp = 0u;
    for (;;) {
        sum = 0u; cnt = 0u; mine = 0u;
#pragma unroll
        for (unsigned j = 0; j < 16; ++j) { const unsigned c = xb_ld(&bar[XB_XCNT(j)]); sum += c; cnt += (c > 0u) ? 1u : 0u; mine = (j == x) ? c : mine; }
        if (sum == G) break;
        __builtin_amdgcn_s_sleep(1);
        if ((++sp & 255u) == 0u) { if (xb_ld(&bar[XB_TMO])) break; if (sp > XB_SPIN_CAP) { atomicAdd(&bar[XB_TMO], 1u); break; } }
    }
    nloc = mine > 0u ? mine : 1u; nx = cnt > 0u ? cnt : 1u;
}
__device__ __forceinline__ void xcd_barrier(const XcdBarrier& b) {
    asm volatile("s_waitcnt vmcnt(0)" ::: "memory");
    __syncthreads();
    if (threadIdx.x == 0) {
        unsigned* bar = b.bar;
        __builtin_amdgcn_s_waitcnt(0);
        unsigned nloc = b.st[0], nx = b.st[1];
        if (nloc == 0u) { xcd_barrier_complete(bar, b.x, nloc, nx); b.st[0] = nloc; b.st[1] = nx; }
        const unsigned old = xb_add(&bar[XB_XSUB(b.x)], 1u);
        const unsigned gen = old / nloc;
        if (old + 1u == (gen + 1u) * nloc) {
            __builtin_amdgcn_fence(__ATOMIC_RELEASE, "agent");
            asm volatile("s_waitcnt vmcnt(0)" ::: "memory");
            const unsigned og = xb_add(&bar[XB_TOP], 1u);
            const unsigned tg = og / nx;
            if (og + 1u == (tg + 1u) * nx) xb_add(&bar[XB_TOPGEN], 1u);
            else XB_SPIN(xb_ld(&bar[XB_TOPGEN]) == tg, bar);
            __builtin_amdgcn_fence(__ATOMIC_ACQUIRE, "agent");
            xb_add(&bar[XB_XGEN(b.x)], 1u);
            asm volatile("s_waitcnt vmcnt(0)" ::: "memory");
        } else {
            XB_SPIN(xb_ld(&bar[XB_XGEN(b.x)]) == gen, bar);
            __builtin_amdgcn_fence(__ATOMIC_ACQUIRE, "agent");
            asm volatile("s_waitcnt vmcnt(0)" ::: "memory");
        }
    }
    __syncthreads();
}

constexpr int NWAVES = 8, NTHR = 512;
constexpr int LDS_MISC = 150528, LDS_BYTES = 150528 + 1024;
constexpr int CW_BAR = 4096;
struct ConvDesc { const float* src; bf16* dst; long long sstride, dstride; int K, N, Npad, mode, row_off, nbatch, items_pb, item0; };
struct ConvTab { ConvDesc d[12]; int nd, total, pad0, pad1; };
struct MArgs { Params p; ConvTab t1, t2; int ph_lo, ph_hi, pad0, pad1; };
struct Ctx { LAS unsigned char* lds; int tid, lane, wave, G, bid, gw, NGW; };

constexpr int CV_S = 65, CV_WAVE = 64 * CV_S * 4;
__device__ __forceinline__ void transpose_item(const float* W, int K, int N, bf16* WT, int mode, int row_off, LAS float* scr, int kb, int nb, int lane) {
    const int k0 = 64 * kb, n0 = 64 * nb, kr = lane >> 4, nq = lane & 15; const int nn = n0 + 4 * nq;
    f32x4 v[16];
#pragma unroll
    for (int i = 0; i < 16; ++i) v[i] = nn < N ? *(const f32x4*)(W + (size_t)(k0 + 4 * i + kr) * N + nn) : (f32x4){0.f, 0.f, 0.f, 0.f};
#pragma unroll
    for (int i = 0; i < 16; ++i) { LAS float* d = scr + (4 * i + kr) * CV_S + 4 * nq; d[0] = v[i].x; d[1] = v[i].y; d[2] = v[i].z; d[3] = v[i].w; }
    asm volatile("s_waitcnt lgkmcnt(0)" ::: "memory");
    if (mode & 2) {
        const int c4 = lane & 3;
#pragma unroll
        for (int j = 0; j < 4; ++j) { const int n = (lane >> 2) + 16 * j; const LAS float* s = scr + (16 * c4) * CV_S + n; v4u o;
#pragma unroll
            for (int e = 0; e < 4; ++e) { int w = 0; w = __builtin_amdgcn_cvt_pk_fp8_f32(s[(4 * e) * CV_S] * 64.0f, s[(4 * e + 1) * CV_S] * 64.0f, w, false); w = __builtin_amdgcn_cvt_pk_fp8_f32(s[(4 * e + 2) * CV_S] * 64.0f, s[(4 * e + 3) * CV_S] * 64.0f, w, true); o[e] = (unsigned)w; }
            const int ng = n0 + n; const int drow = ((mode & 1) ? ((ng >> 7) << 8) + (ng & 127) : ng) + row_off;
            *(v4u*)((unsigned char*)WT + (size_t)drow * K + k0 + 16 * c4) = o; }
        asm volatile("s_waitcnt lgkmcnt(0)" ::: "memory");
        return; }
    const int c = lane & 7;
#pragma unroll
    for (int j = 0; j < 8; ++j) { const int n = (lane >> 3) + 8 * j; const LAS float* s = scr + (8 * c) * CV_S + n;
        v4u o; o.x = pk2(s[0 * CV_S], s[1 * CV_S]); o.y = pk2(s[2 * CV_S], s[3 * CV_S]); o.z = pk2(s[4 * CV_S], s[5 * CV_S]); o.w = pk2(s[6 * CV_S], s[7 * CV_S]);
        const int ng = n0 + n; const int drow = ((mode & 1) ? ((ng >> 7) << 8) + (ng & 127) : ng) + row_off;
        *(v4u*)(WT + (size_t)drow * K + k0 + 8 * c) = o; }
    asm volatile("s_waitcnt lgkmcnt(0)" ::: "memory");
}
__device__ __forceinline__ void ph_convert(const Ctx& c, const ConvTab& tab, int wk, int nworkers) {
    LAS float* scr = (LAS float*)(c.lds + c.wave * CV_WAVE);
    for (int it = wk; it < tab.total; it += nworkers) {
        int j = 0;
        for (int q = 1; q < tab.nd; ++q) if (it >= tab.d[q].item0) j = q;
        const ConvDesc& d = tab.d[j]; const int r = it - d.item0; const int batch = r / d.items_pb, item = r % d.items_pb; const int nblk = d.Npad / 64;
        transpose_item(d.src + (size_t)batch * d.sstride, d.K, d.N, d.dst + (size_t)batch * d.dstride, d.mode, d.row_off, scr, item / nblk, item % nblk, c.lane);
    }
}
__device__ __forceinline__ void ph_ada(const Ctx& c, const Params& p) {
    LAS float* part = (LAS float*)(c.lds + 8 * CV_WAVE);
    for (int it = c.bid; it < 192; it += c.G) {
        const int l = it / 96, j = (it % 96) * 64 + c.lane; const float* w = p.in[I_ADAW] + (size_t)l * 1024 * 6144 + j; const float* cc = p.in[I_C];
        float a0 = 0.f, a1 = 0.f, a2 = 0.f, a3 = 0.f;
        for (int k = c.wave * 128; k < c.wave * 128 + 128; ++k) { const float wv = w[(size_t)k * 6144];
            a0 += siluf_(cc[k]) * wv; a1 += siluf_(cc[1024 + k]) * wv; a2 += siluf_(cc[2048 + k]) * wv; a3 += siluf_(cc[3072 + k]) * wv; }
        part[(c.wave * 4 + 0) * 64 + c.lane] = a0; part[(c.wave * 4 + 1) * 64 + c.lane] = a1; part[(c.wave * 4 + 2) * 64 + c.lane] = a2; part[(c.wave * 4 + 3) * 64 + c.lane] = a3;
        __syncthreads();
        if (c.wave < 4) { float s = 0.f;
#pragma unroll
            for (int w8 = 0; w8 < 8; ++w8) s += part[(w8 * 4 + c.wave) * 64 + c.lane];
            ((float*)(p.ws + WS_MOD))[(size_t)l * 4 * 6144 + (size_t)c.wave * 6144 + j] = s + p.in[I_ADAB][l * 6144 + j]; }
        __syncthreads();
    }
}
template <bool ROUTER, bool COUNT = true>
__device__ __forceinline__ void norm_row(const float* xrow, bf16* orow, const float* w, const float* sc, const float* sh, int lane, const float* rw, const float* rb, int m, unsigned char* ws, LAS unsigned* hist) {
    const f32x4* xr = (const f32x4*)xrow + lane; f32x4 v[4]; float s = 0.f;
#pragma unroll
    for (int j = 0; j < 4; ++j) { v[j] = xr[64 * j]; s += (v[j].x * v[j].x + v[j].y * v[j].y) + (v[j].z * v[j].z + v[j].w * v[j].w); }
    const float rstd = 1.0f / sqrtf(wave_sum(s) * (1.f / D) + 1e-6f);
    float lg[8];
    if (ROUTER) {
#pragma unroll
        for (int e = 0; e < 8; ++e) lg[e] = 0.f;
    }
    unsigned long long* o8 = (unsigned long long*)orow + lane;
#pragma unroll
    for (int j = 0; j < 4; ++j) { const int c = 4 * lane + 256 * j; const f32x4 wv = *(const f32x4*)(w + c), scv = *(const f32x4*)(sc + c), shv = *(const f32x4*)(sh + c);
        f32x4 y = v[j] * rstd * wv * (scv + 1.0f) + shv;
        if (ROUTER) {
#pragma unroll
            for (int i = 0; i < 4; ++i) { const f32x4 r0 = *(const f32x4*)(rw + (size_t)(c + i) * 8), r1 = *(const f32x4*)(rw + (size_t)(c + i) * 8 + 4);
                lg[0] += y[i] * r0.x; lg[1] += y[i] * r0.y; lg[2] += y[i] * r0.z; lg[3] += y[i] * r0.w; lg[4] += y[i] * r1.x; lg[5] += y[i] * r1.y; lg[6] += y[i] * r1.z; lg[7] += y[i] * r1.w; }
        }
        if (ROUTER) ((unsigned*)orow)[lane + 64 * j] = pg8::pk_fp8x4(y.x, y.y, y.z, y.w);
        else o8[64 * j] = (unsigned long long)pk2(y.x, y.y) | ((unsigned long long)pk2(y.z, y.w) << 32); }
    if (ROUTER) {
#pragma unroll
        for (int e = 0; e < 8; ++e) lg[e] = wave_sum(lg[e]) + rb[e];
        int b0 = 0; float v0 = lg[0];
#pragma unroll
        for (int e = 1; e < 8; ++e) if (lg[e] > v0) { v0 = lg[e]; b0 = e; }
        int b1 = -1; float v1 = -3.0e38f;
#pragma unroll
        for (int e = 0; e < 8; ++e) if (e != b0 && lg[e] > v1) { v1 = lg[e]; b1 = e; }
        const float e1 = __expf(v1 - v0), w0 = 1.0f / (1.0f + e1), w1 = e1 / (1.0f + e1);
        if (lane == 0) { int* idx = (int*)(ws + WS_ROUTE + R_IDX); float* tw = (float*)(ws + WS_ROUTE + R_W); idx[2 * m] = b0; idx[2 * m + 1] = b1; tw[2 * m] = w0; tw[2 * m + 1] = w1;
            if (COUNT) { __hip_atomic_fetch_add(hist + b0, 1u, __ATOMIC_RELAXED, __HIP_MEMORY_SCOPE_WORKGROUP); __hip_atomic_fetch_add(hist + b1, 1u, __ATOMIC_RELAXED, __HIP_MEMORY_SCOPE_WORKGROUP); } }
    }
}
template <int WHICH, bool COUNT = true>
__device__ __forceinline__ void ph_norm(const Ctx& c, const Params& p) {
    const int l = WHICH >> 1, f = WHICH & 1;
    const float* src = WHICH == 0 ? p.in[I_X] : p.out; bf16* dst = (bf16*)(p.ws + (WHICH == 3 ? WS_A3 : WS_ACT + A_A));
    const float* w = p.in[f ? I_NFFN : I_NMIX] + l * D; const float* mod = (const float*)(p.ws + WS_MOD) + (size_t)l * 4 * 6144;
    if constexpr (WHICH == 3) {
        LAS unsigned* hist = (LAS unsigned*)(c.lds + 1024);
        if (c.tid < 8) hist[c.tid] = 0u;
        __syncthreads();
        for (int i = 0; i < 8; ++i) { const int m = c.bid * 64 + c.wave * 8 + i; if (m < M) { const int b = m >> 12; const float* mb = mod + (size_t)b * 6144 + 3 * D;
            norm_row<true, COUNT>(src + (size_t)m * D, (bf16*)((unsigned char*)dst + (size_t)m * D), w, mb + D, mb, c.lane, p.in[I_RW], p.in[I_RB], m, p.ws, hist); } }
        __syncthreads();
        if (COUNT && c.tid < 8) ((unsigned*)(p.ws + WS_ROUTE + R_HIST))[c.bid * 8 + c.tid] = hist[c.tid];
    } else {
    for (int m = c.gw; m < M; m += c.NGW) { const int b = m >> 12; const float* mb = mod + (size_t)b * 6144 + (f ? 3 * D : 0);
        norm_row<false, COUNT>(src + (size_t)m * D, dst + (size_t)m * D, w, mb + D, mb, c.lane, p.in[I_RW], p.in[I_RB], m, p.ws, nullptr); }
    }
}

enum { G_ABIN = 0, G_ABOUT, G_FFNGU, G_FFND, G_CDIN, G_CDOUT, G_MOEGU, G_MOED, G_FFND_PROBE, G_CDOUT_PROBE };
template <int WHICH>
__device__ __forceinline__ void ph_gemm(const Ctx& cx, const Params& p) {
    PG8_LAS unsigned char* lds = (PG8_LAS unsigned char*)cx.lds;
    unsigned char* ws = p.ws; unsigned char* act = ws + WS_ACT; const float* mod = (const float*)(ws + WS_MOD);
    const int G = cx.G, c = cx.bid;
    if constexpr (WHICH == G_ABIN) { pg8::Gemm g{(const bf16*)(act + A_A), (const bf16*)(ws + WS_WAB_IN), M, NAB, D, 0}; pg8::StaticOrder S; S.init(M, NAB, G, c);
        pg8::EpiStoreBf16 E{(bf16*)(act + A_P), NAB, nullptr}; pg8::gemm_phase<pg8::EpiStoreBf16, pg8::StaticOrder, true, true>(lds, g, S, E); }
    if constexpr (WHICH == G_ABOUT) { pg8::Gemm g{(const bf16*)(act + A_MIXA), (const bf16*)(ws + WS_WAB_OUT), M, D, D, 0}; pg8::StaticOrder S; S.init(M, D, G, c);
        pg8::EpiRes E{p.in[I_X], p.out, D, mod + 2 * D}; pg8::gemm_phase<pg8::EpiRes, pg8::StaticOrder, true, true>(lds, g, S, E); }
    if constexpr (WHICH == G_FFNGU) { pg8::Gemm g{(const bf16*)(act + A_A), (const bf16*)(ws + WS_WFFN_GU), M, 2 * FF, D, 0}; pg8::StaticOrder S; S.init(M, 2 * FF, G, c);
        pg8::EpiSwiglu E{(bf16*)(act + A_H), FF}; pg8::gemm_phase<pg8::EpiSwiglu, pg8::StaticOrder, true, true>(lds, g, S, E); }
    if constexpr (WHICH == G_FFND) { pg8::Gemm g{(const bf16*)(act + A_H), (const bf16*)(ws + WS_WFFN_D), M, D, FF, 0}; pg8::StaticOrder S; S.init(M, D, G, c);
        pg8::EpiRes E{p.out, p.out, D, mod + 5 * D}; pg8::gemm_phase<pg8::EpiRes, pg8::StaticOrder, true, true>(lds, g, S, E); }
    if constexpr (WHICH == G_FFND_PROBE) { pg8::Gemm g{(const bf16*)(act + A_H), (const bf16*)(ws + WS_WFFN_D), M, D, FF, 0}; pg8::StaticOrder S; S.init(M, D, G, c);
        pg8::EpiRes E{p.out, (float*)(act + A_P), D, mod + 5 * D}; pg8::gemm_phase<pg8::EpiRes, pg8::StaticOrder, true, true>(lds, g, S, E); }
    if constexpr (WHICH == G_CDOUT_PROBE) { pg8::Gemm g{(const bf16*)(act + A_MIXB), (const bf16*)(ws + WS_WCD_OUT), M, D, CDO, 0}; pg8::StaticOrder S; S.init(M, D, G, c);
        pg8::EpiRes E{p.out, (float*)(act + A_P), D, mod + 4 * 6144 + 2 * D}; pg8::gemm_phase<pg8::EpiRes, pg8::StaticOrder, true, true>(lds, g, S, E); }
    if constexpr (WHICH == G_CDIN) { pg8::Gemm g{(const bf16*)(act + A_A), (const bf16*)(ws + WS_WCD_IN), M, NCD, D, 0}; pg8::StaticOrder S; S.init(M, NCD, G, c);
        pg8::EpiStoreBf16 E{(bf16*)(act + A_P), NCD, nullptr}; pg8::gemm_phase<pg8::EpiStoreBf16, pg8::StaticOrder, true, true>(lds, g, S, E); }
    if constexpr (WHICH == G_CDOUT) { pg8::Gemm g{(const bf16*)(act + A_MIXB), (const bf16*)(ws + WS_WCD_OUT), M, D, CDO, 0}; pg8::StaticOrder S; S.init(M, D, G, c);
        pg8::EpiRes E{p.out, p.out, D, mod + 4 * 6144 + 2 * D}; pg8::gemm_phase<pg8::EpiRes, pg8::StaticOrder, true, true>(lds, g, S, E); }
    if constexpr (WHICH == G_MOEGU) { const int* off = (const int*)(ws + WS_ROUTE + R_OFF); const int nMt = __builtin_amdgcn_readfirstlane(off[8]) >> 8;
        pg8::Gemm g{(const bf16*)(act + A_A3P), (const bf16*)(ws + WS_WMOE_GU), nMt * 256, 2 * FFE, D, (size_t)2 * FFE * D}; pg8::GroupedOrder S; S.init(nMt, 2 * FFE, G, c, (const int*)(ws + WS_ROUTE + R_TILEE));
        pg8::EpiSwiglu8 E{act + A_HM, FFE}; pg8::gemm_phase8<pg8::EpiSwiglu8, pg8::GroupedOrder, true, true>(lds, g, S, E); }
    if constexpr (WHICH == G_MOED) { const int* off = (const int*)(ws + WS_ROUTE + R_OFF); const int nMt = __builtin_amdgcn_readfirstlane(off[8]) >> 8;
        pg8::Gemm g{(const bf16*)(act + A_HM), (const bf16*)(ws + WS_WMOE_D), nMt * 256, D, FFE, (size_t)D * FFE}; pg8::GroupedOrder S; S.init(nMt, D, G, c, (const int*)(ws + WS_ROUTE + R_TILEE));
        pg8::EpiStoreBf16S E{(bf16*)(act + A_Y), D, (const float*)(ws + WS_ROUTE + R_GATEW)}; pg8::gemm_phase8<pg8::EpiStoreBf16S, pg8::GroupedOrder, true, true>(lds, g, S, E); }
}

__device__ __forceinline__ void ph_attn_naive(const Ctx& c, const Params& p) {
    const bf16* P0 = (const bf16*)(p.ws + WS_ACT + A_P); const float* relb = p.in[I_RELB];
    for (int gid = c.bid * NTHR + c.tid; gid < M * 8; gid += c.G * NTHR) {
        const int m = gid >> 3, h = gid & 7, t = m & (T - 1), kvh = h >> 2;
        float q[64], o[64];
        { const v4u* qp = (const v4u*)(P0 + (size_t)m * NAB + C_QA + h * 64);
#pragma unroll
          for (int i = 0; i < 8; ++i) { const v4u w = qp[i]; q[8 * i + 0] = bflo(w.x) * 0.125f; q[8 * i + 1] = bfhi(w.x) * 0.125f; q[8 * i + 2] = bflo(w.y) * 0.125f; q[8 * i + 3] = bfhi(w.y) * 0.125f;
              q[8 * i + 4] = bflo(w.z) * 0.125f; q[8 * i + 5] = bfhi(w.z) * 0.125f; q[8 * i + 6] = bflo(w.w) * 0.125f; q[8 * i + 7] = bfhi(w.w) * 0.125f; } }
#pragma unroll
        for (int i = 0; i < 64; ++i) o[i] = 0.f;
        float mx = p.in[I_SINK][h], l = 1.0f;
        const int nd = t + 1 < 128 ? t + 1 : 128;
        for (int dd = 0; dd < nd; ++dd) {
            const bf16* kr = P0 + (size_t)(m - dd) * NAB + C_KA + kvh * 64; const bf16* vr = P0 + (size_t)(m - dd) * NAB + C_VA + kvh * 64;
            float s = 0.f;
#pragma unroll
            for (int i = 0; i < 8; ++i) { const v4u w = ((const v4u*)kr)[i];
                s += q[8 * i + 0] * bflo(w.x) + q[8 * i + 1] * bfhi(w.x) + q[8 * i + 2] * bflo(w.y) + q[8 * i + 3] * bfhi(w.y) + q[8 * i + 4] * bflo(w.z) + q[8 * i + 5] * bfhi(w.z) + q[8 * i + 6] * bflo(w.w) + q[8 * i + 7] * bfhi(w.w); }
            s += relb[T5_BUCKET[dd] * 8 + h];
            const float mn = fmaxf(mx, s), sc = __expf(mx - mn), pp = __expf(s - mn);
            l = l * sc + pp; mx = mn;
#pragma unroll
            for (int i = 0; i < 8; ++i) { const v4u w = ((const v4u*)vr)[i];
                o[8 * i + 0] = o[8 * i + 0] * sc + pp * bflo(w.x); o[8 * i + 1] = o[8 * i + 1] * sc + pp * bfhi(w.x); o[8 * i + 2] = o[8 * i + 2] * sc + pp * bflo(w.y); o[8 * i + 3] = o[8 * i + 3] * sc + pp * bfhi(w.y);
                o[8 * i + 4] = o[8 * i + 4] * sc + pp * bflo(w.z); o[8 * i + 5] = o[8 * i + 5] * sc + pp * bfhi(w.z); o[8 * i + 6] = o[8 * i + 6] * sc + pp * bflo(w.w); o[8 * i + 7] = o[8 * i + 7] * sc + pp * bfhi(w.w); }
        }
        const float inv = 1.0f / l;
        v4u* op = (v4u*)((bf16*)(p.ws + WS_ACT + A_MIXA) + (size_t)m * D + h * 64);
#pragma unroll
        for (int i = 0; i < 8; ++i) { v4u w; w.x = pk2(o[8 * i] * inv, o[8 * i + 1] * inv); w.y = pk2(o[8 * i + 2] * inv, o[8 * i + 3] * inv); w.z = pk2(o[8 * i + 4] * inv, o[8 * i + 5] * inv); w.w = pk2(o[8 * i + 6] * inv, o[8 * i + 7] * inv); op[i] = w; }
    }
}

__device__ __forceinline__ void ph_dn_prep(const Ctx& c, const Params& p) {
    const bf16* P0 = (const bf16*)(p.ws + WS_ACT + A_P); const float* cw = p.in[I_DNCONV]; unsigned char* act = p.ws + WS_ACT; const int lane = c.lane;
    for (int it = c.gw; it < M * 8; it += c.NGW) {
        const int m = it >> 3, h = it & 7, t = m & (T - 1);
        float r[3];
#pragma unroll
        for (int s = 0; s < 3; ++s) { const int ch = s * 512 + h * 64 + lane; float a = 0.f;
#pragma unroll
            for (int k = 0; k < 4; ++k) { const int tt = t - 3 + k; if (tt >= 0) a += cw[k * 1536 + ch] * bf2f(P0[(size_t)(m - 3 + k) * NAB + C_QKVB + ch]); }
            r[s] = siluf_(a); }
        const float nq = 1.0f / sqrtf(wave_sum(r[0] * r[0]) + 1e-6f), nk = 1.0f / sqrtf(wave_sum(r[1] * r[1]) + 1e-6f);
        ((float*)(act + A_DNQ))[(size_t)m * 512 + h * 64 + lane] = r[0] * nq;
        ((float*)(act + A_DNK))[(size_t)m * 512 + h * 64 + lane] = r[1] * nk;
        ((float*)(act + A_DNV))[(size_t)m * 512 + h * 64 + lane] = r[2];
        if (lane == 0) { const float bb = bf2f(P0[(size_t)m * NAB + C_BETA + h]), ab = bf2f(P0[(size_t)m * NAB + C_AB + h]);
            ((float*)(act + A_DNB))[m * 8 + h] = sigmoidf_(bb);
            ((float*)(act + A_DNG))[m * 8 + h] = -__expf(p.in[I_ALOG][h]) * softplusf_(ab + p.in[I_DTB][h]); }
    }
}
__device__ __forceinline__ void ph_dn_scan(const Ctx& c, const Params& p) {
    if (c.wave != 0 || c.bid >= 32) return;
    LAS float* kq = (LAS float*)c.lds;
    const int b = c.bid >> 3, h = c.bid & 7, e = c.lane;
    unsigned char* act = p.ws + WS_ACT; const bf16* P0 = (const bf16*)(act + A_P);
    const float* Q = (const float*)(act + A_DNQ); const float* K = (const float*)(act + A_DNK); const float* V = (const float*)(act + A_DNV);
    const float* Bt = (const float*)(act + A_DNB); const float* Gt = (const float*)(act + A_DNG);
    const float nw = p.in[I_DNNORM][e];
    float S[64];
#pragma unroll
    for (int d = 0; d < 64; ++d) S[d] = 0.f;
    for (int t = 0; t < T; ++t) { const int m = b * T + t;
        asm volatile("s_waitcnt lgkmcnt(0)" ::: "memory");
        kq[e] = K[(size_t)m * 512 + h * 64 + e]; kq[64 + e] = Q[(size_t)m * 512 + h * 64 + e];
        const float v = V[(size_t)m * 512 + h * 64 + e], beta = Bt[m * 8 + h], eg = __expf(Gt[m * 8 + h]);
        asm volatile("s_waitcnt lgkmcnt(0)" ::: "memory");
        float kS = 0.f;
#pragma unroll
        for (int d = 0; d < 64; ++d) { S[d] *= eg; kS += kq[d] * S[d]; }
        const float dl = beta * (v - kS); float o = 0.f;
#pragma unroll
        for (int d = 0; d < 64; ++d) { S[d] += kq[d] * dl; o += kq[64 + d] * S[d]; }
        o *= 0.125f;
        const float rs = 1.0f / sqrtf(wave_sum(o * o) * (1.f / 64.f) + 1e-6f);
        const float gt = bf2f(P0[(size_t)m * NAB + C_GATEB + h * 64 + e]);
        ((bf16*)(act + A_MIXA))[(size_t)m * D + 512 + h * 64 + e] = (bf16)f2bf(o * rs * nw * siluf_(gt));
    }
}

__device__ __forceinline__ void ph_route(const Ctx& c, const Params& p, int curoff) {
    LAS int* tot = (LAS int*)c.lds; LAS int* pre = tot + 8; LAS int* loff = tot + 16; LAS int* posl = tot + 32;
    const unsigned* H = (const unsigned*)(p.ws + WS_ROUTE + R_HIST);
    { const int e = c.wave; int t = 0, pr = 0;
      for (int w = c.lane; w < c.G; w += 64) { const int v = (int)H[w * 8 + e]; t += v; pr += (w < c.bid) ? v : 0; }
#pragma unroll
      for (int o = 1; o < 64; o <<= 1) { t += __shfl_xor(t, o); pr += __shfl_xor(pr, o); }
      if (c.lane == 0) { tot[e] = t; pre[e] = pr; } }
    __syncthreads();
    if (c.tid == 0) { int* off = (int*)(p.ws + WS_ROUTE + R_OFF); int* te = (int*)(p.ws + WS_ROUTE + R_TILEE); int o = 0;
        for (int e = 0; e < 8; ++e) { loff[e] = o; const int n = (tot[e] + 255) & ~255;
            if (c.bid == 0) { off[e] = o; for (int t = o >> 8; t < (o + n) >> 8 && t < MAXT; ++t) te[t] = e; }
            o += n; }
        loff[8] = o; if (c.bid == 0) off[8] = o < MPAD ? o : MPAD; }
    __syncthreads();
    const int* idx = (const int*)(p.ws + WS_ROUTE + R_IDX); const float* tw = (const float*)(p.ws + WS_ROUTE + R_W);
    if (c.wave == 0) { int run[8];
#pragma unroll
        for (int e = 0; e < 8; ++e) run[e] = loff[e] + pre[e];
#pragma unroll
        for (int r = 0; r < 2; ++r) { const int it = 64 * r + c.lane; const int e = idx[c.bid * 128 + it]; int pos = 0;
#pragma unroll
            for (int ex = 0; ex < 8; ++ex) { const unsigned long long mk = __ballot(e == ex); if (e == ex) pos = run[ex] + __popcll(mk & ((1ull << c.lane) - 1ull)); run[ex] += __popcll(mk); }
            posl[it] = pos; ((int*)(p.ws + WS_ROUTE + R_SLOT))[c.bid * 128 + it] = pos; ((float*)(p.ws + WS_ROUTE + R_GATEW))[pos] = tw[c.bid * 128 + it]; } }
    __syncthreads();
    for (int i = 0; i < 16; ++i) { const int it = c.wave * 16 + i; const int m = c.bid * 64 + (it >> 1); const int pos = posl[it];
        const v4u* src = (const v4u*)(p.ws + WS_A3 + (size_t)m * D); v4u* dst = (v4u*)(p.ws + WS_ACT + A_A3P + (size_t)pos * D);
        dst[c.lane] = src[c.lane]; }
}
template <bool PROBE> __device__ __forceinline__ void ph_final(const Ctx& c, const Params& p) {
    const int lane = c.lane;
    const int* slot = (const int*)(p.ws + WS_ROUTE + R_SLOT); const bf16* Y = (const bf16*)(p.ws + WS_ACT + A_Y);
    const float* mod = (const float*)(p.ws + WS_MOD) + 4 * 6144; const float* fw = p.in[I_NFIN];
    for (int m = c.gw; m < M; m += c.NGW) { const int b = m >> 12; const float* g2 = mod + (size_t)b * 6144 + 5 * D;
        const int s0 = slot[2 * m], s1 = slot[2 * m + 1];
        f32x4* xr = (f32x4*)(p.out + (size_t)m * D) + lane; f32x4* xw = PROBE ? (f32x4*)((float*)(p.ws + WS_ACT + A_HM) + (size_t)m * D) + lane : xr; const v2u* y0 = (const v2u*)(Y + (size_t)s0 * D) + lane; const v2u* y1 = (const v2u*)(Y + (size_t)s1 * D) + lane;
        f32x4 v[4]; float s = 0.f;
#pragma unroll
        for (int j = 0; j < 4; ++j) { const f32x4 gv = *(const f32x4*)(g2 + 4 * lane + 256 * j); const v2u a = y0[64 * j], cc = y1[64 * j];
            f32x4 yy; yy.x = bflo(a.x) + bflo(cc.x); yy.y = bfhi(a.x) + bfhi(cc.x); yy.z = bflo(a.y) + bflo(cc.y); yy.w = bfhi(a.y) + bfhi(cc.y);
            v[j] = xr[64 * j] + gv * yy; s += (v[j].x * v[j].x + v[j].y * v[j].y) + (v[j].z * v[j].z + v[j].w * v[j].w); }
        const float rstd = 1.0f / sqrtf(wave_sum(s) * (1.f / D) + 1e-6f);
#pragma unroll
        for (int j = 0; j < 4; ++j) { const f32x4 wv = *(const f32x4*)(fw + 4 * lane + 256 * j); xw[64 * j] = v[j] * rstd * wv; }
    }
}


typedef short bf16x8_t __attribute__((ext_vector_type(8)));
typedef short s16x4_t __attribute__((ext_vector_type(4)));
typedef float f32x16 __attribute__((ext_vector_type(16)));
constexpr int AT_KSTR = 144, AT_VSTR = 520, AT_K = 0, AT_V = 256 * AT_KSTR, AT_BIAS = AT_V + 64 * AT_VSTR, AT_END = AT_BIAS + 2048;
typedef float f32x2_c __attribute__((ext_vector_type(2))); typedef __bf16 bf16x2_c __attribute__((ext_vector_type(2)));
__device__ __forceinline__ unsigned pkbf(float lo, float hi) { f32x2_c v = {lo, hi}; bf16x2_c b = __builtin_convertvector(v, bf16x2_c); return __builtin_bit_cast(unsigned, b); }
__device__ __forceinline__ void attn_unit(const Ctx& c, const Params& p, int u) {
    const int qb = u & 31, kvh = (u >> 5) & 1, b = u >> 6;
    const bf16* P0 = (const bf16*)(p.ws + WS_ACT + A_P);
    LAS unsigned char* lds = c.lds;
    __syncthreads();
    {
        const int key = c.tid >> 1, half = c.tid & 1, tk = 128 * (qb - 1) + key;
        v4u kv[4];
        if (tk >= 0) { const v4u* src = (const v4u*)(P0 + (size_t)(b * T + tk) * NAB + C_KA + kvh * 64 + 32 * half);
#pragma unroll
            for (int i = 0; i < 4; ++i) kv[i] = src[i]; }
        else {
#pragma unroll
            for (int i = 0; i < 4; ++i) kv[i] = (v4u){0u, 0u, 0u, 0u}; }
#pragma unroll
        for (int i = 0; i < 4; ++i) *(LAS v4u*)(lds + AT_K + key * AT_KSTR + 64 * half + 16 * i) = kv[i];
    }
    {
        const int kp = c.tid & 127, dq = c.tid >> 7, tk = 128 * (qb - 1) + 2 * kp;
        v4u va[2], vb[2];
        if (tk >= 0) { const v4u* s0 = (const v4u*)(P0 + (size_t)(b * T + tk) * NAB + C_VA + kvh * 64 + 16 * dq); const v4u* s1 = (const v4u*)(P0 + (size_t)(b * T + tk + 1) * NAB + C_VA + kvh * 64 + 16 * dq);
            va[0] = s0[0]; va[1] = s0[1]; vb[0] = s1[0]; vb[1] = s1[1]; }
        else { va[0] = va[1] = vb[0] = vb[1] = (v4u){0u, 0u, 0u, 0u}; }
#pragma unroll
        for (int i = 0; i < 2; ++i)
#pragma unroll
            for (int k = 0; k < 4; ++k) { const unsigned a = va[i][k], bb = vb[i][k]; const int d = 16 * dq + 8 * i + 2 * k;
                *(LAS unsigned*)(lds + AT_V + d * AT_VSTR + 4 * kp) = (a & 0xffffu) | (bb << 16);
                *(LAS unsigned*)(lds + AT_V + (d + 1) * AT_VSTR + 4 * kp) = (a >> 16) | (bb & 0xffff0000u); }
    }
    { const int hl = c.tid >> 7, dist = c.tid & 127; *(LAS float*)(lds + AT_BIAS + c.tid * 4) = p.in[I_RELB][T5_BUCKET[dist] * 8 + kvh * 4 + hl]; }
    __syncthreads();
    const int hl = c.wave >> 1, hq = kvh * 4 + hl, qh = c.wave & 1, qi = c.lane & 31, hh = c.lane >> 5;
    const float sink = p.in[I_SINK][hq];
    const LAS float* biasT = (const LAS float*)(lds + AT_BIAS + hl * 512);
#pragma unroll 1
    for (int s = 0; s < 2; ++s) {
        const int q0 = 64 * qh + 32 * s, kb0 = q0 >> 5, qq = q0 + qi; const size_t m = (size_t)b * T + 128 * qb + qq;
        bf16x8_t bq[4];
#pragma unroll
        for (int ks = 0; ks < 4; ++ks) bq[ks] = *(const bf16x8_t*)(P0 + m * NAB + C_QA + hq * 64 + 16 * ks + 8 * hh);
        f32x16 sacc[5];
#pragma unroll
        for (int kbi = 0; kbi < 5; ++kbi) {
            f32x16 acc;
#pragma unroll
            for (int r = 0; r < 16; ++r) acc[r] = 0.f;
#pragma unroll
            for (int ks = 0; ks < 4; ++ks) { const bf16x8_t ka = *(const LAS bf16x8_t*)(lds + AT_K + (32 * (kb0 + kbi) + qi) * AT_KSTR + 32 * ks + 16 * hh);
                acc = __builtin_amdgcn_mfma_f32_32x32x16_bf16(ka, bq[ks], acc, 0, 0, 0); }
            sacc[kbi] = acc;
        }
        float mx = -1e30f;
#pragma unroll
        for (int kbi = 0; kbi < 5; ++kbi)
#pragma unroll
            for (int r = 0; r < 16; ++r) { const int sidx = 32 * (kb0 + kbi) + (r & 3) + 8 * (r >> 2) + 4 * hh; const int dist = qq + 128 - sidx;
                const bool valid = dist >= 0 && dist < 128 && (qb > 0 || sidx >= 128);
                const float bv = biasT[dist & 127];
                const float sc = valid ? sacc[kbi][r] * 0.125f + bv : -1e30f; sacc[kbi][r] = sc; mx = fmaxf(mx, sc); }
        mx = fmaxf(mx, __shfl_xor(mx, 32)); mx = fmaxf(mx, sink);
        float l = 0.f;
#pragma unroll
        for (int kbi = 0; kbi < 5; ++kbi)
#pragma unroll
            for (int r = 0; r < 16; ++r) { const float pv = __expf(sacc[kbi][r] - mx); sacc[kbi][r] = pv; l += pv; }
        l += __shfl_xor(l, 32); l += __expf(sink - mx);
        const float inv = 1.0f / l;
        f32x16 oacc[2];
#pragma unroll
        for (int db = 0; db < 2; ++db)
#pragma unroll
            for (int r = 0; r < 16; ++r) oacc[db][r] = 0.f;
#pragma unroll
        for (int kbi = 0; kbi < 5; ++kbi)
#pragma unroll
            for (int s2 = 0; s2 < 2; ++s2) {
                v4u pw; pw.x = pkbf(sacc[kbi][8 * s2 + 0], sacc[kbi][8 * s2 + 1]); pw.y = pkbf(sacc[kbi][8 * s2 + 2], sacc[kbi][8 * s2 + 3]); pw.z = pkbf(sacc[kbi][8 * s2 + 4], sacc[kbi][8 * s2 + 5]); pw.w = pkbf(sacc[kbi][8 * s2 + 6], sacc[kbi][8 * s2 + 7]);
                const bf16x8_t pf = __builtin_bit_cast(bf16x8_t, pw);
                const int keyb = 32 * (kb0 + kbi) + 16 * s2 + 4 * hh;
#pragma unroll
                for (int db = 0; db < 2; ++db) { const LAS unsigned char* vp = lds + AT_V + (32 * db + qi) * AT_VSTR + 2 * keyb;
                    const s16x4_t lo = *(const LAS s16x4_t*)vp, hi = *(const LAS s16x4_t*)(vp + 16);
                    const bf16x8_t vf = (bf16x8_t){lo[0], lo[1], lo[2], lo[3], hi[0], hi[1], hi[2], hi[3]};
                    oacc[db] = __builtin_amdgcn_mfma_f32_32x32x16_bf16(vf, pf, oacc[db], 0, 0, 0); }
            }
        bf16* orow = (bf16*)(p.ws + WS_ACT + A_MIXA) + m * D + hq * 64;
#pragma unroll
        for (int db = 0; db < 2; ++db)
#pragma unroll
            for (int g = 0; g < 4; ++g) { v2u w; w.x = pkbf(oacc[db][4 * g] * inv, oacc[db][4 * g + 1] * inv); w.y = pkbf(oacc[db][4 * g + 2] * inv, oacc[db][4 * g + 3] * inv);
                *(v2u*)(orow + 32 * db + 8 * g + 4 * hh) = w; }
    }
}
__device__ __forceinline__ void ph_attn(const Ctx& c, const Params& p) {
    for (int u = c.bid; u < 256; u += c.G) attn_unit(c, p, u);
}


constexpr int LR_XSTR = 272, LR_XT = 0, LR_XF = 64 * LR_XSTR, LR_GA = LR_XF + 32768, LR_CMB = LR_GA + 32768, LR_XR = LR_CMB + 4096, LR_END = LR_XR + 67 * LR_XSTR;
constexpr size_t A_AB = 192 * MiB, A_SA = 256 * MiB, A_SH = 260 * MiB, A_TA = 264 * MiB, A_TH = 265 * MiB, A_GA = 266 * MiB, A_GH = 266 * MiB + 512 * 1024;
typedef float f32x4_t __attribute__((ext_vector_type(4)));
__device__ __forceinline__ void ph_lru1(const Ctx& c, const Params& p) {
    LAS unsigned char* lds = c.lds; unsigned char* act = p.ws + WS_ACT;
    const int n = c.bid & 7, bg = c.bid >> 3, b = bg >> 3, grp = bg & 7, ch = c.tid & 127, tq = c.tid >> 7, gch = n * 128 + ch;
    const bf16* P1 = (const bf16*)(act + A_P);
    const float cw0 = p.in[I_LCW][gch], cw1 = p.in[I_LCW][1024 + gch], cw2 = p.in[I_LCW][2048 + gch], cw3 = p.in[I_LCW][3072 + gch], cb = p.in[I_LCB][gch];
    const int jl = c.lane & 15, q = c.lane >> 4, w = c.wave, ech = n * 128 + 16 * w + jl;
    const float gab = p.in[I_GAB][ech], gxb = p.in[I_GXB][ech], sp8 = -8.0f * softplusf_(-p.in[I_LAM][ech]);
    bf16x8_t bfa[4], bfx[4];
    { const bf16* wl = (const bf16*)(p.ws + WS_WLRU) + (size_t)n * 256 * 128;
#pragma unroll
      for (int ks = 0; ks < 4; ++ks) { bfa[ks] = *(const bf16x8_t*)(wl + (size_t)(16 * w + jl) * 128 + 32 * ks + 8 * q); bfx[ks] = *(const bf16x8_t*)(wl + (size_t)(128 + 16 * w + jl) * 128 + 32 * ks + 8 * q); } }
    v4u xr[3];
#define LR_FETCH(tile_) do { const int t0_ = 64 * (tile_); _Pragma("unroll") for (int i_ = 0; i_ < 3; ++i_) { const int pc_ = c.tid + 512 * i_; const int row_ = pc_ >> 4, cg_ = pc_ & 15; const int tk_ = t0_ - 3 + row_; \
        xr[i_] = (pc_ < 1072 && tk_ >= 0) ? *(const v4u*)(P1 + ((size_t)b * T + tk_) * NCD + C_XC + n * 128 + 8 * cg_) : (v4u){0u, 0u, 0u, 0u}; } } while (0)
    LR_FETCH(grp * 8);
    float Ag = 1.f, Hg = 0.f;
    for (int r = 0; r < 8; ++r) {
        const int tt = grp * 8 + r; const size_t m0 = (size_t)b * T + 64 * tt;
        __syncthreads();
#pragma unroll
        for (int i = 0; i < 3; ++i) { const int pc = c.tid + 512 * i; if (pc < 1072) *(LAS v4u*)(lds + LR_XR + (pc >> 4) * LR_XSTR + 16 * (pc & 15)) = xr[i]; }
        if (r < 7) LR_FETCH(tt + 1);
        __syncthreads();
        { const LAS unsigned char* xc0 = lds + LR_XR + 2 * ch; float x0 = bf2f(*(const LAS unsigned short*)(xc0 + (16 * tq) * LR_XSTR)), x1 = bf2f(*(const LAS unsigned short*)(xc0 + (16 * tq + 1) * LR_XSTR)), x2 = bf2f(*(const LAS unsigned short*)(xc0 + (16 * tq + 2) * LR_XSTR));
#pragma unroll
          for (int i = 0; i < 16; ++i) { const int tk = 16 * tq + i; const float x3 = bf2f(*(const LAS unsigned short*)(xc0 + (tk + 3) * LR_XSTR));
              const float xc = cb + cw0 * x0 + cw1 * x1 + cw2 * x2 + cw3 * x3;
              *(LAS unsigned short*)(lds + LR_XT + tk * LR_XSTR + 2 * ch) = (unsigned short)f2bf(xc);
              *(LAS float*)(lds + LR_XF + (tk * 128 + ch) * 4) = xc;
              x0 = x1; x1 = x2; x2 = x3; } }
        __syncthreads();
#pragma unroll
        for (int mt = 0; mt < 4; ++mt) {
            f32x4_t aa = {0.f, 0.f, 0.f, 0.f}, ax = {0.f, 0.f, 0.f, 0.f};
#pragma unroll
            for (int ks = 0; ks < 4; ++ks) { const bf16x8_t af = *(const LAS bf16x8_t*)(lds + LR_XT + (16 * mt + jl) * LR_XSTR + 64 * ks + 16 * q);
                aa = __builtin_amdgcn_mfma_f32_16x16x32_bf16(af, bfa[ks], aa, 0, 0, 0); ax = __builtin_amdgcn_mfma_f32_16x16x32_bf16(af, bfx[ks], ax, 0, 0, 0); }
#pragma unroll
            for (int r4 = 0; r4 < 4; ++r4) { const int tk = 16 * mt + 4 * q + r4; LAS float* xf = (LAS float*)(lds + LR_XF + (tk * 128 + 16 * w + jl) * 4);
                const float rr = sigmoidf_(aa[r4] + gab), ii = sigmoidf_(ax[r4] + gxb), la = sp8 * rr, a = __expf(la);
                const float bb = sqrtf(fmaxf(1.0f - a * a, 0.f)) * (ii * xf[0]);
                *(LAS float*)(lds + LR_GA + (tk * 128 + 16 * w + jl) * 4) = 1.0f - a; xf[0] = bb; }
        }
        __syncthreads();
        float Ap = 1.f, h = 0.f; unsigned* AB = (unsigned*)(act + A_AB) + (m0 + 16 * tq) * 1024 + gch;
#pragma unroll
        for (int i = 0; i < 16; ++i) { const float oma = *(const LAS float*)(lds + LR_GA + ((16 * tq + i) * 128 + ch) * 4), bv = *(const LAS float*)(lds + LR_XF + ((16 * tq + i) * 128 + ch) * 4);
            const unsigned pk = pk2(oma, bv); AB[(size_t)i * 1024] = pk;
            const float a = 1.0f - bflo(pk), bq = bfhi(pk); h = a * h + bq; Ap *= a; }
        { const size_t si = (m0 >> 4) + tq; ((float*)(act + A_SA))[si * 1024 + gch] = Ap; ((float*)(act + A_SH))[si * 1024 + gch] = h; }
        *(LAS float*)(lds + LR_CMB + (tq * 128 + ch) * 4) = Ap; *(LAS float*)(lds + LR_CMB + 2048 + (tq * 128 + ch) * 4) = h;
        __syncthreads();
        if (tq == 0) { float A = 1.f, H = 0.f;
#pragma unroll
            for (int g = 0; g < 4; ++g) { const float ag = *(const LAS float*)(lds + LR_CMB + (g * 128 + ch) * 4), hg = *(const LAS float*)(lds + LR_CMB + 2048 + (g * 128 + ch) * 4); H = ag * H + hg; A *= ag; }
            ((float*)(act + A_TA))[(size_t)(b * 64 + tt) * 1024 + gch] = A; ((float*)(act + A_TH))[(size_t)(b * 64 + tt) * 1024 + gch] = H;
            Hg = A * Hg + H; Ag *= A; }
    }
    if (tq == 0) { ((float*)(act + A_GA))[(size_t)(b * 8 + grp) * 1024 + gch] = Ag; ((float*)(act + A_GH))[(size_t)(b * 8 + grp) * 1024 + gch] = Hg; }
#undef LR_FETCH
}
__device__ __forceinline__ void ph_lru2(const Ctx& c, const Params& p) {
    unsigned char* act = p.ws + WS_ACT;
    const int n = c.bid & 7, bg = c.bid >> 3, b = bg >> 3, grp = bg & 7, ch = c.tid & 127, tq = c.tid >> 7, gch = n * 128 + ch;
    const float* GA = (const float*)(act + A_GA); const float* GH = (const float*)(act + A_GH); const float* TA = (const float*)(act + A_TA); const float* TH = (const float*)(act + A_TH);
    const float* SA = (const float*)(act + A_SA); const float* SH = (const float*)(act + A_SH);
    const bf16* yc = (const bf16*)(act + A_P) + C_YC + gch; bf16* mo = (bf16*)(act + A_MIXB) + gch;
    float ht = 0.f;
    for (int g = 0; g < grp; ++g) ht = GA[(size_t)(b * 8 + g) * 1024 + gch] * ht + GH[(size_t)(b * 8 + g) * 1024 + gch];
    for (int r = 0; r < 8; ++r) { const int tt = grp * 8 + r; const size_t m0 = (size_t)b * T + 64 * tt;
        float hs = ht;
        for (int s = 0; s < tq; ++s) { const size_t si = (m0 >> 4) + s; hs = SA[si * 1024 + gch] * hs + SH[si * 1024 + gch]; }
        const unsigned* AB = (const unsigned*)(act + A_AB) + (m0 + 16 * tq) * 1024 + gch;
        unsigned ab[16]; unsigned short yv[16];
#pragma unroll
        for (int i = 0; i < 16; ++i) { ab[i] = AB[(size_t)i * 1024]; yv[i] = yc[(m0 + 16 * tq + i) * NCD]; }
#pragma unroll
        for (int i = 0; i < 16; ++i) { hs = (1.0f - bflo(ab[i])) * hs + bfhi(ab[i]);
            const float y = bf2f(yv[i]); const float ge = y * sigmoidf_(1.5957691216057308f * (y + 0.044715f * y * y * y));
            mo[(m0 + 16 * tq + i) * CDO] = (bf16)f2bf(hs * ge); }
        ht = TA[(size_t)(b * 64 + tt) * 1024 + gch] * ht + TH[(size_t)(b * 64 + tt) * 1024 + gch];
    }
}
__device__ __forceinline__ void ph_sconv(const Ctx& c, const Params& p) {
    const bf16* P1 = (const bf16*)(p.ws + WS_ACT + A_P); const float* sw = p.in[I_SCW];
    for (int it = c.bid * NTHR + c.tid; it < M * 64; it += c.G * NTHR) {
        const int m = it >> 6, cg = it & 63, t = m & (T - 1), c0 = 8 * cg; float acc[8];
#pragma unroll
        for (int e = 0; e < 8; ++e) acc[e] = 0.f;
#pragma unroll
        for (int k = 0; k < 3; ++k) { const int tt = t - 2 + k; if (tt >= 0) { const size_t r = (size_t)(m - 2 + k) * NCD; const v4u cv = *(const v4u*)(P1 + r + C_CD + c0), hv = *(const v4u*)(P1 + r + C_HD + c0);
#pragma unroll
            for (int e = 0; e < 4; ++e) { acc[2 * e] += sw[k * 512 + c0 + 2 * e] * (bflo(cv[e]) * bflo(hv[e])); acc[2 * e + 1] += sw[k * 512 + c0 + 2 * e + 1] * (bfhi(cv[e]) * bfhi(hv[e])); } } }
        const v4u bv = *(const v4u*)(P1 + (size_t)m * NCD + C_BD + c0); v4u o;
#pragma unroll
        for (int e = 0; e < 4; ++e) o[e] = pk2(bflo(bv[e]) * acc[2 * e], bfhi(bv[e]) * acc[2 * e + 1]);
        *(v4u*)((bf16*)(p.ws + WS_ACT + A_MIXB) + (size_t)m * CDO + 1024 + c0) = o; }
}


constexpr size_t A_DNX = 160 * MiB, A_DNEG = 256 * MiB;
constexpr int DN_CHB = 49152, DN_W = 0, DN_QD = 8192, DN_QK = 16384, DN_KD = 24576, DN_U = 32768;
constexpr int DN_KS = 144, DN_R = 9216, DN_WAVE = 2 * DN_R;
__device__ __forceinline__ float rdl(float x, int i) { return __builtin_bit_cast(float, __builtin_amdgcn_readlane(__builtin_bit_cast(int, x), i)); }
__device__ __forceinline__ int lrow_off(int i) { const int a = (i - 1) >> 2, b = (i - 1) & 3; return 4 * (a + 1) * (2 * a + b); }
__host__ __device__ constexpr int lrow_off_c(int i) { return 4 * (((i - 1) >> 2) + 1) * (2 * ((i - 1) >> 2) + ((i - 1) & 3)); }

typedef __amdgpu_buffer_rsrc_t rsrc_t;
__device__ __forceinline__ rsrc_t mk_rsrc(const void* base, unsigned bytes) { return __builtin_amdgcn_make_buffer_rsrc((void*)base, 0, bytes, 0x00020000); }
__device__ __forceinline__ void dn_conv_row(rsrc_t rp, const float* cw, int rowoff, int n, int lane, int coffb, int woff, float (&acc)[64]) {
#pragma unroll
    for (int ch = 0; ch < 64; ++ch) acc[ch] = 0.f;
#pragma unroll
    for (int k = 0; k < 4; ++k) { const int tt = 64 * n + lane - 3 + k;
        v4u xr[8];
        if (tt >= 0) {
#pragma unroll
            for (int i = 0; i < 8; ++i) xr[i] = __builtin_amdgcn_raw_buffer_load_b128(rp, rowoff + (k - 3) * (NAB * 2) + 16 * i, coffb, 0); }
        else {
#pragma unroll
            for (int i = 0; i < 8; ++i) xr[i] = (v4u){0u, 0u, 0u, 0u}; }
#pragma unroll
        for (int i = 0; i < 8; ++i)
#pragma unroll
            for (int e = 0; e < 4; ++e) { const unsigned w = xr[i][e]; acc[8 * i + 2 * e] += cw[k * 1536 + woff + 8 * i + 2 * e] * bflo(w); acc[8 * i + 2 * e + 1] += cw[k * 1536 + woff + 8 * i + 2 * e + 1] * bfhi(w); }
        asm volatile("" ::: "memory"); }
#pragma unroll
    for (int ch = 0; ch < 64; ++ch) acc[ch] = siluf_(acc[ch]);
}
__device__ __forceinline__ void fnma(float& acc, float a, float b) { asm volatile("v_fma_f32 %0, -%1, %2, %0" : "+v"(acc) : "v"(a), "v"(b)); }
__device__ __forceinline__ void dn_solve(const LAS unsigned char* R2, float (&x)[64]) {
#pragma unroll
    for (int i = 1; i < 64; ++i) {
        float a0 = x[i], a1 = 0.f;
#pragma unroll
        for (int g = 0; g < (i + 3) / 4; ++g) { const f32x4_t lv = *(const LAS f32x4_t*)(R2 + (lrow_off_c(i) + 4 * g) * 4);
#pragma unroll
            for (int e = 0; e < 4; ++e) if (4 * g + e < i) { if (e & 1) fnma(a1, lv[e], x[4 * g + e]); else fnma(a0, lv[e], x[4 * g + e]); } }
        x[i] = a0 + a1;
    }
}
__device__ __forceinline__ void dn_prep_chunk(const Ctx& c, const Params& p, int ci, size_t xoff) {
    const int n = ci & 63, h = (ci >> 6) & 7, b = ci >> 9, lane = c.lane;
    const int m0 = b * T + 64 * n;
    LAS unsigned char* R1 = c.lds + c.wave * DN_WAVE; LAS unsigned char* R2 = R1 + DN_R;
    const float* cw = p.in[I_DNCONV];
    const rsrc_t rp = mk_rsrc(p.ws + WS_ACT + A_P, (unsigned)((size_t)M * NAB * 2));
    const rsrc_t rx = mk_rsrc(p.ws + xoff + (size_t)ci * DN_CHB, DN_CHB);
    const int rowoff = (m0 + lane) * (NAB * 2);
#pragma unroll
    for (int s = 0; s < 2; ++s) {
        float acc[64]; dn_conv_row(rp, cw, rowoff, n, lane, (C_QKVB + s * 512 + h * 64) * 2, s * 512 + h * 64, acc);
        float ss = 0.f;
#pragma unroll
        for (int ch = 0; ch < 64; ++ch) ss += acc[ch] * acc[ch];
        const float rn = (s == 1 ? 1.0f : 0.125f) / sqrtf(ss + 1e-6f);
        LAS unsigned char* dst = (s == 1 ? R1 : R2) + lane * DN_KS;
#pragma unroll
        for (int i = 0; i < 8; ++i) { v4u w; w.x = pkbf(acc[8 * i] * rn, acc[8 * i + 1] * rn); w.y = pkbf(acc[8 * i + 2] * rn, acc[8 * i + 3] * rn); w.z = pkbf(acc[8 * i + 4] * rn, acc[8 * i + 5] * rn); w.w = pkbf(acc[8 * i + 6] * rn, acc[8 * i + 7] * rn);
            *(LAS v4u*)(dst + 16 * i) = w; }
        asm volatile("" ::: "memory");
    }
    const float beta = sigmoidf_(bf2f(__builtin_amdgcn_raw_buffer_load_b16(rp, rowoff, (C_BETA + h) * 2, 0)));
    float gc = -__expf(p.in[I_ALOG][h]) * softplusf_(bf2f(__builtin_amdgcn_raw_buffer_load_b16(rp, rowoff, (C_AB + h) * 2, 0)) + p.in[I_DTB][h]);
#pragma unroll
    for (int o = 1; o < 64; o <<= 1) { const float t = __shfl_up(gc, o); if (lane >= o) gc += t; }
    const float gl = rdl(gc, 63), egc = __expf(gc), kdsc = __expf(gl - gc), bw = beta * egc;
    if (lane == 0) ((float*)(p.ws + WS_ACT + A_DNEG))[ci] = __expf(gl);
    asm volatile("s_waitcnt lgkmcnt(0)" ::: "memory");
    const int r32 = lane & 31, hh = lane >> 5, l15 = lane & 15, q4 = lane >> 4;
#pragma unroll
    for (int blk = 0; blk < 4; ++blk) { const int I = blk >> 1, J = blk & 1;
        v4u fa = {0u, 0u, 0u, 0u}, fb = {0u, 0u, 0u, 0u};
        if (!(I == 0 && J == 1)) {
            f32x16 acc;
#pragma unroll
            for (int r = 0; r < 16; ++r) acc[r] = 0.f;
#pragma unroll
            for (int ks = 0; ks < 4; ++ks) { const bf16x8_t ka = *(const LAS bf16x8_t*)(R1 + (32 * J + r32) * DN_KS + 32 * ks + 16 * hh), qb = *(const LAS bf16x8_t*)(R2 + (32 * I + r32) * DN_KS + 32 * ks + 16 * hh);
                acc = __builtin_amdgcn_mfma_f32_32x32x16_bf16(ka, qb, acc, 0, 0, 0); }
            const int i = 32 * I + r32; const float gci = __shfl(gc, i);
            float v[16];
#pragma unroll
            for (int r = 0; r < 16; ++r) { const int j = 32 * J + (r & 3) + 8 * (r >> 2) + 4 * hh; const float gcj = __shfl(gc, j); v[r] = j <= i ? acc[r] * __expf(gci - gcj) : 0.f; }
            fa.x = pkbf(v[0], v[1]); fa.y = pkbf(v[2], v[3]); fa.z = pkbf(v[8], v[9]); fa.w = pkbf(v[10], v[11]);
            fb.x = pkbf(v[4], v[5]); fb.y = pkbf(v[6], v[7]); fb.z = pkbf(v[12], v[13]); fb.w = pkbf(v[14], v[15]);
        }
        const int vo = (r32 >> 4) * 2048 + (l15 + 16 * hh) * 16;
        __builtin_amdgcn_raw_buffer_store_b128(fa, rx, (vo) + (DN_QK + 4096 * I + 1024 * J), 0, 0);
        __builtin_amdgcn_raw_buffer_store_b128(fb, rx, (vo) + (DN_QK + 4096 * I + 1024 * J + 512), 0, 0);
    }
#pragma unroll
    for (int mt = 0; mt < 4; ++mt) { const int row = 16 * mt + l15; const float sc = __shfl(egc, row);
#pragma unroll
        for (int ks = 0; ks < 2; ++ks) { const v2u a = *(const LAS v2u*)(R2 + row * DN_KS + 64 * ks + 8 * q4), bq = *(const LAS v2u*)(R2 + row * DN_KS + 64 * ks + 32 + 8 * q4);
            v4u w; w.x = pkbf(bflo(a.x) * sc, bfhi(a.x) * sc); w.y = pkbf(bflo(a.y) * sc, bfhi(a.y) * sc); w.z = pkbf(bflo(bq.x) * sc, bfhi(bq.x) * sc); w.w = pkbf(bflo(bq.y) * sc, bfhi(bq.y) * sc);
            __builtin_amdgcn_raw_buffer_store_b128(w, rx, (lane * 16) + (DN_QD + (mt * 2 + ks) * 1024), 0, 0); } }
    asm volatile("s_waitcnt lgkmcnt(0)" ::: "memory");
#pragma unroll
    for (int blk = 0; blk < 3; ++blk) { const int I = blk == 0 ? 0 : 1, J = blk == 2 ? 1 : 0;
        f32x16 acc;
#pragma unroll
        for (int r = 0; r < 16; ++r) acc[r] = 0.f;
#pragma unroll
        for (int ks = 0; ks < 4; ++ks) { const bf16x8_t ki = *(const LAS bf16x8_t*)(R1 + (32 * I + r32) * DN_KS + 32 * ks + 16 * hh), kj = *(const LAS bf16x8_t*)(R1 + (32 * J + r32) * DN_KS + 32 * ks + 16 * hh);
            acc = __builtin_amdgcn_mfma_f32_32x32x16_bf16(ki, kj, acc, 0, 0, 0); }
        const int j = 32 * J + r32; const float gcj = __shfl(gc, j);
#pragma unroll
        for (int r = 0; r < 16; ++r) { const int i = 32 * I + (r & 3) + 8 * (r >> 2) + 4 * hh; const float gci = __shfl(gc, i), bi = __shfl(beta, i);
            if (i > j) *(LAS float*)(R2 + (lrow_off(i) + j) * 4) = bi * acc[r] * __expf(gci - gcj); }
    }
    asm volatile("s_waitcnt lgkmcnt(0)" ::: "memory");
    {   float xu[64];
        { const int cb = (C_QKVB + 1024 + h * 64) * 2, wo = 1024 + h * 64 + lane;
          const float w0 = cw[wo], w1 = cw[1536 + wo], w2 = cw[2 * 1536 + wo], w3 = cw[3 * 1536 + wo];
          float x0 = 0.f, x1 = 0.f, x2 = 0.f;
          if (n > 0) { x0 = bf2f(__builtin_amdgcn_raw_buffer_load_b16(rp, lane * 2, (m0 - 3) * (NAB * 2) + cb, 0)); x1 = bf2f(__builtin_amdgcn_raw_buffer_load_b16(rp, lane * 2, (m0 - 2) * (NAB * 2) + cb, 0)); x2 = bf2f(__builtin_amdgcn_raw_buffer_load_b16(rp, lane * 2, (m0 - 1) * (NAB * 2) + cb, 0)); }
#pragma unroll
          for (int i = 0; i < 64; ++i) { const float x3 = bf2f(__builtin_amdgcn_raw_buffer_load_b16(rp, lane * 2, (m0 + i) * (NAB * 2) + cb, 0)); xu[i] = siluf_(w0 * x0 + w1 * x1 + w2 * x2 + w3 * x3) * rdl(beta, i); x0 = x1; x1 = x2; x2 = x3; } }
        dn_solve(R2, xu);
        const int vo = q4 * 4096 + l15 * 16;
#pragma unroll
        for (int mt = 0; mt < 4; ++mt)
#pragma unroll
            for (int qq = 0; qq < 4; ++qq) { const int i0 = 16 * mt + 4 * qq; f32x4_t uv = {xu[i0], xu[i0 + 1], xu[i0 + 2], xu[i0 + 3]};
                __builtin_amdgcn_raw_buffer_store_b128(__builtin_bit_cast(v4u, uv), rx, (vo) + (DN_U + mt * 1024 + qq * 256), 0, 0); }
    }
    asm volatile("" ::: "memory");
    float xw[64];
#pragma unroll
    for (int i = 0; i < 64; ++i) xw[i] = bf2f(*(const LAS unsigned short*)(R1 + i * DN_KS + 2 * lane)) * rdl(bw, i);
    asm volatile("s_waitcnt lgkmcnt(0)" ::: "memory");
    { LAS unsigned char* row = R1 + lane * DN_KS;
#pragma unroll
      for (int i = 0; i < 8; ++i) { v4u w = *(LAS v4u*)(row + 16 * i);
          w.x = pkbf(bflo(w.x) * kdsc, bfhi(w.x) * kdsc); w.y = pkbf(bflo(w.y) * kdsc, bfhi(w.y) * kdsc); w.z = pkbf(bflo(w.z) * kdsc, bfhi(w.z) * kdsc); w.w = pkbf(bflo(w.w) * kdsc, bfhi(w.w) * kdsc);
          *(LAS v4u*)(row + 16 * i) = w; } }
    asm volatile("s_waitcnt lgkmcnt(0)" ::: "memory");
#pragma unroll
    for (int dt = 0; dt < 4; ++dt)
#pragma unroll
        for (int ks = 0; ks < 2; ++ks) { unsigned short e[8];
#pragma unroll
            for (int jj = 0; jj < 8; ++jj) e[jj] = *(const LAS unsigned short*)(R1 + (32 * ks + 16 * (jj >> 2) + 4 * q4 + (jj & 3)) * DN_KS + 2 * (16 * dt + l15));
            v4u w; w.x = e[0] | ((unsigned)e[1] << 16); w.y = e[2] | ((unsigned)e[3] << 16); w.z = e[4] | ((unsigned)e[5] << 16); w.w = e[6] | ((unsigned)e[7] << 16);
            __builtin_amdgcn_raw_buffer_store_b128(w, rx, (lane * 16) + (DN_KD + (dt * 2 + ks) * 1024), 0, 0); }
    asm volatile("s_waitcnt lgkmcnt(0)" ::: "memory");
    dn_solve(R2, xw);
#pragma unroll
    for (int i = 0; i < 64; ++i) *(LAS unsigned short*)(R1 + i * DN_KS + 2 * lane) = (unsigned short)(f2bf(xw[i]) ^ 0x8000u);
    asm volatile("s_waitcnt lgkmcnt(0)" ::: "memory");
#pragma unroll
    for (int mt = 0; mt < 4; ++mt)
#pragma unroll
        for (int ks = 0; ks < 2; ++ks) { const int row = 16 * mt + l15; const v2u a = *(const LAS v2u*)(R1 + row * DN_KS + 64 * ks + 8 * q4), bq = *(const LAS v2u*)(R1 + row * DN_KS + 64 * ks + 32 + 8 * q4);
            v4u w; w.x = a.x; w.y = a.y; w.z = bq.x; w.w = bq.y;
            __builtin_amdgcn_raw_buffer_store_b128(w, rx, (lane * 16) + (DN_W + (mt * 2 + ks) * 1024), 0, 0); }
    asm volatile("s_waitcnt lgkmcnt(0)" ::: "memory");
}
__device__ __forceinline__ void ph_dn_prep2(const Ctx& c, const Params& p, size_t xoff) {
    if (c.gw < 2048) dn_prep_chunk(c, p, c.gw, xoff);
}

constexpr int SC_SLOT = DN_CHB, SC_OB = 2 * DN_CHB, SC_OSTR = 272, SC_OBSZ = 64 * SC_OSTR;
__device__ __forceinline__ bf16x8_t pack8(const f32x4_t& a, const f32x4_t& b) { v4u w; w.x = pkbf(a[0], a[1]); w.y = pkbf(a[2], a[3]); w.z = pkbf(b[0], b[1]); w.w = pkbf(b[2], b[3]); return __builtin_bit_cast(bf16x8_t, w); }
__device__ __forceinline__ void ph_dn_scan2(const Ctx& c, const Params& p) {
    if (c.bid >= 32) return;
    const int b = c.bid >> 3, h = c.bid & 7, lane = c.lane;
    LAS unsigned char* lds = c.lds;
    const unsigned char* dnx = p.ws + WS_ACT + A_DNX + (size_t)(c.bid * 64) * DN_CHB; const float* EG = (const float*)(p.ws + WS_ACT + A_DNEG) + c.bid * 64;
    const bf16* P0 = (const bf16*)(p.ws + WS_ACT + A_P);
    if (c.wave >= 4) {
        const int lw = c.wave - 4, il = lane >> 2, qd = lane & 3;
        float nw[16];
#pragma unroll
        for (int k = 0; k < 16; ++k) nw[k] = p.in[I_DNNORM][16 * qd + k];
        v4u ra[12], rb[12], ga[2] = {{0u, 0u, 0u, 0u}, {0u, 0u, 0u, 0u}}, gb[2] = {{0u, 0u, 0u, 0u}, {0u, 0u, 0u, 0u}};
#define DN_LOAD(R, k) do { const v4u* _s = (const v4u*)(dnx + (size_t)(k) * DN_CHB) + lw * 64 + lane; _Pragma("unroll") for (int _i = 0; _i < 12; ++_i) R[_i] = _s[_i * 256]; } while (0)
#define DN_WRITE(R, slot) do { LAS v4u* _d = (LAS v4u*)(lds + (slot) * SC_SLOT) + lw * 64 + lane; _Pragma("unroll") for (int _i = 0; _i < 12; ++_i) _d[_i * 256] = R[_i]; } while (0)
#define DN_GLOAD(G, k) do { const v4u* _g = (const v4u*)(P0 + ((size_t)b * T + 64 * (k) + 16 * lw + il) * NAB + C_GATEB + h * 64 + 16 * qd); G[0] = _g[0]; G[1] = _g[1]; } while (0)
#define DN_EPI(G, k) do { const LAS unsigned char* _ob = lds + SC_OB + ((k) & 1) * SC_OBSZ + (16 * lw + il) * SC_OSTR + 64 * qd; float _o[16]; float _ss = 0.f; \
            _Pragma("unroll") for (int _i = 0; _i < 4; ++_i) { const f32x4_t _v = *(const LAS f32x4_t*)(_ob + 16 * _i); _o[4 * _i] = _v[0]; _o[4 * _i + 1] = _v[1]; _o[4 * _i + 2] = _v[2]; _o[4 * _i + 3] = _v[3]; _ss += (_v[0] * _v[0] + _v[1] * _v[1]) + (_v[2] * _v[2] + _v[3] * _v[3]); } \
            _ss += __shfl_xor(_ss, 1); _ss += __shfl_xor(_ss, 2); const float _rs = 1.0f / sqrtf(_ss * (1.f / 64.f) + 1e-6f); unsigned _w[8]; \
            _Pragma("unroll") for (int _i = 0; _i < 8; ++_i) { const unsigned _gw = G[_i >> 2][_i & 3]; const float _g0 = bflo(_gw), _g1 = bfhi(_gw); _w[_i] = pkbf(_o[2 * _i] * _rs * nw[2 * _i] * siluf_(_g0), _o[2 * _i + 1] * _rs * nw[2 * _i + 1] * siluf_(_g1)); } \
            v4u* _dst = (v4u*)((bf16*)(p.ws + WS_ACT + A_MIXA) + ((size_t)b * T + 64 * (k) + 16 * lw + il) * D + 512 + h * 64 + 16 * qd); _dst[0] = (v4u){_w[0], _w[1], _w[2], _w[3]}; _dst[1] = (v4u){_w[4], _w[5], _w[6], _w[7]}; } while (0)
        DN_LOAD(ra, 0); DN_WRITE(ra, 0); DN_LOAD(rb, 1); DN_LOAD(ra, 2);
        for (int n = 0; n < 64; n += 2) {
            asm volatile("s_waitcnt lgkmcnt(0)" ::: "memory"); __syncthreads();
            DN_WRITE(rb, 1);
            if (n >= 1) DN_EPI(gb, n - 1);
            DN_GLOAD(ga, n);
            if (n + 3 < 64) DN_LOAD(rb, n + 3);
            asm volatile("s_waitcnt lgkmcnt(0)" ::: "memory"); __syncthreads();
            if (n + 2 < 64) DN_WRITE(ra, 0);
            DN_EPI(ga, n);
            DN_GLOAD(gb, n + 1);
            if (n + 4 < 64) DN_LOAD(ra, n + 4);
        }
        asm volatile("s_waitcnt lgkmcnt(0)" ::: "memory"); __syncthreads();
        DN_EPI(gb, 63);
#undef DN_LOAD
#undef DN_WRITE
#undef DN_GLOAD
#undef DN_EPI
    } else {
        const int w = c.wave, e15 = lane & 15, q4 = lane >> 4;
        f32x4_t S[4];
#pragma unroll
        for (int dt = 0; dt < 4; ++dt) S[dt] = (f32x4_t){0.f, 0.f, 0.f, 0.f};
        float egn = EG[0];
#define DN_STEP(n_, slot) do { const LAS unsigned char* sb = lds + (slot) * SC_SLOT; const float eg = egn; egn = EG[(n_) + 1 < 64 ? (n_) + 1 : 63]; \
            const bf16x8_t Bs0 = pack8(S[0], S[1]), Bs1 = pack8(S[2], S[3]); f32x4_t vn[4], oo[4]; \
            _Pragma("unroll") for (int mt = 0; mt < 4; ++mt) { vn[mt] = *(const LAS f32x4_t*)(sb + DN_U + ((w * 4 + mt) * 64 + lane) * 16); \
                vn[mt] = __builtin_amdgcn_mfma_f32_16x16x32_bf16(*(const LAS bf16x8_t*)(sb + DN_W + ((mt * 2 + 0) * 64 + lane) * 16), Bs0, vn[mt], 0, 0, 0); \
                vn[mt] = __builtin_amdgcn_mfma_f32_16x16x32_bf16(*(const LAS bf16x8_t*)(sb + DN_W + ((mt * 2 + 1) * 64 + lane) * 16), Bs1, vn[mt], 0, 0, 0); \
                oo[mt] = (f32x4_t){0.f, 0.f, 0.f, 0.f}; \
                oo[mt] = __builtin_amdgcn_mfma_f32_16x16x32_bf16(*(const LAS bf16x8_t*)(sb + DN_QD + ((mt * 2 + 0) * 64 + lane) * 16), Bs0, oo[mt], 0, 0, 0); \
                oo[mt] = __builtin_amdgcn_mfma_f32_16x16x32_bf16(*(const LAS bf16x8_t*)(sb + DN_QD + ((mt * 2 + 1) * 64 + lane) * 16), Bs1, oo[mt], 0, 0, 0); } \
            const bf16x8_t Bv0 = pack8(vn[0], vn[1]), Bv1 = pack8(vn[2], vn[3]); \
            _Pragma("unroll") for (int mt = 0; mt < 4; ++mt) { \
                oo[mt] = __builtin_amdgcn_mfma_f32_16x16x32_bf16(*(const LAS bf16x8_t*)(sb + DN_QK + ((mt * 2 + 0) * 64 + lane) * 16), Bv0, oo[mt], 0, 0, 0); \
                if (mt >= 2) oo[mt] = __builtin_amdgcn_mfma_f32_16x16x32_bf16(*(const LAS bf16x8_t*)(sb + DN_QK + ((mt * 2 + 1) * 64 + lane) * 16), Bv1, oo[mt], 0, 0, 0); } \
            _Pragma("unroll") for (int dt = 0; dt < 4; ++dt) { S[dt] = S[dt] * eg; \
                S[dt] = __builtin_amdgcn_mfma_f32_16x16x32_bf16(*(const LAS bf16x8_t*)(sb + DN_KD + ((dt * 2 + 0) * 64 + lane) * 16), Bv0, S[dt], 0, 0, 0); \
                S[dt] = __builtin_amdgcn_mfma_f32_16x16x32_bf16(*(const LAS bf16x8_t*)(sb + DN_KD + ((dt * 2 + 1) * 64 + lane) * 16), Bv1, S[dt], 0, 0, 0); } \
            LAS unsigned char* ob = lds + SC_OB + ((n_) & 1) * SC_OBSZ + (16 * w + e15) * 4; \
            _Pragma("unroll") for (int mt = 0; mt < 4; ++mt) _Pragma("unroll") for (int r4 = 0; r4 < 4; ++r4) *(LAS float*)(ob + (16 * mt + 4 * q4 + r4) * SC_OSTR) = oo[mt][r4]; } while (0)
        for (int n = 0; n < 64; n += 2) {
            asm volatile("s_waitcnt lgkmcnt(0)" ::: "memory"); __syncthreads();
            DN_STEP(n, 0);
            asm volatile("s_waitcnt lgkmcnt(0)" ::: "memory"); __syncthreads();
            DN_STEP(n + 1, 1);
        }
        asm volatile("s_waitcnt lgkmcnt(0)" ::: "memory"); __syncthreads();
#undef DN_STEP
    }
}


constexpr size_t A_ODN = 257 * MiB;
__device__ __forceinline__ void ph_dn_scan_simple(const Ctx& c, const Params& p) {
    if (c.bid >= 32 || c.wave >= 4) return;
    const int b = c.bid >> 3, h = c.bid & 7, lane = c.lane, w = c.wave, e15 = lane & 15, q4 = lane >> 4;
    const unsigned char* dnx = p.ws + WS_ACT + A_DNX + (size_t)(c.bid * 64) * DN_CHB; const float* EG = (const float*)(p.ws + WS_ACT + A_DNEG) + c.bid * 64;
    float* ODN = (float*)(p.ws + WS_ACT + A_ODN);
    f32x4_t S[4];
#pragma unroll
    for (int dt = 0; dt < 4; ++dt) S[dt] = (f32x4_t){0.f, 0.f, 0.f, 0.f};
    for (int n = 0; n < 64; ++n) { const unsigned char* sb = dnx + (size_t)n * DN_CHB; const float eg = EG[n];
        const bf16x8_t Bs0 = pack8(S[0], S[1]), Bs1 = pack8(S[2], S[3]); f32x4_t vn[4], oo[4];
#pragma unroll
        for (int mt = 0; mt < 4; ++mt) { vn[mt] = *(const f32x4_t*)(sb + DN_U + ((w * 4 + mt) * 64 + lane) * 16);
            vn[mt] = __builtin_amdgcn_mfma_f32_16x16x32_bf16(*(const bf16x8_t*)(sb + DN_W + ((mt * 2 + 0) * 64 + lane) * 16), Bs0, vn[mt], 0, 0, 0);
            vn[mt] = __builtin_amdgcn_mfma_f32_16x16x32_bf16(*(const bf16x8_t*)(sb + DN_W + ((mt * 2 + 1) * 64 + lane) * 16), Bs1, vn[mt], 0, 0, 0);
            oo[mt] = (f32x4_t){0.f, 0.f, 0.f, 0.f};
            oo[mt] = __builtin_amdgcn_mfma_f32_16x16x32_bf16(*(const bf16x8_t*)(sb + DN_QD + ((mt * 2 + 0) * 64 + lane) * 16), Bs0, oo[mt], 0, 0, 0);
            oo[mt] = __builtin_amdgcn_mfma_f32_16x16x32_bf16(*(const bf16x8_t*)(sb + DN_QD + ((mt * 2 + 1) * 64 + lane) * 16), Bs1, oo[mt], 0, 0, 0); }
        const bf16x8_t Bv0 = pack8(vn[0], vn[1]), Bv1 = pack8(vn[2], vn[3]);
#pragma unroll
        for (int mt = 0; mt < 4; ++mt) {
            oo[mt] = __builtin_amdgcn_mfma_f32_16x16x32_bf16(*(const bf16x8_t*)(sb + DN_QK + ((mt * 2 + 0) * 64 + lane) * 16), Bv0, oo[mt], 0, 0, 0);
            oo[mt] = __builtin_amdgcn_mfma_f32_16x16x32_bf16(*(const bf16x8_t*)(sb + DN_QK + ((mt * 2 + 1) * 64 + lane) * 16), Bv1, oo[mt], 0, 0, 0); }
#pragma unroll
        for (int dt = 0; dt < 4; ++dt) { S[dt] = S[dt] * eg;
            S[dt] = __builtin_amdgcn_mfma_f32_16x16x32_bf16(*(const bf16x8_t*)(sb + DN_KD + ((dt * 2 + 0) * 64 + lane) * 16), Bv0, S[dt], 0, 0, 0);
            S[dt] = __builtin_amdgcn_mfma_f32_16x16x32_bf16(*(const bf16x8_t*)(sb + DN_KD + ((dt * 2 + 1) * 64 + lane) * 16), Bv1, S[dt], 0, 0, 0); }
#pragma unroll
        for (int mt = 0; mt < 4; ++mt)
#pragma unroll
            for (int r4 = 0; r4 < 4; ++r4) ODN[((size_t)b * T + 64 * n + 16 * mt + 4 * q4 + r4) * 512 + h * 64 + 16 * w + e15] = oo[mt][r4];
    }
}
__device__ __forceinline__ void ph_dn_epi_simple(const Ctx& c, const Params& p) {
    const float* ODN = (const float*)(p.ws + WS_ACT + A_ODN); const bf16* P0 = (const bf16*)(p.ws + WS_ACT + A_P);
    for (int it = c.gw; it < M * 8; it += c.NGW) { const int m = it >> 3, h = it & 7;
        const float o = ODN[(size_t)m * 512 + h * 64 + c.lane];
        const float rs = 1.0f / sqrtf(wave_sum(o * o) * (1.f / 64.f) + 1e-6f);
        const float gt = bf2f(P0[(size_t)m * NAB + C_GATEB + h * 64 + c.lane]);
        ((bf16*)(p.ws + WS_ACT + A_MIXA))[(size_t)m * D + 512 + h * 64 + c.lane] = (bf16)f2bf(o * rs * p.in[I_DNNORM][c.lane] * siluf_(gt)); }
}

__global__ void __launch_bounds__(NTHR, 2) mega(MArgs a) {
    extern __shared__ __attribute__((aligned(16))) unsigned char lds_raw[];
    Ctx c; c.lds = (LAS unsigned char*)lds_raw; c.tid = threadIdx.x; c.lane = c.tid & 63; c.wave = __builtin_amdgcn_readfirstlane(c.tid >> 6);
    c.G = gridDim.x; c.bid = blockIdx.x; c.gw = c.bid * NWAVES + c.wave; c.NGW = c.G * NWAVES;
    const Params& p = a.p;
    volatile LAS unsigned* MISC = (volatile LAS unsigned*)(c.lds + LDS_MISC);
    if (c.tid < 64) MISC[c.tid] = 0u;
    __syncthreads();
    XcdBarrier bar = xcd_barrier_post((unsigned*)(p.ws + WS_CTL) + CW_BAR, MISC);
    const int lo = a.ph_lo, hi = a.ph_hi;
#define IN(k) (lo <= (k) && (k) < hi)
#define SEAM(k) do { if (IN(k) && IN((k) + 1)) xcd_barrier(bar); } while (0)
#ifndef DUP_MASK
#define DUP_MASK 0
#endif
#define DUP(k) ((DUP_MASK >> (k)) & 1)
    if (IN(0)) { ph_convert(c, a.t1, c.gw, c.NGW); ph_ada(c, p); if (DUP(0)) { xcd_barrier(bar); ph_convert(c, a.t1, c.gw, c.NGW); ph_ada(c, p); } } SEAM(0);
    if (IN(1)) { ph_norm<0>(c, p); if (DUP(1)) { xcd_barrier(bar); ph_norm<0>(c, p); } } SEAM(1);
    if (IN(2)) { ph_gemm<G_ABIN>(c, p); if (DUP(2)) { xcd_barrier(bar); ph_gemm<G_ABIN>(c, p); } } SEAM(2);
    if (IN(3)) { ph_dn_prep2(c, p, A_DNX + WS_ACT); if (DUP(3)) { xcd_barrier(bar); ph_dn_prep2(c, p, A_DNX + WS_ACT); } } SEAM(3);
    if (IN(4)) { if (c.bid < 32) ph_dn_scan2(c, p); else { for (int u = c.bid - 32; u < 256; u += c.G - 32) attn_unit(c, p, u); __syncthreads(); ph_convert(c, a.t2, (c.bid - 32) * NWAVES + c.wave, (c.G - 32) * NWAVES); } if (DUP(4)) { xcd_barrier(bar); if (c.bid < 32) ph_dn_scan2(c, p); else { for (int u = c.bid - 32; u < 256; u += c.G - 32) attn_unit(c, p, u); __syncthreads(); ph_convert(c, a.t2, (c.bid - 32) * NWAVES + c.wave, (c.G - 32) * NWAVES); } } if (DUP(20)) { xcd_barrier(bar); if (c.bid < 32) ph_dn_scan2(c, p); } } SEAM(4);
    if (IN(5)) { ph_gemm<G_ABOUT>(c, p); if (DUP(5)) { xcd_barrier(bar); ph_gemm<G_ABOUT>(c, p); } } SEAM(5);
    if (IN(6)) { ph_norm<1>(c, p); if (DUP(6)) { xcd_barrier(bar); ph_norm<1>(c, p); } } SEAM(6);
    if (IN(7)) { ph_gemm<G_FFNGU>(c, p); if (DUP(7)) { xcd_barrier(bar); ph_gemm<G_FFNGU>(c, p); } } SEAM(7);
    if (IN(8)) { if (DUP(8)) { ph_gemm<G_FFND_PROBE>(c, p); xcd_barrier(bar); } ph_gemm<G_FFND>(c, p); } SEAM(8);
    if (IN(9)) { ph_norm<2>(c, p); if (DUP(9)) { xcd_barrier(bar); ph_norm<2>(c, p); } } SEAM(9);
    if (IN(10)) { ph_gemm<G_CDIN>(c, p); if (DUP(10)) { xcd_barrier(bar); ph_gemm<G_CDIN>(c, p); } } SEAM(10);
    if (IN(11)) { ph_lru1(c, p); ph_sconv(c, p); if (DUP(11)) { xcd_barrier(bar); ph_lru1(c, p); ph_sconv(c, p); } } SEAM(11);
    if (IN(12)) { ph_lru2(c, p); if (DUP(12)) { xcd_barrier(bar); ph_lru2(c, p); } } SEAM(12);
    if (IN(13)) { if (DUP(13)) { ph_gemm<G_CDOUT_PROBE>(c, p); xcd_barrier(bar); } ph_gemm<G_CDOUT>(c, p); } SEAM(13);
    if (IN(14)) { ph_norm<3>(c, p); } SEAM(14);
    if (IN(15)) { ph_route(c, p, 0); if (DUP(15)) { xcd_barrier(bar); ph_route(c, p, 64); } } SEAM(15);
    if (IN(16)) { ph_gemm<G_MOEGU>(c, p); if (DUP(16)) { xcd_barrier(bar); ph_gemm<G_MOEGU>(c, p); } } SEAM(16);
    if (IN(17)) { ph_gemm<G_MOED>(c, p); if (DUP(17)) { xcd_barrier(bar); ph_gemm<G_MOED>(c, p); } } SEAM(17);
    if (IN(18)) { if (DUP(18)) { ph_final<true>(c, p); xcd_barrier(bar); } ph_final<false>(c, p); }
#undef IN
#undef SEAM
}

constexpr int N_PHASES = 19;
static void add_desc(ConvTab& t, const float* src, bf16* dst, int K, int N, int Npad, int mode, int row_off, int nbatch, long long sstride, long long dstride) {
    ConvDesc& d = t.d[t.nd]; d.src = src; d.dst = dst; d.sstride = sstride; d.dstride = dstride; d.K = K; d.N = N; d.Npad = Npad; d.mode = mode; d.row_off = row_off; d.nbatch = nbatch;
    d.items_pb = (K / 64) * (Npad / 64); d.item0 = t.total; t.total += d.items_pb * nbatch; t.nd++;
}
extern "C" void kernel_launch(void* const* d_in, const int* in_sizes, int n_in, void* d_out, int out_size, void* d_ws, size_t ws_size, hipStream_t stream) {
    static int grid = 0;
    if (grid == 0) {
        if (n_in != 33 || out_size != M * D || ws_size < WS_END) { fprintf(stderr, "kernel_launch: unexpected shapes (n_in %d out %d ws %zu)\n", n_in, out_size, ws_size); grid = -1; return; }
        int dev = 0, cus = 0;
        if (hipGetDevice(&dev) != hipSuccess || hipDeviceGetAttribute(&cus, hipDeviceAttributeMultiprocessorCount, dev) != hipSuccess) { grid = -1; return; }
        if (hipFuncSetAttribute((const void*)mega, hipFuncAttributeMaxDynamicSharedMemorySize, LDS_BYTES) != hipSuccess) { fprintf(stderr, "kernel_launch: hipFuncSetAttribute failed\n"); grid = -1; return; }
        int per_cu = 0;
        if (hipOccupancyMaxActiveBlocksPerMultiprocessor(&per_cu, (const void*)mega, NTHR, LDS_BYTES) != hipSuccess || per_cu < 1) { fprintf(stderr, "kernel_launch: occupancy query says %d\n", per_cu); }
        (void)hipGetLastError();
        grid = cus;
    }
    if (grid < 0) return;
    MArgs a{};
    for (int i = 0; i < 33; ++i) a.p.in[i] = (const float*)d_in[i];
    a.p.out = (float*)d_out; a.p.ws = (unsigned char*)d_ws;
    unsigned char* ws = a.p.ws; const Params& p = a.p;
    (void)hipMemsetAsync(ws + WS_CTL, 0, CTL_ZERO_BYTES, stream);
    add_desc(a.t1, p.in[I_ABIN], (bf16*)(ws + WS_WAB_IN), D, 2832, NAB, 0, 0, 1, 0, 0);
    add_desc(a.t1, p.in[I_ABOUT], (bf16*)(ws + WS_WAB_OUT), D, D, D, 0, 0, 1, 0, 0);
    add_desc(a.t1, p.in[I_FG], (bf16*)(ws + WS_WFFN_GU), D, FF, FF, 1, 0, 1, 0, 0);
    add_desc(a.t1, p.in[I_FU], (bf16*)(ws + WS_WFFN_GU), D, FF, FF, 1, 128, 1, 0, 0);
    add_desc(a.t1, p.in[I_FD], (bf16*)(ws + WS_WFFN_D), FF, D, D, 0, 0, 1, 0, 0);
    add_desc(a.t1, p.in[I_CDIN], (bf16*)(ws + WS_WCD_IN), D, NCD, NCD, 0, 0, 1, 0, 0);
    add_desc(a.t1, p.in[I_CDOUT], (bf16*)(ws + WS_WCD_OUT), CDO, D, D, 0, 0, 1, 0, 0);
    add_desc(a.t1, p.in[I_GAW], (bf16*)(ws + WS_WLRU), 128, 128, 128, 0, 0, 8, 128 * 128, 256 * 128);
    add_desc(a.t1, p.in[I_GXW], (bf16*)(ws + WS_WLRU), 128, 128, 128, 0, 128, 8, 128 * 128, 256 * 128);
    add_desc(a.t2, p.in[I_MG], (bf16*)(ws + WS_WMOE_GU), D, FFE, FFE, 3, 0, NE, (long long)D * FFE, (long long)FFE * D);
    add_desc(a.t2, p.in[I_MU], (bf16*)(ws + WS_WMOE_GU), D, FFE, FFE, 3, 128, NE, (long long)D * FFE, (long long)FFE * D);
    add_desc(a.t2, p.in[I_MD], (bf16*)(ws + WS_WMOE_D), FFE, D, D, 2, 0, NE, (long long)FFE * D, (long long)D * FFE / 2);
    a.ph_lo = 0; a.ph_hi = N_PHASES;
    hipLaunchKernelGGL(mega, dim3(grid), dim3(NTHR), LDS_BYTES, stream, a);
}
```

```cpp
#define DUP_MASK 0
#include <hip/hip_runtime.h>
#include <cstdio>
#include <cstdint>
namespace pg8 {
#define PG8_LAS __attribute__((address_space(3)))
typedef unsigned short bf16_t;
typedef short bf16x8 __attribute__((ext_vector_type(8)));
typedef float f32x4 __attribute__((ext_vector_type(4)));
typedef unsigned u32x4 __attribute__((ext_vector_type(4)));
constexpr int BM = 256, BK = 64, HALF = 128, HTB = HALF * BK * 2  , STAGE_BYTES = 8 * HTB, NXCD = 8, WGM = 8;

__host__ __device__ __forceinline__ int lds_byte(int r, int c) { const int st = (r >> 4) * 2 + (c >> 5), rr = r & 15, cc = c & 31, ob = rr * 64 + cc * 2; return st * 1024 + (ob ^ (((ob >> 9) & 1) << 5)); }
__host__ __device__ __forceinline__ void stage_rc(int b, int& R, int& C) { const int st = b / 1024, sb = b % 1024, swz = sb ^ (((sb >> 9) & 1) << 5); R = (st >> 1) * 16 + swz / 64; C = (st & 1) * 32 + (swz % 64) / 2; }
__host__ __device__ __forceinline__ int perm32(int rho) { const int n = rho >> 4, i = rho & 15; return 8 * (i >> 2) + 4 * n + (i & 3); }

struct Unit { int pm, pn, e; };
struct Gemm { const bf16_t* A; const bf16_t* Bt; int M, N, K; size_t eb; };

struct StaticOrder {
    int nM, nN, nwg, G, c;
    __host__ __device__ void init(int M, int N, int G_, int c_) { nM = M / BM; nN = N / BM; nwg = nM * nN; G = G_; c = c_; }
    __host__ __device__ bool next(int i, Unit& u) const {
        const long L = (long)i * G + c; if (L >= nwg) return false;
        int wgid = (int)L; { const int q = nwg / NXCD, r = nwg % NXCD, xcd = wgid % NXCD, off = wgid / NXCD; wgid = (xcd < r ? xcd * (q + 1) : r * (q + 1) + (xcd - r) * q) + off; }
        const int nig = WGM * nN, gid = wgid / nig, fm = gid * WGM, gsz = (nM - fm) < WGM ? (nM - fm) : WGM;
        u.pm = fm + ((wgid % nig) % gsz); u.pn = (wgid % nig) / gsz; u.e = 0; return true;
    }
    __device__ __forceinline__ void a_ready(const Unit&) const {}
    __device__ __forceinline__ void done(const Unit&) const {}
};

__device__ __forceinline__ unsigned cvt_pk_bf16(float lo, float hi) { unsigned r; asm volatile("v_cvt_pk_bf16_f32 %0, %1, %2" : "=v"(r) : "v"(lo), "v"(hi)); return r; }

__device__ __forceinline__ float fast_silu(float g) { return g * __builtin_amdgcn_rcpf(1.0f + __expf(-g)); }
struct EpiStoreBf16 {
    static constexpr bool PERM = true, AFTER_DRAIN = false;
    bf16_t* O; int ldc; const float* rowscale;
    __device__ __forceinline__ void operator()(const f32x4 (&acc)[2][2][4][2], const Unit& u, int wr, int wc, int fr, int fq) const {
        const int row0 = u.pm * BM + wr * 64 + fr, col0 = u.pn * BM + wc * 32 + 8 * fq;
#pragma unroll
        for (int ai = 0; ai < 2; ++ai)
#pragma unroll
            for (int m = 0; m < 4; ++m) { const int row = row0 + ai * HALF + m * 16; bf16_t* rowp = O + (size_t)row * ldc + col0;
                const float s = rowscale ? rowscale[row] : 1.f;
#pragma unroll
                for (int bj = 0; bj < 2; ++bj) { const f32x4 v0 = acc[ai][bj][m][0] * s, v1 = acc[ai][bj][m][1] * s;
                    u32x4 w; w.x = cvt_pk_bf16(v0[0], v0[1]); w.y = cvt_pk_bf16(v0[2], v0[3]); w.z = cvt_pk_bf16(v1[0], v1[1]); w.w = cvt_pk_bf16(v1[2], v1[3]);
                    *(u32x4*)(rowp + bj * HALF) = w; } }
    }
};
struct EpiSwiglu {
    static constexpr bool PERM = true, AFTER_DRAIN = false;
    bf16_t* O; int ldc;
    __device__ __forceinline__ void operator()(const f32x4 (&acc)[2][2][4][2], const Unit& u, int wr, int wc, int fr, int fq) const {
        const int row0 = u.pm * BM + wr * 64 + fr, col0 = u.pn * HALF + wc * 32 + 8 * fq;
#pragma unroll
        for (int ai = 0; ai < 2; ++ai)
#pragma unroll
            for (int m = 0; m < 4; ++m) { const int row = row0 + ai * HALF + m * 16; bf16_t* rowp = O + (size_t)row * ldc + col0;
                const f32x4 g0 = acc[ai][0][m][0], g1 = acc[ai][0][m][1], u0 = acc[ai][1][m][0], u1 = acc[ai][1][m][1];
                float h[8];
#pragma unroll
                for (int i = 0; i < 4; ++i) { h[i] = fast_silu(g0[i]) * u0[i]; h[4 + i] = fast_silu(g1[i]) * u1[i]; }
                u32x4 w; w.x = cvt_pk_bf16(h[0], h[1]); w.y = cvt_pk_bf16(h[2], h[3]); w.z = cvt_pk_bf16(h[4], h[5]); w.w = cvt_pk_bf16(h[6], h[7]);
                *(u32x4*)rowp = w; }
    }
};
struct EpiRes {
    static constexpr bool PERM = false, AFTER_DRAIN = false;
    const float* base; float* out; int ldc; const float* gate;
    __device__ __forceinline__ void operator()(const f32x4 (&acc)[2][2][4][2], const Unit& u, int wr, int wc, int fr, int fq) const {
        const int row0 = u.pm * BM + wr * 64 + fr, col0 = u.pn * BM + wc * 32 + 4 * fq;
        const float* gp = gate + (size_t)(u.pm >> 4) * 6144 + col0;
        f32x4 gv[2][2];
#pragma unroll
        for (int bj = 0; bj < 2; ++bj)
#pragma unroll
            for (int n = 0; n < 2; ++n) gv[bj][n] = *(const f32x4*)(gp + bj * HALF + n * 16);
#pragma unroll
        for (int ai = 0; ai < 2; ++ai)
#pragma unroll
            for (int m = 0; m < 4; ++m) { const size_t off = (size_t)(row0 + ai * HALF + m * 16) * ldc + col0;
#pragma unroll
                for (int bj = 0; bj < 2; ++bj)
#pragma unroll
                    for (int n = 0; n < 2; ++n) { const f32x4 bs = *(const f32x4*)(base + off + bj * HALF + n * 16);
                        *(f32x4*)(out + off + bj * HALF + n * 16) = bs + gv[bj][n] * acc[ai][bj][m][n]; } }
    }
};

__device__ __forceinline__ unsigned pk_fp8x4(float a, float b, float c, float d) { int w = 0; w = __builtin_amdgcn_cvt_pk_fp8_f32(a, b, w, false); w = __builtin_amdgcn_cvt_pk_fp8_f32(c, d, w, true); return (unsigned)w; }
constexpr float WSCALE = 1.0f / 64.0f;
typedef unsigned u32x2 __attribute__((ext_vector_type(2)));
struct EpiSwiglu8 {
    static constexpr bool PERM = true, AFTER_DRAIN = false;
    unsigned char* O; int ldc;
    __device__ __forceinline__ void operator()(const f32x4 (&acc)[2][2][4][2], const Unit& u, int wr, int wc, int fr, int fq) const {
        const unsigned off0 = (unsigned)(u.pm * BM + wr * 64 + fr) * (unsigned)ldc + (unsigned)(u.pn * HALF + wc * 32 + 8 * fq);
#pragma unroll
        for (int ai = 0; ai < 2; ++ai)
#pragma unroll
            for (int m = 0; m < 4; ++m) { unsigned char* rowp = O + (size_t)(off0 + (unsigned)((ai * HALF + m * 16) * ldc));
#pragma unroll
                for (int n = 0; n < 2; ++n) { const f32x4 g = acc[ai][0][m][n], uu = acc[ai][1][m][n];
                    *(unsigned*)(rowp + 4 * n) = pk_fp8x4(fast_silu(g[0]) * uu[0], fast_silu(g[1]) * uu[1], fast_silu(g[2]) * uu[2], fast_silu(g[3]) * uu[3]); } }
    }
};
struct EpiStoreBf16S {
    static constexpr bool PERM = true, AFTER_DRAIN = false;
    bf16_t* O; int ldc; const float* rowscale;
    __device__ __forceinline__ void operator()(const f32x4 (&acc)[2][2][4][2], const Unit& u, int wr, int wc, int fr, int fq) const {
        asm volatile("" : "+v"(fr), "+v"(fq));
        const int row0 = u.pm * BM + wr * 64 + fr, col0 = u.pn * BM + wc * 32 + 8 * fq;
#pragma unroll
        for (int ai = 0; ai < 2; ++ai)
#pragma unroll
            for (int m = 0; m < 4; ++m) { const int row = row0 + ai * HALF + m * 16; bf16_t* rowp = O + (size_t)row * ldc + col0;
                const float s = rowscale[row];
#pragma unroll
                for (int bj = 0; bj < 2; ++bj) { const f32x4 v0 = acc[ai][bj][m][0] * s, v1 = acc[ai][bj][m][1] * s;
                    u32x4 w; w.x = cvt_pk_bf16(v0[0], v0[1]); w.y = cvt_pk_bf16(v0[2], v0[3]); w.z = cvt_pk_bf16(v1[0], v1[1]); w.w = cvt_pk_bf16(v1[2], v1[3]);
                    *(u32x4*)(rowp + bj * HALF) = w; } }
    }
};
struct GroupedOrder {
    int nM, nN, nwg, G, c; const int* tile_e;
    __device__ void init(int nMt, int N, int G_, int c_, const int* te) { nM = nMt; nN = N / BM; nwg = nM * nN; G = G_; c = c_; tile_e = te; }
    __device__ bool next(int i, Unit& u) const {
        const int L = i * G + c; if (L >= nwg) return false;
        u.pm = L / nN; u.pn = L - u.pm * nN; u.e = __builtin_amdgcn_readfirstlane(tile_e[u.pm]); return true;
    }
    __device__ __forceinline__ void a_ready(const Unit&) const {}
    __device__ __forceinline__ void done(const Unit&) const {}
};

template <class Epi, class Sched, bool ALIGN_EPI = false, bool SP2 = false>
__device__ __forceinline__ void gemm_phase(PG8_LAS unsigned char* lds, const Gemm g, const Sched& S, const Epi& E) {
    const int tid = threadIdx.x, wid = __builtin_amdgcn_readfirstlane(tid >> 6), lane = tid & 63, wr = wid >> 2, wc = wid & 3, fr = lane & 15, fq = lane >> 4;
    const int K = g.K, nt = K / BK;
    unsigned voffA[2], voffB[2];
#pragma unroll
    for (int i = 0; i < 2; ++i) { int R, C; stage_rc(tid * 16 + i * 8192, R, C); const int Rb = Epi::PERM ? ((R & ~31) + perm32(R & 31)) : R;
        voffA[i] = (unsigned)(R * K + C) * 2u; voffB[i] = (unsigned)(Rb * K + C) * 2u; }
    const size_t kstep = (size_t)(BK * 2);
    const size_t hstep = (size_t)HALF * K * 2;
    const size_t tstep = 2 * hstep;
    const unsigned ldsw = (unsigned)wid * 1024u;
    const int aoff = lds_byte(wr * 64 + fr, fq * 8), boff = lds_byte(wc * 32 + fr, fq * 8);
#define PG8_SA(b, h) (((b) * 2 + (h)) * HTB)
#define PG8_SB(b, h) ((4 + (b) * 2 + (h)) * HTB)
#define PG8_STAGE(bufoff, gbase, voff) do { _Pragma("unroll") for (int _i = 0; _i < 2; ++_i) \
        __builtin_amdgcn_global_load_lds((const unsigned*)((const char*)(gbase) + (voff)[_i]), (PG8_LAS unsigned*)(lds + (bufoff) + ldsw + _i * 8192), 16, 0, 0); } while (0)
#define PG8_LDA(dst, b, h) do { _Pragma("unroll") for (int m = 0; m < 4; ++m) _Pragma("unroll") for (int k = 0; k < 2; ++k) dst[m][k] = *(const PG8_LAS bf16x8*)(lds + PG8_SA(b, h) + aoff + m * 2048 + k * 1024); } while (0)
#define PG8_LDB(dst, b, h) do { _Pragma("unroll") for (int n = 0; n < 2; ++n) _Pragma("unroll") for (int k = 0; k < 2; ++k) dst[n][k] = *(const PG8_LAS bf16x8*)(lds + PG8_SB(b, h) + boff + n * 2048 + k * 1024); } while (0)
#define PG8_MMA(ai, bj, At, Bt) do { __builtin_amdgcn_s_setprio(1); _Pragma("unroll") for (int m = 0; m < 4; ++m) _Pragma("unroll") for (int n = 0; n < 2; ++n) _Pragma("unroll") for (int k = 0; k < 2; ++k) \
        acc[ai][bj][m][n] = __builtin_amdgcn_mfma_f32_16x16x32_bf16(Bt[n][k], At[m][k], acc[ai][bj][m][n], 0, 0, 0); __builtin_amdgcn_s_setprio(0); } while (0)
#define PG8_WAIT_V(n) asm volatile("s_waitcnt vmcnt(" #n ")" ::: "memory")
#define PG8_WAIT_L(n) asm volatile("s_waitcnt lgkmcnt(" #n ")" ::: "memory")
#define PG8_BAR __builtin_amdgcn_s_barrier()
#define PG8_SCHED __builtin_amdgcn_sched_barrier(0)
    Unit cur, nxt; int ui = 0;
    if (!S.next(0, cur)) return;
    f32x4 acc[2][2][4][2];
#pragma unroll
    for (int a = 0; a < 2; ++a)
#pragma unroll
        for (int b = 0; b < 2; ++b)
#pragma unroll
            for (int m = 0; m < 4; ++m)
#pragma unroll
                for (int n = 0; n < 2; ++n) acc[a][b][m][n] = (f32x4){0.f, 0.f, 0.f, 0.f};
    bf16x8 At[4][2], B0[2][2], B1[2][2];
    const char* cA = (const char*)g.A + (size_t)cur.pm * tstep; const char* cB = (const char*)g.Bt + (size_t)cur.e * g.eb + (size_t)cur.pn * tstep;
    S.a_ready(cur);
    if constexpr (SP2) {
        PG8_STAGE(PG8_SB(0, 0), cB, voffB); PG8_STAGE(PG8_SB(0, 1), cB + hstep, voffB); PG8_STAGE(PG8_SA(0, 0), cA, voffA); PG8_STAGE(PG8_SA(0, 1), cA + hstep, voffA);
        if (wr == 1) PG8_BAR;
        PG8_WAIT_V(2); PG8_BAR;
        PG8_STAGE(PG8_SB(1, 0), cB + kstep, voffB); PG8_STAGE(PG8_SA(1, 0), cA + kstep, voffA); PG8_STAGE(PG8_SB(1, 1), cB + hstep + kstep, voffB);
        PG8_WAIT_V(6); PG8_BAR;
    } else {
        PG8_STAGE(PG8_SB(0, 0), cB, voffB); PG8_STAGE(PG8_SA(0, 0), cA, voffA); PG8_STAGE(PG8_SB(0, 1), cB + hstep, voffB); PG8_STAGE(PG8_SA(0, 1), cA + hstep, voffA);
        if (wr == 1) PG8_BAR;
        PG8_WAIT_V(4); PG8_BAR;
        PG8_STAGE(PG8_SB(1, 0), cB + kstep, voffB); PG8_STAGE(PG8_SA(1, 0), cA + kstep, voffA); PG8_STAGE(PG8_SB(1, 1), cB + hstep + kstep, voffB);
        PG8_WAIT_V(6); PG8_BAR;
    }
    for (;;) {
        const bool has_next = S.next(ui + 1, nxt);
        const char* nA = has_next ? (const char*)g.A + (size_t)nxt.pm * tstep : cA; const char* nB = has_next ? (const char*)g.Bt + (size_t)nxt.e * g.eb + (size_t)nxt.pn * tstep : cB;
        for (int t = 0; t < nt; t += 2) {
            const bool last = (t == nt - 2);
            const char* a1 = cA + (size_t)(t + 1) * kstep;
            const char* a2 = last ? nA : cA + (size_t)(t + 2) * kstep; const char* b2 = last ? nB : cB + (size_t)(t + 2) * kstep;
            const char* a3 = a2 + kstep; const char* b3 = b2 + kstep;
            if (last && has_next) S.a_ready(nxt);
            if constexpr (SP2) {
            PG8_LDB(B0, 0, 0); PG8_LDB(B1, 0, 1); PG8_SCHED; PG8_LDA(At, 0, 0); PG8_STAGE(PG8_SA(1, 1), a1 + hstep, voffA);
            PG8_WAIT_V(8); PG8_WAIT_L(0); PG8_BAR; PG8_MMA(0, 0, At, B0); PG8_MMA(0, 1, At, B1); PG8_BAR; PG8_SCHED;
            PG8_LDA(At, 0, 1); PG8_STAGE(PG8_SB(0, 0), b2, voffB); PG8_STAGE(PG8_SB(0, 1), b2 + hstep, voffB); PG8_STAGE(PG8_SA(0, 0), a2, voffA);
            PG8_WAIT_V(8); PG8_WAIT_L(0); PG8_BAR; PG8_MMA(1, 0, At, B0); PG8_MMA(1, 1, At, B1); PG8_BAR; PG8_SCHED;
            PG8_LDB(B0, 1, 0); PG8_LDB(B1, 1, 1); PG8_SCHED; PG8_LDA(At, 1, 0); PG8_STAGE(PG8_SA(0, 1), a2 + hstep, voffA);
            PG8_WAIT_V(8); PG8_WAIT_L(0); PG8_BAR; PG8_MMA(0, 0, At, B0); PG8_MMA(0, 1, At, B1); PG8_BAR; PG8_SCHED;
            PG8_LDA(At, 1, 1); PG8_STAGE(PG8_SB(1, 0), b3, voffB); PG8_STAGE(PG8_SB(1, 1), b3 + hstep, voffB); PG8_STAGE(PG8_SA(1, 0), a3, voffA);
            PG8_WAIT_V(8); PG8_WAIT_L(0); PG8_BAR; PG8_MMA(1, 0, At, B0); PG8_MMA(1, 1, At, B1); PG8_BAR; PG8_SCHED;
            } else {
            PG8_LDB(B0, 0, 0); PG8_SCHED; PG8_LDA(At, 0, 0); PG8_STAGE(PG8_SA(1, 1), a1 + hstep, voffA);
            PG8_WAIT_L(8); PG8_BAR; PG8_WAIT_L(0); PG8_MMA(0, 0, At, B0); PG8_BAR; PG8_SCHED;
            PG8_LDB(B1, 0, 1); PG8_STAGE(PG8_SB(0, 0), b2, voffB);
            PG8_BAR; PG8_WAIT_L(0); PG8_MMA(0, 1, At, B1); PG8_BAR;
            PG8_LDA(At, 0, 1); PG8_STAGE(PG8_SA(0, 0), a2, voffA);
            PG8_BAR; PG8_WAIT_L(0); PG8_MMA(1, 0, At, B0); PG8_BAR; PG8_SCHED;
            PG8_STAGE(PG8_SB(0, 1), b2 + hstep, voffB);
            PG8_WAIT_V(6); PG8_BAR; PG8_MMA(1, 1, At, B1); PG8_BAR;
            PG8_LDB(B0, 1, 0); PG8_SCHED; PG8_LDA(At, 1, 0); PG8_STAGE(PG8_SA(0, 1), a2 + hstep, voffA);
            PG8_WAIT_L(8); PG8_BAR; PG8_WAIT_L(0); PG8_MMA(0, 0, At, B0); PG8_BAR; PG8_SCHED;
            PG8_LDB(B1, 1, 1); PG8_STAGE(PG8_SB(1, 0), b3, voffB);
            PG8_BAR; PG8_WAIT_L(0); PG8_MMA(0, 1, At, B1); PG8_BAR;
            PG8_LDA(At, 1, 1); PG8_STAGE(PG8_SA(1, 0), a3, voffA);
            PG8_BAR; PG8_WAIT_L(0); PG8_MMA(1, 0, At, B0); PG8_BAR; PG8_SCHED;
            PG8_STAGE(PG8_SB(1, 1), b3 + hstep, voffB);
            PG8_WAIT_V(6); PG8_BAR; PG8_MMA(1, 1, At, B1); PG8_BAR;
            }
        }
        if constexpr (ALIGN_EPI) { if (wr == 0) PG8_BAR; }
        if constexpr (!Epi::AFTER_DRAIN) { E(acc, cur, wr, wc, fr, fq); S.done(cur); }
        if (!has_next) break;
#pragma unroll
        for (int a = 0; a < 2; ++a)
#pragma unroll
            for (int b = 0; b < 2; ++b)
#pragma unroll
                for (int m = 0; m < 4; ++m)
#pragma unroll
                    for (int n = 0; n < 2; ++n) acc[a][b][m][n] = (f32x4){0.f, 0.f, 0.f, 0.f};
        cur = nxt; cA = nA; cB = nB; ++ui;
        if constexpr (ALIGN_EPI) { if (wr == 1) PG8_BAR; }
    }
    PG8_WAIT_V(0);
    if constexpr (!ALIGN_EPI) { if (wr == 0) PG8_BAR; }
    PG8_BAR;
    if constexpr (Epi::AFTER_DRAIN) { E.fused(acc, cur, wr, wc, fr, fq, lds, wid, lane); S.done(cur); }
#undef PG8_SA
#undef PG8_SB
#undef PG8_STAGE
#undef PG8_LDA
#undef PG8_LDB
#undef PG8_MMA
#undef PG8_WAIT_V
#undef PG8_WAIT_L
#undef PG8_BAR
#undef PG8_SCHED
}
__host__ __device__ __forceinline__ int lds_byte8(int r, int cb) { const int st = (r >> 4) * 2 + (cb >> 6), rr = r & 15, ob = rr * 64 + (cb & 63); return st * 1024 + (ob ^ (((ob >> 9) & 1) << 4)); }
__host__ __device__ __forceinline__ void stage_rc8(int b, int& R, int& C) { const int st = b / 1024, sb = b % 1024, swz = sb ^ (((sb >> 9) & 1) << 4); R = (st >> 1) * 16 + swz / 64; C = (st & 1) * 64 + (swz % 64); }
typedef int i32x8 __attribute__((ext_vector_type(8))); typedef int i32x4v __attribute__((ext_vector_type(4)));
__device__ __forceinline__ i32x8 cat8(bf16x8 lo, bf16x8 hi) { const i32x4v a = __builtin_bit_cast(i32x4v, lo), b = __builtin_bit_cast(i32x4v, hi); return __builtin_shufflevector(a, b, 0, 1, 2, 3, 4, 5, 6, 7); }
template <class Epi, class Sched, bool ALIGN_EPI = false, bool SP2 = false>
__device__ __forceinline__ void gemm_phase8(PG8_LAS unsigned char* lds, const Gemm g, const Sched& S, const Epi& E) {
    const int tid = threadIdx.x, wid = __builtin_amdgcn_readfirstlane(tid >> 6), lane = tid & 63, wr = wid >> 2, wc = wid & 3, fr = lane & 15, fq = lane >> 4;
    const int K = g.K, nt = K / 128;
    unsigned voffA[2], voffB[2];
#pragma unroll
    for (int i = 0; i < 2; ++i) { int R, C; stage_rc(tid * 16 + i * 8192, R, C); const int Rb = Epi::PERM ? ((R & ~31) + perm32(R & 31)) : R;
        voffA[i] = (unsigned)(R * K + 2 * C); voffB[i] = (unsigned)(Rb * K + 2 * C); }
    const unsigned kstep = (unsigned)(BK * 2);
    const unsigned hstep = (unsigned)HALF * (unsigned)K;
    const unsigned tstep = 2u * hstep;
    const unsigned ldsw = (unsigned)wid * 1024u;
    const int aoff = lds_byte(wr * 64 + fr, fq * 16), boff = lds_byte(wc * 32 + fr, fq * 16);
#define PG8_SA(b, h) (((b) * 2 + (h)) * HTB)
#define PG8_SB(b, h) ((4 + (b) * 2 + (h)) * HTB)
#define PG8_STAGEA(bufoff, goff, voff) do { _Pragma("unroll") for (int _i = 0; _i < 2; ++_i) \
        __builtin_amdgcn_global_load_lds((const unsigned*)(gA_base + (size_t)((unsigned)(goff) + (voff)[_i])), (PG8_LAS unsigned*)(lds + (bufoff) + ldsw + _i * 8192), 16, 0, 0); } while (0)
#define PG8_STAGEB(bufoff, goff, voff) do { _Pragma("unroll") for (int _i = 0; _i < 2; ++_i) \
        __builtin_amdgcn_global_load_lds((const unsigned*)(gB_base + (size_t)((unsigned)(goff) + (voff)[_i])), (PG8_LAS unsigned*)(lds + (bufoff) + ldsw + _i * 8192), 16, 0, 0); } while (0)
#define PG8_LDA(dst, b, h) do { _Pragma("unroll") for (int m = 0; m < 4; ++m) { const i32x4v lo_ = *(const PG8_LAS i32x4v*)(lds + PG8_SA(b, h) + aoff + m * 2048), hi_ = *(const PG8_LAS i32x4v*)(lds + PG8_SA(b, h) + aoff + 16 + m * 2048); dst[m] = __builtin_shufflevector(lo_, hi_, 0, 1, 2, 3, 4, 5, 6, 7); } } while (0)
#define PG8_LDB(dst, b, h) do { _Pragma("unroll") for (int n = 0; n < 2; ++n) { const i32x4v lo_ = *(const PG8_LAS i32x4v*)(lds + PG8_SB(b, h) + boff + n * 2048), hi_ = *(const PG8_LAS i32x4v*)(lds + PG8_SB(b, h) + boff + 16 + n * 2048); dst[n] = __builtin_shufflevector(lo_, hi_, 0, 1, 2, 3, 4, 5, 6, 7); } } while (0)
#define PG8_MMA(ai, bj, At, Bt) do { __builtin_amdgcn_s_setprio(1); _Pragma("unroll") for (int m = 0; m < 4; ++m) _Pragma("unroll") for (int n = 0; n < 2; ++n) \
        asm volatile("v_mfma_scale_f32_16x16x128_f8f6f4 %0, %1, %2, %0, %3, %4 op_sel_hi:[0,0,0]" : "+v"(acc[ai][bj][m][n]) : "v"(Bt[n]), "v"(At[m]), "v"(sc_w), "v"(sc_1));     __builtin_amdgcn_s_setprio(0); } while (0)
#define PG8_WAIT_V(n) asm volatile("s_waitcnt vmcnt(" #n ")" ::: "memory")
#define PG8_WAIT_L(n) asm volatile("s_waitcnt lgkmcnt(" #n ")" ::: "memory")
#define PG8_BAR __builtin_amdgcn_s_barrier()
#define PG8_SCHED __builtin_amdgcn_sched_barrier(0)
    Unit cur, nxt; int ui = 0;
    if (!S.next(0, cur)) return;
    f32x4 acc[2][2][4][2];
#pragma unroll
    for (int a = 0; a < 2; ++a)
#pragma unroll
        for (int b = 0; b < 2; ++b)
#pragma unroll
            for (int m = 0; m < 4; ++m)
#pragma unroll
                for (int n = 0; n < 2; ++n) acc[a][b][m][n] = (f32x4){0.f, 0.f, 0.f, 0.f};
    i32x8 At[4], B0[2], B1[2]; const int sc_w = 0x79797979, sc_1 = 0x7f7f7f7f;
    const char* gA_base = (const char*)g.A; const char* gB_base = (const char*)g.Bt; const unsigned eb32 = (unsigned)g.eb;
    unsigned cA = (unsigned)cur.pm * tstep, cB = (unsigned)cur.e * eb32 + (unsigned)cur.pn * tstep;
    S.a_ready(cur);
    if constexpr (SP2) {
        PG8_STAGEB(PG8_SB(0, 0), cB, voffB); PG8_STAGEB(PG8_SB(0, 1), cB + hstep, voffB); PG8_STAGEA(PG8_SA(0, 0), cA, voffA); PG8_STAGEA(PG8_SA(0, 1), cA + hstep, voffA);
        if (wr == 1) PG8_BAR;
        PG8_WAIT_V(2); PG8_BAR;
        PG8_STAGEB(PG8_SB(1, 0), cB + kstep, voffB); PG8_STAGEA(PG8_SA(1, 0), cA + kstep, voffA); PG8_STAGEB(PG8_SB(1, 1), cB + hstep + kstep, voffB);
        PG8_WAIT_V(6); PG8_BAR;
    } else {
        PG8_STAGEB(PG8_SB(0, 0), cB, voffB); PG8_STAGEA(PG8_SA(0, 0), cA, voffA); PG8_STAGEB(PG8_SB(0, 1), cB + hstep, voffB); PG8_STAGEA(PG8_SA(0, 1), cA + hstep, voffA);
        if (wr == 1) PG8_BAR;
        PG8_WAIT_V(4); PG8_BAR;
        PG8_STAGEB(PG8_SB(1, 0), cB + kstep, voffB); PG8_STAGEA(PG8_SA(1, 0), cA + kstep, voffA); PG8_STAGEB(PG8_SB(1, 1), cB + hstep + kstep, voffB);
        PG8_WAIT_V(6); PG8_BAR;
    }
    for (;;) {
        const bool has_next = S.next(ui + 1, nxt);
        const unsigned nA = has_next ? (unsigned)nxt.pm * tstep : cA; const unsigned nB = has_next ? (unsigned)nxt.e * eb32 + (unsigned)nxt.pn * tstep : cB;
        for (int t = 0; t < nt; t += 2) {
            const bool last = (t == nt - 2);
            const unsigned a1 = cA + (unsigned)(t + 1) * kstep;
            const unsigned a2 = last ? nA : cA + (unsigned)(t + 2) * kstep; const unsigned b2 = last ? nB : cB + (unsigned)(t + 2) * kstep;
            const unsigned a3 = a2 + kstep; const unsigned b3 = b2 + kstep;
            if (last && has_next) S.a_ready(nxt);
            if constexpr (SP2) {
            PG8_LDB(B0, 0, 0); PG8_LDB(B1, 0, 1); PG8_SCHED; PG8_LDA(At, 0, 0); PG8_STAGEA(PG8_SA(1, 1), a1 + hstep, voffA);
            PG8_WAIT_V(8); PG8_WAIT_L(0); PG8_BAR; PG8_MMA(0, 0, At, B0); PG8_MMA(0, 1, At, B1); PG8_BAR; PG8_SCHED;
            PG8_LDA(At, 0, 1); PG8_STAGEB(PG8_SB(0, 0), b2, voffB); PG8_STAGEB(PG8_SB(0, 1), b2 + hstep, voffB); PG8_STAGEA(PG8_SA(0, 0), a2, voffA);
            PG8_WAIT_V(8); PG8_WAIT_L(0); PG8_BAR; PG8_MMA(1, 0, At, B0); PG8_MMA(1, 1, At, B1); PG8_BAR; PG8_SCHED;
            PG8_LDB(B0, 1, 0); PG8_LDB(B1, 1, 1); PG8_SCHED; PG8_LDA(At, 1, 0); PG8_STAGEA(PG8_SA(0, 1), a2 + hstep, voffA);
            PG8_WAIT_V(8); PG8_WAIT_L(0); PG8_BAR; PG8_MMA(0, 0, At, B0); PG8_MMA(0, 1, At, B1); PG8_BAR; PG8_SCHED;
            PG8_LDA(At, 1, 1); PG8_STAGEB(PG8_SB(1, 0), b3, voffB); PG8_STAGEB(PG8_SB(1, 1), b3 + hstep, voffB); PG8_STAGEA(PG8_SA(1, 0), a3, voffA);
            PG8_WAIT_V(8); PG8_WAIT_L(0); PG8_BAR; PG8_MMA(1, 0, At, B0); PG8_MMA(1, 1, At, B1); PG8_BAR; PG8_SCHED;
            } else {
            PG8_LDB(B0, 0, 0); PG8_SCHED; PG8_LDA(At, 0, 0); PG8_STAGEA(PG8_SA(1, 1), a1 + hstep, voffA);
            PG8_WAIT_L(8); PG8_BAR; PG8_WAIT_L(0); PG8_MMA(0, 0, At, B0); PG8_BAR; PG8_SCHED;
            PG8_LDB(B1, 0, 1); PG8_STAGEB(PG8_SB(0, 0), b2, voffB);
            PG8_BAR; PG8_WAIT_L(0); PG8_MMA(0, 1, At, B1); PG8_BAR;
            PG8_LDA(At, 0, 1); PG8_STAGEA(PG8_SA(0, 0), a2, voffA);
            PG8_BAR; PG8_WAIT_L(0); PG8_MMA(1, 0, At, B0); PG8_BAR; PG8_SCHED;
            PG8_STAGEB(PG8_SB(0, 1), b2 + hstep, voffB);
            PG8_WAIT_V(6); PG8_BAR; PG8_MMA(1, 1, At, B1); PG8_BAR;
            PG8_LDB(B0, 1, 0); PG8_SCHED; PG8_LDA(At, 1, 0); PG8_STAGEA(PG8_SA(0, 1), a2 + hstep, voffA);
            PG8_WAIT_L(8); PG8_BAR; PG8_WAIT_L(0); PG8_MMA(0, 0, At, B0); PG8_BAR; PG8_SCHED;
            PG8_LDB(B1, 1, 1); PG8_STAGEB(PG8_SB(1, 0), b3, voffB);
            PG8_BAR; PG8_WAIT_L(0); PG8_MMA(0, 1, At, B1); PG8_BAR;
            PG8_LDA(At, 1, 1); PG8_STAGEA(PG8_SA(1, 0), a3, voffA);
            PG8_BAR; PG8_WAIT_L(0); PG8_MMA(1, 0, At, B0); PG8_BAR; PG8_SCHED;
            PG8_STAGEB(PG8_SB(1, 1), b3 + hstep, voffB);
            PG8_WAIT_V(6); PG8_BAR; PG8_MMA(1, 1, At, B1); PG8_BAR;
            }
        }
        if constexpr (ALIGN_EPI) { if (wr == 0) PG8_BAR; }
        asm volatile("s_nop 15\n\ts_nop 15" ::: "memory");
        if constexpr (!Epi::AFTER_DRAIN) { E(acc, cur, wr, wc, fr, fq); S.done(cur); }
        if (!has_next) break;
#pragma unroll
        for (int a = 0; a < 2; ++a)
#pragma unroll
            for (int b = 0; b < 2; ++b)
#pragma unroll
                for (int m = 0; m < 4; ++m)
#pragma unroll
                    for (int n = 0; n < 2; ++n) acc[a][b][m][n] = (f32x4){0.f, 0.f, 0.f, 0.f};
        cur = nxt; cA = nA; cB = nB; ++ui;
        if constexpr (ALIGN_EPI) { if (wr == 1) PG8_BAR; }
    }
    PG8_WAIT_V(0);
    if constexpr (!ALIGN_EPI) { if (wr == 0) PG8_BAR; }
    PG8_BAR;
    if constexpr (Epi::AFTER_DRAIN) { E.fused(acc, cur, wr, wc, fr, fq, lds, wid, lane); S.done(cur); }
#undef PG8_SA
#undef PG8_SB
#undef PG8_STAGEA
#undef PG8_STAGEB
#undef PG8_LDA
#undef PG8_LDB
#undef PG8_MMA
#undef PG8_WAIT_V
#undef PG8_WAIT_L
#undef PG8_BAR
#undef PG8_SCHED
}
}

constexpr int BATCH = 4, T = 4096, D = 1024, M = BATCH * T;
constexpr int NAB = 3072;
constexpr int FF = 2816, NCD = 3584, CDO = 1536, FFE = 3584, NE = 8;
constexpr int MPAD = 2 * M + NE * 256;
constexpr int MAXT = MPAD / 256;
constexpr int C_QA = 0, C_KA = 512, C_VA = 640, C_QKVB = 768, C_GATEB = 2304, C_BETA = 2816, C_AB = 2824;
constexpr int C_XC = 0, C_YC = 1024, C_BD = 2048, C_CD = 2560, C_HD = 3072;
constexpr size_t MiB = 1u << 20;
constexpr size_t WS_CTL = 0, CTL_ZERO_BYTES = 1 * MiB;
constexpr size_t WS_MOD = 1 * MiB;
constexpr size_t WS_ROUTE = 1 * MiB + 256 * 1024;
constexpr size_t WS_WAB_IN = 2 * MiB, WS_WAB_OUT = 8 * MiB, WS_WFFN_GU = 10 * MiB, WS_WFFN_D = 21 * MiB, WS_WCD_IN = 27 * MiB, WS_WCD_OUT = 34 * MiB, WS_WLRU = 37 * MiB;
constexpr size_t WS_WMOE_GU = 38 * MiB, WS_WMOE_D = 150 * MiB;
constexpr size_t WS_ACT = 206 * MiB;
constexpr size_t WS_END = 512 * MiB;
constexpr size_t A_A = 0, A_P = 32 * MiB, A_MIXA = 128 * MiB, A_DNQ = 160 * MiB, A_DNK = 192 * MiB, A_DNV = 224 * MiB, A_DNB = 256 * MiB, A_DNG = 257 * MiB;
constexpr size_t A_H = 160 * MiB;
constexpr size_t A_MIXB = 144 * MiB, A_XC = 192 * MiB;
constexpr size_t A_A3P = 0, A_HM = 68 * MiB, A_Y = 0;
constexpr size_t WS_A3 = 2 * MiB;
constexpr size_t WS_LA = 38 * MiB, WS_LB = 102 * MiB;
constexpr size_t R_IDX = 0, R_W = 128 * 1024, R_SLOT = 256 * 1024, R_GATEW = 384 * 1024, R_TILEE = 528 * 1024, R_OFF = 532 * 1024, R_HIST = 536 * 1024;
constexpr int CW_CNT = 1024, CW_CUR = 1024 + 64;

typedef unsigned short bf16;
typedef float f32x4 __attribute__((ext_vector_type(4)));
typedef unsigned v4u __attribute__((ext_vector_type(4)));
typedef unsigned v2u __attribute__((ext_vector_type(2)));
__device__ __forceinline__ unsigned f2bf(float f) { unsigned u = __builtin_bit_cast(unsigned, f); return (u + 0x7fffu + ((u >> 16) & 1u)) >> 16; }
__device__ __forceinline__ unsigned pk2(float lo, float hi) { return f2bf(lo) | (f2bf(hi) << 16); }
__device__ __forceinline__ float bf2f(unsigned short b) { return __builtin_bit_cast(float, (unsigned)b << 16); }
__device__ __forceinline__ float bflo(unsigned w) { return __builtin_bit_cast(float, w << 16); }
__device__ __forceinline__ float bfhi(unsigned w) { return __builtin_bit_cast(float, w & 0xffff0000u); }
__device__ __forceinline__ float wave_sum(float v) {
#pragma unroll
    for (int o = 1; o < 64; o <<= 1) v += __shfl_xor(v, o);
    return v;
}
__device__ __forceinline__ float sigmoidf_(float x) { return __builtin_amdgcn_rcpf(1.0f + __expf(-x)); }
__device__ __forceinline__ float siluf_(float x) { return x * __builtin_amdgcn_rcpf(1.0f + __expf(-x)); }
__device__ __forceinline__ float softplusf_(float x) { return fmaxf(x, 0.f) + log1pf(__expf(-fabsf(x))); }
__device__ __forceinline__ float gelu_tanhf_(float x) { const float u = 0.7978845608028654f * (x + 0.044715f * x * x * x); return 0.5f * x * (1.0f + tanhf(u)); }

__device__ const unsigned char T5_BUCKET[128] = {0, 1, 2, 3, 4, 5, 6, 7, 8, 9, 10, 11, 12, 13, 14, 15, 16, 16, 16, 17, 17, 18, 18, 18, 19, 19, 19, 20, 20, 20, 20, 21, 21, 21, 21, 22, 22, 22, 22, 22, 23, 23, 23, 23, 23, 23, 24, 24, 24, 24, 24, 24, 25, 25, 25, 25, 25, 25, 25, 26, 26, 26, 26, 26, 26, 26, 26, 27, 27, 27, 27, 27, 27, 27, 27, 27, 27, 28, 28, 28, 28, 28, 28, 28, 28, 28, 28, 29, 29, 29, 29, 29, 29, 29, 29, 29, 29, 29, 29, 30, 30, 30, 30, 30, 30, 30, 30, 30, 30, 30, 30, 30, 30, 31, 31, 31, 31, 31, 31, 31, 31, 31, 31, 31, 31, 31, 31, 31};

struct Params { const float* in[33]; float* out; unsigned char* ws; };
enum { I_X = 0, I_C, I_RELB, I_ADAW, I_ADAB, I_NMIX, I_NFFN, I_NFIN, I_ABIN, I_SINK, I_DNCONV, I_ALOG, I_DTB, I_DNNORM, I_ABOUT, I_FG, I_FU, I_FD, I_CDIN, I_LCW, I_LCB, I_GAW, I_GAB, I_GXW, I_GXB, I_LAM, I_SCW, I_CDOUT, I_RW, I_RB, I_MG, I_MU, I_MD };


#define LAS __attribute__((address_space(3)))
#define XB_TMO      128
#define XB_XCNT(j)  (256  + 64 * (j))
#define XB_XSUB(j)  (1280 + 64 * (j))
#define XB_XGEN(j)  (2304 + 64 * (j))
#define XB_TOP      3328
#define XB_TOPGEN   3392
#define XCD_BAR_WORDS 3456
#define XB_SPIN_CAP (1u << 18)

__device__ __forceinline__ unsigned xb_ld(unsigned* p)              { return __hip_atomic_load(p, __ATOMIC_RELAXED, __HIP_MEMORY_SCOPE_AGENT); }
__device__ __forceinline__ unsigned xb_add(unsigned* p, unsigned v) { return __hip_atomic_fetch_add(p, v, __ATOMIC_RELAXED, __HIP_MEMORY_SCOPE_AGENT); }
__device__ __forceinline__ unsigned xb_xcc_id() { return (unsigned)__builtin_amdgcn_s_getreg((3 << 11) | 20) & 0xFu; }
#define XB_SPIN(cond, bar) do { unsigned _sp = 0; while (cond) { __builtin_amdgcn_s_sleep(1); \
    if ((++_sp & 255u) == 0u) { if (xb_ld(&(bar)[XB_TMO])) break; if (_sp > XB_SPIN_CAP) { atomicAdd(&(bar)[XB_TMO], 1u); break; } } } } while (0)

struct XcdBarrier {
    unsigned* bar; unsigned x;
    volatile LAS unsigned* st;
};
__device__ __forceinline__ XcdBarrier xcd_barrier_post(unsigned* bar, volatile LAS unsigned* st) {
    XcdBarrier b; b.bar = bar; b.x = xb_xcc_id(); b.st = st;
    if (threadIdx.x == 0) (void)xb_add(&bar[XB_XCNT(b.x)], 1u);
    return b;
}
__device__ __forceinline__ void xcd_barrier_complete(unsigned* bar, unsigned x, unsigned& nloc, unsigned& nx) {
    const unsigned G = gridDim.x * gridDim.y * gridDim.z;
    unsigned sum, cnt, mine, sp = 0u;
    for (;;) {
        sum = 0u; cnt = 0u; mine = 0u;
#pragma unroll
        for (unsigned j = 0; j < 16; ++j) { const unsigned c = xb_ld(&bar[XB_XCNT(j)]); sum += c; cnt += (c > 0u) ? 1u : 0u; mine = (j == x) ? c : mine; }
        if (sum == G) break;
        __builtin_amdgcn_s_sleep(1);
        if ((++sp & 255u) == 0u) { if (xb_ld(&bar[XB_TMO])) break; if (sp > XB_SPIN_CAP) { atomicAdd(&bar[XB_TMO], 1u); break; } }
    }
    nloc = mine > 0u ? mine : 1u; nx = cnt > 0u ? cnt : 1u;
}
__device__ __forceinline__ void xcd_barrier(const XcdBarrier& b) {
    asm volatile("s_waitcnt vmcnt(0)" ::: "memory");
    __syncthreads();
    if (threadIdx.x == 0) {
        unsigned* bar = b.bar;
        __builtin_amdgcn_s_waitcnt(0);
        unsigned nloc = b.st[0], nx = b.st[1];
        if (nloc == 0u) { xcd_barrier_complete(bar, b.x, nloc, nx); b.st[0] = nloc; b.st[1] = nx; }
        const unsigned old = xb_add(&bar[XB_XSUB(b.x)], 1u);
        const unsigned gen = old / nloc;
        if (old + 1u == (gen + 1u) * nloc) {
            __builtin_amdgcn_fence(__ATOMIC_RELEASE, "agent");
            asm volatile("s_waitcnt vmcnt(0)" ::: "memory");
            const unsigned og = xb_add(&bar[XB_TOP], 1u);
            const unsigned tg = og / nx;
            if (og + 1u == (tg + 1u) * nx) xb_add(&bar[XB_TOPGEN], 1u);
            else XB_SPIN(xb_ld(&bar[XB_TOPGEN]) == tg, bar);
            __builtin_amdgcn_fence(__ATOMIC_ACQUIRE, "agent");
            xb_add(&bar[XB_XGEN(b.x)], 1u);
            asm volatile("s_waitcnt vmcnt(0)" ::: "memory");
        } else {
            XB_SPIN(xb_ld(&bar[XB_XGEN(b.x)]) == gen, bar);
            __builtin_amdgcn_fence(__ATOMIC_ACQUIRE, "agent");
            asm volatile("s_waitcnt vmcnt(0)" ::: "memory");
        }
    }
    __syncthreads();
}

constexpr int NWAVES = 8, NTHR = 512;
constexpr int LDS_MISC = 150528, LDS_BYTES = 150528 + 1024;
constexpr int CW_BAR = 4096;
struct ConvDesc { const float* src; bf16* dst; long long sstride, dstride; int K, N, Npad, mode, row_off, nbatch, items_pb, item0; };
struct ConvTab { ConvDesc d[12]; int nd, total, pad0, pad1; };
struct MArgs { Params p; ConvTab t1, t2; int ph_lo, ph_hi, pad0, pad1; };
struct Ctx { LAS unsigned char* lds; int tid, lane, wave, G, bid, gw, NGW; };

constexpr int CV_S = 65, CV_WAVE = 64 * CV_S * 4;
__device__ __forceinline__ void transpose_item(const float* W, int K, int N, bf16* WT, int mode, int row_off, LAS float* scr, int kb, int nb, int lane) {
    const int k0 = 64 * kb, n0 = 64 * nb, kr = lane >> 4, nq = lane & 15; const int nn = n0 + 4 * nq;
    f32x4 v[16];
#pragma unroll
    for (int i = 0; i < 16; ++i) v[i] = nn < N ? __builtin_nontemporal_load((const f32x4*)(W + (size_t)(k0 + 4 * i + kr) * N + nn)) : (f32x4){0.f, 0.f, 0.f, 0.f};
#pragma unroll
    for (int i = 0; i < 16; ++i) { LAS float* d = scr + (4 * i + kr) * CV_S + 4 * nq; d[0] = v[i].x; d[1] = v[i].y; d[2] = v[i].z; d[3] = v[i].w; }
    asm volatile("s_waitcnt lgkmcnt(0)" ::: "memory");
    if (mode & 2) {
        const int c4 = lane & 3;
#pragma unroll
        for (int j = 0; j < 4; ++j) { const int n = (lane >> 2) + 16 * j; const LAS float* s = scr + (16 * c4) * CV_S + n; v4u o;
#pragma unroll
            for (int e = 0; e < 4; ++e) { int w = 0; w = __builtin_amdgcn_cvt_pk_fp8_f32(s[(4 * e) * CV_S] * 64.0f, s[(4 * e + 1) * CV_S] * 64.0f, w, false); w = __builtin_amdgcn_cvt_pk_fp8_f32(s[(4 * e + 2) * CV_S] * 64.0f, s[(4 * e + 3) * CV_S] * 64.0f, w, true); o[e] = (unsigned)w; }
            const int ng = n0 + n; const int drow = ((mode & 1) ? ((ng >> 7) << 8) + (ng & 127) : ng) + row_off;
            *(v4u*)((unsigned char*)WT + (size_t)drow * K + k0 + 16 * c4) = o; }
        asm volatile("s_waitcnt lgkmcnt(0)" ::: "memory");
        return; }
    const int c = lane & 7;
#pragma unroll
    for (int j = 0; j < 8; ++j) { const int n = (lane >> 3) + 8 * j; const LAS float* s = scr + (8 * c) * CV_S + n;
        v4u o; o.x = pk2(s[0 * CV_S], s[1 * CV_S]); o.y = pk2(s[2 * CV_S], s[3 * CV_S]); o.z = pk2(s[4 * CV_S], s[5 * CV_S]); o.w = pk2(s[6 * CV_S], s[7 * CV_S]);
        const int ng = n0 + n; const int drow = ((mode & 1) ? ((ng >> 7) << 8) + (ng & 127) : ng) + row_off;
        *(v4u*)(WT + (size_t)drow * K + k0 + 8 * c) = o; }
    asm volatile("s_waitcnt lgkmcnt(0)" ::: "memory");
}
__device__ __forceinline__ void ph_convert(const Ctx& c, const ConvTab& tab, int wk, int nworkers) {
    LAS float* scr = (LAS float*)(c.lds + c.wave * CV_WAVE);
    for (int it = wk; it < tab.total; it += nworkers) {
        int j = 0;
        for (int q = 1; q < tab.nd; ++q) if (it >= tab.d[q].item0) j = q;
        const ConvDesc& d = tab.d[j]; const int r = it - d.item0; const int batch = r / d.items_pb, item = r % d.items_pb; const int nkb = d.K / 64;
        transpose_item(d.src + (size_t)batch * d.sstride, d.K, d.N, d.dst + (size_t)batch * d.dstride, d.mode, d.row_off, scr, item % nkb, item / nkb, c.lane);
    }
}
__device__ __forceinline__ void ph_ada(const Ctx& c, const Params& p) {
    LAS float* part = (LAS float*)(c.lds + 8 * CV_WAVE);
    for (int it = c.bid; it < 192; it += c.G) {
        const int l = it / 96, j = (it % 96) * 64 + c.lane; const float* w = p.in[I_ADAW] + (size_t)l * 1024 * 6144 + j; const float* cc = p.in[I_C];
        float a0 = 0.f, a1 = 0.f, a2 = 0.f, a3 = 0.f;
        for (int k = c.wave * 128; k < c.wave * 128 + 128; ++k) { const float wv = __builtin_nontemporal_load(w + (size_t)k * 6144);
            a0 += siluf_(cc[k]) * wv; a1 += siluf_(cc[1024 + k]) * wv; a2 += siluf_(cc[2048 + k]) * wv; a3 += siluf_(cc[3072 + k]) * wv; }
        part[(c.wave * 4 + 0) * 64 + c.lane] = a0; part[(c.wave * 4 + 1) * 64 + c.lane] = a1; part[(c.wave * 4 + 2) * 64 + c.lane] = a2; part[(c.wave * 4 + 3) * 64 + c.lane] = a3;
        __syncthreads();
        if (c.wave < 4) { float s = 0.f;
#pragma unroll
            for (int w8 = 0; w8 < 8; ++w8) s += part[(w8 * 4 + c.wave) * 64 + c.lane];
            ((float*)(p.ws + WS_MOD))[(size_t)l * 4 * 6144 + (size_t)c.wave * 6144 + j] = s + p.in[I_ADAB][l * 6144 + j]; }
        __syncthreads();
    }
}
template <bool ROUTER, bool COUNT = true>
__device__ __forceinline__ void norm_row(const float* xrow, bf16* orow, const float* w, const float* sc, const float* sh, int lane, const float* rw, const float* rb, int m, unsigned char* ws, LAS unsigned* hist) {
    const f32x4* xr = (const f32x4*)xrow + lane; f32x4 v[4]; float s = 0.f;
#pragma unroll
    for (int j = 0; j < 4; ++j) { v[j] = xr[64 * j]; s += (v[j].x * v[j].x + v[j].y * v[j].y) + (v[j].z * v[j].z + v[j].w * v[j].w); }
    const float rstd = 1.0f / sqrtf(wave_sum(s) * (1.f / D) + 1e-6f);
    float lg[8];
    if (ROUTER) {
#pragma unroll
        for (int e = 0; e < 8; ++e) lg[e] = 0.f;
    }
    unsigned long long* o8 = (unsigned long long*)orow + lane;
#pragma unroll
    for (int j = 0; j < 4; ++j) { const int c = 4 * lane + 256 * j; const f32x4 wv = *(const f32x4*)(w + c), scv = *(const f32x4*)(sc + c), shv = *(const f32x4*)(sh + c);
        f32x4 y = v[j] * rstd * wv * (scv + 1.0f) + shv;
        if (ROUTER) {
#pragma unroll
            for (int i = 0; i < 4; ++i) { const f32x4 r0 = *(const f32x4*)(rw + (size_t)(c + i) * 8), r1 = *(const f32x4*)(rw + (size_t)(c + i) * 8 + 4);
                lg[0] += y[i] * r0.x; lg[1] += y[i] * r0.y; lg[2] += y[i] * r0.z; lg[3] += y[i] * r0.w; lg[4] += y[i] * r1.x; lg[5] += y[i] * r1.y; lg[6] += y[i] * r1.z; lg[7] += y[i] * r1.w; }
        }
        if (ROUTER) ((unsigned*)orow)[lane + 64 * j] = pg8::pk_fp8x4(y.x, y.y, y.z, y.w);
        else o8[64 * j] = (unsigned long long)pk2(y.x, y.y) | ((unsigned long long)pk2(y.z, y.w) << 32); }
    if (ROUTER) {
#pragma unroll
        for (int e = 0; e < 8; ++e) lg[e] = wave_sum(lg[e]) + rb[e];
        int b0 = 0; float v0 = lg[0];
#pragma unroll
        for (int e = 1; e < 8; ++e) if (lg[e] > v0) { v0 = lg[e]; b0 = e; }
        int b1 = -1; float v1 = -3.0e38f;
#pragma unroll
        for (int e = 0; e < 8; ++e) if (e != b0 && lg[e] > v1) { v1 = lg[e]; b1 = e; }
        const float e1 = __expf(v1 - v0), w0 = 1.0f / (1.0f + e1), w1 = e1 / (1.0f + e1);
        if (lane == 0) { int* idx = (int*)(ws + WS_ROUTE + R_IDX); float* tw = (float*)(ws + WS_ROUTE + R_W); idx[2 * m] = b0; idx[2 * m + 1] = b1; tw[2 * m] = w0; tw[2 * m + 1] = w1;
            if (COUNT) { __hip_atomic_fetch_add(hist + b0, 1u, __ATOMIC_RELAXED, __HIP_MEMORY_SCOPE_WORKGROUP); __hip_atomic_fetch_add(hist + b1, 1u, __ATOMIC_RELAXED, __HIP_MEMORY_SCOPE_WORKGROUP); } }
    }
}
template <int WHICH, bool COUNT = true>
__device__ __forceinline__ void ph_norm(const Ctx& c, const Params& p) {
    const int l = WHICH >> 1, f = WHICH & 1;
    const float* src = WHICH == 0 ? p.in[I_X] : p.out; bf16* dst = (bf16*)(p.ws + (WHICH == 3 ? WS_A3 : WS_ACT + A_A));
    const float* w = p.in[f ? I_NFFN : I_NMIX] + l * D; const float* mod = (const float*)(p.ws + WS_MOD) + (size_t)l * 4 * 6144;
    if constexpr (WHICH == 3) {
        LAS unsigned* hist = (LAS unsigned*)(c.lds + 1024);
        if (c.tid < 8) hist[c.tid] = 0u;
        __syncthreads();
        for (int i = 0; i < 8; ++i) { const int m = c.bid * 64 + c.wave * 8 + i; if (m < M) { const int b = m >> 12; const float* mb = mod + (size_t)b * 6144 + 3 * D;
            norm_row<true, COUNT>(src + (size_t)m * D, (bf16*)((unsigned char*)dst + (size_t)m * D), w, mb + D, mb, c.lane, p.in[I_RW], p.in[I_RB], m, p.ws, hist); } }
        __syncthreads();
        if (COUNT && c.tid < 8) ((unsigned*)(p.ws + WS_ROUTE + R_HIST))[c.bid * 8 + c.tid] = hist[c.tid];
    } else {
    for (int k0 = 0; c.gw + c.NGW * k0 < M; k0 += 4) {
        f32x4 v[4][4]; float s[4];
#pragma unroll
        for (int r = 0; r < 4; ++r) { const int m = c.gw + c.NGW * (k0 + r); const f32x4* xr = (const f32x4*)(src + (size_t)(m < M ? m : 0) * D) + c.lane; s[r] = 0.f;
#pragma unroll
            for (int j = 0; j < 4; ++j) { v[r][j] = xr[64 * j]; s[r] += (v[r][j].x * v[r][j].x + v[r][j].y * v[r][j].y) + (v[r][j].z * v[r][j].z + v[r][j].w * v[r][j].w); } }
#pragma unroll
        for (int o = 1; o < 64; o <<= 1) {
#pragma unroll
            for (int r = 0; r < 4; ++r) s[r] += __shfl_xor(s[r], o); }
#pragma unroll
        for (int r = 0; r < 4; ++r) { const int m = c.gw + c.NGW * (k0 + r); if (m < M) { const int b = m >> 12; const float* mb = mod + (size_t)b * 6144 + (f ? 3 * D : 0);
            const float rstd = 1.0f / sqrtf(s[r] * (1.f / D) + 1e-6f); unsigned long long* o8 = (unsigned long long*)(dst + (size_t)m * D) + c.lane;
#pragma unroll
            for (int j = 0; j < 4; ++j) { const int cc = 4 * c.lane + 256 * j; const f32x4 wv = *(const f32x4*)(w + cc), scv = *(const f32x4*)(mb + D + cc), shv = *(const f32x4*)(mb + cc);
                const f32x4 y = v[r][j] * rstd * wv * (scv + 1.0f) + shv;
                o8[64 * j] = (unsigned long long)pk2(y.x, y.y) | ((unsigned long long)pk2(y.z, y.w) << 32); } } }
    }
    }
}

enum { G_ABIN = 0, G_ABOUT, G_FFNGU, G_FFND, G_CDIN, G_CDOUT, G_MOEGU, G_MOED, G_FFND_PROBE, G_CDOUT_PROBE };
template <int WHICH>
__device__ __forceinline__ void ph_gemm(const Ctx& cx, const Params& p) {
    PG8_LAS unsigned char* lds = (PG8_LAS unsigned char*)cx.lds;
    unsigned char* ws = p.ws; unsigned char* act = ws + WS_ACT; const float* mod = (const float*)(ws + WS_MOD);
    const int G = cx.G, c = cx.bid;
    if constexpr (WHICH == G_ABIN) { pg8::Gemm g{(const bf16*)(act + A_A), (const bf16*)(ws + WS_WAB_IN), M, NAB, D, 0}; pg8::StaticOrder S; S.init(M, NAB, G, c);
        pg8::EpiStoreBf16 E{(bf16*)(act + A_P), NAB, nullptr}; pg8::gemm_phase<pg8::EpiStoreBf16, pg8::StaticOrder, true, true>(lds, g, S, E); }
    if constexpr (WHICH == G_ABOUT) { pg8::Gemm g{(const bf16*)(act + A_MIXA), (const bf16*)(ws + WS_WAB_OUT), M, D, D, 0}; pg8::StaticOrder S; S.init(M, D, G, c);
        pg8::EpiRes E{p.in[I_X], p.out, D, mod + 2 * D}; pg8::gemm_phase<pg8::EpiRes, pg8::StaticOrder, true, true>(lds, g, S, E); }
    if constexpr (WHICH == G_FFNGU) { pg8::Gemm g{(const bf16*)(act + A_A), (const bf16*)(ws + WS_WFFN_GU), M, 2 * FF, D, 0}; pg8::StaticOrder S; S.init(M, 2 * FF, G, c);
        pg8::EpiSwiglu E{(bf16*)(act + A_H), FF}; pg8::gemm_phase<pg8::EpiSwiglu, pg8::StaticOrder, true, true>(lds, g, S, E); }
    if constexpr (WHICH == G_FFND) { pg8::Gemm g{(const bf16*)(act + A_H), (const bf16*)(ws + WS_WFFN_D), M, D, FF, 0}; pg8::StaticOrder S; S.init(M, D, G, c);
        pg8::EpiRes E{p.out, p.out, D, mod + 5 * D}; pg8::gemm_phase<pg8::EpiRes, pg8::StaticOrder, true, true>(lds, g, S, E); }
    if constexpr (WHICH == G_FFND_PROBE) { pg8::Gemm g{(const bf16*)(act + A_H), (const bf16*)(ws + WS_WFFN_D), M, D, FF, 0}; pg8::StaticOrder S; S.init(M, D, G, c);
        pg8::EpiRes E{p.out, (float*)(act + A_P), D, mod + 5 * D}; pg8::gemm_phase<pg8::EpiRes, pg8::StaticOrder, true, true>(lds, g, S, E); }
    if constexpr (WHICH == G_CDOUT_PROBE) { pg8::Gemm g{(const bf16*)(act + A_MIXB), (const bf16*)(ws + WS_WCD_OUT), M, D, CDO, 0}; pg8::StaticOrder S; S.init(M, D, G, c);
        pg8::EpiRes E{p.out, (float*)(act + A_P), D, mod + 4 * 6144 + 2 * D}; pg8::gemm_phase<pg8::EpiRes, pg8::StaticOrder, true, true>(lds, g, S, E); }
    if constexpr (WHICH == G_CDIN) { pg8::Gemm g{(const bf16*)(act + A_A), (const bf16*)(ws + WS_WCD_IN), M, NCD, D, 0}; pg8::StaticOrder S; S.init(M, NCD, G, c);
        pg8::EpiStoreBf16 E{(bf16*)(act + A_P), NCD, nullptr}; pg8::gemm_phase<pg8::EpiStoreBf16, pg8::StaticOrder, true, true>(lds, g, S, E); }
    if constexpr (WHICH == G_CDOUT) { pg8::Gemm g{(const bf16*)(act + A_MIXB), (const bf16*)(ws + WS_WCD_OUT), M, D, CDO, 0}; pg8::StaticOrder S; S.init(M, D, G, c);
        pg8::EpiRes E{p.out, p.out, D, mod + 4 * 6144 + 2 * D}; pg8::gemm_phase<pg8::EpiRes, pg8::StaticOrder, true, true>(lds, g, S, E); }
    if constexpr (WHICH == G_MOEGU) { const int* off = (const int*)(ws + WS_ROUTE + R_OFF); const int nMt = __builtin_amdgcn_readfirstlane(off[8]) >> 8;
        pg8::Gemm g{(const bf16*)(act + A_A3P), (const bf16*)(ws + WS_WMOE_GU), nMt * 256, 2 * FFE, D, (size_t)2 * FFE * D}; pg8::GroupedOrder S; S.init(nMt, 2 * FFE, G, c, (const int*)(ws + WS_ROUTE + R_TILEE));
        pg8::EpiSwiglu8 E{act + A_HM, FFE}; pg8::gemm_phase8<pg8::EpiSwiglu8, pg8::GroupedOrder, true, true>(lds, g, S, E); }
    if constexpr (WHICH == G_MOED) { const int* off = (const int*)(ws + WS_ROUTE + R_OFF); const int nMt = __builtin_amdgcn_readfirstlane(off[8]) >> 8;
        pg8::Gemm g{(const bf16*)(act + A_HM), (const bf16*)(ws + WS_WMOE_D), nMt * 256, D, FFE, (size_t)D * FFE}; pg8::GroupedOrder S; S.init(nMt, D, G, c, (const int*)(ws + WS_ROUTE + R_TILEE));
        pg8::EpiStoreBf16S E{(bf16*)(act + A_Y), D, (const float*)(ws + WS_ROUTE + R_GATEW)}; pg8::gemm_phase8<pg8::EpiStoreBf16S, pg8::GroupedOrder, true, true>(lds, g, S, E); }
}

__device__ __forceinline__ void ph_attn_naive(const Ctx& c, const Params& p) {
    const bf16* P0 = (const bf16*)(p.ws + WS_ACT + A_P); const float* relb = p.in[I_RELB];
    for (int gid = c.bid * NTHR + c.tid; gid < M * 8; gid += c.G * NTHR) {
        const int m = gid >> 3, h = gid & 7, t = m & (T - 1), kvh = h >> 2;
        float q[64], o[64];
        { const v4u* qp = (const v4u*)(P0 + (size_t)m * NAB + C_QA + h * 64);
#pragma unroll
          for (int i = 0; i < 8; ++i) { const v4u w = qp[i]; q[8 * i + 0] = bflo(w.x) * 0.125f; q[8 * i + 1] = bfhi(w.x) * 0.125f; q[8 * i + 2] = bflo(w.y) * 0.125f; q[8 * i + 3] = bfhi(w.y) * 0.125f;
              q[8 * i + 4] = bflo(w.z) * 0.125f; q[8 * i + 5] = bfhi(w.z) * 0.125f; q[8 * i + 6] = bflo(w.w) * 0.125f; q[8 * i + 7] = bfhi(w.w) * 0.125f; } }
#pragma unroll
        for (int i = 0; i < 64; ++i) o[i] = 0.f;
        float mx = p.in[I_SINK][h], l = 1.0f;
        const int nd = t + 1 < 128 ? t + 1 : 128;
        for (int dd = 0; dd < nd; ++dd) {
            const bf16* kr = P0 + (size_t)(m - dd) * NAB + C_KA + kvh * 64; const bf16* vr = P0 + (size_t)(m - dd) * NAB + C_VA + kvh * 64;
            float s = 0.f;
#pragma unroll
            for (int i = 0; i < 8; ++i) { const v4u w = ((const v4u*)kr)[i];
                s += q[8 * i + 0] * bflo(w.x) + q[8 * i + 1] * bfhi(w.x) + q[8 * i + 2] * bflo(w.y) + q[8 * i + 3] * bfhi(w.y) + q[8 * i + 4] * bflo(w.z) + q[8 * i + 5] * bfhi(w.z) + q[8 * i + 6] * bflo(w.w) + q[8 * i + 7] * bfhi(w.w); }
            s += relb[T5_BUCKET[dd] * 8 + h];
            const float mn = fmaxf(mx, s), sc = __expf(mx - mn), pp = __expf(s - mn);
            l = l * sc + pp; mx = mn;
#pragma unroll
            for (int i = 0; i < 8; ++i) { const v4u w = ((const v4u*)vr)[i];
                o[8 * i + 0] = o[8 * i + 0] * sc + pp * bflo(w.x); o[8 * i + 1] = o[8 * i + 1] * sc + pp * bfhi(w.x); o[8 * i + 2] = o[8 * i + 2] * sc + pp * bflo(w.y); o[8 * i + 3] = o[8 * i + 3] * sc + pp * bfhi(w.y);
                o[8 * i + 4] = o[8 * i + 4] * sc + pp * bflo(w.z); o[8 * i + 5] = o[8 * i + 5] * sc + pp * bfhi(w.z); o[8 * i + 6] = o[8 * i + 6] * sc + pp * bflo(w.w); o[8 * i + 7] = o[8 * i + 7] * sc + pp * bfhi(w.w); }
        }
        const float inv = 1.0f / l;
        v4u* op = (v4u*)((bf16*)(p.ws + WS_ACT + A_MIXA) + (size_t)m * D + h * 64);
#pragma unroll
        for (int i = 0; i < 8; ++i) { v4u w; w.x = pk2(o[8 * i] * inv, o[8 * i + 1] * inv); w.y = pk2(o[8 * i + 2] * inv, o[8 * i + 3] * inv); w.z = pk2(o[8 * i + 4] * inv, o[8 * i + 5] * inv); w.w = pk2(o[8 * i + 6] * inv, o[8 * i + 7] * inv); op[i] = w; }
    }
}

__device__ __forceinline__ void ph_dn_prep(const Ctx& c, const Params& p) {
    const bf16* P0 = (const bf16*)(p.ws + WS_ACT + A_P); const float* cw = p.in[I_DNCONV]; unsigned char* act = p.ws + WS_ACT; const int lane = c.lane;
    for (int it = c.gw; it < M * 8; it += c.NGW) {
        const int m = it >> 3, h = it & 7, t = m & (T - 1);
        float r[3];
#pragma unroll
        for (int s = 0; s < 3; ++s) { const int ch = s * 512 + h * 64 + lane; float a = 0.f;
#pragma unroll
            for (int k = 0; k < 4; ++k) { const int tt = t - 3 + k; if (tt >= 0) a += cw[k * 1536 + ch] * bf2f(P0[(size_t)(m - 3 + k) * NAB + C_QKVB + ch]); }
            r[s] = siluf_(a); }
        const float nq = 1.0f / sqrtf(wave_sum(r[0] * r[0]) + 1e-6f), nk = 1.0f / sqrtf(wave_sum(r[1] * r[1]) + 1e-6f);
        ((float*)(act + A_DNQ))[(size_t)m * 512 + h * 64 + lane] = r[0] * nq;
        ((float*)(act + A_DNK))[(size_t)m * 512 + h * 64 + lane] = r[1] * nk;
        ((float*)(act + A_DNV))[(size_t)m * 512 + h * 64 + lane] = r[2];
        if (lane == 0) { const float bb = bf2f(P0[(size_t)m * NAB + C_BETA + h]), ab = bf2f(P0[(size_t)m * NAB + C_AB + h]);
            ((float*)(act + A_DNB))[m * 8 + h] = sigmoidf_(bb);
            ((float*)(act + A_DNG))[m * 8 + h] = -__expf(p.in[I_ALOG][h]) * softplusf_(ab + p.in[I_DTB][h]); }
    }
}
__device__ __forceinline__ void ph_dn_scan(const Ctx& c, const Params& p) {
    if (c.wave != 0 || c.bid >= 32) return;
    LAS float* kq = (LAS float*)c.lds;
    const int b = c.bid >> 3, h = c.bid & 7, e = c.lane;
    unsigned char* act = p.ws + WS_ACT; const bf16* P0 = (const bf16*)(act + A_P);
    const float* Q = (const float*)(act + A_DNQ); const float* K = (const float*)(act + A_DNK); const float* V = (const float*)(act + A_DNV);
    const float* Bt = (const float*)(act + A_DNB); const float* Gt = (const float*)(act + A_DNG);
    const float nw = p.in[I_DNNORM][e];
    float S[64];
#pragma unroll
    for (int d = 0; d < 64; ++d) S[d] = 0.f;
    for (int t = 0; t < T; ++t) { const int m = b * T + t;
        asm volatile("s_waitcnt lgkmcnt(0)" ::: "memory");
        kq[e] = K[(size_t)m * 512 + h * 64 + e]; kq[64 + e] = Q[(size_t)m * 512 + h * 64 + e];
        const float v = V[(size_t)m * 512 + h * 64 + e], beta = Bt[m * 8 + h], eg = __expf(Gt[m * 8 + h]);
        asm volatile("s_waitcnt lgkmcnt(0)" ::: "memory");
        float kS = 0.f;
#pragma unroll
        for (int d = 0; d < 64; ++d) { S[d] *= eg; kS += kq[d] * S[d]; }
        const float dl = beta * (v - kS); float o = 0.f;
#pragma unroll
        for (int d = 0; d < 64; ++d) { S[d] += kq[d] * dl; o += kq[64 + d] * S[d]; }
        o *= 0.125f;
        const float rs = 1.0f / sqrtf(wave_sum(o * o) * (1.f / 64.f) + 1e-6f);
        const float gt = bf2f(P0[(size_t)m * NAB + C_GATEB + h * 64 + e]);
        ((bf16*)(act + A_MIXA))[(size_t)m * D + 512 + h * 64 + e] = (bf16)f2bf(o * rs * nw * siluf_(gt));
    }
}

__device__ __forceinline__ void ph_route(const Ctx& c, const Params& p, int curoff) {
    LAS int* tot = (LAS int*)c.lds; LAS int* pre = tot + 8; LAS int* loff = tot + 16; LAS int* posl = tot + 32;
    const unsigned* H = (const unsigned*)(p.ws + WS_ROUTE + R_HIST);
    { const int e = c.wave; int t = 0, pr = 0;
      for (int w = c.lane; w < c.G; w += 64) { const int v = (int)H[w * 8 + e]; t += v; pr += (w < c.bid) ? v : 0; }
#pragma unroll
      for (int o = 1; o < 64; o <<= 1) { t += __shfl_xor(t, o); pr += __shfl_xor(pr, o); }
      if (c.lane == 0) { tot[e] = t; pre[e] = pr; } }
    __syncthreads();
    if (c.tid == 0) { int* off = (int*)(p.ws + WS_ROUTE + R_OFF); int* te = (int*)(p.ws + WS_ROUTE + R_TILEE); int o = 0;
        for (int e = 0; e < 8; ++e) { loff[e] = o; const int n = (tot[e] + 255) & ~255;
            if (c.bid == 0) { off[e] = o; for (int t = o >> 8; t < (o + n) >> 8 && t < MAXT; ++t) te[t] = e; }
            o += n; }
        loff[8] = o; if (c.bid == 0) off[8] = o < MPAD ? o : MPAD; }
    __syncthreads();
    const int* idx = (const int*)(p.ws + WS_ROUTE + R_IDX); const float* tw = (const float*)(p.ws + WS_ROUTE + R_W);
    if (c.wave == 0) { int run[8];
#pragma unroll
        for (int e = 0; e < 8; ++e) run[e] = loff[e] + pre[e];
#pragma unroll
        for (int r = 0; r < 2; ++r) { const int it = 64 * r + c.lane; const int e = idx[c.bid * 128 + it]; int pos = 0;
#pragma unroll
            for (int ex = 0; ex < 8; ++ex) { const unsigned long long mk = __ballot(e == ex); if (e == ex) pos = run[ex] + __popcll(mk & ((1ull << c.lane) - 1ull)); run[ex] += __popcll(mk); }
            posl[it] = pos; ((int*)(p.ws + WS_ROUTE + R_SLOT))[c.bid * 128 + it] = pos; ((float*)(p.ws + WS_ROUTE + R_GATEW))[pos] = tw[c.bid * 128 + it]; } }
    __syncthreads();
    for (int i = 0; i < 16; ++i) { const int it = c.wave * 16 + i; const int m = c.bid * 64 + (it >> 1); const int pos = posl[it];
        const v4u* src = (const v4u*)(p.ws + WS_A3 + (size_t)m * D); v4u* dst = (v4u*)(p.ws + WS_ACT + A_A3P + (size_t)pos * D);
        dst[c.lane] = src[c.lane]; }
}
template <bool PROBE> __device__ __forceinline__ void ph_final(const Ctx& c, const Params& p) {
    const int lane = c.lane;
    const int* slot = (const int*)(p.ws + WS_ROUTE + R_SLOT); const bf16* Y = (const bf16*)(p.ws + WS_ACT + A_Y);
    const float* mod = (const float*)(p.ws + WS_MOD) + 4 * 6144; const float* fw = p.in[I_NFIN];
    for (int m = c.gw; m < M; m += c.NGW) { const int b = m >> 12; const float* g2 = mod + (size_t)b * 6144 + 5 * D;
        const int s0 = slot[2 * m], s1 = slot[2 * m + 1];
        f32x4* xr = (f32x4*)(p.out + (size_t)m * D) + lane; f32x4* xw = PROBE ? (f32x4*)((float*)(p.ws + WS_ACT + A_HM) + (size_t)m * D) + lane : xr; const v2u* y0 = (const v2u*)(Y + (size_t)s0 * D) + lane; const v2u* y1 = (const v2u*)(Y + (size_t)s1 * D) + lane;
        f32x4 v[4]; float s = 0.f;
#pragma unroll
        for (int j = 0; j < 4; ++j) { const f32x4 gv = *(const f32x4*)(g2 + 4 * lane + 256 * j); const v2u a = y0[64 * j], cc = y1[64 * j];
            f32x4 yy; yy.x = bflo(a.x) + bflo(cc.x); yy.y = bfhi(a.x) + bfhi(cc.x); yy.z = bflo(a.y) + bflo(cc.y); yy.w = bfhi(a.y) + bfhi(cc.y);
            v[j] = xr[64 * j] + gv * yy; s += (v[j].x * v[j].x + v[j].y * v[j].y) + (v[j].z * v[j].z + v[j].w * v[j].w); }
        const float rstd = 1.0f / sqrtf(wave_sum(s) * (1.f / D) + 1e-6f);
#pragma unroll
        for (int j = 0; j < 4; ++j) { const f32x4 wv = *(const f32x4*)(fw + 4 * lane + 256 * j); xw[64 * j] = v[j] * rstd * wv; }
    }
}


typedef short bf16x8_t __attribute__((ext_vector_type(8)));
typedef short s16x4_t __attribute__((ext_vector_type(4)));
typedef float f32x16 __attribute__((ext_vector_type(16)));
constexpr int AT_KSTR = 144, AT_VSTR = 520, AT_K = 0, AT_V = 256 * AT_KSTR, AT_BIAS = AT_V + 64 * AT_VSTR, AT_END = AT_BIAS + 2048;
typedef float f32x2_c __attribute__((ext_vector_type(2))); typedef __bf16 bf16x2_c __attribute__((ext_vector_type(2)));
__device__ __forceinline__ unsigned pkbf(float lo, float hi) { f32x2_c v = {lo, hi}; bf16x2_c b = __builtin_convertvector(v, bf16x2_c); return __builtin_bit_cast(unsigned, b); }
__device__ __forceinline__ void attn_unit(const Ctx& c, const Params& p, int u) {
    const int qb = u & 31, kvh = (u >> 5) & 1, b = u >> 6;
    const bf16* P0 = (const bf16*)(p.ws + WS_ACT + A_P);
    LAS unsigned char* lds = c.lds;
    __syncthreads();
    {
        const int key = c.tid >> 1, half = c.tid & 1, tk = 128 * (qb - 1) + key;
        v4u kv[4];
        if (tk >= 0) { const v4u* src = (const v4u*)(P0 + (size_t)(b * T + tk) * NAB + C_KA + kvh * 64 + 32 * half);
#pragma unroll
            for (int i = 0; i < 4; ++i) kv[i] = src[i]; }
        else {
#pragma unroll
            for (int i = 0; i < 4; ++i) kv[i] = (v4u){0u, 0u, 0u, 0u}; }
#pragma unroll
        for (int i = 0; i < 4; ++i) *(LAS v4u*)(lds + AT_K + key * AT_KSTR + 64 * half + 16 * i) = kv[i];
    }
    {
        const int kp = c.tid & 127, dq = c.tid >> 7, tk = 128 * (qb - 1) + 2 * kp;
        v4u va[2], vb[2];
        if (tk >= 0) { const v4u* s0 = (const v4u*)(P0 + (size_t)(b * T + tk) * NAB + C_VA + kvh * 64 + 16 * dq); const v4u* s1 = (const v4u*)(P0 + (size_t)(b * T + tk + 1) * NAB + C_VA + kvh * 64 + 16 * dq);
            va[0] = s0[0]; va[1] = s0[1]; vb[0] = s1[0]; vb[1] = s1[1]; }
        else { va[0] = va[1] = vb[0] = vb[1] = (v4u){0u, 0u, 0u, 0u}; }
#pragma unroll
        for (int i = 0; i < 2; ++i)
#pragma unroll
            for (int k = 0; k < 4; ++k) { const unsigned a = va[i][k], bb = vb[i][k]; const int d = 16 * dq + 8 * i + 2 * k;
                *(LAS unsigned*)(lds + AT_V + d * AT_VSTR + 4 * kp) = (a & 0xffffu) | (bb << 16);
                *(LAS unsigned*)(lds + AT_V + (d + 1) * AT_VSTR + 4 * kp) = (a >> 16) | (bb & 0xffff0000u); }
    }
    { const int hl = c.tid >> 7, dist = c.tid & 127; *(LAS float*)(lds + AT_BIAS + c.tid * 4) = p.in[I_RELB][T5_BUCKET[dist] * 8 + kvh * 4 + hl]; }
    __syncthreads();
    const int hl = c.wave >> 1, hq = kvh * 4 + hl, qh = c.wave & 1, qi = c.lane & 31, hh = c.lane >> 5;
    const float sink = p.in[I_SINK][hq];
    const LAS float* biasT = (const LAS float*)(lds + AT_BIAS + hl * 512);
#pragma unroll 1
    for (int s = 0; s < 2; ++s) {
        const int q0 = 64 * qh + 32 * s, kb0 = q0 >> 5, qq = q0 + qi; const size_t m = (size_t)b * T + 128 * qb + qq;
        bf16x8_t bq[4];
#pragma unroll
        for (int ks = 0; ks < 4; ++ks) bq[ks] = *(const bf16x8_t*)(P0 + m * NAB + C_QA + hq * 64 + 16 * ks + 8 * hh);
        f32x16 sacc[5];
#pragma unroll
        for (int kbi = 0; kbi < 5; ++kbi) {
            f32x16 acc;
#pragma unroll
            for (int r = 0; r < 16; ++r) acc[r] = 0.f;
#pragma unroll
            for (int ks = 0; ks < 4; ++ks) { const bf16x8_t ka = *(const LAS bf16x8_t*)(lds + AT_K + (32 * (kb0 + kbi) + qi) * AT_KSTR + 32 * ks + 16 * hh);
                acc = __builtin_amdgcn_mfma_f32_32x32x16_bf16(ka, bq[ks], acc, 0, 0, 0); }
            sacc[kbi] = acc;
        }
        float mx = -1e30f;
#pragma unroll
        for (int kbi = 0; kbi < 5; ++kbi)
#pragma unroll
            for (int r = 0; r < 16; ++r) { const int sidx = 32 * (kb0 + kbi) + (r & 3) + 8 * (r >> 2) + 4 * hh; const int dist = qq + 128 - sidx;
                const bool valid = dist >= 0 && dist < 128 && (qb > 0 || sidx >= 128);
                const float bv = biasT[dist & 127];
                const float sc = valid ? sacc[kbi][r] * 0.125f + bv : -1e30f; sacc[kbi][r] = sc; mx = fmaxf(mx, sc); }
        mx = fmaxf(mx, __shfl_xor(mx, 32)); mx = fmaxf(mx, sink);
        float l = 0.f;
#pragma unroll
        for (int kbi = 0; kbi < 5; ++kbi)
#pragma unroll
            for (int r = 0; r < 16; ++r) { const float pv = __expf(sacc[kbi][r] - mx); sacc[kbi][r] = pv; l += pv; }
        l += __shfl_xor(l, 32); l += __expf(sink - mx);
        const float inv = 1.0f / l;
        f32x16 oacc[2];
#pragma unroll
        for (int db = 0; db < 2; ++db)
#pragma unroll
            for (int r = 0; r < 16; ++r) oacc[db][r] = 0.f;
#pragma unroll
        for (int kbi = 0; kbi < 5; ++kbi)
#pragma unroll
            for (int s2 = 0; s2 < 2; ++s2) {
                v4u pw; pw.x = pkbf(sacc[kbi][8 * s2 + 0], sacc[kbi][8 * s2 + 1]); pw.y = pkbf(sacc[kbi][8 * s2 + 2], sacc[kbi][8 * s2 + 3]); pw.z = pkbf(sacc[kbi][8 * s2 + 4], sacc[kbi][8 * s2 + 5]); pw.w = pkbf(sacc[kbi][8 * s2 + 6], sacc[kbi][8 * s2 + 7]);
                const bf16x8_t pf = __builtin_bit_cast(bf16x8_t, pw);
                const int keyb = 32 * (kb0 + kbi) + 16 * s2 + 4 * hh;
#pragma unroll
                for (int db = 0; db < 2; ++db) { const LAS unsigned char* vp = lds + AT_V + (32 * db + qi) * AT_VSTR + 2 * keyb;
                    const s16x4_t lo = *(const LAS s16x4_t*)vp, hi = *(const LAS s16x4_t*)(vp + 16);
                    const bf16x8_t vf = (bf16x8_t){lo[0], lo[1], lo[2], lo[3], hi[0], hi[1], hi[2], hi[3]};
                    oacc[db] = __builtin_amdgcn_mfma_f32_32x32x16_bf16(vf, pf, oacc[db], 0, 0, 0); }
            }
        bf16* orow = (bf16*)(p.ws + WS_ACT + A_MIXA) + m * D + hq * 64;
#pragma unroll
        for (int db = 0; db < 2; ++db)
#pragma unroll
            for (int g = 0; g < 4; ++g) { v2u w; w.x = pkbf(oacc[db][4 * g] * inv, oacc[db][4 * g + 1] * inv); w.y = pkbf(oacc[db][4 * g + 2] * inv, oacc[db][4 * g + 3] * inv);
                *(v2u*)(orow + 32 * db + 8 * g + 4 * hh) = w; }
    }
}
__device__ __forceinline__ void ph_attn(const Ctx& c, const Params& p) {
    for (int u = c.bid; u < 256; u += c.G) attn_unit(c, p, u);
}


constexpr int LR_XSTR = 272, LR_XT = 0, LR_XF = 64 * LR_XSTR, LR_GA = LR_XF + 32768, LR_CMB = LR_GA + 32768, LR_XR = LR_CMB + 4096, LR_END = LR_XR + 67 * LR_XSTR;
constexpr size_t A_AB = 192 * MiB, A_SA = 256 * MiB, A_SH = 260 * MiB, A_TA = 264 * MiB, A_TH = 265 * MiB, A_GA = 266 * MiB, A_GH = 266 * MiB + 512 * 1024;
typedef float f32x4_t __attribute__((ext_vector_type(4)));
__device__ __forceinline__ void ph_lru1(const Ctx& c, const Params& p) {
    LAS unsigned char* lds = c.lds; unsigned char* act = p.ws + WS_ACT;
    const int n = c.bid & 7, bg = c.bid >> 3, b = bg >> 3, grp = bg & 7, ch = c.tid & 127, tq = c.tid >> 7, gch = n * 128 + ch;
    const bf16* P1 = (const bf16*)(act + A_P);
    const float cw0 = p.in[I_LCW][gch], cw1 = p.in[I_LCW][1024 + gch], cw2 = p.in[I_LCW][2048 + gch], cw3 = p.in[I_LCW][3072 + gch], cb = p.in[I_LCB][gch];
    const int jl = c.lane & 15, q = c.lane >> 4, w = c.wave, ech = n * 128 + 16 * w + jl;
    const float gab = p.in[I_GAB][ech], gxb = p.in[I_GXB][ech], sp8 = -8.0f * softplusf_(-p.in[I_LAM][ech]);
    bf16x8_t bfa[4], bfx[4];
    { const bf16* wl = (const bf16*)(p.ws + WS_WLRU) + (size_t)n * 256 * 128;
#pragma unroll
      for (int ks = 0; ks < 4; ++ks) { bfa[ks] = *(const bf16x8_t*)(wl + (size_t)(16 * w + jl) * 128 + 32 * ks + 8 * q); bfx[ks] = *(const bf16x8_t*)(wl + (size_t)(128 + 16 * w + jl) * 128 + 32 * ks + 8 * q); } }
    v4u xr[3];
#define LR_FETCH(tile_) do { const int t0_ = 64 * (tile_); _Pragma("unroll") for (int i_ = 0; i_ < 3; ++i_) { const int pc_ = c.tid + 512 * i_; const int row_ = pc_ >> 4, cg_ = pc_ & 15; const int tk_ = t0_ - 3 + row_; \
        xr[i_] = (pc_ < 1072 && tk_ >= 0) ? *(const v4u*)(P1 + ((size_t)b * T + tk_) * NCD + C_XC + n * 128 + 8 * cg_) : (v4u){0u, 0u, 0u, 0u}; } } while (0)
    LR_FETCH(grp * 8);
    float Ag = 1.f, Hg = 0.f;
    for (int r = 0; r < 8; ++r) {
        const int tt = grp * 8 + r; const size_t m0 = (size_t)b * T + 64 * tt;
        __syncthreads();
#pragma unroll
        for (int i = 0; i < 3; ++i) { const int pc = c.tid + 512 * i; if (pc < 1072) *(LAS v4u*)(lds + LR_XR + (pc >> 4) * LR_XSTR + 16 * (pc & 15)) = xr[i]; }
        if (r < 7) LR_FETCH(tt + 1);
        __syncthreads();
        { const LAS unsigned char* xc0 = lds + LR_XR + 2 * ch; float x0 = bf2f(*(const LAS unsigned short*)(xc0 + (16 * tq) * LR_XSTR)), x1 = bf2f(*(const LAS unsigned short*)(xc0 + (16 * tq + 1) * LR_XSTR)), x2 = bf2f(*(const LAS unsigned short*)(xc0 + (16 * tq + 2) * LR_XSTR));
#pragma unroll
          for (int i = 0; i < 16; ++i) { const int tk = 16 * tq + i; const float x3 = bf2f(*(const LAS unsigned short*)(xc0 + (tk + 3) * LR_XSTR));
              const float xc = cb + cw0 * x0 + cw1 * x1 + cw2 * x2 + cw3 * x3;
              *(LAS unsigned short*)(lds + LR_XT + tk * LR_XSTR + 2 * ch) = (unsigned short)f2bf(xc);
              *(LAS float*)(lds + LR_XF + (tk * 128 + ch) * 4) = xc;
              x0 = x1; x1 = x2; x2 = x3; } }
        __syncthreads();
#pragma unroll
        for (int mt = 0; mt < 4; ++mt) {
            f32x4_t aa = {0.f, 0.f, 0.f, 0.f}, ax = {0.f, 0.f, 0.f, 0.f};
#pragma unroll
            for (int ks = 0; ks < 4; ++ks) { const bf16x8_t af = *(const LAS bf16x8_t*)(lds + LR_XT + (16 * mt + jl) * LR_XSTR + 64 * ks + 16 * q);
                aa = __builtin_amdgcn_mfma_f32_16x16x32_bf16(af, bfa[ks], aa, 0, 0, 0); ax = __builtin_amdgcn_mfma_f32_16x16x32_bf16(af, bfx[ks], ax, 0, 0, 0); }
#pragma unroll
            for (int r4 = 0; r4 < 4; ++r4) { const int tk = 16 * mt + 4 * q + r4; LAS float* xf = (LAS float*)(lds + LR_XF + (tk * 128 + 16 * w + jl) * 4);
                const float rr = sigmoidf_(aa[r4] + gab), ii = sigmoidf_(ax[r4] + gxb), la = sp8 * rr, a = __expf(la);
                const float bb = sqrtf(fmaxf(1.0f - a * a, 0.f)) * (ii * xf[0]);
                *(LAS float*)(lds + LR_GA + (tk * 128 + 16 * w + jl) * 4) = 1.0f - a; xf[0] = bb; }
        }
        __syncthreads();
        float Ap = 1.f, h = 0.f; unsigned* AB = (unsigned*)(act + A_AB) + (m0 + 16 * tq) * 1024 + gch;
#pragma unroll
        for (int i = 0; i < 16; ++i) { const float oma = *(const LAS float*)(lds + LR_GA + ((16 * tq + i) * 128 + ch) * 4), bv = *(const LAS float*)(lds + LR_XF + ((16 * tq + i) * 128 + ch) * 4);
            const unsigned pk = pk2(oma, bv); AB[(size_t)i * 1024] = pk;
            const float a = 1.0f - bflo(pk), bq = bfhi(pk); h = a * h + bq; Ap *= a; }
        { const size_t si = (m0 >> 4) + tq; ((float*)(act + A_SA))[si * 1024 + gch] = Ap; ((float*)(act + A_SH))[si * 1024 + gch] = h; }
        *(LAS float*)(lds + LR_CMB + (tq * 128 + ch) * 4) = Ap; *(LAS float*)(lds + LR_CMB + 2048 + (tq * 128 + ch) * 4) = h;
        __syncthreads();
        if (tq == 0) { float A = 1.f, H = 0.f;
#pragma unroll
            for (int g = 0; g < 4; ++g) { const float ag = *(const LAS float*)(lds + LR_CMB + (g * 128 + ch) * 4), hg = *(const LAS float*)(lds + LR_CMB + 2048 + (g * 128 + ch) * 4); H = ag * H + hg; A *= ag; }
            ((float*)(act + A_TA))[(size_t)(b * 64 + tt) * 1024 + gch] = A; ((float*)(act + A_TH))[(size_t)(b * 64 + tt) * 1024 + gch] = H;
            Hg = A * Hg + H; Ag *= A; }
    }
    if (tq == 0) { ((float*)(act + A_GA))[(size_t)(b * 8 + grp) * 1024 + gch] = Ag; ((float*)(act + A_GH))[(size_t)(b * 8 + grp) * 1024 + gch] = Hg; }
#undef LR_FETCH
}
__device__ __forceinline__ void ph_lru2(const Ctx& c, const Params& p) {
    unsigned char* act = p.ws + WS_ACT;
    const int n = c.bid & 7, bg = c.bid >> 3, b = bg >> 3, grp = bg & 7, ch = c.tid & 127, tq = c.tid >> 7, gch = n * 128 + ch;
    const float* GA = (const float*)(act + A_GA); const float* GH = (const float*)(act + A_GH); const float* TA = (const float*)(act + A_TA); const float* TH = (const float*)(act + A_TH);
    const float* SA = (const float*)(act + A_SA); const float* SH = (const float*)(act + A_SH);
    const bf16* yc = (const bf16*)(act + A_P) + C_YC + gch; bf16* mo = (bf16*)(act + A_MIXB) + gch;
    float ht = 0.f;
    for (int g = 0; g < grp; ++g) ht = GA[(size_t)(b * 8 + g) * 1024 + gch] * ht + GH[(size_t)(b * 8 + g) * 1024 + gch];
    for (int r = 0; r < 8; ++r) { const int tt = grp * 8 + r; const size_t m0 = (size_t)b * T + 64 * tt;
        float hs = ht;
        for (int s = 0; s < tq; ++s) { const size_t si = (m0 >> 4) + s; hs = SA[si * 1024 + gch] * hs + SH[si * 1024 + gch]; }
        const unsigned* AB = (const unsigned*)(act + A_AB) + (m0 + 16 * tq) * 1024 + gch;
        unsigned ab[16]; unsigned short yv[16];
#pragma unroll
        for (int i = 0; i < 16; ++i) { ab[i] = AB[(size_t)i * 1024]; yv[i] = yc[(m0 + 16 * tq + i) * NCD]; }
#pragma unroll
        for (int i = 0; i < 16; ++i) { hs = (1.0f - bflo(ab[i])) * hs + bfhi(ab[i]);
            const float y = bf2f(yv[i]); const float ge = y * sigmoidf_(1.5957691216057308f * (y + 0.044715f * y * y * y));
            mo[(m0 + 16 * tq + i) * CDO] = (bf16)f2bf(hs * ge); }
        ht = TA[(size_t)(b * 64 + tt) * 1024 + gch] * ht + TH[(size_t)(b * 64 + tt) * 1024 + gch];
    }
}
__device__ __forceinline__ void ph_sconv(const Ctx& c, const Params& p) {
    const bf16* P1 = (const bf16*)(p.ws + WS_ACT + A_P); const float* sw = p.in[I_SCW];
    for (int it = c.bid * NTHR + c.tid; it < M * 64; it += c.G * NTHR) {
        const int m = it >> 6, cg = it & 63, t = m & (T - 1), c0 = 8 * cg; float acc[8];
#pragma unroll
        for (int e = 0; e < 8; ++e) acc[e] = 0.f;
#pragma unroll
        for (int k = 0; k < 3; ++k) { const int tt = t - 2 + k; if (tt >= 0) { const size_t r = (size_t)(m - 2 + k) * NCD; const v4u cv = *(const v4u*)(P1 + r + C_CD + c0), hv = *(const v4u*)(P1 + r + C_HD + c0);
#pragma unroll
            for (int e = 0; e < 4; ++e) { acc[2 * e] += sw[k * 512 + c0 + 2 * e] * (bflo(cv[e]) * bflo(hv[e])); acc[2 * e + 1] += sw[k * 512 + c0 + 2 * e + 1] * (bfhi(cv[e]) * bfhi(hv[e])); } } }
        const v4u bv = *(const v4u*)(P1 + (size_t)m * NCD + C_BD + c0); v4u o;
#pragma unroll
        for (int e = 0; e < 4; ++e) o[e] = pk2(bflo(bv[e]) * acc[2 * e], bfhi(bv[e]) * acc[2 * e + 1]);
        *(v4u*)((bf16*)(p.ws + WS_ACT + A_MIXB) + (size_t)m * CDO + 1024 + c0) = o; }
}


constexpr size_t A_DNX = 160 * MiB, A_DNEG = 256 * MiB;
constexpr int DN_CHB = 49152, DN_W = 0, DN_QD = 8192, DN_QK = 16384, DN_KD = 24576, DN_U = 32768;
constexpr int DN_KS = 144, DN_R = 9216, DN_WAVE = 2 * DN_R, DN_CW = 8 * DN_WAVE;
__device__ __forceinline__ float rdl(float x, int i) { return __builtin_bit_cast(float, __builtin_amdgcn_readlane(__builtin_bit_cast(int, x), i)); }
__device__ __forceinline__ int lrow_off(int i) { const int a = (i - 1) >> 2, b = (i - 1) & 3; return 4 * (a + 1) * (2 * a + b); }
__host__ __device__ constexpr int lrow_off_c(int i) { return 4 * (((i - 1) >> 2) + 1) * (2 * ((i - 1) >> 2) + ((i - 1) & 3)); }

typedef __amdgpu_buffer_rsrc_t rsrc_t;
__device__ __forceinline__ rsrc_t mk_rsrc(const void* base, unsigned bytes) { return __builtin_amdgcn_make_buffer_rsrc((void*)base, 0, bytes, 0x00020000); }
__device__ __forceinline__ void dn_conv_row(rsrc_t rp, const LAS float* cwl, int rowoff, int n, int lane, int coffb, float (&acc)[64]) {
#pragma unroll
    for (int ch = 0; ch < 64; ++ch) acc[ch] = 0.f;
#pragma unroll
    for (int k = 0; k < 4; ++k) { const int tt = 64 * n + lane - 3 + k;
        v4u xr[8];
        if (tt >= 0) {
#pragma unroll
            for (int i = 0; i < 8; ++i) xr[i] = __builtin_amdgcn_raw_buffer_load_b128(rp, rowoff + (k - 3) * (NAB * 2) + 16 * i, coffb, 0); }
        else {
#pragma unroll
            for (int i = 0; i < 8; ++i) xr[i] = (v4u){0u, 0u, 0u, 0u}; }
#pragma unroll
        for (int i = 0; i < 8; ++i) { const f32x4_t wa = *(const LAS f32x4_t*)(cwl + k * 64 + 8 * i), wb = *(const LAS f32x4_t*)(cwl + k * 64 + 8 * i + 4);
            acc[8 * i + 0] += wa[0] * bflo(xr[i][0]); acc[8 * i + 1] += wa[1] * bfhi(xr[i][0]); acc[8 * i + 2] += wa[2] * bflo(xr[i][1]); acc[8 * i + 3] += wa[3] * bfhi(xr[i][1]);
            acc[8 * i + 4] += wb[0] * bflo(xr[i][2]); acc[8 * i + 5] += wb[1] * bfhi(xr[i][2]); acc[8 * i + 6] += wb[2] * bflo(xr[i][3]); acc[8 * i + 7] += wb[3] * bfhi(xr[i][3]); }
        asm volatile("" ::: "memory"); }
#pragma unroll
    for (int ch = 0; ch < 64; ++ch) acc[ch] = siluf_(acc[ch]);
}
__device__ __forceinline__ void fnma(float& acc, float a, float b) { asm volatile("v_fma_f32 %0, -%1, %2, %0" : "+v"(acc) : "v"(a), "v"(b)); }
__device__ __forceinline__ void dn_solve(const LAS unsigned char* R2, float (&x)[64]) {
#pragma unroll
    for (int i = 1; i < 64; ++i) {
        f32x4_t lv[16];
#pragma unroll
        for (int g = 0; g < (i + 3) / 4; ++g) lv[g] = *(const LAS f32x4_t*)(R2 + (lrow_off_c(i) + 4 * g) * 4);
        float a0 = x[i], a1 = 0.f;
#pragma unroll
        for (int g = 0; g < (i + 3) / 4; ++g) {
#pragma unroll
            for (int e = 0; e < 4; ++e) if (4 * g + e < i) { if (e & 1) fnma(a1, lv[g][e], x[4 * g + e]); else fnma(a0, lv[g][e], x[4 * g + e]); } }
        x[i] = a0 + a1;
    }
}
__device__ __forceinline__ void dn_prep_chunk(const Ctx& c, const Params& p, int ci, size_t xoff) {
    const int n = ci & 63, h = (ci >> 6) & 7, b = ci >> 9, lane = c.lane;
    const int m0 = b * T + 64 * n;
    LAS unsigned char* R1 = c.lds + c.wave * DN_WAVE; LAS unsigned char* R2 = R1 + DN_R;
    const LAS float* cwl = (const LAS float*)(c.lds + DN_CW);
    const rsrc_t rp = mk_rsrc(p.ws + WS_ACT + A_P, (unsigned)((size_t)M * NAB * 2));
    const rsrc_t rx = mk_rsrc(p.ws + xoff + (size_t)ci * DN_CHB, DN_CHB);
    const int rowoff = (m0 + lane) * (NAB * 2);
#pragma unroll
    for (int s = 0; s < 2; ++s) {
        float acc[64]; dn_conv_row(rp, cwl + s * 256, rowoff, n, lane, (C_QKVB + s * 512 + h * 64) * 2, acc);
        float ss = 0.f;
#pragma unroll
        for (int ch = 0; ch < 64; ++ch) ss += acc[ch] * acc[ch];
        const float rn = (s == 1 ? 1.0f : 0.125f) / sqrtf(ss + 1e-6f);
        LAS unsigned char* dst = (s == 1 ? R1 : R2) + lane * DN_KS;
#pragma unroll
        for (int i = 0; i < 8; ++i) { v4u w; w.x = pkbf(acc[8 * i] * rn, acc[8 * i + 1] * rn); w.y = pkbf(acc[8 * i + 2] * rn, acc[8 * i + 3] * rn); w.z = pkbf(acc[8 * i + 4] * rn, acc[8 * i + 5] * rn); w.w = pkbf(acc[8 * i + 6] * rn, acc[8 * i + 7] * rn);
            *(LAS v4u*)(dst + 16 * i) = w; }
        asm volatile("" ::: "memory");
    }
    const float beta = sigmoidf_(bf2f(__builtin_amdgcn_raw_buffer_load_b16(rp, rowoff, (C_BETA + h) * 2, 0)));
    float gc = -__expf(p.in[I_ALOG][h]) * softplusf_(bf2f(__builtin_amdgcn_raw_buffer_load_b16(rp, rowoff, (C_AB + h) * 2, 0)) + p.in[I_DTB][h]);
#pragma unroll
    for (int o = 1; o < 64; o <<= 1) { const float t = __shfl_up(gc, o); if (lane >= o) gc += t; }
    const float gl = rdl(gc, 63), egc = __expf(gc), kdsc = __expf(gl - gc), bw = beta * egc;
    if (lane == 0) ((float*)(p.ws + WS_ACT + A_DNEG))[ci] = __expf(gl);
    asm volatile("s_waitcnt lgkmcnt(0)" ::: "memory");
    const int r32 = lane & 31, hh = lane >> 5, l15 = lane & 15, q4 = lane >> 4;
#pragma unroll
    for (int blk = 0; blk < 4; ++blk) { const int I = blk >> 1, J = blk & 1;
        v4u fa = {0u, 0u, 0u, 0u}, fb = {0u, 0u, 0u, 0u};
        if (!(I == 0 && J == 1)) {
            f32x16 acc;
#pragma unroll
            for (int r = 0; r < 16; ++r) acc[r] = 0.f;
#pragma unroll
            for (int ks = 0; ks < 4; ++ks) { const bf16x8_t ka = *(const LAS bf16x8_t*)(R1 + (32 * J + r32) * DN_KS + 32 * ks + 16 * hh), qb = *(const LAS bf16x8_t*)(R2 + (32 * I + r32) * DN_KS + 32 * ks + 16 * hh);
                acc = __builtin_amdgcn_mfma_f32_32x32x16_bf16(ka, qb, acc, 0, 0, 0); }
            const int i = 32 * I + r32; const float gci = __shfl(gc, i);
            float v[16];
#pragma unroll
            for (int r = 0; r < 16; ++r) { const int j = 32 * J + (r & 3) + 8 * (r >> 2) + 4 * hh; const float gcj = __shfl(gc, j); v[r] = j <= i ? acc[r] * __expf(gci - gcj) : 0.f; }
            fa.x = pkbf(v[0], v[1]); fa.y = pkbf(v[2], v[3]); fa.z = pkbf(v[8], v[9]); fa.w = pkbf(v[10], v[11]);
            fb.x = pkbf(v[4], v[5]); fb.y = pkbf(v[6], v[7]); fb.z = pkbf(v[12], v[13]); fb.w = pkbf(v[14], v[15]);
        }
        const int vo = (r32 >> 4) * 2048 + (l15 + 16 * hh) * 16;
        __builtin_amdgcn_raw_buffer_store_b128(fa, rx, (vo) + (DN_QK + 4096 * I + 1024 * J), 0, 0);
        __builtin_amdgcn_raw_buffer_store_b128(fb, rx, (vo) + (DN_QK + 4096 * I + 1024 * J + 512), 0, 0);
    }
#pragma unroll
    for (int mt = 0; mt < 4; ++mt) { const int row = 16 * mt + l15; const float sc = __shfl(egc, row);
#pragma unroll
        for (int ks = 0; ks < 2; ++ks) { const v2u a = *(const LAS v2u*)(R2 + row * DN_KS + 64 * ks + 8 * q4), bq = *(const LAS v2u*)(R2 + row * DN_KS + 64 * ks + 32 + 8 * q4);
            v4u w; w.x = pkbf(bflo(a.x) * sc, bfhi(a.x) * sc); w.y = pkbf(bflo(a.y) * sc, bfhi(a.y) * sc); w.z = pkbf(bflo(bq.x) * sc, bfhi(bq.x) * sc); w.w = pkbf(bflo(bq.y) * sc, bfhi(bq.y) * sc);
            __builtin_amdgcn_raw_buffer_store_b128(w, rx, (lane * 16) + (DN_QD + (mt * 2 + ks) * 1024), 0, 0); } }
    asm volatile("s_waitcnt lgkmcnt(0)" ::: "memory");
#pragma unroll
    for (int blk = 0; blk < 3; ++blk) { const int I = blk == 0 ? 0 : 1, J = blk == 2 ? 1 : 0;
        f32x16 acc;
#pragma unroll
        for (int r = 0; r < 16; ++r) acc[r] = 0.f;
#pragma unroll
        for (int ks = 0; ks < 4; ++ks) { const bf16x8_t ki = *(const LAS bf16x8_t*)(R1 + (32 * I + r32) * DN_KS + 32 * ks + 16 * hh), kj = *(const LAS bf16x8_t*)(R1 + (32 * J + r32) * DN_KS + 32 * ks + 16 * hh);
            acc = __builtin_amdgcn_mfma_f32_32x32x16_bf16(ki, kj, acc, 0, 0, 0); }
        const int j = 32 * J + r32; const float gcj = __shfl(gc, j);
#pragma unroll
        for (int r = 0; r < 16; ++r) { const int i = 32 * I + (r & 3) + 8 * (r >> 2) + 4 * hh; const float gci = __shfl(gc, i), bi = __shfl(beta, i);
            if (i > j) *(LAS float*)(R2 + (lrow_off(i) + j) * 4) = bi * acc[r] * __expf(gci - gcj); }
    }
    asm volatile("s_waitcnt lgkmcnt(0)" ::: "memory");
    {   float xu[64];
        { const int cb = (C_QKVB + 1024 + h * 64) * 2;
          const float w0 = cwl[512 + lane], w1 = cwl[512 + 64 + lane], w2 = cwl[512 + 128 + lane], w3 = cwl[512 + 192 + lane];
          float x0 = 0.f, x1 = 0.f, x2 = 0.f;
          if (n > 0) { x0 = bf2f(__builtin_amdgcn_raw_buffer_load_b16(rp, lane * 2, (m0 - 3) * (NAB * 2) + cb, 0)); x1 = bf2f(__builtin_amdgcn_raw_buffer_load_b16(rp, lane * 2, (m0 - 2) * (NAB * 2) + cb, 0)); x2 = bf2f(__builtin_amdgcn_raw_buffer_load_b16(rp, lane * 2, (m0 - 1) * (NAB * 2) + cb, 0)); }
#pragma unroll
          for (int i = 0; i < 64; ++i) { const float x3 = bf2f(__builtin_amdgcn_raw_buffer_load_b16(rp, lane * 2, (m0 + i) * (NAB * 2) + cb, 0)); xu[i] = siluf_(w0 * x0 + w1 * x1 + w2 * x2 + w3 * x3) * rdl(beta, i); x0 = x1; x1 = x2; x2 = x3; } }
        dn_solve(R2, xu);
        const int vo = q4 * 4096 + l15 * 16;
#pragma unroll
        for (int mt = 0; mt < 4; ++mt)
#pragma unroll
            for (int qq = 0; qq < 4; ++qq) { const int i0 = 16 * mt + 4 * qq; f32x4_t uv = {xu[i0], xu[i0 + 1], xu[i0 + 2], xu[i0 + 3]};
                __builtin_amdgcn_raw_buffer_store_b128(__builtin_bit_cast(v4u, uv), rx, (vo) + (DN_U + mt * 1024 + qq * 256), 0, 0); }
    }
    asm volatile("" ::: "memory");
    float xw[64];
#pragma unroll
    for (int i = 0; i < 64; ++i) xw[i] = bf2f(*(const LAS unsigned short*)(R1 + i * DN_KS + 2 * lane)) * rdl(bw, i);
    asm volatile("s_waitcnt lgkmcnt(0)" ::: "memory");
    { LAS unsigned char* row = R1 + lane * DN_KS;
#pragma unroll
      for (int i = 0; i < 8; ++i) { v4u w = *(LAS v4u*)(row + 16 * i);
          w.x = pkbf(bflo(w.x) * kdsc, bfhi(w.x) * kdsc); w.y = pkbf(bflo(w.y) * kdsc, bfhi(w.y) * kdsc); w.z = pkbf(bflo(w.z) * kdsc, bfhi(w.z) * kdsc); w.w = pkbf(bflo(w.w) * kdsc, bfhi(w.w) * kdsc);
          *(LAS v4u*)(row + 16 * i) = w; } }
    asm volatile("s_waitcnt lgkmcnt(0)" ::: "memory");
#pragma unroll
    for (int dt = 0; dt < 4; ++dt)
#pragma unroll
        for (int ks = 0; ks < 2; ++ks) { unsigned short e[8];
#pragma unroll
            for (int jj = 0; jj < 8; ++jj) e[jj] = *(const LAS unsigned short*)(R1 + (32 * ks + 16 * (jj >> 2) + 4 * q4 + (jj & 3)) * DN_KS + 2 * (16 * dt + l15));
            v4u w; w.x = e[0] | ((unsigned)e[1] << 16); w.y = e[2] | ((unsigned)e[3] << 16); w.z = e[4] | ((unsigned)e[5] << 16); w.w = e[6] | ((unsigned)e[7] << 16);
            __builtin_amdgcn_raw_buffer_store_b128(w, rx, (lane * 16) + (DN_KD + (dt * 2 + ks) * 1024), 0, 0); }
    asm volatile("s_waitcnt lgkmcnt(0)" ::: "memory");
    dn_solve(R2, xw);
#pragma unroll
    for (int i = 0; i < 64; ++i) *(LAS unsigned short*)(R1 + i * DN_KS + 2 * lane) = (unsigned short)(f2bf(xw[i]) ^ 0x8000u);
    asm volatile("s_waitcnt lgkmcnt(0)" ::: "memory");
#pragma unroll
    for (int mt = 0; mt < 4; ++mt)
#pragma unroll
        for (int ks = 0; ks < 2; ++ks) { const int row = 16 * mt + l15; const v2u a = *(const LAS v2u*)(R1 + row * DN_KS + 64 * ks + 8 * q4), bq = *(const LAS v2u*)(R1 + row * DN_KS + 64 * ks + 32 + 8 * q4);
            v4u w; w.x = a.x; w.y = a.y; w.z = bq.x; w.w = bq.y;
            __builtin_amdgcn_raw_buffer_store_b128(w, rx, (lane * 16) + (DN_W + (mt * 2 + ks) * 1024), 0, 0); }
    asm volatile("s_waitcnt lgkmcnt(0)" ::: "memory");
}
__device__ __forceinline__ void ph_dn_prep2(const Ctx& c, const Params& p, size_t xoff) {
    { const int h = (c.bid >> 3) & 7; LAS float* cwl = (LAS float*)(c.lds + DN_CW);
      for (int i = c.tid; i < 768; i += NTHR) { const int g = i >> 8, k = (i >> 6) & 3, ch = i & 63; cwl[i] = p.in[I_DNCONV][k * 1536 + g * 512 + h * 64 + ch]; }
      __syncthreads(); }
    if (c.gw < 2048) dn_prep_chunk(c, p, c.gw, xoff);
}

constexpr int SC_SLOT = DN_CHB, SC_OB = 2 * DN_CHB, SC_OSTR = 272, SC_OBSZ = 64 * SC_OSTR;
__device__ __forceinline__ bf16x8_t pack8(const f32x4_t& a, const f32x4_t& b) { v4u w; w.x = pkbf(a[0], a[1]); w.y = pkbf(a[2], a[3]); w.z = pkbf(b[0], b[1]); w.w = pkbf(b[2], b[3]); return __builtin_bit_cast(bf16x8_t, w); }
__device__ __forceinline__ void ph_dn_scan2(const Ctx& c, const Params& p) {
    if (c.bid >= 32) return;
    const int b = c.bid >> 3, h = c.bid & 7, lane = c.lane;
    LAS unsigned char* lds = c.lds;
    const unsigned char* dnx = p.ws + WS_ACT + A_DNX + (size_t)(c.bid * 64) * DN_CHB; const float* EG = (const float*)(p.ws + WS_ACT + A_DNEG) + c.bid * 64;
    const bf16* P0 = (const bf16*)(p.ws + WS_ACT + A_P);
    if (c.wave >= 4) {
        const int lw = c.wave - 4, il = lane >> 2, qd = lane & 3;
        float nw[16];
#pragma unroll
        for (int k = 0; k < 16; ++k) nw[k] = p.in[I_DNNORM][16 * qd + k];
        v4u ra[12], rb[12], ga[2] = {{0u, 0u, 0u, 0u}, {0u, 0u, 0u, 0u}}, gb[2] = {{0u, 0u, 0u, 0u}, {0u, 0u, 0u, 0u}};
#define DN_LOAD(R, k) do { const v4u* _s = (const v4u*)(dnx + (size_t)(k) * DN_CHB) + lw * 64 + lane; _Pragma("unroll") for (int _i = 0; _i < 12; ++_i) R[_i] = _s[_i * 256]; } while (0)
#define DN_WRITE(R, slot) do { LAS v4u* _d = (LAS v4u*)(lds + (slot) * SC_SLOT) + lw * 64 + lane; _Pragma("unroll") for (int _i = 0; _i < 12; ++_i) _d[_i * 256] = R[_i]; } while (0)
#define DN_GLOAD(G, k) do { const v4u* _g = (const v4u*)(P0 + ((size_t)b * T + 64 * (k) + 16 * lw + il) * NAB + C_GATEB + h * 64 + 16 * qd); G[0] = _g[0]; G[1] = _g[1]; } while (0)
#define DN_EPI(G, k) do { const LAS unsigned char* _ob = lds + SC_OB + ((k) & 1) * SC_OBSZ + (16 * lw + il) * SC_OSTR + 64 * qd; float _o[16]; float _ss = 0.f; \
            _Pragma("unroll") for (int _i = 0; _i < 4; ++_i) { const f32x4_t _v = *(const LAS f32x4_t*)(_ob + 16 * _i); _o[4 * _i] = _v[0]; _o[4 * _i + 1] = _v[1]; _o[4 * _i + 2] = _v[2]; _o[4 * _i + 3] = _v[3]; _ss += (_v[0] * _v[0] + _v[1] * _v[1]) + (_v[2] * _v[2] + _v[3] * _v[3]); } \
            _ss += __shfl_xor(_ss, 1); _ss += __shfl_xor(_ss, 2); const float _rs = 1.0f / sqrtf(_ss * (1.f / 64.f) + 1e-6f); unsigned _w[8]; \
            _Pragma("unroll") for (int _i = 0; _i < 8; ++_i) { const unsigned _gw = G[_i >> 2][_i & 3]; const float _g0 = bflo(_gw), _g1 = bfhi(_gw); _w[_i] = pkbf(_o[2 * _i] * _rs * nw[2 * _i] * siluf_(_g0), _o[2 * _i + 1] * _rs * nw[2 * _i + 1] * siluf_(_g1)); } \
            v4u* _dst = (v4u*)((bf16*)(p.ws + WS_ACT + A_MIXA) + ((size_t)b * T + 64 * (k) + 16 * lw + il) * D + 512 + h * 64 + 16 * qd); _dst[0] = (v4u){_w[0], _w[1], _w[2], _w[3]}; _dst[1] = (v4u){_w[4], _w[5], _w[6], _w[7]}; } while (0)
        DN_LOAD(ra, 0); DN_WRITE(ra, 0); DN_LOAD(rb, 1); DN_LOAD(ra, 2);
        for (int n = 0; n < 64; n += 2) {
            asm volatile("s_waitcnt lgkmcnt(0)" ::: "memory"); __syncthreads();
            DN_WRITE(rb, 1);
            if (n >= 1) DN_EPI(gb, n - 1);
            DN_GLOAD(ga, n);
            if (n + 3 < 64) DN_LOAD(rb, n + 3);
            asm volatile("s_waitcnt lgkmcnt(0)" ::: "memory"); __syncthreads();
            if (n + 2 < 64) DN_WRITE(ra, 0);
            DN_EPI(ga, n);
            DN_GLOAD(gb, n + 1);
            if (n + 4 < 64) DN_LOAD(ra, n + 4);
        }
        asm volatile("s_waitcnt lgkmcnt(0)" ::: "memory"); __syncthreads();
        DN_EPI(gb, 63);
#undef DN_LOAD
#undef DN_WRITE
#undef DN_GLOAD
#undef DN_EPI
    } else {
        const int w = c.wave, e15 = lane & 15, q4 = lane >> 4;
        f32x4_t S[4];
#pragma unroll
        for (int dt = 0; dt < 4; ++dt) S[dt] = (f32x4_t){0.f, 0.f, 0.f, 0.f};
        float egn = EG[0];
#define DN_STEP(n_, slot) do { const LAS unsigned char* sb = lds + (slot) * SC_SLOT; const float eg = egn; egn = EG[(n_) + 1 < 64 ? (n_) + 1 : 63]; \
            const bf16x8_t Bs0 = pack8(S[0], S[1]), Bs1 = pack8(S[2], S[3]); f32x4_t vn[4], oo[4]; \
            _Pragma("unroll") for (int mt = 0; mt < 4; ++mt) { vn[mt] = *(const LAS f32x4_t*)(sb + DN_U + ((w * 4 + mt) * 64 + lane) * 16); \
                vn[mt] = __builtin_amdgcn_mfma_f32_16x16x32_bf16(*(const LAS bf16x8_t*)(sb + DN_W + ((mt * 2 + 0) * 64 + lane) * 16), Bs0, vn[mt], 0, 0, 0); \
                vn[mt] = __builtin_amdgcn_mfma_f32_16x16x32_bf16(*(const LAS bf16x8_t*)(sb + DN_W + ((mt * 2 + 1) * 64 + lane) * 16), Bs1, vn[mt], 0, 0, 0); \
                oo[mt] = (f32x4_t){0.f, 0.f, 0.f, 0.f}; \
                oo[mt] = __builtin_amdgcn_mfma_f32_16x16x32_bf16(*(const LAS bf16x8_t*)(sb + DN_QD + ((mt * 2 + 0) * 64 + lane) * 16), Bs0, oo[mt], 0, 0, 0); \
                oo[mt] = __builtin_amdgcn_mfma_f32_16x16x32_bf16(*(const LAS bf16x8_t*)(sb + DN_QD + ((mt * 2 + 1) * 64 + lane) * 16), Bs1, oo[mt], 0, 0, 0); } \
            const bf16x8_t Bv0 = pack8(vn[0], vn[1]), Bv1 = pack8(vn[2], vn[3]); \
            _Pragma("unroll") for (int mt = 0; mt < 4; ++mt) { \
                oo[mt] = __builtin_amdgcn_mfma_f32_16x16x32_bf16(*(const LAS bf16x8_t*)(sb + DN_QK + ((mt * 2 + 0) * 64 + lane) * 16), Bv0, oo[mt], 0, 0, 0); \
                if (mt >= 2) oo[mt] = __builtin_amdgcn_mfma_f32_16x16x32_bf16(*(const LAS bf16x8_t*)(sb + DN_QK + ((mt * 2 + 1) * 64 + lane) * 16), Bv1, oo[mt], 0, 0, 0); } \
            _Pragma("unroll") for (int dt = 0; dt < 4; ++dt) { S[dt] = S[dt] * eg; \
                S[dt] = __builtin_amdgcn_mfma_f32_16x16x32_bf16(*(const LAS bf16x8_t*)(sb + DN_KD + ((dt * 2 + 0) * 64 + lane) * 16), Bv0, S[dt], 0, 0, 0); \
                S[dt] = __builtin_amdgcn_mfma_f32_16x16x32_bf16(*(const LAS bf16x8_t*)(sb + DN_KD + ((dt * 2 + 1) * 64 + lane) * 16), Bv1, S[dt], 0, 0, 0); } \
            LAS unsigned char* ob = lds + SC_OB + ((n_) & 1) * SC_OBSZ + (16 * w + e15) * 4; \
            _Pragma("unroll") for (int mt = 0; mt < 4; ++mt) _Pragma("unroll") for (int r4 = 0; r4 < 4; ++r4) *(LAS float*)(ob + (16 * mt + 4 * q4 + r4) * SC_OSTR) = oo[mt][r4]; } while (0)
        for (int n = 0; n < 64; n += 2) {
            asm volatile("s_waitcnt lgkmcnt(0)" ::: "memory"); __syncthreads();
            DN_STEP(n, 0);
            asm volatile("s_waitcnt lgkmcnt(0)" ::: "memory"); __syncthreads();
            DN_STEP(n + 1, 1);
        }
        asm volatile("s_waitcnt lgkmcnt(0)" ::: "memory"); __syncthreads();
#undef DN_STEP
    }
}


constexpr size_t A_ODN = 257 * MiB;
__device__ __forceinline__ void ph_dn_scan_simple(const Ctx& c, const Params& p) {
    if (c.bid >= 32 || c.wave >= 4) return;
    const int b = c.bid >> 3, h = c.bid & 7, lane = c.lane, w = c.wave, e15 = lane & 15, q4 = lane >> 4;
    const unsigned char* dnx = p.ws + WS_ACT + A_DNX + (size_t)(c.bid * 64) * DN_CHB; const float* EG = (const float*)(p.ws + WS_ACT + A_DNEG) + c.bid * 64;
    float* ODN = (float*)(p.ws + WS_ACT + A_ODN);
    f32x4_t S[4];
#pragma unroll
    for (int dt = 0; dt < 4; ++dt) S[dt] = (f32x4_t){0.f, 0.f, 0.f, 0.f};
    for (int n = 0; n < 64; ++n) { const unsigned char* sb = dnx + (size_t)n * DN_CHB; const float eg = EG[n];
        const bf16x8_t Bs0 = pack8(S[0], S[1]), Bs1 = pack8(S[2], S[3]); f32x4_t vn[4], oo[4];
#pragma unroll
        for (int mt = 0; mt < 4; ++mt) { vn[mt] = *(const f32x4_t*)(sb + DN_U + ((w * 4 + mt) * 64 + lane) * 16);
            vn[mt] = __builtin_amdgcn_mfma_f32_16x16x32_bf16(*(const bf16x8_t*)(sb + DN_W + ((mt * 2 + 0) * 64 + lane) * 16), Bs0, vn[mt], 0, 0, 0);
            vn[mt] = __builtin_amdgcn_mfma_f32_16x16x32_bf16(*(const bf16x8_t*)(sb + DN_W + ((mt * 2 + 1) * 64 + lane) * 16), Bs1, vn[mt], 0, 0, 0);
            oo[mt] = (f32x4_t){0.f, 0.f, 0.f, 0.f};
            oo[mt] = __builtin_amdgcn_mfma_f32_16x16x32_bf16(*(const bf16x8_t*)(sb + DN_QD + ((mt * 2 + 0) * 64 + lane) * 16), Bs0, oo[mt], 0, 0, 0);
            oo[mt] = __builtin_amdgcn_mfma_f32_16x16x32_bf16(*(const bf16x8_t*)(sb + DN_QD + ((mt * 2 + 1) * 64 + lane) * 16), Bs1, oo[mt], 0, 0, 0); }
        const bf16x8_t Bv0 = pack8(vn[0], vn[1]), Bv1 = pack8(vn[2], vn[3]);
#pragma unroll
        for (int mt = 0; mt < 4; ++mt) {
            oo[mt] = __builtin_amdgcn_mfma_f32_16x16x32_bf16(*(const bf16x8_t*)(sb + DN_QK + ((mt * 2 + 0) * 64 + lane) * 16), Bv0, oo[mt], 0, 0, 0);
            oo[mt] = __builtin_amdgcn_mfma_f32_16x16x32_bf16(*(const bf16x8_t*)(sb + DN_QK + ((mt * 2 + 1) * 64 + lane) * 16), Bv1, oo[mt], 0, 0, 0); }
#pragma unroll
        for (int dt = 0; dt < 4; ++dt) { S[dt] = S[dt] * eg;
            S[dt] = __builtin_amdgcn_mfma_f32_16x16x32_bf16(*(const bf16x8_t*)(sb + DN_KD + ((dt * 2 + 0) * 64 + lane) * 16), Bv0, S[dt], 0, 0, 0);
            S[dt] = __builtin_amdgcn_mfma_f32_16x16x32_bf16(*(const bf16x8_t*)(sb + DN_KD + ((dt * 2 + 1) * 64 + lane) * 16), Bv1, S[dt], 0, 0, 0); }
#pragma unroll
        for (int mt = 0; mt < 4; ++mt)
#pragma unroll
            for (int r4 = 0; r4 < 4; ++r4) ODN[((size_t)b * T + 64 * n + 16 * mt + 4 * q4 + r4) * 512 + h * 64 + 16 * w + e15] = oo[mt][r4];
    }
}
__device__ __forceinline__ void ph_dn_epi_simple(const Ctx& c, const Params& p) {
    const float* ODN = (const float*)(p.ws + WS_ACT + A_ODN); const bf16* P0 = (const bf16*)(p.ws + WS_ACT + A_P);
    for (int it = c.gw; it < M * 8; it += c.NGW) { const int m = it >> 3, h = it & 7;
        const float o = ODN[(size_t)m * 512 + h * 64 + c.lane];
        const float rs = 1.0f / sqrtf(wave_sum(o * o) * (1.f / 64.f) + 1e-6f);
        const float gt = bf2f(P0[(size_t)m * NAB + C_GATEB + h * 64 + c.lane]);
        ((bf16*)(p.ws + WS_ACT + A_MIXA))[(size_t)m * D + 512 + h * 64 + c.lane] = (bf16)f2bf(o * rs * p.in[I_DNNORM][c.lane] * siluf_(gt)); }
}

__global__ void __launch_bounds__(NTHR, 2) mega(MArgs a) {
    extern __shared__ __attribute__((aligned(16))) unsigned char lds_raw[];
    Ctx c; c.lds = (LAS unsigned char*)lds_raw; c.tid = threadIdx.x; c.lane = c.tid & 63; c.wave = __builtin_amdgcn_readfirstlane(c.tid >> 6);
    c.G = gridDim.x; c.bid = blockIdx.x; c.gw = c.bid * NWAVES + c.wave; c.NGW = c.G * NWAVES;
    const Params& p = a.p;
    volatile LAS unsigned* MISC = (volatile LAS unsigned*)(c.lds + LDS_MISC);
    if (c.tid < 64) MISC[c.tid] = 0u;
    __syncthreads();
    XcdBarrier bar = xcd_barrier_post((unsigned*)(p.ws + WS_CTL) + CW_BAR, MISC);
    const int lo = a.ph_lo, hi = a.ph_hi;
#define IN(k) (lo <= (k) && (k) < hi)
#define SEAM(k) do { if (IN(k) && IN((k) + 1)) xcd_barrier(bar); } while (0)
#ifndef DUP_MASK
#define DUP_MASK 0
#endif
#define DUP(k) ((DUP_MASK >> (k)) & 1)
    if (IN(0)) { ph_convert(c, a.t1, c.gw, c.NGW); ph_ada(c, p); if (DUP(0)) { xcd_barrier(bar); ph_convert(c, a.t1, c.gw, c.NGW); ph_ada(c, p); } } SEAM(0);
    if (IN(1)) { ph_norm<0>(c, p); if (DUP(1)) { xcd_barrier(bar); ph_norm<0>(c, p); } } SEAM(1);
    if (IN(2)) { ph_gemm<G_ABIN>(c, p); if (DUP(2)) { xcd_barrier(bar); ph_gemm<G_ABIN>(c, p); } } SEAM(2);
    if (IN(3)) { ph_dn_prep2(c, p, A_DNX + WS_ACT); if (DUP(3)) { xcd_barrier(bar); ph_dn_prep2(c, p, A_DNX + WS_ACT); } } SEAM(3);
    if (IN(4)) { if (c.bid < 32) ph_dn_scan2(c, p); else { for (int u = c.bid - 32; u < 256; u += c.G - 32) attn_unit(c, p, u); __syncthreads(); ph_convert(c, a.t2, (c.bid - 32) * NWAVES + c.wave, (c.G - 32) * NWAVES); } if (DUP(4)) { xcd_barrier(bar); if (c.bid < 32) ph_dn_scan2(c, p); else { for (int u = c.bid - 32; u < 256; u += c.G - 32) attn_unit(c, p, u); __syncthreads(); ph_convert(c, a.t2, (c.bid - 32) * NWAVES + c.wave, (c.G - 32) * NWAVES); } } if (DUP(20)) { xcd_barrier(bar); if (c.bid < 32) ph_dn_scan2(c, p); } } SEAM(4);
    if (IN(5)) { ph_gemm<G_ABOUT>(c, p); if (DUP(5)) { xcd_barrier(bar); ph_gemm<G_ABOUT>(c, p); } } SEAM(5);
    if (IN(6)) { ph_norm<1>(c, p); if (DUP(6)) { xcd_barrier(bar); ph_norm<1>(c, p); } } SEAM(6);
    if (IN(7)) { ph_gemm<G_FFNGU>(c, p); if (DUP(7)) { xcd_barrier(bar); ph_gemm<G_FFNGU>(c, p); } } SEAM(7);
    if (IN(8)) { if (DUP(8)) { ph_gemm<G_FFND_PROBE>(c, p); xcd_barrier(bar); } ph_gemm<G_FFND>(c, p); } SEAM(8);
    if (IN(9)) { ph_norm<2>(c, p); if (DUP(9)) { xcd_barrier(bar); ph_norm<2>(c, p); } } SEAM(9);
    if (IN(10)) { ph_gemm<G_CDIN>(c, p); if (DUP(10)) { xcd_barrier(bar); ph_gemm<G_CDIN>(c, p); } } SEAM(10);
    if (IN(11)) { ph_lru1(c, p); ph_sconv(c, p); if (DUP(11)) { xcd_barrier(bar); ph_lru1(c, p); ph_sconv(c, p); } } SEAM(11);
    if (IN(12)) { ph_lru2(c, p); if (DUP(12)) { xcd_barrier(bar); ph_lru2(c, p); } } SEAM(12);
    if (IN(13)) { if (DUP(13)) { ph_gemm<G_CDOUT_PROBE>(c, p); xcd_barrier(bar); } ph_gemm<G_CDOUT>(c, p); } SEAM(13);
    if (IN(14)) { ph_norm<3>(c, p); } SEAM(14);
    if (IN(15)) { ph_route(c, p, 0); if (DUP(15)) { xcd_barrier(bar); ph_route(c, p, 64); } } SEAM(15);
    if (IN(16)) { ph_gemm<G_MOEGU>(c, p); if (DUP(16)) { xcd_barrier(bar); ph_gemm<G_MOEGU>(c, p); } } SEAM(16);
    if (IN(17)) { ph_gemm<G_MOED>(c, p); if (DUP(17)) { xcd_barrier(bar); ph_gemm<G_MOED>(c, p); } } SEAM(17);
    if (IN(18)) { if (DUP(18)) { ph_final<true>(c, p); xcd_barrier(bar); } ph_final<false>(c, p); }
#undef IN
#undef SEAM
}

constexpr int N_PHASES = 19;
static void add_desc(ConvTab& t, const float* src, bf16* dst, int K, int N, int Npad, int mode, int row_off, int nbatch, long long sstride, long long dstride) {
    ConvDesc& d = t.d[t.nd]; d.src = src; d.dst = dst; d.sstride = sstride; d.dstride = dstride; d.K = K; d.N = N; d.Npad = Npad; d.mode = mode; d.row_off = row_off; d.nbatch = nbatch;
    d.items_pb = (K / 64) * (Npad / 64); d.item0 = t.total; t.total += d.items_pb * nbatch; t.nd++;
}
extern "C" void kernel_launch(void* const* d_in, const int* in_sizes, int n_in, void* d_out, int out_size, void* d_ws, size_t ws_size, hipStream_t stream) {
    static int grid = 0;
    if (grid == 0) {
        if (n_in != 33 || out_size != M * D || ws_size < WS_END) { fprintf(stderr, "kernel_launch: unexpected shapes (n_in %d out %d ws %zu)\n", n_in, out_size, ws_size); grid = -1; return; }
        int dev = 0, cus = 0;
        if (hipGetDevice(&dev) != hipSuccess || hipDeviceGetAttribute(&cus, hipDeviceAttributeMultiprocessorCount, dev) != hipSuccess) { grid = -1; return; }
        if (hipFuncSetAttribute((const void*)mega, hipFuncAttributeMaxDynamicSharedMemorySize, LDS_BYTES) != hipSuccess) { fprintf(stderr, "kernel_launch: hipFuncSetAttribute failed\n"); grid = -1; return; }
        int per_cu = 0;
        if (hipOccupancyMaxActiveBlocksPerMultiprocessor(&per_cu, (const void*)mega, NTHR, LDS_BYTES) != hipSuccess || per_cu < 1) { fprintf(stderr, "kernel_launch: occupancy query says %d\n", per_cu); }
        (void)hipGetLastError();
        grid = cus;
    }
    if (grid < 0) return;
    MArgs a{};
    for (int i = 0; i < 33; ++i) a.p.in[i] = (const float*)d_in[i];
    a.p.out = (float*)d_out; a.p.ws = (unsigned char*)d_ws;
    unsigned char* ws = a.p.ws; const Params& p = a.p;
    (void)hipMemsetAsync(ws + WS_CTL, 0, CTL_ZERO_BYTES, stream);
    add_desc(a.t1, p.in[I_ABIN], (bf16*)(ws + WS_WAB_IN), D, 2832, NAB, 0, 0, 1, 0, 0);
    add_desc(a.t1, p.in[I_ABOUT], (bf16*)(ws + WS_WAB_OUT), D, D, D, 0, 0, 1, 0, 0);
    add_desc(a.t1, p.in[I_FG], (bf16*)(ws + WS_WFFN_GU), D, FF, FF, 1, 0, 1, 0, 0);
    add_desc(a.t1, p.in[I_FU], (bf16*)(ws + WS_WFFN_GU), D, FF, FF, 1, 128, 1, 0, 0);
    add_desc(a.t1, p.in[I_FD], (bf16*)(ws + WS_WFFN_D), FF, D, D, 0, 0, 1, 0, 0);
    add_desc(a.t1, p.in[I_CDIN], (bf16*)(ws + WS_WCD_IN), D, NCD, NCD, 0, 0, 1, 0, 0);
    add_desc(a.t1, p.in[I_CDOUT], (bf16*)(ws + WS_WCD_OUT), CDO, D, D, 0, 0, 1, 0, 0);
    add_desc(a.t1, p.in[I_GAW], (bf16*)(ws + WS_WLRU), 128, 128, 128, 0, 0, 8, 128 * 128, 256 * 128);
    add_desc(a.t1, p.in[I_GXW], (bf16*)(ws + WS_WLRU), 128, 128, 128, 0, 128, 8, 128 * 128, 256 * 128);
    add_desc(a.t2, p.in[I_MG], (bf16*)(ws + WS_WMOE_GU), D, FFE, FFE, 3, 0, NE, (long long)D * FFE, (long long)FFE * D);
    add_desc(a.t2, p.in[I_MU], (bf16*)(ws + WS_WMOE_GU), D, FFE, FFE, 3, 128, NE, (long long)D * FFE, (long long)FFE * D);
    add_desc(a.t2, p.in[I_MD], (bf16*)(ws + WS_WMOE_D), FFE, D, D, 2, 0, NE, (long long)FFE * D, (long long)D * FFE / 2);
    a.ph_lo = 0; a.ph_hi = N_PHASES;
    hipLaunchKernelGGL(mega, dim3(grid), dim3(NTHR), LDS_BYTES, stream, a);
}
```
